# Optimizing an MI355X kernel written in HIP

```python
import math
import jax, jax.numpy as jnp
from jax import lax
import numpy as np


D_MODEL = 1024
BATCH = 16
SEQ = 2048
DEPTH = 4

POOL_GROUPS = 4
POOL_GROUP_CH = D_MODEL // 8
POOL_WIDTH = POOL_GROUPS * POOL_GROUP_CH
POOL_WINDOWS = (2, 4, 8, 16)
N_Q_HEADS = 8
N_KV_HEADS = 2
GQA_GROUP = N_Q_HEADS // N_KV_HEADS
HEAD_DIM = 64
Q_WIDTH = N_Q_HEADS * HEAD_DIM
KV_WIDTH = N_KV_HEADS * HEAD_DIM
WINDOW = 128
ATT_BLOCK = 128
D_IN = POOL_WIDTH + Q_WIDTH + 2 * KV_WIDTH + 2 * D_MODEL
V_START = POOL_WIDTH + Q_WIDTH + KV_WIDTH
V_END = V_START + KV_WIDTH
SPLIT_POINTS = (POOL_WIDTH, POOL_WIDTH + Q_WIDTH, POOL_WIDTH + Q_WIDTH + KV_WIDTH, V_END, V_END + D_MODEL)
N_EXPERTS = 64
EXPERT_FF = D_MODEL // 4
TOP_K = 8
N_EXPERT_GROUPS = 8
EXPERTS_PER_GROUP = N_EXPERTS // N_EXPERT_GROUPS
TOPK_GROUPS = 4
ROUTED_SCALE = 2.5
MOE_BLOCK = 256
ALPHA = (2.0 * DEPTH) ** 0.25
BETA = (8.0 * DEPTH) ** -0.25
LN_EPS = 1e-5

kernel_name = 'hybrid_pool_swa_moe_deepnorm'


def _layer_norm(x, g, b):
    xf = x.astype(jnp.float32)
    mu = xf.mean(-1, keepdims=True)
    var = jnp.square(xf - mu).mean(-1, keepdims=True)
    y = (xf - mu) * lax.rsqrt(var + LN_EPS)
    return (y * g.astype(jnp.float32) + b.astype(jnp.float32)).astype(x.dtype)


def _alibi_slopes():
    return jnp.asarray(2.0 ** (-8.0 * np.arange(1, N_Q_HEADS + 1) / N_Q_HEADS), dtype=jnp.float32)


def _pool_mixer(u, w_pool, pool_scale):
    B, S, _ = u.shape
    c = jnp.cumsum(u.astype(jnp.float32), axis=1)
    c = jnp.concatenate([jnp.zeros((B, 1, POOL_WIDTH), jnp.float32), c], axis=1)
    t1 = jnp.arange(1, S + 1, dtype=jnp.float32)[:, None]
    means = []
    for gi, w in enumerate(POOL_WINDOWS):
        cg = c[:, :, gi * POOL_GROUP_CH:(gi + 1) * POOL_GROUP_CH]
        lo = jnp.concatenate([jnp.zeros((B, w - 1, POOL_GROUP_CH), jnp.float32), cg[:, :S + 1 - w]], axis=1)
        means.append((cg[:, 1:] - lo) / jnp.minimum(t1, float(w)))
    pooled = jnp.stack(means, axis=2)
    ug = u.reshape(B, S, POOL_GROUPS, POOL_GROUP_CH).astype(jnp.float32)
    mixed = jnp.einsum('bsgc,gcd->bsgd', (pooled - ug).astype(u.dtype), w_pool)
    return mixed.reshape(B, S, POOL_WIDTH) * pool_scale


def _sliding_window_attention(q, k, v, sinks):
    B, S = q.shape[0], q.shape[1]
    nb = S // ATT_BLOCK
    qb = q.reshape(B, nb, ATT_BLOCK, N_KV_HEADS, GQA_GROUP, HEAD_DIM)

    def banded(t):
        cur = t.reshape(B, nb, ATT_BLOCK, N_KV_HEADS, HEAD_DIM)
        prev = jnp.concatenate([jnp.zeros_like(cur[:, :1]), cur[:, :-1]], axis=1)
        return jnp.concatenate([prev, cur], axis=2)

    kb, vb = banded(k), banded(v)
    s = jnp.einsum('bnqhgd,bnkhd->bnhgqk', qb, kb).astype(jnp.float32) * (HEAD_DIM ** -0.5)
    qi = jnp.arange(ATT_BLOCK)[:, None]
    kj = jnp.arange(2 * ATT_BLOCK)[None, :]
    dist = ATT_BLOCK + qi - kj
    key_pos = jnp.arange(nb)[:, None, None] * ATT_BLOCK - ATT_BLOCK + kj[None]
    valid = (dist >= 0) & (dist < WINDOW) & (key_pos >= 0)
    slopes = _alibi_slopes().reshape(N_KV_HEADS, GQA_GROUP, 1, 1)
    s = s - slopes * dist.astype(jnp.float32)
    s = jnp.where(valid[None, :, None, None], s, -jnp.inf)
    sink = sinks.astype(jnp.float32).reshape(1, 1, N_KV_HEADS, GQA_GROUP, 1, 1)
    m = jnp.maximum(s.max(-1, keepdims=True), sink)
    p = jnp.exp(s - m)
    denom = p.sum(-1, keepdims=True) + jnp.exp(sink - m)
    o = jnp.einsum('bnhgqk,bnkhd->bnqhgd', (p / denom).astype(v.dtype), vb)
    return o.reshape(B, S, Q_WIDTH)


def _mixer(x, w_in, b_in, w_pool, pool_scale, sinks, w_br_pool, w_br_attn, w_out):
    B, S, _ = x.shape
    h = jnp.einsum('bsd,de->bse', x, w_in) + b_in
    u, q, k, v, g_pool, g_attn = jnp.split(h, list(SPLIT_POINTS), axis=-1)
    y_pool = jnp.einsum('bsp,pd->bsd', _pool_mixer(u, w_pool, pool_scale), w_br_pool)
    o = _sliding_window_attention(q.reshape(B, S, N_Q_HEADS, HEAD_DIM),
                                  k.reshape(B, S, N_KV_HEADS, HEAD_DIM),
                                  v.reshape(B, S, N_KV_HEADS, HEAD_DIM), sinks)
    y_attn = jnp.einsum('bse,ed->bsd', o, w_br_attn)
    merged = jax.nn.sigmoid(g_pool) * y_pool + jax.nn.sigmoid(g_attn) * y_attn
    return jnp.einsum('bsd,de->bse', merged, w_out)


def _swiglu(x, wg, wu, wd):
    return jnp.dot(jax.nn.silu(jnp.dot(x, wg)) * jnp.dot(x, wu), wd)


def _moe(x, w_router, router_bias, w_eg, w_eu, w_ed, w_sg, w_su, w_sd):
    B, S, D = x.shape
    T = B * S
    xt = x.reshape(T, D)
    scores = jax.nn.sigmoid(jnp.dot(xt, w_router).astype(jnp.float32))
    biased = scores + router_bias.astype(jnp.float32)
    grp_score = lax.top_k(biased.reshape(T, N_EXPERT_GROUPS, EXPERTS_PER_GROUP), 2)[0].sum(-1)
    _, top_groups = lax.top_k(grp_score, TOPK_GROUPS)
    grp_keep = jax.nn.one_hot(top_groups, N_EXPERT_GROUPS, dtype=jnp.float32).sum(1) > 0
    expert_keep = jnp.repeat(grp_keep, EXPERTS_PER_GROUP, axis=1)
    _, top_e = lax.top_k(jnp.where(expert_keep, biased, -jnp.inf), TOP_K)
    sel = jnp.take_along_axis(scores, top_e, axis=1)
    gates = sel / sel.sum(-1, keepdims=True) * ROUTED_SCALE
    A = T * TOP_K
    e_flat = top_e.reshape(A).astype(jnp.int32)
    tok_flat = jnp.repeat(jnp.arange(T, dtype=jnp.int32), TOP_K)
    g_flat = gates.reshape(A)
    order = jnp.argsort(e_flat, stable=True)
    e_s, tok_s, g_s = e_flat[order], tok_flat[order], g_flat[order]
    counts = jnp.bincount(e_flat, length=N_EXPERTS)
    starts = jnp.cumsum(counts) - counts
    pcounts = (counts + MOE_BLOCK - 1) // MOE_BLOCK * MOE_BLOCK
    pends = jnp.cumsum(pcounts)
    pstarts = pends - pcounts
    dest = pstarts[e_s] + (jnp.arange(A, dtype=jnp.int32) - starts[e_s])
    n_pad = -(-A // MOE_BLOCK) * MOE_BLOCK + N_EXPERTS * MOE_BLOCK
    n_blocks = n_pad // MOE_BLOCK
    buf_tok = jnp.full((n_pad,), T, jnp.int32).at[dest].set(tok_s)
    buf_gate = jnp.zeros((n_pad,), jnp.float32).at[dest].set(g_s)
    blk_expert = jnp.minimum(jnp.searchsorted(pends, jnp.arange(n_blocks, dtype=jnp.int32) * MOE_BLOCK, side='right'),
                             N_EXPERTS - 1).astype(jnp.int32)
    x_pad = jnp.concatenate([xt, jnp.zeros((1, D), xt.dtype)], axis=0)

    def expert_block(acc, blk):
        tok_b, gate_b, e = blk
        xb = x_pad[tok_b]
        yb = _swiglu(xb, w_eg[e], w_eu[e], w_ed[e]) * gate_b[:, None].astype(xb.dtype)
        return acc.at[tok_b].add(yb), None

    acc, _ = lax.scan(expert_block, jnp.zeros((T + 1, D), x.dtype),
                      (buf_tok.reshape(n_blocks, MOE_BLOCK), buf_gate.reshape(n_blocks, MOE_BLOCK), blk_expert))
    y = acc[:T] + _swiglu(xt, w_sg, w_su, w_sd)
    return y.reshape(B, S, D)


def setup_inputs(seed: int = 0) -> dict:
    key = jax.random.key(seed)
    ks = jax.random.split(key, 24)

    def nrm(k, shape, scale):
        return jax.random.normal(k, shape, jnp.float32) * scale

    col_scale = np.ones((D_IN,), np.float32)
    col_scale[V_START:V_END] = BETA
    return {
        'x': nrm(ks[0], (BATCH, SEQ, D_MODEL), 1.0),
        'ln0_g': 1.0 + nrm(ks[1], (D_MODEL,), 0.02),
        'ln0_b': nrm(ks[2], (D_MODEL,), 0.02),
        'w_in': nrm(ks[3], (DEPTH, D_MODEL, D_IN), D_MODEL ** -0.5) * jnp.asarray(col_scale),
        'b_in': nrm(ks[4], (DEPTH, D_IN), 0.02),
        'w_pool': nrm(ks[5], (DEPTH, POOL_GROUPS, POOL_GROUP_CH, POOL_GROUP_CH), POOL_GROUP_CH ** -0.5),
        'pool_scale': 1.0 + nrm(ks[6], (DEPTH, POOL_WIDTH), 0.02),
        'attn_sinks': nrm(ks[7], (DEPTH, N_Q_HEADS), 0.5),
        'w_br_pool': nrm(ks[8], (DEPTH, POOL_WIDTH, D_MODEL), POOL_WIDTH ** -0.5),
        'w_br_attn': nrm(ks[9], (DEPTH, Q_WIDTH, D_MODEL), Q_WIDTH ** -0.5),
        'w_out': nrm(ks[10], (DEPTH, D_MODEL, D_MODEL), D_MODEL ** -0.5 * BETA),
        'ln1_g': 1.0 + nrm(ks[11], (DEPTH, D_MODEL), 0.02),
        'ln1_b': nrm(ks[12], (DEPTH, D_MODEL), 0.02),
        'w_router': nrm(ks[13], (DEPTH, D_MODEL, N_EXPERTS), D_MODEL ** -0.5),
        'router_bias': nrm(ks[14], (DEPTH, N_EXPERTS), 0.01),
        'w_exp_gate': nrm(ks[15], (DEPTH, N_EXPERTS, D_MODEL, EXPERT_FF), D_MODEL ** -0.5),
        'w_exp_up': nrm(ks[16], (DEPTH, N_EXPERTS, D_MODEL, EXPERT_FF), D_MODEL ** -0.5),
        'w_exp_down': nrm(ks[17], (DEPTH, N_EXPERTS, EXPERT_FF, D_MODEL), EXPERT_FF ** -0.5 * BETA),
        'w_sh_gate': nrm(ks[18], (DEPTH, D_MODEL, EXPERT_FF), D_MODEL ** -0.5),
        'w_sh_up': nrm(ks[19], (DEPTH, D_MODEL, EXPERT_FF), D_MODEL ** -0.5),
        'w_sh_down': nrm(ks[20], (DEPTH, EXPERT_FF, D_MODEL), EXPERT_FF ** -0.5 * BETA),
        'ln2_g': 1.0 + nrm(ks[21], (DEPTH, D_MODEL), 0.02),
        'ln2_b': nrm(ks[22], (DEPTH, D_MODEL), 0.02),
    }


def reference(x, ln0_g, ln0_b, w_in, b_in, w_pool, pool_scale, attn_sinks, w_br_pool, w_br_attn, w_out,
              ln1_g, ln1_b, w_router, router_bias, w_exp_gate, w_exp_up, w_exp_down,
              w_sh_gate, w_sh_up, w_sh_down, ln2_g, ln2_b):
    x = _layer_norm(x, ln0_g, ln0_b)
    for l in range(DEPTH):
        mix = _mixer(x, w_in[l], b_in[l], w_pool[l], pool_scale[l], attn_sinks[l],
                     w_br_pool[l], w_br_attn[l], w_out[l])
        x = _layer_norm(ALPHA * x + mix, ln1_g[l], ln1_b[l])
        ffn = _moe(x, w_router[l], router_bias[l], w_exp_gate[l], w_exp_up[l], w_exp_down[l],
                   w_sh_gate[l], w_sh_up[l], w_sh_down[l])
        x = _layer_norm(ALPHA * x + ffn, ln2_g[l], ln2_b[l])
    return x
```

```cpp
#include <hip/hip_runtime.h>
#include <stdint.h>
#include <stdio.h>

#ifndef MK_ONE_LAUNCH
#define MK_ONE_LAUNCH 1
#endif

#define GAS __attribute__((address_space(1)))
#define LAS __attribute__((address_space(3)))
typedef unsigned short h16;
typedef short h16x8 __attribute__((ext_vector_type(8)));
typedef float f32x4 __attribute__((ext_vector_type(4)));
typedef float f32x2 __attribute__((ext_vector_type(2)));
typedef unsigned u32x4 __attribute__((ext_vector_type(4)));
typedef unsigned u32x2 __attribute__((ext_vector_type(2)));

constexpr int NB = 16, SEQ = 2048, T = NB * SEQ, D = 1024, DIN = 3328, DEPTH = 4;
constexpr int C_U = 0, C_Q = 512, C_K = 1024, C_V = 1152, C_GP = 1280, C_GA = 2304;
constexpr int NE = 64, FF = 256, TOPK = 8;
constexpr int NASSIGN = T * TOPK;
constexpr int NBLK_MAX = NASSIGN / 256 + NE;
constexpr int A_PAD = NBLK_MAX * 256;
constexpr float ALPHA = 1.6817928305074290f;
constexpr float LN_EPS = 1e-5f;
constexpr int NPH = 12;

constexpr size_t MiB = 1u << 20;
constexpr size_t WS_CTL = 0, CTL_ZERO_BYTES = 1 * MiB;
constexpr size_t WS_W = 1 * MiB;
constexpr size_t W_IN_T = WS_W + 0 * MiB;
constexpr size_t W_PE_T = WS_W + 7 * MiB;
constexpr size_t W_BA_T = WS_W + 8 * MiB;
constexpr size_t W_OUT_T = WS_W + 9 * MiB;
constexpr size_t W_R_T = WS_W + 11 * MiB;
constexpr size_t W_SGU_T = WS_W + 12 * MiB;
constexpr size_t W_SD_T = WS_W + 13 * MiB;
constexpr size_t W_EGU_T = WS_W + 14 * MiB;
constexpr size_t W_ED_T = WS_W + 78 * MiB;
constexpr size_t WS_XB = 111 * MiB;
constexpr size_t WS_HB = 175 * MiB;
constexpr size_t WS_HS = 311 * MiB;
constexpr size_t WS_MISC = 327 * MiB;
constexpr size_t MS_LOGIT = WS_MISC;
constexpr size_t MS_ESEL = WS_MISC + 8 * MiB;
constexpr size_t MS_GATE = WS_MISC + 9 * MiB;
constexpr size_t MS_RANK = WS_MISC + 10 * MiB;
constexpr size_t MS_SLOT = WS_MISC + 11 * MiB;
constexpr size_t MS_TOKL = WS_MISC + 12 * MiB;
constexpr size_t MS_GATL = WS_MISC + 13 * MiB + 256 * 1024;
constexpr size_t MS_WCNT = WS_MISC + 14 * MiB + 512 * 1024;
constexpr size_t MS_GTOT = WS_MISC + 15 * MiB;
constexpr size_t MS_BLKE = WS_MISC + 15 * MiB + 256 * 1024;
constexpr size_t WS_R = 343 * MiB;
constexpr size_t R_HH = WS_R;
constexpr size_t R_PD = WS_R + 208 * MiB;
constexpr size_t R_MG = WS_R + 240 * MiB;
constexpr size_t WS_END = WS_R + 544 * MiB;
static_assert((size_t)A_PAD * 4 <= 1 * MiB + 256 * 1024, "toklist");
static_assert((size_t)A_PAD * 256 * 2 <= 136 * MiB, "Hbuf");
static_assert((size_t)A_PAD * 1024 * 2 <= 544 * MiB, "Yd");

constexpr int CW_BAR = 4096;

constexpr int RING_BYTES = 131072;
constexpr int LDSCTL_OFF = RING_BYTES, MISC_OFF = LDSCTL_OFF + 320;
constexpr int LDS_BYTES = 147456;

#define RLX_AGENT __ATOMIC_RELAXED, __HIP_MEMORY_SCOPE_AGENT
typedef _Float16 f16x2 __attribute__((ext_vector_type(2)));
typedef _Float16 f16x8 __attribute__((ext_vector_type(8)));
__device__ __forceinline__ float h2f(unsigned short h) { return (float)__builtin_bit_cast(_Float16, h); }
__device__ __forceinline__ unsigned short f2h(float f) { return __builtin_bit_cast(unsigned short, (_Float16)f); }
__device__ __forceinline__ unsigned cvt_pk_h16(float lo, float hi) { f32x2 v = {lo, hi}; return __builtin_bit_cast(unsigned, __builtin_convertvector(v, f16x2)); }
__device__ __forceinline__ float lo16(unsigned w) { return (float)__builtin_bit_cast(f16x2, w)[0]; }
__device__ __forceinline__ float hi16(unsigned w) { return (float)__builtin_bit_cast(f16x2, w)[1]; }
__device__ __forceinline__ float sigmoidf_(float x) { return __builtin_amdgcn_rcpf(1.0f + __builtin_amdgcn_exp2f(-1.4426950408889634f * x)); }
__device__ __forceinline__ float wave_sum(float v) {
#pragma unroll
    for (int o = 1; o < 64; o <<= 1) v += __shfl_xor(v, o);
    return v;
}
__device__ __forceinline__ float wave_max(float v) {
#pragma unroll
    for (int o = 1; o < 64; o <<= 1) v = fmaxf(v, __shfl_xor(v, o));
    return v;
}

#define XB_TMO      128
#define XB_XCNT(j)  (256  + 64 * (j))
#define XB_XSUB(j)  (1280 + 64 * (j))
#define XB_XGEN(j)  (2304 + 64 * (j))
#define XB_TOP      3328
#define XB_TOPGEN   3392
#define XCD_BAR_WORDS 3456
#define XB_SPIN_CAP (1u << 18)
__device__ __forceinline__ unsigned xb_ld(unsigned* p)              { return __hip_atomic_load(p, __ATOMIC_RELAXED, __HIP_MEMORY_SCOPE_AGENT); }
__device__ __forceinline__ unsigned xb_add(unsigned* p, unsigned v) { return __hip_atomic_fetch_add(p, v, __ATOMIC_RELAXED, __HIP_MEMORY_SCOPE_AGENT); }
__device__ __forceinline__ unsigned xb_xcc_id() { return (unsigned)__builtin_amdgcn_s_getreg((3 << 11) | 20) & 0xFu; }
#define XB_SPIN(cond, bar) do { unsigned _sp = 0; while (cond) { __builtin_amdgcn_s_sleep(1); \
    if ((++_sp & 255u) == 0u) { if (xb_ld(&(bar)[XB_TMO])) break; if (_sp > XB_SPIN_CAP) { atomicAdd(&(bar)[XB_TMO], 1u); break; } } } } while (0)
struct XcdBarrier { unsigned* bar; unsigned x; volatile LAS unsigned* st; };
__device__ __forceinline__ XcdBarrier xcd_barrier_post(unsigned* bar, volatile LAS unsigned* st) {
    XcdBarrier b; b.bar = bar; b.x = xb_xcc_id(); b.st = st;
    if (threadIdx.x == 0) (void)xb_add(&bar[XB_XCNT(b.x)], 1u);
    return b;
}
__device__ __forceinline__ void xcd_barrier_complete(unsigned* bar, unsigned x, unsigned& nloc, unsigned& nx) {
    const unsigned G = gridDim.x * gridDim.y * gridDim.z;
    unsigned sum, cnt, mine, sp = 0u;
    for (;;) {
        sum = 0u; cnt = 0u; mine = 0u;
#pragma unroll
        for (unsigned j = 0; j < 16; ++j) { const unsigned c = xb_ld(&bar[XB_XCNT(j)]); sum += c; cnt += (c > 0u) ? 1u : 0u; mine = (j == x) ? c : mine; }
        if (sum == G) break;
        __builtin_amdgcn_s_sleep(1);
        if ((++sp & 255u) == 0u) { if (xb_ld(&bar[XB_TMO])) break; if (sp > XB_SPIN_CAP) { atomicAdd(&bar[XB_TMO], 1u); break; } }
    }
    nloc = mine > 0u ? mine : 1u; nx = cnt > 0u ? cnt : 1u;
}
__device__ __forceinline__ void xcd_barrier(const XcdBarrier& b) {
    asm volatile("s_waitcnt vmcnt(0)" ::: "memory");
    __syncthreads();
    if (threadIdx.x == 0) {
        unsigned* bar = b.bar;
        __builtin_amdgcn_s_waitcnt(0);
        unsigned nloc = b.st[0], nx = b.st[1];
        if (nloc == 0u) { xcd_barrier_complete(bar, b.x, nloc, nx); b.st[0] = nloc; b.st[1] = nx; }
        const unsigned old = xb_add(&bar[XB_XSUB(b.x)], 1u);
        const unsigned gen = old / nloc;
        if (old + 1u == (gen + 1u) * nloc) {
            __builtin_amdgcn_fence(__ATOMIC_RELEASE, "agent");
            asm volatile("s_waitcnt vmcnt(0)" ::: "memory");
            const unsigned og = xb_add(&bar[XB_TOP], 1u);
            const unsigned tg = og / nx;
            if (og + 1u == (tg + 1u) * nx) xb_add(&bar[XB_TOPGEN], 1u);
            else XB_SPIN(xb_ld(&bar[XB_TOPGEN]) == tg, bar);
            __builtin_amdgcn_fence(__ATOMIC_ACQUIRE, "agent");
            xb_add(&bar[XB_XGEN(b.x)], 1u);
            asm volatile("s_waitcnt vmcnt(0)" ::: "memory");
        } else {
            XB_SPIN(xb_ld(&bar[XB_XGEN(b.x)]) == gen, bar);
            __builtin_amdgcn_fence(__ATOMIC_ACQUIRE, "agent");
            asm volatile("s_waitcnt vmcnt(0)" ::: "memory");
        }
    }
    __syncthreads();
}

struct Unit {
    const char* a;
    const char* b;
    const int* ridx;
    unsigned apitch, bpitch;
    int row0;
    int col0;
    int kind;
};
#define ACC_T f32x4 (&acc)[2][2][4][2]

template <class Epi, class Sched>
__device__ __forceinline__ void gemm_phase_simple(const int K, const Sched& S, const Epi& E) {
    int tid = threadIdx.x; asm volatile("" : "+v"(tid));
    const int wid = __builtin_amdgcn_readfirstlane(tid >> 6), lane = tid & 63, wr = wid >> 2, wc = wid & 3, fr = lane & 15, fq = lane >> 4;
    Unit u;
    for (int i = 0; S.next(i, u); ++i) {
        f32x4 acc[2][2][4][2];
#pragma unroll
        for (int a = 0; a < 2; ++a)
#pragma unroll
            for (int b = 0; b < 2; ++b)
#pragma unroll
                for (int m = 0; m < 4; ++m)
#pragma unroll
                    for (int n = 0; n < 2; ++n) acc[a][b][m][n] = (f32x4){0.f, 0.f, 0.f, 0.f};
        unsigned offA[2][4], offB[2][2];
#pragma unroll
        for (int ai = 0; ai < 2; ++ai)
#pragma unroll
            for (int m = 0; m < 4; ++m) { const int r = 128 * ai + 64 * wr + 16 * m + fr; const int row = u.ridx ? u.ridx[r] : u.row0 + r; offA[ai][m] = (unsigned)row * u.apitch + (unsigned)fq * 16u; }
#pragma unroll
        for (int bj = 0; bj < 2; ++bj)
#pragma unroll
            for (int n = 0; n < 2; ++n) { const int wrow = 128 * bj + 32 * wc + 8 * (fr >> 2) + 4 * n + (fr & 3); offB[bj][n] = (unsigned)wrow * u.bpitch + (unsigned)fq * 16u; }
#pragma unroll 1
        for (int k0 = 0; k0 < K; k0 += 32) {
            h16x8 b[2][2];
#pragma unroll
            for (int bj = 0; bj < 2; ++bj)
#pragma unroll
                for (int n = 0; n < 2; ++n) b[bj][n] = *(const h16x8*)(u.b + offB[bj][n] + (size_t)k0 * 2);
#pragma unroll
            for (int ai = 0; ai < 2; ++ai) {
                h16x8 a[4];
#pragma unroll
                for (int m = 0; m < 4; ++m) a[m] = *(const h16x8*)(u.a + offA[ai][m] + (size_t)k0 * 2);
#pragma unroll
                for (int bj = 0; bj < 2; ++bj)
#pragma unroll
                    for (int m = 0; m < 4; ++m)
#pragma unroll
                        for (int n = 0; n < 2; ++n) acc[ai][bj][m][n] = __builtin_amdgcn_mfma_f32_16x16x32_f16(__builtin_bit_cast(f16x8, b[bj][n]), __builtin_bit_cast(f16x8, a[m]), acc[ai][bj][m][n], 0, 0, 0);
                asm volatile("" ::: "memory");
            }
        }
        E(acc, u, wr, wc, fr, fq);
    }
}

constexpr int NXCD = 8, WGM = 8;
struct TileOrder {
    int nM, nN, nwg, G, c;
    __device__ void init(int M, int N, int G_, int c_) { nM = M / 256; nN = N / 256; nwg = nM * nN; G = G_; c = c_; }
    __device__ bool tile(int i, int& pm, int& pn) const {
        const long L = (long)i * G + c; if (L >= nwg) return false;
        int wgid = (int)L; { const int q = nwg / NXCD, r = nwg % NXCD, xcd = wgid % NXCD, off = wgid / NXCD; wgid = (xcd < r ? xcd * (q + 1) : r * (q + 1) + (xcd - r) * q) + off; }
        const int nig = WGM * nN, gid = wgid / nig, fm = gid * WGM, gsz = (nM - fm) < WGM ? (nM - fm) : WGM;
        pm = fm + ((wgid % nig) % gsz); pn = (wgid % nig) / gsz; return true;
    }
};
struct SchedDense {
    TileOrder o; const char* a; const char* b; unsigned apitch, bpitch;
    __device__ bool next(int i, Unit& u) const {
        int pm, pn; if (!o.tile(i, pm, pn)) return false;
        u.a = a; u.b = b + (size_t)pn * 256 * bpitch; u.ridx = nullptr; u.apitch = apitch; u.bpitch = bpitch; u.row0 = pm * 256; u.col0 = pn * 256; u.kind = 0; return true;
    }
};
struct SchedMerged {
    TileOrder o; const char* pd; const char* oo; const char* wpe; const char* wba;
    __device__ bool next(int i, Unit& u) const {
        int pm, pn; if (!o.tile(i >> 1, pm, pn)) return false;
        const int part = i & 1;
        u.a = part ? oo : pd; u.apitch = part ? DIN * 2 : 512 * 2; u.b = (part ? wba : wpe) + (size_t)pn * 256 * 1024; u.bpitch = 1024; u.ridx = nullptr; u.row0 = pm * 256; u.col0 = pn * 256; u.kind = part; return true;
    }
};
struct SchedSharedRouter {
    int G, c; const char* xb; const char* wsgu; const char* wr;
    __device__ bool next(int i, Unit& u) const {
        const int L = i * G + c; if (L >= 384) return false;
        u.a = xb; u.apitch = 2048; u.bpitch = 2048; u.ridx = nullptr;
        if (L < 256) { const int pm = L >> 1, pn = L & 1; u.b = wsgu + (size_t)pn * 256 * 2048; u.row0 = pm * 256; u.col0 = pn * 128; u.kind = 0; }
        else { const int pm = L - 256; u.b = wr; u.row0 = pm * 256; u.col0 = 0; u.kind = 1; }
        return true;
    }
};
struct SchedMoeGU {
    int G, c, nblk; const char* xb; const char* wegu; const int* blke; const int* tokl;
    __device__ bool next(int i, Unit& u) const {
        const int L = i * G + c; if (L >= 2 * nblk) return false;
        const int rb = L >> 1, pn = L & 1, e = __builtin_amdgcn_readfirstlane(blke[rb]);
        u.a = xb; u.apitch = 2048; u.bpitch = 2048; u.b = wegu + ((size_t)e * 512 + pn * 256) * 2048; u.ridx = tokl + rb * 256; u.row0 = rb * 256; u.col0 = pn * 128; u.kind = 0; return true;
    }
};
struct SchedMoeDown {
    int G, c, nblk; const char* hb; const char* hs; const char* wed; const char* wsd; const int* blke;
    __device__ bool next(int i, Unit& u) const {
        const int L = i * G + c; if (L >= 4 * nblk + 512) return false;
        u.apitch = 512; u.bpitch = 512; u.ridx = nullptr;
        if (L < 4 * nblk) { const int rb = L >> 2, pn = L & 3, e = __builtin_amdgcn_readfirstlane(blke[rb]); u.a = hb; u.b = wed + ((size_t)e * 1024 + pn * 256) * 512; u.row0 = rb * 256; u.col0 = pn * 256; u.kind = 0; }
        else { const int L2 = L - 4 * nblk, pm = L2 >> 2, pn = L2 & 3; u.a = hs; u.b = wsd + (size_t)pn * 256 * 512; u.row0 = pm * 256; u.col0 = pn * 256; u.kind = 1; }
        return true;
    }
};

__device__ __forceinline__ u32x4 pack8(const f32x4& v0, const f32x4& v1) { u32x4 w; w.x = cvt_pk_h16(v0[0], v0[1]); w.y = cvt_pk_h16(v0[2], v0[3]); w.z = cvt_pk_h16(v1[0], v1[1]); w.w = cvt_pk_h16(v1[2], v1[3]); return w; }
__device__ __forceinline__ void unpack8(const u32x4& w, f32x4& v0, f32x4& v1) { v0 = (f32x4){lo16(w.x), hi16(w.x), lo16(w.y), hi16(w.y)}; v1 = (f32x4){lo16(w.z), hi16(w.z), lo16(w.w), hi16(w.w)}; }
__device__ __forceinline__ f32x4 sig4(const f32x4& v) { return (f32x4){sigmoidf_(v[0]), sigmoidf_(v[1]), sigmoidf_(v[2]), sigmoidf_(v[3])}; }
__device__ __forceinline__ f32x4 swiglu4(const f32x4& g, const f32x4& u) { return (f32x4){g[0] * sigmoidf_(g[0]) * u[0], g[1] * sigmoidf_(g[1]) * u[1], g[2] * sigmoidf_(g[2]) * u[2], g[3] * sigmoidf_(g[3]) * u[3]}; }

struct EpiInProj {
    h16* H; const float* bias;
    __device__ __forceinline__ void operator()(const ACC_T, const Unit& u, int wr, int wc, int fr, int fq) const {
        const int pn = u.col0 >> 8; const float sc = (pn == 2 || pn == 3) ? 0.125f : 1.f; const bool sg = pn >= 5;
        f32x4 bv[2][2];
#pragma unroll
        for (int bj = 0; bj < 2; ++bj)
#pragma unroll
            for (int n = 0; n < 2; ++n) bv[bj][n] = *(const f32x4*)(bias + u.col0 + 128 * bj + 32 * wc + 8 * fq + 4 * n);
#pragma unroll
        for (int ai = 0; ai < 2; ++ai)
#pragma unroll
            for (int m = 0; m < 4; ++m) { const int row = u.row0 + 128 * ai + 64 * wr + 16 * m + fr; h16* rowp = H + (size_t)row * DIN + u.col0 + 32 * wc + 8 * fq;
#pragma unroll
                for (int bj = 0; bj < 2; ++bj) { f32x4 v0 = (acc[ai][bj][m][0] + bv[bj][0]) * sc, v1 = (acc[ai][bj][m][1] + bv[bj][1]) * sc;
                    if (sg) { v0 = sig4(v0); v1 = sig4(v1); }
                    *(u32x4*)(rowp + 128 * bj) = pack8(v0, v1); } }
    }
};
struct EpiMerged {
    h16* MG; const h16* H;
    __device__ __forceinline__ void operator()(const ACC_T, const Unit& u, int wr, int wc, int fr, int fq) const {
        const int goff = u.kind ? C_GA : C_GP;
#pragma unroll
        for (int ai = 0; ai < 2; ++ai)
#pragma unroll
            for (int m = 0; m < 4; ++m) { const int row = u.row0 + 128 * ai + 64 * wr + 16 * m + fr; const int col = u.col0 + 32 * wc + 8 * fq;
#pragma unroll
                for (int bj = 0; bj < 2; ++bj) { const u32x4 gw = *(const u32x4*)(H + (size_t)row * DIN + goff + col + 128 * bj); f32x4 g0, g1; unpack8(gw, g0, g1);
                    f32x4 v0 = acc[ai][bj][m][0] * g0, v1 = acc[ai][bj][m][1] * g1; h16* mp = MG + (size_t)row * D + col + 128 * bj;
                    if (u.kind) { const u32x4 pw = *(const u32x4*)mp; f32x4 p0, p1; unpack8(pw, p0, p1); v0 += p0; v1 += p1; }
                    *(u32x4*)mp = pack8(v0, v1); } }
    }
};
struct EpiResid {
    float* X;
    __device__ __forceinline__ void operator()(const ACC_T, const Unit& u, int wr, int wc, int fr, int fq) const {
#pragma unroll
        for (int ai = 0; ai < 2; ++ai)
#pragma unroll
            for (int m = 0; m < 4; ++m) { const int row = u.row0 + 128 * ai + 64 * wr + 16 * m + fr; float* xp = X + (size_t)row * D + u.col0 + 32 * wc + 8 * fq;
#pragma unroll
                for (int bj = 0; bj < 2; ++bj)
#pragma unroll
                    for (int n = 0; n < 2; ++n) { f32x4* p = (f32x4*)(xp + 128 * bj + 4 * n); *p = *p * ALPHA + acc[ai][bj][m][n]; } }
    }
};
struct EpiSharedRouter {
    h16* HS; float* LG;
    __device__ __forceinline__ void operator()(const ACC_T, const Unit& u, int wr, int wc, int fr, int fq) const {
#pragma unroll
        for (int ai = 0; ai < 2; ++ai)
#pragma unroll
            for (int m = 0; m < 4; ++m) { const int row = u.row0 + 128 * ai + 64 * wr + 16 * m + fr;
                if (u.kind == 0) { *(u32x4*)(HS + (size_t)row * FF + u.col0 + 32 * wc + 8 * fq) = pack8(swiglu4(acc[ai][0][m][0], acc[ai][1][m][0]), swiglu4(acc[ai][0][m][1], acc[ai][1][m][1])); }
                else if (wc < 2) {
#pragma unroll
                    for (int n = 0; n < 2; ++n) *(f32x4*)(LG + (size_t)row * NE + 32 * wc + 8 * fq + 4 * n) = acc[ai][0][m][n] + acc[ai][1][m][n]; } }
    }
};
struct EpiMoeGU {
    h16* HB; const float* gatl;
    __device__ __forceinline__ void operator()(const ACC_T, const Unit& u, int wr, int wc, int fr, int fq) const {
#pragma unroll
        for (int ai = 0; ai < 2; ++ai)
#pragma unroll
            for (int m = 0; m < 4; ++m) { const int row = u.row0 + 128 * ai + 64 * wr + 16 * m + fr; const float g = gatl[row];
                *(u32x4*)(HB + (size_t)row * FF + u.col0 + 32 * wc + 8 * fq) = pack8(swiglu4(acc[ai][0][m][0], acc[ai][1][m][0]) * g, swiglu4(acc[ai][0][m][1], acc[ai][1][m][1]) * g); }
    }
};
struct EpiMoeDown {
    h16* YD; float* X;
    __device__ __forceinline__ void operator()(const ACC_T, const Unit& u, int wr, int wc, int fr, int fq) const {
        if (u.kind) { EpiResid r{X}; r(acc, u, wr, wc, fr, fq); return; }
#pragma unroll
        for (int ai = 0; ai < 2; ++ai)
#pragma unroll
            for (int m = 0; m < 4; ++m) { const int row = u.row0 + 128 * ai + 64 * wr + 16 * m + fr; h16* yp = YD + (size_t)row * D + u.col0 + 32 * wc + 8 * fq;
#pragma unroll
                for (int bj = 0; bj < 2; ++bj) *(u32x4*)(yp + 128 * bj) = pack8(acc[ai][bj][m][0], acc[ai][bj][m][1]); }
    }
};

struct Args { const float* in[23]; float* out; unsigned char* ws; int ph_lo, ph_hi; };
struct Frame {
    LAS unsigned char* lds; int tid, lane, wave, vcu, G, gw, NGW;
};

__device__ __forceinline__ void ln_store(f32x4 (&v)[4], const float* gam, const float* bet, float* o32, h16* o16, int lane) {
    float s = 0.f;
#pragma unroll
    for (int j = 0; j < 4; ++j) s += (v[j].x + v[j].y) + (v[j].z + v[j].w);
    const float mean = wave_sum(s) * (1.f / D); float s2 = 0.f;
#pragma unroll
    for (int j = 0; j < 4; ++j) { v[j] = v[j] - mean; s2 += (v[j].x * v[j].x + v[j].y * v[j].y) + (v[j].z * v[j].z + v[j].w * v[j].w); }
    const float rstd = 1.f / sqrtf(wave_sum(s2) * (1.f / D) + LN_EPS);
#pragma unroll
    for (int j = 0; j < 4; ++j) { const f32x4 g = *(const f32x4*)(gam + 4 * lane + 256 * j), b = *(const f32x4*)(bet + 4 * lane + 256 * j); const f32x4 y = v[j] * rstd * g + b;
        *(f32x4*)(o32 + 4 * lane + 256 * j) = y; u32x2 w; w.x = cvt_pk_h16(y[0], y[1]); w.y = cvt_pk_h16(y[2], y[3]); *(u32x2*)(o16 + 4 * lane + 256 * j) = w; }
}

__device__ __forceinline__ void tr_item(const float* W, int N, h16* WT, int ldt, int k0, int n0, int drow0, LAS float* scr, int lane) {
#pragma unroll 8
    for (int i = 0; i < 32; ++i) { const int kk = 2 * i + (lane >> 5); scr[kk * 33 + (lane & 31)] = W[(size_t)(k0 + kk) * N + n0 + (lane & 31)]; }
    asm volatile("s_waitcnt lgkmcnt(0)" ::: "memory");
    const int c = lane & 7;
#pragma unroll
    for (int j = 0; j < 4; ++j) { const int n = (lane >> 3) + 8 * j; const LAS float* s = scr + (8 * c) * 33 + n;
        u32x4 o; o.x = cvt_pk_h16(s[0 * 33], s[1 * 33]); o.y = cvt_pk_h16(s[2 * 33], s[3 * 33]); o.z = cvt_pk_h16(s[4 * 33], s[5 * 33]); o.w = cvt_pk_h16(s[6 * 33], s[7 * 33]);
        *(u32x4*)(WT + (size_t)(drow0 + n) * ldt + k0 + 8 * c) = o; }
    asm volatile("s_waitcnt lgkmcnt(0)" ::: "memory");
}
__device__ __forceinline__ void tr_item_hilo(const float* W, int N, h16* WT, int ldt, int k0, int n0, LAS float* scr, int lane) {
#pragma unroll 8
    for (int i = 0; i < 32; ++i) { const int kk = 2 * i + (lane >> 5); scr[kk * 33 + (lane & 31)] = W[(size_t)(k0 + kk) * N + n0 + (lane & 31)]; }
    asm volatile("s_waitcnt lgkmcnt(0)" ::: "memory");
    const int c = lane & 7;
#pragma unroll
    for (int j = 0; j < 4; ++j) { const int n = (lane >> 3) + 8 * j; const LAS float* s = scr + (8 * c) * 33 + n;
        float v[8], r[8];
#pragma unroll
        for (int q = 0; q < 8; ++q) { v[q] = s[q * 33]; r[q] = v[q] - h2f(f2h(v[q])); }
        u32x4 o; o.x = cvt_pk_h16(v[0], v[1]); o.y = cvt_pk_h16(v[2], v[3]); o.z = cvt_pk_h16(v[4], v[5]); o.w = cvt_pk_h16(v[6], v[7]);
        *(u32x4*)(WT + (size_t)(n0 + n) * ldt + k0 + 8 * c) = o;
        o.x = cvt_pk_h16(r[0], r[1]); o.y = cvt_pk_h16(r[2], r[3]); o.z = cvt_pk_h16(r[4], r[5]); o.w = cvt_pk_h16(r[6], r[7]);
        *(u32x4*)(WT + (size_t)(128 + n0 + n) * ldt + k0 + 8 * c) = o; }
    asm volatile("s_waitcnt lgkmcnt(0)" ::: "memory");
}

#define X32   (args.out)
#define XB    ((h16*)(args.ws + WS_XB))
#define HH    ((h16*)(args.ws + R_HH))
#define PD    ((h16*)(args.ws + R_PD))
#define MG    ((h16*)(args.ws + R_MG))
#define HB    ((h16*)(args.ws + WS_HB))
#define HS    ((h16*)(args.ws + WS_HS))
#define YD    ((h16*)(args.ws + WS_R))
#define LOGIT ((float*)(args.ws + MS_LOGIT))
#define ESEL  ((int*)(args.ws + MS_ESEL))
#define GATE  ((float*)(args.ws + MS_GATE))
#define RANKL ((int*)(args.ws + MS_RANK))
#define SLOT  ((int*)(args.ws + MS_SLOT))
#define TOKL  ((int*)(args.ws + MS_TOKL))
#define GATL  ((float*)(args.ws + MS_GATL))
#define WCNT  ((int*)(args.ws + MS_WCNT))
#define GTOT  ((int*)(args.ws + MS_GTOT))
#define BLKE  ((int*)(args.ws + MS_BLKE))
#define L_W_IN   (args.in[3] + (size_t)l * D * DIN)
#define L_B_IN   (args.in[4] + (size_t)l * DIN)
#define L_W_POOL (args.in[5] + (size_t)l * 4 * 128 * 128)
#define L_PSCALE (args.in[6] + (size_t)l * 512)
#define L_SINKS  (args.in[7] + (size_t)l * 8)
#define L_W_BRP  (args.in[8] + (size_t)l * 512 * D)
#define L_W_BRA  (args.in[9] + (size_t)l * 512 * D)
#define L_W_OUT  (args.in[10] + (size_t)l * D * D)
#define L_LN1G   (args.in[11] + (size_t)l * D)
#define L_LN1B   (args.in[12] + (size_t)l * D)
#define L_W_R    (args.in[13] + (size_t)l * D * NE)
#define L_RBIAS  (args.in[14] + (size_t)l * NE)
#define L_W_EG   (args.in[15] + (size_t)l * NE * D * FF)
#define L_W_EU   (args.in[16] + (size_t)l * NE * D * FF)
#define L_W_ED   (args.in[17] + (size_t)l * NE * FF * D)
#define L_W_SG   (args.in[18] + (size_t)l * D * FF)
#define L_W_SU   (args.in[19] + (size_t)l * D * FF)
#define L_W_SD   (args.in[20] + (size_t)l * FF * D)
#define L_LN2G   (args.in[21] + (size_t)l * D)
#define L_LN2B   (args.in[22] + (size_t)l * D)
__global__ void __launch_bounds__(512, 2) fwd_kernel(Args args) {
    extern __shared__ __attribute__((aligned(16))) unsigned char lds_raw[];
    Frame F;
    F.lds = (LAS unsigned char*)lds_raw;
    F.tid = threadIdx.x; F.lane = F.tid & 63; F.wave = __builtin_amdgcn_readfirstlane(F.tid >> 6);
    F.G = gridDim.x; { const int bx = blockIdx.x; F.vcu = (F.G % 8 == 0) ? (bx % 8) * (F.G / 8) + bx / 8 : bx; }
    F.gw = F.vcu * 8 + F.wave; F.NGW = F.G * 8;
    unsigned* ctl = (unsigned*)(args.ws + WS_CTL);
    volatile LAS unsigned* MISC = (volatile LAS unsigned*)(F.lds + MISC_OFF);
    for (int u = F.tid; u < (LDS_BYTES - LDSCTL_OFF) / 4; u += 512) ((LAS unsigned*)(F.lds + LDSCTL_OFF))[u] = 0u;
    __syncthreads();
#if MK_ONE_LAUNCH
    XcdBarrier bar = xcd_barrier_post(ctl + CW_BAR, MISC + 8);
#define GRID_BAR() xcd_barrier(bar)
#else
#define GRID_BAR() do {} while (0)
#endif
    const int lo = args.ph_lo, hi = args.ph_hi;
#ifndef PHASE_MASK
#define PHASE_MASK 0xfff
#endif
#define IN(p) (((PHASE_MASK >> ((p) - pb)) & 1) && lo <= (p) && (p) < hi)
#define PHASE_REGS int lane = F.lane, tid = F.tid; asm volatile("" : "+v"(lane), "+v"(tid)); (void)lane; (void)tid;

    for (int l = 0; l < DEPTH; ++l) {
        const int pb = l * NPH;
        if (IN(pb + 0)) {
            PHASE_REGS
            LAS float* scr = (LAS float*)(F.lds + F.wave * 16384);
            const float* w_in = L_W_IN; const float* w_br_attn = L_W_BRA; const float* w_out = L_W_OUT; const float* w_sg = L_W_SG; const float* w_su = L_W_SU; const float* w_sd = L_W_SD;
            const float* w_eg = L_W_EG; const float* w_eu = L_W_EU; const float* w_ed = L_W_ED; const float* w_router = L_W_R;
            constexpr int I_IN = 16 * 104, I_BA = 8 * 32, I_OUT = 16 * 32, I_SG = 16 * 8, I_SD = 4 * 32, I_EG = 64 * 128, I_ED = 64 * 128, I_R = 16 * 2;
            constexpr int NITEMS = I_IN + I_BA + I_OUT + 2 * I_SG + I_SD + 2 * I_EG + I_ED + I_R;
            for (int it = F.gw; it < NITEMS; it += F.NGW) {
                int r = it;
                if (r < I_IN) { const int kb = r / 104, nb = r % 104; tr_item(w_in, DIN, (h16*)(args.ws + W_IN_T), 1024, 64 * kb, 32 * nb, 32 * nb, scr, lane); continue; } r -= I_IN;
                if (r < I_BA) { const int kb = r / 32, nb = r % 32; tr_item(w_br_attn, D, (h16*)(args.ws + W_BA_T), 512, 64 * kb, 32 * nb, 32 * nb, scr, lane); continue; } r -= I_BA;
                if (r < I_OUT) { const int kb = r / 32, nb = r % 32; tr_item(w_out, D, (h16*)(args.ws + W_OUT_T), 1024, 64 * kb, 32 * nb, 32 * nb, scr, lane); continue; } r -= I_OUT;
                if (r < 2 * I_SG) { const int up = r / I_SG, q = r % I_SG, kb = q / 8, nb = q % 8, n0 = 32 * nb; tr_item(up ? w_su : w_sg, FF, (h16*)(args.ws + W_SGU_T), 1024, 64 * kb, n0, 256 * (n0 >> 7) + (n0 & 127) + 128 * up, scr, lane); continue; } r -= 2 * I_SG;
                if (r < I_SD) { const int kb = r / 32, nb = r % 32; tr_item(w_sd, D, (h16*)(args.ws + W_SD_T), 256, 64 * kb, 32 * nb, 32 * nb, scr, lane); continue; } r -= I_SD;
                if (r < 2 * I_EG) { const int up = r / I_EG, q = r % I_EG, e = q / 128, q2 = q % 128, kb = q2 / 8, nb = q2 % 8, n0 = 32 * nb;
                    tr_item((up ? w_eu : w_eg) + (size_t)e * D * FF, FF, (h16*)(args.ws + W_EGU_T) + (size_t)e * 512 * 1024, 1024, 64 * kb, n0, 256 * (n0 >> 7) + (n0 & 127) + 128 * up, scr, lane); continue; } r -= 2 * I_EG;
                if (r < I_ED) { const int e = r / 128, q2 = r % 128, kb = q2 / 32, nb = q2 % 32; tr_item(w_ed + (size_t)e * FF * D, D, (h16*)(args.ws + W_ED_T) + (size_t)e * 1024 * 256, 256, 64 * kb, 32 * nb, 32 * nb, scr, lane); continue; } r -= I_ED;
                { const int kb = r / 2, nb = r % 2; tr_item_hilo(w_router, NE, (h16*)(args.ws + W_R_T), 1024, 64 * kb, 32 * nb, scr, lane); }
            }
            { h16* wpe = (h16*)(args.ws + W_PE_T); const float* w_pool = L_W_POOL; const float* pool_scale = L_PSCALE; const float* w_br_pool = L_W_BRP;
              for (int idx = F.gw; idx < 512 * 16; idx += F.NGW) { const int cg = idx >> 4, n = ((idx & 15) << 6) + lane, g = cg >> 7; float s = 0.f;
                  const float* wp = w_pool + (size_t)cg * 128; const float* ps = pool_scale + 128 * g; const float* wb = w_br_pool + (size_t)(128 * g) * D + n;
                  for (int d = 0; d < 128; ++d) s += wp[d] * ps[d] * wb[(size_t)d * D];
                  wpe[(size_t)n * 512 + cg] = (h16)f2h(s); } }
            if (l == 0) {
                for (int m = F.gw; m < T; m += F.NGW) { f32x4 v[4];
#pragma unroll
                    for (int j = 0; j < 4; ++j) v[j] = *(const f32x4*)(args.in[0] + (size_t)m * D + 4 * lane + 256 * j);
                    ln_store(v, args.in[1], args.in[2], X32 + (size_t)m * D, XB + (size_t)m * D, lane); }
            }
            GRID_BAR();
        }
        if (IN(pb + 1)) {
            PHASE_REGS
            SchedDense S; S.o.init(T, DIN, F.G, (int)blockIdx.x); S.a = (const char*)XB; S.b = (const char*)(args.ws + W_IN_T); S.apitch = 2048; S.bpitch = 2048;
            EpiInProj E{HH, L_B_IN};
            gemm_phase_simple(1024, S, E);
            GRID_BAR();
        }
        if (IN(pb + 2)) {
            PHASE_REGS
            for (int idx = F.vcu * 512 + tid; idx < T * 64; idx += F.G * 512) {
                const int t = idx >> 6, c8 = idx & 63, g = c8 >> 4, w = 2 << g, s = t & (SEQ - 1), n = (s + 1 < w) ? s + 1 : w;
                float a[8] = {0, 0, 0, 0, 0, 0, 0, 0}; f32x4 u0, u1;
                for (int i = 0; i < n; ++i) { const u32x4 q = *(const u32x4*)(HH + (size_t)(t - i) * DIN + C_U + c8 * 8); f32x4 v0, v1; unpack8(q, v0, v1); if (i == 0) { u0 = v0; u1 = v1; }
#pragma unroll
                    for (int j = 0; j < 4; ++j) { a[j] += v0[j]; a[4 + j] += v1[j]; } }
                const float rn = 1.0f / (float)n; f32x4 o0, o1;
#pragma unroll
                for (int j = 0; j < 4; ++j) { o0[j] = a[j] * rn - u0[j]; o1[j] = a[4 + j] * rn - u1[j]; }
                *(u32x4*)(PD + (size_t)t * 512 + c8 * 8) = pack8(o0, o1);
            }
            LAS float* qs = (LAS float*)(F.lds + 65536 + F.wave * 1024); LAS float* ps = qs + 64;
            for (int item = F.gw; item < T * 8; item += F.NGW) {
                const int t = item >> 3, hq = item & 7, hk = hq >> 2, s = t & (SEQ - 1);
                const float slope = exp2f(-(float)(hq + 1)), sink = L_SINKS[hq];
                h16* qp = HH + (size_t)t * DIN + C_Q + hq * 64;
                qs[lane] = h2f(qp[lane]);
                asm volatile("s_waitcnt lgkmcnt(0)" ::: "memory");
                float sc[2];
#pragma unroll
                for (int h = 0; h < 2; ++h) { const int j = lane + 64 * h; float d = -INFINITY;
                    if (j <= s) { const h16* kp = HH + (size_t)(t - j) * DIN + C_K + hk * 64; d = 0.f;
#pragma unroll
                        for (int c = 0; c < 8; ++c) { const u32x4 kw = *(const u32x4*)(kp + 8 * c); f32x4 k0, k1; unpack8(kw, k0, k1);
#pragma unroll
                            for (int e = 0; e < 4; ++e) d += qs[8 * c + e] * k0[e] + qs[8 * c + 4 + e] * k1[e]; }
                        d -= slope * (float)j; }
                    sc[h] = d; }
                const float mx = fmaxf(wave_max(fmaxf(sc[0], sc[1])), sink);
                const float p0 = __expf(sc[0] - mx), p1 = __expf(sc[1] - mx);
                const float den = wave_sum(p0 + p1) + __expf(sink - mx);
                ps[lane] = p0; ps[lane + 64] = p1;
                asm volatile("s_waitcnt lgkmcnt(0)" ::: "memory");
                const int nk = (s + 1 < 128) ? s + 1 : 128; float o = 0.f;
                const h16* vp = HH + (size_t)t * DIN + C_V + hk * 64 + lane;
                for (int j = 0; j < nk; ++j) o += ps[j] * h2f(vp[-(ptrdiff_t)j * DIN]);
                qp[lane] = (h16)f2h(o / den);
                asm volatile("s_waitcnt lgkmcnt(0)" ::: "memory");
            }
            GRID_BAR();
        }
        if (IN(pb + 3)) {
            PHASE_REGS
            SchedMerged S; S.o.init(T, D, F.G, (int)blockIdx.x); S.pd = (const char*)PD; S.oo = (const char*)(HH + C_Q); S.wpe = (const char*)(args.ws + W_PE_T); S.wba = (const char*)(args.ws + W_BA_T);
            EpiMerged E{MG, HH};
            gemm_phase_simple(512, S, E);
            GRID_BAR();
        }
        if (IN(pb + 4)) {
            PHASE_REGS
            SchedDense S; S.o.init(T, D, F.G, (int)blockIdx.x); S.a = (const char*)MG; S.b = (const char*)(args.ws + W_OUT_T); S.apitch = 2048; S.bpitch = 2048;
            EpiResid E{X32};
            gemm_phase_simple(1024, S, E);
            GRID_BAR();
        }
        if (IN(pb + 5)) {
            PHASE_REGS
            for (int m = F.gw; m < T; m += F.NGW) { f32x4 v[4];
#pragma unroll
                for (int j = 0; j < 4; ++j) v[j] = *(const f32x4*)(X32 + (size_t)m * D + 4 * lane + 256 * j);
                ln_store(v, L_LN1G, L_LN1B, X32 + (size_t)m * D, XB + (size_t)m * D, lane); }
            GRID_BAR();
        }
        if (IN(pb + 6)) {
            PHASE_REGS
            SchedSharedRouter S{F.G, F.vcu, (const char*)XB, (const char*)(args.ws + W_SGU_T), (const char*)(args.ws + W_R_T)};
            EpiSharedRouter E{HS, LOGIT};
            gemm_phase_simple(1024, S, E);
            GRID_BAR();
        }
        if (IN(pb + 7)) {
            PHASE_REGS
            LAS int* lcnt = (LAS int*)(F.lds);
            const float rb = L_RBIAS[lane];
            for (int w = F.vcu; w < 256; w += F.G) {
                int mycnt = 0; const int t0 = w * 128 + F.wave * 16;
                for (int tt = 0; tt < 16; ++tt) { const int t = t0 + tt;
                    const float lg = LOGIT[(size_t)t * NE + lane]; const float scv = 1.0f / (1.0f + __expf(-lg)); const float bs = scv + rb;
                    float m1 = bs; m1 = fmaxf(m1, __shfl_xor(m1, 1)); m1 = fmaxf(m1, __shfl_xor(m1, 2)); m1 = fmaxf(m1, __shfl_xor(m1, 4));
                    const unsigned long long eq = __ballot(bs == m1); const int g = lane >> 3; const unsigned gm = (unsigned)(eq >> (8 * g)) & 0xffu; const int first = __builtin_ctz(gm);
                    float m2 = ((lane & 7) == first) ? -INFINITY : bs; m2 = fmaxf(m2, __shfl_xor(m2, 1)); m2 = fmaxf(m2, __shfl_xor(m2, 2)); m2 = fmaxf(m2, __shfl_xor(m2, 4));
                    const float gs = m1 + m2; int grank = 0;
#pragma unroll
                    for (int j = 0; j < 8; ++j) { const float gj = __shfl(gs, 8 * j); grank += (gj > gs || (gj == gs && j < g)) ? 1 : 0; }
                    const bool keep = grank < 4; const float v = keep ? bs : -INFINITY; int rank = 0;
                    for (int j = 0; j < 64; ++j) { const float vj = __shfl(v, j); rank += (vj > v || (vj == v && j < lane)) ? 1 : 0; }
                    const bool sel = keep && rank < 8;
                    const float ssum = wave_sum(sel ? scv : 0.f);
                    if (sel) { ESEL[t * 8 + rank] = lane; GATE[t * 8 + rank] = scv / ssum * 2.5f; RANKL[t * 8 + rank] = mycnt; mycnt++; }
                }
                WCNT[(size_t)(w * 8 + F.wave) * 64 + lane] = mycnt;
                lcnt[F.wave * 64 + lane] = mycnt;
                __syncthreads();
                if (F.wave == 0) { int s = 0;
#pragma unroll
                    for (int v = 0; v < 8; ++v) s += lcnt[v * 64 + lane];
                    GTOT[w * 64 + lane] = s; }
                __syncthreads();
            }
            GRID_BAR();
        }
        if (IN(pb + 8)) {
            PHASE_REGS
            for (int w = F.vcu; w < 256; w += F.G) {
                int tot = 0, before = 0;
                for (int w2 = 0; w2 < 256; ++w2) { const int c = GTOT[w2 * 64 + lane]; tot += c; before += (w2 < w) ? c : 0; }
                for (int v2 = 0; v2 < F.wave; ++v2) before += WCNT[(size_t)(w * 8 + v2) * 64 + lane];
                const int pc = (tot + 255) & ~255; int incl = pc;
#pragma unroll
                for (int o = 1; o < 64; o <<= 1) { const int xv = __shfl_up(incl, o); if (lane >= o) incl += xv; }
                const int pstart = incl - pc, base = pstart + before; const int t0 = w * 128 + F.wave * 16;
#pragma unroll
                for (int it = 0; it < 2; ++it) { const int idx = it * 64 + lane, tt = t0 + (idx >> 3), k = idx & 7; const int e = ESEL[tt * 8 + k], r = RANKL[tt * 8 + k]; const float g = GATE[tt * 8 + k];
                    const int dest = __shfl(base, e) + r; TOKL[dest] = tt; GATL[dest] = g; SLOT[tt * 8 + k] = dest; }
                if (w == 0 && F.wave == 0) {
                    for (int e = 0; e < 64; ++e) { const int ps_ = __shfl(pstart, e), te = __shfl(tot, e), pe = __shfl(pc, e);
                        for (int i2 = te + lane; i2 < pe; i2 += 64) { TOKL[ps_ + i2] = 0; GATL[ps_ + i2] = 0.f; } } }
                if (w == 0 && F.wave == 1) {
                    const int nblk = __shfl(incl, 63) >> 8;
                    for (int rbk = lane; rbk < nblk; rbk += 64) { int cnt = 0;
                        for (int e = 0; e < 64; ++e) { const int pend = __shfl(incl, e); cnt += (pend <= rbk * 256) ? 1 : 0; }
                        BLKE[rbk] = cnt < 63 ? cnt : 63; }
                    if (lane == 0) BLKE[NBLK_MAX] = nblk; }
            }
            GRID_BAR();
        }
        if (IN(pb + 9)) {
            PHASE_REGS
            const int nblk = __builtin_amdgcn_readfirstlane(BLKE[NBLK_MAX]);
            SchedMoeGU S{F.G, F.vcu, nblk, (const char*)XB, (const char*)(args.ws + W_EGU_T), BLKE, TOKL};
            EpiMoeGU E{HB, GATL};
            gemm_phase_simple(1024, S, E);
            GRID_BAR();
        }
        if (IN(pb + 10)) {
            PHASE_REGS
            const int nblk = __builtin_amdgcn_readfirstlane(BLKE[NBLK_MAX]);
            SchedMoeDown S{F.G, F.vcu, nblk, (const char*)HB, (const char*)HS, (const char*)(args.ws + W_ED_T), (const char*)(args.ws + W_SD_T), BLKE};
            EpiMoeDown E{YD, X32};
            gemm_phase_simple(256, S, E);
            GRID_BAR();
        }
        if (IN(pb + 11)) {
            PHASE_REGS
            for (int m = F.gw; m < T; m += F.NGW) { f32x4 v[4];
#pragma unroll
                for (int j = 0; j < 4; ++j) v[j] = *(const f32x4*)(X32 + (size_t)m * D + 4 * lane + 256 * j);
                for (int k = 0; k < 8; ++k) { const int sl = SLOT[m * 8 + k]; const h16* yp = YD + (size_t)sl * D + 4 * lane;
#pragma unroll
                    for (int j = 0; j < 4; ++j) { const u32x2 q = *(const u32x2*)(yp + 256 * j); v[j] += (f32x4){lo16(q.x), hi16(q.x), lo16(q.y), hi16(q.y)}; } }
                ln_store(v, L_LN2G, L_LN2B, X32 + (size_t)m * D, XB + (size_t)m * D, lane); }
            if (pb + 11 != DEPTH * NPH - 1) GRID_BAR();
        }
    }
#undef IN
}

extern "C" void kernel_launch(void* const* d_in, const int* in_sizes, int n_in, void* d_out, int out_size, void* d_ws, size_t ws_size, hipStream_t stream) {
    static int grid = 0;
    if (grid == 0) {
        if (n_in != 23 || out_size != T * D || ws_size < WS_END) { fprintf(stderr, "kernel_launch: unexpected shapes (n_in %d out %d ws %zu)\n", n_in, out_size, ws_size); grid = -1; return; }
        int dev = 0, cus = 0;
        if (hipGetDevice(&dev) != hipSuccess || hipDeviceGetAttribute(&cus, hipDeviceAttributeMultiprocessorCount, dev) != hipSuccess) { grid = -1; return; }
        if (hipFuncSetAttribute((const void*)fwd_kernel, hipFuncAttributeMaxDynamicSharedMemorySize, LDS_BYTES) != hipSuccess) { fprintf(stderr, "kernel_launch: hipFuncSetAttribute failed\n"); grid = -1; return; }
        int per_cu = 0;
        if (hipOccupancyMaxActiveBlocksPerMultiprocessor(&per_cu, (const void*)fwd_kernel, 512, LDS_BYTES) != hipSuccess || per_cu < 1) { fprintf(stderr, "kernel_launch: occupancy query says %d\n", per_cu); }
        (void)hipGetLastError();
        grid = cus;
    }
    if (grid < 0) return;
    (void)hipMemsetAsync((char*)d_ws + WS_CTL, 0, CTL_ZERO_BYTES, stream);
    Args a{};
    for (int i = 0; i < 23; ++i) a.in[i] = (const float*)d_in[i];
    a.out = (float*)d_out; a.ws = (unsigned char*)d_ws;
#if MK_ONE_LAUNCH
    a.ph_lo = 0; a.ph_hi = DEPTH * NPH;
    hipLaunchKernelGGL(fwd_kernel, dim3(grid), dim3(512), LDS_BYTES, stream, a);
#else
    for (int p = 0; p < DEPTH * NPH; ++p) { a.ph_lo = p; a.ph_hi = p + 1; hipLaunchKernelGGL(fwd_kernel, dim3(grid), dim3(512), LDS_BYTES, stream, a); }
#endif
}
```

```cpp
#include <hip/hip_runtime.h>
#include <stdint.h>
#include <stdio.h>

#ifndef MK_ONE_LAUNCH
#define MK_ONE_LAUNCH 1
#endif

#define GAS __attribute__((address_space(1)))
#define LAS __attribute__((address_space(3)))
typedef unsigned short h16;
typedef short h16x8 __attribute__((ext_vector_type(8)));
typedef float f32x4 __attribute__((ext_vector_type(4)));
typedef float f32x2 __attribute__((ext_vector_type(2)));
typedef unsigned u32x4 __attribute__((ext_vector_type(4)));
typedef unsigned u32x2 __attribute__((ext_vector_type(2)));

constexpr int NB = 16, SEQ = 2048, T = NB * SEQ, D = 1024, DIN = 3328, DEPTH = 4;
constexpr int C_U = 0, C_Q = 512, C_K = 1024, C_V = 1152, C_GP = 1280, C_GA = 2304;
constexpr int NE = 64, FF = 256, TOPK = 8;
constexpr int NASSIGN = T * TOPK;
constexpr int NBLK_MAX = NASSIGN / 256 + NE;
constexpr int A_PAD = NBLK_MAX * 256;
constexpr float ALPHA = 1.6817928305074290f;
constexpr float LN_EPS = 1e-5f;
constexpr int NPH = 12;

constexpr size_t MiB = 1u << 20;
constexpr size_t WS_CTL = 0, CTL_ZERO_BYTES = 1 * MiB;
constexpr size_t WS_W = 1 * MiB;
constexpr size_t W_IN_T = WS_W + 0 * MiB;
constexpr size_t W_PE_T = WS_W + 7 * MiB;
constexpr size_t W_BA_T = WS_W + 8 * MiB;
constexpr size_t W_OUT_T = WS_W + 9 * MiB;
constexpr size_t W_R_T = WS_W + 11 * MiB;
constexpr size_t W_SGU_T = WS_W + 12 * MiB;
constexpr size_t W_SD_T = WS_W + 13 * MiB;
constexpr size_t W_EGU_T = WS_W + 14 * MiB;
constexpr size_t W_ED_T = WS_W + 78 * MiB;
constexpr size_t WS_XB = 111 * MiB;
constexpr size_t WS_HB = 175 * MiB;
constexpr size_t WS_HS = 311 * MiB;
constexpr size_t WS_MISC = 327 * MiB;
constexpr size_t MS_LOGIT = WS_MISC;
constexpr size_t MS_ESEL = WS_MISC + 8 * MiB;
constexpr size_t MS_GATE = WS_MISC + 9 * MiB;
constexpr size_t MS_RANK = WS_MISC + 10 * MiB;
constexpr size_t MS_SLOT = WS_MISC + 11 * MiB;
constexpr size_t MS_TOKL = WS_MISC + 12 * MiB;
constexpr size_t MS_GATL = WS_MISC + 13 * MiB + 256 * 1024;
constexpr size_t MS_WCNT = WS_MISC + 14 * MiB + 512 * 1024;
constexpr size_t MS_GTOT = WS_MISC + 15 * MiB;
constexpr size_t MS_BLKE = WS_MISC + 15 * MiB + 256 * 1024;
constexpr size_t WS_R = 343 * MiB;
constexpr size_t R_HH = WS_R;
constexpr size_t R_PD = WS_R + 208 * MiB;
constexpr size_t R_MG = WS_R + 240 * MiB;
constexpr size_t WS_END = WS_R + 544 * MiB;
static_assert((size_t)A_PAD * 4 <= 1 * MiB + 256 * 1024, "toklist");
static_assert((size_t)A_PAD * 256 * 2 <= 136 * MiB, "Hbuf");
static_assert((size_t)A_PAD * 1024 * 2 <= 544 * MiB, "Yd");

constexpr int CW_BAR = 4096;

constexpr int RING_BYTES = 131072;
constexpr int LDSCTL_OFF = RING_BYTES, MISC_OFF = LDSCTL_OFF + 320;
constexpr int LDS_BYTES = 147456;

#define RLX_AGENT __ATOMIC_RELAXED, __HIP_MEMORY_SCOPE_AGENT
__device__ __forceinline__ int lane_id() { int l; asm volatile("v_mbcnt_lo_u32_b32 %0, -1, 0\n\tv_mbcnt_hi_u32_b32 %0, -1, %0" : "=v"(l)); return l; }
typedef _Float16 f16x2 __attribute__((ext_vector_type(2)));
typedef _Float16 f16x8 __attribute__((ext_vector_type(8)));
__device__ __forceinline__ float h2f(unsigned short h) { return (float)__builtin_bit_cast(_Float16, h); }
__device__ __forceinline__ unsigned short f2h(float f) { return __builtin_bit_cast(unsigned short, (_Float16)f); }
__device__ __forceinline__ unsigned cvt_pk_h16(float lo, float hi) { f32x2 v = {lo, hi}; return __builtin_bit_cast(unsigned, __builtin_convertvector(v, f16x2)); }
__device__ __forceinline__ float lo16(unsigned w) { return (float)__builtin_bit_cast(f16x2, w)[0]; }
__device__ __forceinline__ float hi16(unsigned w) { return (float)__builtin_bit_cast(f16x2, w)[1]; }
__device__ __forceinline__ float sigmoidf_(float x) { return __builtin_amdgcn_rcpf(1.0f + __builtin_amdgcn_exp2f(-1.4426950408889634f * x)); }
__device__ __forceinline__ float wave_sum(float v) {
#pragma unroll
    for (int o = 1; o < 64; o <<= 1) v += __shfl_xor(v, o);
    return v;
}
__device__ __forceinline__ float wave_max(float v) {
#pragma unroll
    for (int o = 1; o < 64; o <<= 1) v = fmaxf(v, __shfl_xor(v, o));
    return v;
}

#define XB_TMO      128
#define XB_XCNT(j)  (256  + 64 * (j))
#define XB_XSUB(j)  (1280 + 64 * (j))
#define XB_XGEN(j)  (2304 + 64 * (j))
#define XB_TOP      3328
#define XB_TOPGEN   3392
#define XCD_BAR_WORDS 3456
#define XB_SPIN_CAP (1u << 18)
__device__ __forceinline__ unsigned xb_ld(unsigned* p)              { return __hip_atomic_load(p, __ATOMIC_RELAXED, __HIP_MEMORY_SCOPE_AGENT); }
__device__ __forceinline__ unsigned xb_add(unsigned* p, unsigned v) { return __hip_atomic_fetch_add(p, v, __ATOMIC_RELAXED, __HIP_MEMORY_SCOPE_AGENT); }
__device__ __forceinline__ unsigned xb_xcc_id() { return (unsigned)__builtin_amdgcn_s_getreg((3 << 11) | 20) & 0xFu; }
#define XB_SPIN(cond, bar) do { unsigned _sp = 0; while (cond) { __builtin_amdgcn_s_sleep(1); \
    if ((++_sp & 255u) == 0u) { if (xb_ld(&(bar)[XB_TMO])) break; if (_sp > XB_SPIN_CAP) { atomicAdd(&(bar)[XB_TMO], 1u); break; } } } } while (0)
struct XcdBarrier { unsigned* bar; unsigned x; volatile LAS unsigned* st; };
__device__ __forceinline__ XcdBarrier xcd_barrier_post(unsigned* bar, volatile LAS unsigned* st) {
    XcdBarrier b; b.bar = bar; b.x = xb_xcc_id(); b.st = st;
    if (threadIdx.x == 0) (void)xb_add(&bar[XB_XCNT(b.x)], 1u);
    return b;
}
__device__ __forceinline__ void xcd_barrier_complete(unsigned* bar, unsigned x, unsigned& nloc, unsigned& nx) {
    const unsigned G = gridDim.x * gridDim.y * gridDim.z;
    unsigned sum, cnt, mine, sp = 0u;
    for (;;) {
        sum = 0u; cnt = 0u; mine = 0u;
#pragma unroll
        for (unsigned j = 0; j < 16; ++j) { const unsigned c = xb_ld(&bar[XB_XCNT(j)]); sum += c; cnt += (c > 0u) ? 1u : 0u; mine = (j == x) ? c : mine; }
        if (sum == G) break;
        __builtin_amdgcn_s_sleep(1);
        if ((++sp & 255u) == 0u) { if (xb_ld(&bar[XB_TMO])) break; if (sp > XB_SPIN_CAP) { atomicAdd(&bar[XB_TMO], 1u); break; } }
    }
    nloc = mine > 0u ? mine : 1u; nx = cnt > 0u ? cnt : 1u;
}
__device__ __forceinline__ void xcd_barrier(const XcdBarrier& b, const int wave) {
    asm volatile("s_waitcnt vmcnt(0)" ::: "memory");
    __syncthreads();
    if (wave == 0 && lane_id() == 0) {
        unsigned* bar = b.bar;
        __builtin_amdgcn_s_waitcnt(0);
        unsigned nloc = b.st[0], nx = b.st[1];
        if (nloc == 0u) { xcd_barrier_complete(bar, b.x, nloc, nx); b.st[0] = nloc; b.st[1] = nx; }
        const unsigned old = xb_add(&bar[XB_XSUB(b.x)], 1u);
        const unsigned gen = old / nloc;
        if (old + 1u == (gen + 1u) * nloc) {
            __builtin_amdgcn_fence(__ATOMIC_RELEASE, "agent");
            asm volatile("s_waitcnt vmcnt(0)" ::: "memory");
            const unsigned og = xb_add(&bar[XB_TOP], 1u);
            const unsigned tg = og / nx;
            if (og + 1u == (tg + 1u) * nx) xb_add(&bar[XB_TOPGEN], 1u);
            else XB_SPIN(xb_ld(&bar[XB_TOPGEN]) == tg, bar);
            __builtin_amdgcn_fence(__ATOMIC_ACQUIRE, "agent");
            xb_add(&bar[XB_XGEN(b.x)], 1u);
            asm volatile("s_waitcnt vmcnt(0)" ::: "memory");
        } else {
            XB_SPIN(xb_ld(&bar[XB_XGEN(b.x)]) == gen, bar);
            __builtin_amdgcn_fence(__ATOMIC_ACQUIRE, "agent");
            asm volatile("s_waitcnt vmcnt(0)" ::: "memory");
        }
    }
    __syncthreads();
}

struct Unit {
    const char* a;
    const char* b;
    const int* ridx;
    unsigned apitch, bpitch;
    int row0;
    int col0;
    int kind;
};
#define ACC_T f32x4 (&acc)[2][2][4][2]

template <class Epi, class Sched>
__device__ __forceinline__ void gemm_phase_simple(const int wid, const int K, const Sched& S, const Epi& E) {
    const int lane = lane_id(), tid = wid * 64 + lane; (void)tid;
    const int  wr = wid >> 2, wc = wid & 3, fr = lane & 15, fq = lane >> 4;
    Unit u;
    for (int i = 0; S.next(i, u); ++i) {
        f32x4 acc[2][2][4][2];
#pragma unroll
        for (int a = 0; a < 2; ++a)
#pragma unroll
            for (int b = 0; b < 2; ++b)
#pragma unroll
                for (int m = 0; m < 4; ++m)
#pragma unroll
                    for (int n = 0; n < 2; ++n) acc[a][b][m][n] = (f32x4){0.f, 0.f, 0.f, 0.f};
        unsigned offA[2][4], offB[2][2];
#pragma unroll
        for (int ai = 0; ai < 2; ++ai)
#pragma unroll
            for (int m = 0; m < 4; ++m) { const int r = 128 * ai + 64 * wr + 16 * m + fr; const int row = u.ridx ? u.ridx[r] : u.row0 + r; offA[ai][m] = (unsigned)row * u.apitch + (unsigned)fq * 16u; }
#pragma unroll
        for (int bj = 0; bj < 2; ++bj)
#pragma unroll
            for (int n = 0; n < 2; ++n) { const int wrow = 128 * bj + 32 * wc + 8 * (fr >> 2) + 4 * n + (fr & 3); offB[bj][n] = (unsigned)wrow * u.bpitch + (unsigned)fq * 16u; }
#pragma unroll 1
        for (int k0 = 0; k0 < K; k0 += 32) {
            h16x8 b[2][2];
#pragma unroll
            for (int bj = 0; bj < 2; ++bj)
#pragma unroll
                for (int n = 0; n < 2; ++n) b[bj][n] = *(const h16x8*)(u.b + offB[bj][n] + (size_t)k0 * 2);
#pragma unroll
            for (int ai = 0; ai < 2; ++ai) {
                h16x8 a[4];
#pragma unroll
                for (int m = 0; m < 4; ++m) a[m] = *(const h16x8*)(u.a + offA[ai][m] + (size_t)k0 * 2);
#pragma unroll
                for (int bj = 0; bj < 2; ++bj)
#pragma unroll
                    for (int m = 0; m < 4; ++m)
#pragma unroll
                        for (int n = 0; n < 2; ++n) acc[ai][bj][m][n] = __builtin_amdgcn_mfma_f32_16x16x32_f16(__builtin_bit_cast(f16x8, b[bj][n]), __builtin_bit_cast(f16x8, a[m]), acc[ai][bj][m][n], 0, 0, 0);
                asm volatile("" ::: "memory");
            }
        }
        E(acc, u, wr, wc, fr, fq);
    }
}


#ifndef FAST_GEMM
#define FAST_GEMM 1
#endif
constexpr int HTB = 128 * 64 * 2;
__device__ __forceinline__ int lds_byte(int r, int c) { const int st = (r >> 4) * 2 + (c >> 5), rr = r & 15, cc = c & 31, ob = rr * 64 + cc * 2; return st * 1024 + (ob ^ (((ob >> 9) & 1) << 5)); }
__device__ __forceinline__ void stage_rc(int b, int& R, int& C) { const int st = b / 1024, sb = b % 1024, swz = sb ^ (((sb >> 9) & 1) << 5); R = (st >> 1) * 16 + swz / 64; C = (st & 1) * 32 + (swz % 64) / 2; }
__device__ __forceinline__ int perm32(int rho) { const int n = rho >> 4, i = rho & 15; return 8 * (i >> 2) + 4 * n + (i & 3); }

__device__ __forceinline__ const char* uptr(const char* p) { const unsigned long long v = (unsigned long long)p; const unsigned lo = __builtin_amdgcn_readfirstlane((unsigned)v), hi = __builtin_amdgcn_readfirstlane((unsigned)(v >> 32)); return (const char*)(((unsigned long long)hi << 32) | lo); }
template <class Epi, class Sched>
__device__ __forceinline__ void gemm_phase(LAS unsigned char* lds, const int wid, const int K, const Sched& S, const Epi& E) {
    const int lane = lane_id(), tid = wid * 64 + lane;
    const int  wr = wid >> 2, wc = wid & 3, fr = lane & 15, fq = lane >> 4;
    const int nt = K / 64;
    const unsigned ldsw = (unsigned)wid * 1024u;
    const int aoff = lds_byte(wr * 64 + fr, fq * 8), boff = lds_byte(wc * 32 + fr, fq * 8);
#define G_SA(b, h) (((b) * 2 + (h)) * HTB)
#define G_SB(b, h) ((4 + (b) * 2 + (h)) * HTB)
#define G_STAGE(bufoff, gbase, o0, o1) do { \
        __builtin_amdgcn_global_load_lds((const unsigned*)((const char*)(gbase) + (o0)), (LAS unsigned*)(lds + (bufoff) + ldsw), 16, 0, 0); \
        __builtin_amdgcn_global_load_lds((const unsigned*)((const char*)(gbase) + (o1)), (LAS unsigned*)(lds + (bufoff) + ldsw + 8192), 16, 0, 0); } while (0)
#define G_LDA(dst, b, h) do { _Pragma("unroll") for (int m = 0; m < 4; ++m) _Pragma("unroll") for (int k = 0; k < 2; ++k) dst[m][k] = *(const LAS h16x8*)(lds + G_SA(b, h) + aoff + m * 2048 + k * 1024); } while (0)
#define G_LDB(dst, b, h) do { _Pragma("unroll") for (int n = 0; n < 2; ++n) _Pragma("unroll") for (int k = 0; k < 2; ++k) dst[n][k] = *(const LAS h16x8*)(lds + G_SB(b, h) + boff + n * 2048 + k * 1024); } while (0)
#define G_MMA(ai, bj, At, Bt) do { __builtin_amdgcn_s_setprio(1); _Pragma("unroll") for (int m = 0; m < 4; ++m) _Pragma("unroll") for (int n = 0; n < 2; ++n) _Pragma("unroll") for (int k = 0; k < 2; ++k) \
        acc[ai][bj][m][n] = __builtin_amdgcn_mfma_f32_16x16x32_f16(__builtin_bit_cast(f16x8, Bt[n][k]), __builtin_bit_cast(f16x8, At[m][k]), acc[ai][bj][m][n], 0, 0, 0); __builtin_amdgcn_s_setprio(0); } while (0)
#define G_WAIT_V(n) asm volatile("s_waitcnt vmcnt(" #n ")" ::: "memory")
#define G_WAIT_L(n) asm volatile("s_waitcnt lgkmcnt(" #n ")" ::: "memory")
#define G_BAR __builtin_amdgcn_s_barrier()
#define G_SCHED __builtin_amdgcn_sched_barrier(0)
#define G_OFFS(u, OA, OB) do { int tl_ = wid * 64 + lane_id(); _Pragma("unroll") for (int i = 0; i < 2; ++i) { int R_, C_; stage_rc(tl_ * 16 + i * 8192, R_, C_); const int Rb_ = (R_ & ~31) + perm32(R_ & 31); \
        _Pragma("unroll") for (int h = 0; h < 2; ++h) { const int r_ = h * 128 + R_; const int row_ = (u).ridx ? (u).ridx[r_] : (u).row0 + r_; \
        OA[h][i] = (unsigned)row_ * (u).apitch + (unsigned)C_ * 2u; OB[h][i] = (unsigned)(h * 128 + Rb_) * (u).bpitch + (unsigned)C_ * 2u; } } } while (0)
    Unit cur, nxt; int ui = 0;
    if (!S.next(0, cur)) return;
    unsigned cOA[2][2], cOB[2][2];
    G_OFFS(cur, cOA, cOB);
    f32x4 acc[2][2][4][2];
#pragma unroll
    for (int a = 0; a < 2; ++a)
#pragma unroll
        for (int b = 0; b < 2; ++b)
#pragma unroll
            for (int m = 0; m < 4; ++m)
#pragma unroll
                for (int n = 0; n < 2; ++n) acc[a][b][m][n] = (f32x4){0.f, 0.f, 0.f, 0.f};
    h16x8 At[4][2], B0[2][2], B1[2][2];
    const char* cA = uptr(cur.a); const char* cB = uptr(cur.b);
    G_STAGE(G_SB(0, 0), cB, cOB[0][0], cOB[0][1]); G_STAGE(G_SB(0, 1), cB, cOB[1][0], cOB[1][1]); G_STAGE(G_SA(0, 0), cA, cOA[0][0], cOA[0][1]); G_STAGE(G_SA(0, 1), cA, cOA[1][0], cOA[1][1]);
    if (wr == 1) G_BAR;
    G_WAIT_V(2); G_BAR;
    { const char* cA1 = uptr(cA + 128); const char* cB1 = uptr(cB + 128);
      G_STAGE(G_SB(1, 0), cB1, cOB[0][0], cOB[0][1]); G_STAGE(G_SA(1, 0), cA1, cOA[0][0], cOA[0][1]); G_STAGE(G_SB(1, 1), cB1, cOB[1][0], cOB[1][1]); }
    G_WAIT_V(6); G_BAR;
    for (;;) {
        bool has_next = false; const char* nA = cA; const char* nB = cB;
#pragma unroll 1
        for (int t = 0; t < nt; t += 2) {
            const bool last = (t == nt - 2);
            const char* a1 = uptr(cA + (size_t)(t + 1) * 128);
            G_LDB(B0, 0, 0); G_LDB(B1, 0, 1); G_SCHED; G_LDA(At, 0, 0); G_STAGE(G_SA(1, 1), a1, cOA[1][0], cOA[1][1]);
            G_WAIT_V(8); G_WAIT_L(0); G_BAR; G_MMA(0, 0, At, B0); G_MMA(0, 1, At, B1); G_BAR; G_SCHED;
            if (last) { has_next = S.next(ui + 1, nxt); if (has_next) { nA = uptr(nxt.a); nB = uptr(nxt.b); G_OFFS(nxt, cOA, cOB); } }
            const char* a2 = uptr(last ? nA : cA + (size_t)(t + 2) * 128); const char* b2 = uptr(last ? nB : cB + (size_t)(t + 2) * 128);
            const char* a3 = uptr(a2 + 128); const char* b3 = uptr(b2 + 128);
            G_LDA(At, 0, 1); G_STAGE(G_SB(0, 0), b2, cOB[0][0], cOB[0][1]); G_STAGE(G_SB(0, 1), b2, cOB[1][0], cOB[1][1]); G_STAGE(G_SA(0, 0), a2, cOA[0][0], cOA[0][1]);
            G_WAIT_V(8); G_WAIT_L(0); G_BAR; G_MMA(1, 0, At, B0); G_MMA(1, 1, At, B1); G_BAR; G_SCHED;
            G_LDB(B0, 1, 0); G_LDB(B1, 1, 1); G_SCHED; G_LDA(At, 1, 0); G_STAGE(G_SA(0, 1), a2, cOA[1][0], cOA[1][1]);
            G_WAIT_V(8); G_WAIT_L(0); G_BAR; G_MMA(0, 0, At, B0); G_MMA(0, 1, At, B1); G_BAR; G_SCHED;
            G_LDA(At, 1, 1); G_STAGE(G_SB(1, 0), b3, cOB[0][0], cOB[0][1]); G_STAGE(G_SB(1, 1), b3, cOB[1][0], cOB[1][1]); G_STAGE(G_SA(1, 0), a3, cOA[0][0], cOA[0][1]);
            G_WAIT_V(8); G_WAIT_L(0); G_BAR; G_MMA(1, 0, At, B0); G_MMA(1, 1, At, B1); G_BAR; G_SCHED;
        }
        if (wr == 0) G_BAR;
        E(acc, cur, wr, wc, fr, fq);
        if (!has_next) break;
#pragma unroll
        for (int a = 0; a < 2; ++a)
#pragma unroll
            for (int b = 0; b < 2; ++b)
#pragma unroll
                for (int m = 0; m < 4; ++m)
#pragma unroll
                    for (int n = 0; n < 2; ++n) acc[a][b][m][n] = (f32x4){0.f, 0.f, 0.f, 0.f};
        cur = nxt; cA = nA; cB = nB; ++ui;
        if (wr == 1) G_BAR;
    }
    G_WAIT_V(0);
    G_BAR;
#undef G_SA
#undef G_SB
#undef G_STAGE
#undef G_LDA
#undef G_LDB
#undef G_MMA
#undef G_WAIT_V
#undef G_WAIT_L
#undef G_BAR
#undef G_SCHED
#undef G_OFFS
}
#if FAST_GEMM
#define GEMM_PHASE(K, S, E) gemm_phase(F.lds, F.wave, K, S, E)
#else
#define GEMM_PHASE(K, S, E) gemm_phase_simple(F.wave, K, S, E)
#endif

constexpr int NXCD = 8, WGM = 8;
struct TileOrder {
    int nM, nN, nwg, G, c;
    __device__ void init(int M, int N, int G_, int c_) { nM = M / 256; nN = N / 256; nwg = nM * nN; G = G_; c = c_; }
    __device__ bool tile(int i, int& pm, int& pn) const {
        const long L = (long)i * G + c; if (L >= nwg) return false;
        int wgid = (int)L; { const int q = nwg / NXCD, r = nwg % NXCD, xcd = wgid % NXCD, off = wgid / NXCD; wgid = (xcd < r ? xcd * (q + 1) : r * (q + 1) + (xcd - r) * q) + off; }
        const int nig = WGM * nN, gid = wgid / nig, fm = gid * WGM, gsz = (nM - fm) < WGM ? (nM - fm) : WGM;
        pm = fm + ((wgid % nig) % gsz); pn = (wgid % nig) / gsz; return true;
    }
};
struct SchedDense {
    TileOrder o; const char* a; const char* b; unsigned apitch, bpitch;
    __device__ bool next(int i, Unit& u) const {
        int pm, pn; if (!o.tile(i, pm, pn)) return false;
        u.a = a; u.b = b + (size_t)pn * 256 * bpitch; u.ridx = nullptr; u.apitch = apitch; u.bpitch = bpitch; u.row0 = pm * 256; u.col0 = pn * 256; u.kind = 0; return true;
    }
};
struct SchedMerged {
    TileOrder o; const char* pd; const char* oo; const char* wpe; const char* wba;
    __device__ bool next(int i, Unit& u) const {
        int pm, pn; if (!o.tile(i >> 1, pm, pn)) return false;
        const int part = i & 1;
        u.a = part ? oo : pd; u.apitch = part ? DIN * 2 : 512 * 2; u.b = (part ? wba : wpe) + (size_t)pn * 256 * 1024; u.bpitch = 1024; u.ridx = nullptr; u.row0 = pm * 256; u.col0 = pn * 256; u.kind = part; return true;
    }
};
struct SchedSharedRouter {
    int G, c; const char* xb; const char* wsgu; const char* wr;
    __device__ bool next(int i, Unit& u) const {
        const int L = i * G + c; if (L >= 384) return false;
        u.a = xb; u.apitch = 2048; u.bpitch = 2048; u.ridx = nullptr;
        if (L < 256) { const int pm = L >> 1, pn = L & 1; u.b = wsgu + (size_t)pn * 256 * 2048; u.row0 = pm * 256; u.col0 = pn * 128; u.kind = 0; }
        else { const int pm = L - 256; u.b = wr; u.row0 = pm * 256; u.col0 = 0; u.kind = 1; }
        return true;
    }
};
struct SchedMoeGU {
    int G, c, nblk; const char* xb; const char* wegu; const int* blke; const int* tokl;
    __device__ bool next(int i, Unit& u) const {
        const int L = i * G + c; if (L >= 2 * nblk) return false;
        const int rb = L >> 1, pn = L & 1, e = __builtin_amdgcn_readfirstlane(blke[rb]);
        u.a = xb; u.apitch = 2048; u.bpitch = 2048; u.b = wegu + ((size_t)e * 512 + pn * 256) * 2048; u.ridx = tokl + rb * 256; u.row0 = rb * 256; u.col0 = pn * 128; u.kind = 0; return true;
    }
};
struct SchedMoeDown {
    int G, c, nblk; const char* hb; const char* hs; const char* wed; const char* wsd; const int* blke;
    __device__ bool next(int i, Unit& u) const {
        const int L = i * G + c; if (L >= 4 * nblk + 512) return false;
        u.apitch = 512; u.bpitch = 512; u.ridx = nullptr;
        if (L < 4 * nblk) { const int rb = L >> 2, pn = L & 3, e = __builtin_amdgcn_readfirstlane(blke[rb]); u.a = hb; u.b = wed + ((size_t)e * 1024 + pn * 256) * 512; u.row0 = rb * 256; u.col0 = pn * 256; u.kind = 0; }
        else { const int L2 = L - 4 * nblk, pm = L2 >> 2, pn = L2 & 3; u.a = hs; u.b = wsd + (size_t)pn * 256 * 512; u.row0 = pm * 256; u.col0 = pn * 256; u.kind = 1; }
        return true;
    }
};

__device__ __forceinline__ u32x4 pack8(const f32x4& v0, const f32x4& v1) { u32x4 w; w.x = cvt_pk_h16(v0[0], v0[1]); w.y = cvt_pk_h16(v0[2], v0[3]); w.z = cvt_pk_h16(v1[0], v1[1]); w.w = cvt_pk_h16(v1[2], v1[3]); return w; }
__device__ __forceinline__ void unpack8(const u32x4& w, f32x4& v0, f32x4& v1) { v0 = (f32x4){lo16(w.x), hi16(w.x), lo16(w.y), hi16(w.y)}; v1 = (f32x4){lo16(w.z), hi16(w.z), lo16(w.w), hi16(w.w)}; }
__device__ __forceinline__ f32x4 sig4(const f32x4& v) { return (f32x4){sigmoidf_(v[0]), sigmoidf_(v[1]), sigmoidf_(v[2]), sigmoidf_(v[3])}; }
__device__ __forceinline__ f32x4 swiglu4(const f32x4& g, const f32x4& u) { return (f32x4){g[0] * sigmoidf_(g[0]) * u[0], g[1] * sigmoidf_(g[1]) * u[1], g[2] * sigmoidf_(g[2]) * u[2], g[3] * sigmoidf_(g[3]) * u[3]}; }

struct EpiInProj {
    h16* H; const float* bias;
    __device__ __forceinline__ void operator()(const ACC_T, const Unit& u, int wr, int wc, int fr, int fq) const {
        const int pn = u.col0 >> 8; const float sc = (pn == 2 || pn == 3) ? 0.125f : 1.f; const bool sg = pn >= 5;
        f32x4 bv[2][2];
#pragma unroll
        for (int bj = 0; bj < 2; ++bj)
#pragma unroll
            for (int n = 0; n < 2; ++n) bv[bj][n] = *(const f32x4*)(bias + u.col0 + 128 * bj + 32 * wc + 8 * fq + 4 * n);
#pragma unroll
        for (int ai = 0; ai < 2; ++ai)
#pragma unroll
            for (int m = 0; m < 4; ++m) { const int row = u.row0 + 128 * ai + 64 * wr + 16 * m + fr; h16* rowp = H + (size_t)row * DIN + u.col0 + 32 * wc + 8 * fq;
#pragma unroll
                for (int bj = 0; bj < 2; ++bj) { f32x4 v0 = (acc[ai][bj][m][0] + bv[bj][0]) * sc, v1 = (acc[ai][bj][m][1] + bv[bj][1]) * sc;
                    if (sg) { v0 = sig4(v0); v1 = sig4(v1); }
                    *(u32x4*)(rowp + 128 * bj) = pack8(v0, v1); } }
    }
};
struct EpiMerged {
    h16* MG; const h16* H;
    __device__ __forceinline__ void operator()(const ACC_T, const Unit& u, int wr, int wc, int fr, int fq) const {
        const int goff = u.kind ? C_GA : C_GP;
#pragma unroll
        for (int ai = 0; ai < 2; ++ai)
#pragma unroll
            for (int m = 0; m < 4; ++m) { const int row = u.row0 + 128 * ai + 64 * wr + 16 * m + fr; const int col = u.col0 + 32 * wc + 8 * fq;
#pragma unroll
                for (int bj = 0; bj < 2; ++bj) { const u32x4 gw = *(const u32x4*)(H + (size_t)row * DIN + goff + col + 128 * bj); f32x4 g0, g1; unpack8(gw, g0, g1);
                    f32x4 v0 = acc[ai][bj][m][0] * g0, v1 = acc[ai][bj][m][1] * g1; h16* mp = MG + (size_t)row * D + col + 128 * bj;
                    if (u.kind) { const u32x4 pw = *(const u32x4*)mp; f32x4 p0, p1; unpack8(pw, p0, p1); v0 += p0; v1 += p1; }
                    *(u32x4*)mp = pack8(v0, v1); } }
    }
};
struct EpiResid {
    float* X;
    __device__ __forceinline__ void operator()(const ACC_T, const Unit& u, int wr, int wc, int fr, int fq) const {
#pragma unroll
        for (int ai = 0; ai < 2; ++ai)
#pragma unroll
            for (int m = 0; m < 4; ++m) { const int row = u.row0 + 128 * ai + 64 * wr + 16 * m + fr; float* xp = X + (size_t)row * D + u.col0 + 32 * wc + 8 * fq;
#pragma unroll
                for (int bj = 0; bj < 2; ++bj)
#pragma unroll
                    for (int n = 0; n < 2; ++n) { f32x4* p = (f32x4*)(xp + 128 * bj + 4 * n); *p = *p * ALPHA + acc[ai][bj][m][n]; } }
    }
};
struct EpiSharedRouter {
    h16* HS; float* LG;
    __device__ __forceinline__ void operator()(const ACC_T, const Unit& u, int wr, int wc, int fr, int fq) const {
#pragma unroll
        for (int ai = 0; ai < 2; ++ai)
#pragma unroll
            for (int m = 0; m < 4; ++m) { const int row = u.row0 + 128 * ai + 64 * wr + 16 * m + fr;
                if (u.kind == 0) { *(u32x4*)(HS + (size_t)row * FF + u.col0 + 32 * wc + 8 * fq) = pack8(swiglu4(acc[ai][0][m][0], acc[ai][1][m][0]), swiglu4(acc[ai][0][m][1], acc[ai][1][m][1])); }
                else if (wc < 2) {
#pragma unroll
                    for (int n = 0; n < 2; ++n) *(f32x4*)(LG + (size_t)row * NE + 32 * wc + 8 * fq + 4 * n) = acc[ai][0][m][n] + acc[ai][1][m][n]; } }
    }
};
struct EpiMoeGU {
    h16* HB; const float* gatl;
    __device__ __forceinline__ void operator()(const ACC_T, const Unit& u, int wr, int wc, int fr, int fq) const {
#pragma unroll
        for (int ai = 0; ai < 2; ++ai)
#pragma unroll
            for (int m = 0; m < 4; ++m) { const int row = u.row0 + 128 * ai + 64 * wr + 16 * m + fr; const float g = gatl[row];
                *(u32x4*)(HB + (size_t)row * FF + u.col0 + 32 * wc + 8 * fq) = pack8(swiglu4(acc[ai][0][m][0], acc[ai][1][m][0]) * g, swiglu4(acc[ai][0][m][1], acc[ai][1][m][1]) * g); }
    }
};
struct EpiMoeDown {
    h16* YD; float* X;
    __device__ __forceinline__ void operator()(const ACC_T, const Unit& u, int wr, int wc, int fr, int fq) const {
        if (u.kind) { EpiResid r{X}; r(acc, u, wr, wc, fr, fq); return; }
#pragma unroll
        for (int ai = 0; ai < 2; ++ai)
#pragma unroll
            for (int m = 0; m < 4; ++m) { const int row = u.row0 + 128 * ai + 64 * wr + 16 * m + fr; h16* yp = YD + (size_t)row * D + u.col0 + 32 * wc + 8 * fq;
#pragma unroll
                for (int bj = 0; bj < 2; ++bj) *(u32x4*)(yp + 128 * bj) = pack8(acc[ai][bj][m][0], acc[ai][bj][m][1]); }
    }
};

struct Args { const float* in[23]; float* out; unsigned char* ws; int ph_lo, ph_hi; };
struct Frame {
    LAS unsigned char* lds; int wave, vcu, G, gw, NGW;
};

__device__ __forceinline__ void ln_store(f32x4 (&v)[4], const float* gam, const float* bet, float* o32, h16* o16, int lane) {
    float s = 0.f;
#pragma unroll
    for (int j = 0; j < 4; ++j) s += (v[j].x + v[j].y) + (v[j].z + v[j].w);
    const float mean = wave_sum(s) * (1.f / D); float s2 = 0.f;
#pragma unroll
    for (int j = 0; j < 4; ++j) { v[j] = v[j] - mean; s2 += (v[j].x * v[j].x + v[j].y * v[j].y) + (v[j].z * v[j].z + v[j].w * v[j].w); }
    const float rstd = 1.f / sqrtf(wave_sum(s2) * (1.f / D) + LN_EPS);
#pragma unroll
    for (int j = 0; j < 4; ++j) { const f32x4 g = *(const f32x4*)(gam + 4 * lane + 256 * j), b = *(const f32x4*)(bet + 4 * lane + 256 * j); const f32x4 y = v[j] * rstd * g + b;
        *(f32x4*)(o32 + 4 * lane + 256 * j) = y; u32x2 w; w.x = cvt_pk_h16(y[0], y[1]); w.y = cvt_pk_h16(y[2], y[3]); *(u32x2*)(o16 + 4 * lane + 256 * j) = w; }
}

__device__ __forceinline__ void tr_item(const float* W, int N, h16* WT, int ldt, int k0, int n0, int drow0, LAS float* scr, int lane) {
#pragma unroll 8
    for (int i = 0; i < 32; ++i) { const int kk = 2 * i + (lane >> 5); scr[kk * 33 + (lane & 31)] = W[(size_t)(k0 + kk) * N + n0 + (lane & 31)]; }
    asm volatile("s_waitcnt lgkmcnt(0)" ::: "memory");
    const int c = lane & 7;
#pragma unroll
    for (int j = 0; j < 4; ++j) { const int n = (lane >> 3) + 8 * j; const LAS float* s = scr + (8 * c) * 33 + n;
        u32x4 o; o.x = cvt_pk_h16(s[0 * 33], s[1 * 33]); o.y = cvt_pk_h16(s[2 * 33], s[3 * 33]); o.z = cvt_pk_h16(s[4 * 33], s[5 * 33]); o.w = cvt_pk_h16(s[6 * 33], s[7 * 33]);
        *(u32x4*)(WT + (size_t)(drow0 + n) * ldt + k0 + 8 * c) = o; }
    asm volatile("s_waitcnt lgkmcnt(0)" ::: "memory");
}
__device__ __forceinline__ void tr_item_hilo(const float* W, int N, h16* WT, int ldt, int k0, int n0, LAS float* scr, int lane) {
#pragma unroll 8
    for (int i = 0; i < 32; ++i) { const int kk = 2 * i + (lane >> 5); scr[kk * 33 + (lane & 31)] = W[(size_t)(k0 + kk) * N + n0 + (lane & 31)]; }
    asm volatile("s_waitcnt lgkmcnt(0)" ::: "memory");
    const int c = lane & 7;
#pragma unroll
    for (int j = 0; j < 4; ++j) { const int n = (lane >> 3) + 8 * j; const LAS float* s = scr + (8 * c) * 33 + n;
        float v[8], r[8];
#pragma unroll
        for (int q = 0; q < 8; ++q) { v[q] = s[q * 33]; r[q] = v[q] - h2f(f2h(v[q])); }
        u32x4 o; o.x = cvt_pk_h16(v[0], v[1]); o.y = cvt_pk_h16(v[2], v[3]); o.z = cvt_pk_h16(v[4], v[5]); o.w = cvt_pk_h16(v[6], v[7]);
        *(u32x4*)(WT + (size_t)(n0 + n) * ldt + k0 + 8 * c) = o;
        o.x = cvt_pk_h16(r[0], r[1]); o.y = cvt_pk_h16(r[2], r[3]); o.z = cvt_pk_h16(r[4], r[5]); o.w = cvt_pk_h16(r[6], r[7]);
        *(u32x4*)(WT + (size_t)(128 + n0 + n) * ldt + k0 + 8 * c) = o; }
    asm volatile("s_waitcnt lgkmcnt(0)" ::: "memory");
}


typedef float f32x16 __attribute__((ext_vector_type(16)));
constexpr int AT_KP = 144, AT_VP = 528, AT_VOFF = 256 * AT_KP;
__device__ __forceinline__ int crow(int r, int hi) { return (r & 3) + 8 * (r >> 2) + 4 * hi; }
__device__ __forceinline__ void attn_unit(LAS unsigned char* lds, h16* HHp, const float* sinks, const int b, const int n, const int hk, const int tid) {
    const int lane = tid & 63, wid = __builtin_amdgcn_readfirstlane(tid >> 6), q32 = lane & 31, hi = lane >> 5;
    const int g = wid >> 1, qh = wid & 1, hq = hk * 4 + g;
    const int tb = b * SEQ + n * 128;
    LAS unsigned char* Ks = lds; LAS unsigned char* Vs = lds + AT_VOFF;
#pragma unroll
    for (int i = 0; i < 4; ++i) { const int idx = tid + 512 * i, key = idx >> 3, ch = idx & 7; const int tok = (n > 0) ? tb - 128 + key : tb + (key & 127);
        const h16* kp = HHp + (size_t)tok * DIN + C_K + hk * 64 + ch * 8; const u32x4 kw = *(const u32x4*)kp; const u32x4 vw = *(const u32x4*)(kp + 128);
        *(LAS u32x4*)(Ks + key * AT_KP + ch * 16) = kw;
        LAS unsigned short* vd = (LAS unsigned short*)(Vs + (ch * 8) * AT_VP + key * 2);
        vd[0 * (AT_VP / 2)] = (unsigned short)(vw.x & 0xffffu); vd[1 * (AT_VP / 2)] = (unsigned short)(vw.x >> 16); vd[2 * (AT_VP / 2)] = (unsigned short)(vw.y & 0xffffu); vd[3 * (AT_VP / 2)] = (unsigned short)(vw.y >> 16);
        vd[4 * (AT_VP / 2)] = (unsigned short)(vw.z & 0xffffu); vd[5 * (AT_VP / 2)] = (unsigned short)(vw.z >> 16); vd[6 * (AT_VP / 2)] = (unsigned short)(vw.w & 0xffffu); vd[7 * (AT_VP / 2)] = (unsigned short)(vw.w >> 16); }
    __syncthreads();
    const float slope = exp2f(-(float)(hq + 1)), sink = sinks[hq];
#pragma unroll 1
    for (int sub = 0; sub < 2; ++sub) {
        const int q0 = 64 * qh + 32 * sub, qi = q0 + q32;
        h16* qp = HHp + (size_t)(tb + qi) * DIN + C_Q + hq * 64;
        f16x8 qf[4];
#pragma unroll
        for (int ks = 0; ks < 4; ++ks) qf[ks] = *(const f16x8*)(qp + 16 * ks + 8 * hi);
        f32x16 sv[5]; float mx = -INFINITY;
#pragma unroll
        for (int j = 0; j < 5; ++j) { const int key0 = q0 + 32 * j; f32x16 c;
#pragma unroll
            for (int r = 0; r < 16; ++r) c[r] = 0.f;
#pragma unroll
            for (int ks = 0; ks < 4; ++ks) { const f16x8 kf = *(const LAS f16x8*)(Ks + (key0 + q32) * AT_KP + (16 * ks + 8 * hi) * 2); c = __builtin_amdgcn_mfma_f32_32x32x16_f16(kf, qf[ks], c, 0, 0, 0); }
            int hil = hi; asm volatile("" : "+v"(hil));
#pragma unroll
            for (int r = 0; r < 16; ++r) { const int kj = key0 + crow(r, hil); const int dist = 128 + qi - kj; const bool valid = (dist >= 0) && (dist < 128) && (n > 0 || kj >= 128);
                const float v = valid ? c[r] - slope * (float)dist : -INFINITY; c[r] = v; mx = fmaxf(mx, v); }
            sv[j] = c; __builtin_amdgcn_sched_barrier(0); }
        mx = fmaxf(mx, __shfl_xor(mx, 32)); mx = fmaxf(mx, sink);
        float lsum = 0.f; f32x16 o0, o1;
#pragma unroll
        for (int r = 0; r < 16; ++r) { o0[r] = 0.f; o1[r] = 0.f; }
#pragma unroll
        for (int j = 0; j < 5; ++j) { const int key0 = q0 + 32 * j;
#pragma unroll
            for (int r = 0; r < 16; ++r) { const float pv = __expf(sv[j][r] - mx); sv[j][r] = pv; lsum += pv; }
#pragma unroll
            for (int cc = 0; cc < 2; ++cc) {
                u32x4 pw; pw.x = cvt_pk_h16(sv[j][8 * cc + 0], sv[j][8 * cc + 1]); pw.y = cvt_pk_h16(sv[j][8 * cc + 2], sv[j][8 * cc + 3]); pw.z = cvt_pk_h16(sv[j][8 * cc + 4], sv[j][8 * cc + 5]); pw.w = cvt_pk_h16(sv[j][8 * cc + 6], sv[j][8 * cc + 7]);
                const f16x8 pb = __builtin_bit_cast(f16x8, pw);
                const LAS unsigned char* vp = Vs + q32 * AT_VP + (key0 + 16 * cc + 4 * hi) * 2;
                { const u32x2 a0 = *(const LAS u32x2*)vp, a1 = *(const LAS u32x2*)(vp + 16); const u32x4 vw = {a0.x, a0.y, a1.x, a1.y}; o0 = __builtin_amdgcn_mfma_f32_32x32x16_f16(__builtin_bit_cast(f16x8, vw), pb, o0, 0, 0, 0); }
                { const u32x2 a0 = *(const LAS u32x2*)(vp + 32 * AT_VP), a1 = *(const LAS u32x2*)(vp + 32 * AT_VP + 16); const u32x4 vw = {a0.x, a0.y, a1.x, a1.y}; o1 = __builtin_amdgcn_mfma_f32_32x32x16_f16(__builtin_bit_cast(f16x8, vw), pb, o1, 0, 0, 0); }
                __builtin_amdgcn_sched_barrier(0);
            } }
        lsum += __shfl_xor(lsum, 32); lsum += __expf(sink - mx);
        const float rl = 1.0f / lsum;
#pragma unroll
        for (int rg = 0; rg < 4; ++rg) { u32x2 w0, w1;
            w0.x = cvt_pk_h16(o0[4 * rg] * rl, o0[4 * rg + 1] * rl); w0.y = cvt_pk_h16(o0[4 * rg + 2] * rl, o0[4 * rg + 3] * rl);
            w1.x = cvt_pk_h16(o1[4 * rg] * rl, o1[4 * rg + 1] * rl); w1.y = cvt_pk_h16(o1[4 * rg + 2] * rl, o1[4 * rg + 3] * rl);
            *(u32x2*)(qp + 8 * rg + 4 * hi) = w0; *(u32x2*)(qp + 32 + 8 * rg + 4 * hi) = w1; }
    }
    __syncthreads();
}
template <int W> __device__ __forceinline__ void pool_item(const h16* HHp, h16* PDp, const int g, const int t, const int c8) {
    const int s = t & (SEQ - 1); f32x4 a0 = {0.f, 0.f, 0.f, 0.f}, a1 = {0.f, 0.f, 0.f, 0.f}, u0, u1;
    const h16* up = HHp + (size_t)t * DIN + C_U + c8 * 8;
#pragma unroll
    for (int i = 0; i < W; ++i) { const int ii = (i <= s) ? i : 0; const u32x4 q = *(const u32x4*)(up - (size_t)ii * DIN); f32x4 v0, v1; unpack8(q, v0, v1); if (i == 0) { u0 = v0; u1 = v1; }
        if (i <= s) { a0 += v0; a1 += v1; } }
    const float rn = 1.0f / (float)((s + 1 < W) ? s + 1 : W);
    *(u32x4*)(PDp + (size_t)t * 512 + c8 * 8) = pack8(a0 * rn - u0, a1 * rn - u1);
}

#define X32   (args.out)
#define XB    ((h16*)(args.ws + WS_XB))
#define HH    ((h16*)(args.ws + R_HH))
#define PD    ((h16*)(args.ws + R_PD))
#define MG    ((h16*)(args.ws + R_MG))
#define HB    ((h16*)(args.ws + WS_HB))
#define HS    ((h16*)(args.ws + WS_HS))
#define YD    ((h16*)(args.ws + WS_R))
#define LOGIT ((float*)(args.ws + MS_LOGIT))
#define ESEL  ((int*)(args.ws + MS_ESEL))
#define GATE  ((float*)(args.ws + MS_GATE))
#define RANKL ((int*)(args.ws + MS_RANK))
#define SLOT  ((int*)(args.ws + MS_SLOT))
#define TOKL  ((int*)(args.ws + MS_TOKL))
#define GATL  ((float*)(args.ws + MS_GATL))
#define WCNT  ((int*)(args.ws + MS_WCNT))
#define GTOT  ((int*)(args.ws + MS_GTOT))
#define BLKE  ((int*)(args.ws + MS_BLKE))
#define L_W_IN   (args.in[3] + (size_t)l * D * DIN)
#define L_B_IN   (args.in[4] + (size_t)l * DIN)
#define L_W_POOL (args.in[5] + (size_t)l * 4 * 128 * 128)
#define L_PSCALE (args.in[6] + (size_t)l * 512)
#define L_SINKS  (args.in[7] + (size_t)l * 8)
#define L_W_BRP  (args.in[8] + (size_t)l * 512 * D)
#define L_W_BRA  (args.in[9] + (size_t)l * 512 * D)
#define L_W_OUT  (args.in[10] + (size_t)l * D * D)
#define L_LN1G   (args.in[11] + (size_t)l * D)
#define L_LN1B   (args.in[12] + (size_t)l * D)
#define L_W_R    (args.in[13] + (size_t)l * D * NE)
#define L_RBIAS  (args.in[14] + (size_t)l * NE)
#define L_W_EG   (args.in[15] + (size_t)l * NE * D * FF)
#define L_W_EU   (args.in[16] + (size_t)l * NE * D * FF)
#define L_W_ED   (args.in[17] + (size_t)l * NE * FF * D)
#define L_W_SG   (args.in[18] + (size_t)l * D * FF)
#define L_W_SU   (args.in[19] + (size_t)l * D * FF)
#define L_W_SD   (args.in[20] + (size_t)l * FF * D)
#define L_LN2G   (args.in[21] + (size_t)l * D)
#define L_LN2B   (args.in[22] + (size_t)l * D)
__global__ void __launch_bounds__(512, 2) fwd_kernel(Args args) {
    extern __shared__ __attribute__((aligned(16))) unsigned char lds_raw[];
    Frame F;
    F.lds = (LAS unsigned char*)lds_raw;
    F.wave = __builtin_amdgcn_readfirstlane((int)threadIdx.x >> 6);
    F.G = gridDim.x; { const int bx = blockIdx.x; F.vcu = (F.G % 8 == 0) ? (bx % 8) * (F.G / 8) + bx / 8 : bx; }
    F.gw = F.vcu * 8 + F.wave; F.NGW = F.G * 8;
    unsigned* ctl = (unsigned*)(args.ws + WS_CTL);
    volatile LAS unsigned* MISC = (volatile LAS unsigned*)(F.lds + MISC_OFF);
    for (int u = threadIdx.x; u < (LDS_BYTES - LDSCTL_OFF) / 4; u += 512) ((LAS unsigned*)(F.lds + LDSCTL_OFF))[u] = 0u;
    __syncthreads();
#if MK_ONE_LAUNCH
    XcdBarrier bar = xcd_barrier_post(ctl + CW_BAR, MISC + 8);
#define GRID_BAR() xcd_barrier(bar, F.wave)
#else
#define GRID_BAR() do {} while (0)
#endif
    const int lo = args.ph_lo, hi = args.ph_hi;
#ifndef PHASE_MASK
#define PHASE_MASK 0xfff
#endif
#define IN(p) (((PHASE_MASK >> ((p) - pb)) & 1) && lo <= (p) && (p) < hi)
#define PHASE_REGS const int lane = lane_id(); const int tid = F.wave * 64 + lane; int vcu = F.vcu, bx = (int)blockIdx.x; asm volatile("" : "+s"(vcu), "+s"(bx)); (void)lane; (void)tid; (void)vcu; (void)bx;

    for (int l = 0; l < DEPTH; ++l) {
        const int pb = l * NPH;
        if (IN(pb + 0)) {
            PHASE_REGS
            LAS float* scr = (LAS float*)(F.lds + F.wave * 16384);
            const float* w_in = L_W_IN; const float* w_br_attn = L_W_BRA; const float* w_out = L_W_OUT; const float* w_sg = L_W_SG; const float* w_su = L_W_SU; const float* w_sd = L_W_SD;
            const float* w_eg = L_W_EG; const float* w_eu = L_W_EU; const float* w_ed = L_W_ED; const float* w_router = L_W_R;
            constexpr int I_IN = 16 * 104, I_BA = 8 * 32, I_OUT = 16 * 32, I_SG = 16 * 8, I_SD = 4 * 32, I_EG = 64 * 128, I_ED = 64 * 128, I_R = 16 * 2;
            constexpr int NITEMS = I_IN + I_BA + I_OUT + 2 * I_SG + I_SD + 2 * I_EG + I_ED + I_R;
            for (int it = F.gw; it < NITEMS; it += F.NGW) {
                int r = it;
                if (r < I_IN) { const int kb = r / 104, nb = r % 104; tr_item(w_in, DIN, (h16*)(args.ws + W_IN_T), 1024, 64 * kb, 32 * nb, 32 * nb, scr, lane); continue; } r -= I_IN;
                if (r < I_BA) { const int kb = r / 32, nb = r % 32; tr_item(w_br_attn, D, (h16*)(args.ws + W_BA_T), 512, 64 * kb, 32 * nb, 32 * nb, scr, lane); continue; } r -= I_BA;
                if (r < I_OUT) { const int kb = r / 32, nb = r % 32; tr_item(w_out, D, (h16*)(args.ws + W_OUT_T), 1024, 64 * kb, 32 * nb, 32 * nb, scr, lane); continue; } r -= I_OUT;
                if (r < 2 * I_SG) { const int up = r / I_SG, q = r % I_SG, kb = q / 8, nb = q % 8, n0 = 32 * nb; tr_item(up ? w_su : w_sg, FF, (h16*)(args.ws + W_SGU_T), 1024, 64 * kb, n0, 256 * (n0 >> 7) + (n0 & 127) + 128 * up, scr, lane); continue; } r -= 2 * I_SG;
                if (r < I_SD) { const int kb = r / 32, nb = r % 32; tr_item(w_sd, D, (h16*)(args.ws + W_SD_T), 256, 64 * kb, 32 * nb, 32 * nb, scr, lane); continue; } r -= I_SD;
                if (r < 2 * I_EG) { const int up = r / I_EG, q = r % I_EG, e = q / 128, q2 = q % 128, kb = q2 / 8, nb = q2 % 8, n0 = 32 * nb;
                    tr_item((up ? w_eu : w_eg) + (size_t)e * D * FF, FF, (h16*)(args.ws + W_EGU_T) + (size_t)e * 512 * 1024, 1024, 64 * kb, n0, 256 * (n0 >> 7) + (n0 & 127) + 128 * up, scr, lane); continue; } r -= 2 * I_EG;
                if (r < I_ED) { const int e = r / 128, q2 = r % 128, kb = q2 / 32, nb = q2 % 32; tr_item(w_ed + (size_t)e * FF * D, D, (h16*)(args.ws + W_ED_T) + (size_t)e * 1024 * 256, 256, 64 * kb, 32 * nb, 32 * nb, scr, lane); continue; } r -= I_ED;
                { const int kb = r / 2, nb = r % 2; tr_item_hilo(w_router, NE, (h16*)(args.ws + W_R_T), 1024, 64 * kb, 32 * nb, scr, lane); }
            }
            { h16* wpe = (h16*)(args.ws + W_PE_T); const float* w_pool = L_W_POOL; const float* pool_scale = L_PSCALE; const float* w_br_pool = L_W_BRP;
              for (int idx = F.gw; idx < 512 * 16; idx += F.NGW) { const int cg = idx >> 4, n = ((idx & 15) << 6) + lane, g = cg >> 7; float s = 0.f;
                  const float* wp = w_pool + (size_t)cg * 128; const float* ps = pool_scale + 128 * g; const float* wb = w_br_pool + (size_t)(128 * g) * D + n;
#pragma unroll 16
                  for (int d = 0; d < 128; ++d) s += wp[d] * ps[d] * wb[(size_t)d * D];
                  wpe[(size_t)n * 512 + cg] = (h16)f2h(s); } }
            if (l == 0) {
                for (int m = F.gw; m < T; m += F.NGW) { f32x4 v[4];
#pragma unroll
                    for (int j = 0; j < 4; ++j) v[j] = *(const f32x4*)(args.in[0] + (size_t)m * D + 4 * lane + 256 * j);
                    ln_store(v, args.in[1], args.in[2], X32 + (size_t)m * D, XB + (size_t)m * D, lane); }
            }
            GRID_BAR();
        }
        if (IN(pb + 1)) {
            PHASE_REGS
            SchedDense S; S.o.init(T, DIN, F.G, bx); S.a = (const char*)XB; S.b = (const char*)(args.ws + W_IN_T); S.apitch = 2048; S.bpitch = 2048;
            EpiInProj E{HH, L_B_IN};
            GEMM_PHASE(1024, S, E);
            GRID_BAR();
        }
        if (IN(pb + 2)) {
            PHASE_REGS
            for (int it = F.gw; it < 4 * (T / 4); it += F.NGW) { const int g = it & 3, t = (it >> 2) * 4 + (lane >> 4), c8 = 16 * g + (lane & 15);
                if (g == 0) pool_item<2>(HH, PD, g, t, c8); else if (g == 1) pool_item<4>(HH, PD, g, t, c8); else if (g == 2) pool_item<8>(HH, PD, g, t, c8); else pool_item<16>(HH, PD, g, t, c8); }
            for (int U = vcu; U < NB * 16 * 2; U += F.G) attn_unit(F.lds, HH, L_SINKS, U >> 5, (U >> 1) & 15, U & 1, tid);
            GRID_BAR();
        }
        if (IN(pb + 3)) {
            PHASE_REGS
            SchedMerged S; S.o.init(T, D, F.G, bx); S.pd = (const char*)PD; S.oo = (const char*)(HH + C_Q); S.wpe = (const char*)(args.ws + W_PE_T); S.wba = (const char*)(args.ws + W_BA_T);
            EpiMerged E{MG, HH};
            GEMM_PHASE(512, S, E);
            GRID_BAR();
        }
        if (IN(pb + 4)) {
            PHASE_REGS
            SchedDense S; S.o.init(T, D, F.G, bx); S.a = (const char*)MG; S.b = (const char*)(args.ws + W_OUT_T); S.apitch = 2048; S.bpitch = 2048;
            EpiResid E{X32};
            GEMM_PHASE(1024, S, E);
            GRID_BAR();
        }
        if (IN(pb + 5)) {
            PHASE_REGS
            for (int m = F.gw; m < T; m += F.NGW) { f32x4 v[4];
#pragma unroll
                for (int j = 0; j < 4; ++j) v[j] = *(const f32x4*)(X32 + (size_t)m * D + 4 * lane + 256 * j);
                ln_store(v, L_LN1G, L_LN1B, X32 + (size_t)m * D, XB + (size_t)m * D, lane); }
            GRID_BAR();
        }
        if (IN(pb + 6)) {
            PHASE_REGS
            SchedSharedRouter S{F.G, vcu, (const char*)XB, (const char*)(args.ws + W_SGU_T), (const char*)(args.ws + W_R_T)};
            EpiSharedRouter E{HS, LOGIT};
            GEMM_PHASE(1024, S, E);
            GRID_BAR();
        }
        if (IN(pb + 7)) {
            PHASE_REGS
            LAS int* lcnt = (LAS int*)(F.lds);
            const float rb = L_RBIAS[lane];
            for (int w = vcu; w < 256; w += F.G) {
                int mycnt = 0; const int t0 = w * 128 + F.wave * 16;
                for (int tt = 0; tt < 16; ++tt) { const int t = t0 + tt;
                    const float lg = LOGIT[(size_t)t * NE + lane]; const float scv = 1.0f / (1.0f + __expf(-lg)); const float bs = scv + rb;
                    float m1 = bs; m1 = fmaxf(m1, __shfl_xor(m1, 1)); m1 = fmaxf(m1, __shfl_xor(m1, 2)); m1 = fmaxf(m1, __shfl_xor(m1, 4));
                    const unsigned long long eq = __ballot(bs == m1); const int g = lane >> 3; const unsigned gm = (unsigned)(eq >> (8 * g)) & 0xffu; const int first = __builtin_ctz(gm);
                    float m2 = ((lane & 7) == first) ? -INFINITY : bs; m2 = fmaxf(m2, __shfl_xor(m2, 1)); m2 = fmaxf(m2, __shfl_xor(m2, 2)); m2 = fmaxf(m2, __shfl_xor(m2, 4));
                    const float gs = m1 + m2; int grank = 0;
#pragma unroll
                    for (int j = 0; j < 8; ++j) { const float gj = __shfl(gs, 8 * j); grank += (gj > gs || (gj == gs && j < g)) ? 1 : 0; }
                    const bool keep = grank < 4; const float v = keep ? bs : -INFINITY; int rank = 0;
                    for (int j = 0; j < 64; ++j) { const float vj = __shfl(v, j); rank += (vj > v || (vj == v && j < lane)) ? 1 : 0; }
                    const bool sel = keep && rank < 8;
                    const float ssum = wave_sum(sel ? scv : 0.f);
                    if (sel) { ESEL[t * 8 + rank] = lane; GATE[t * 8 + rank] = scv / ssum * 2.5f; RANKL[t * 8 + rank] = mycnt; mycnt++; }
                }
                WCNT[(size_t)(w * 8 + F.wave) * 64 + lane] = mycnt;
                lcnt[F.wave * 64 + lane] = mycnt;
                __syncthreads();
                if (F.wave == 0) { int s = 0;
#pragma unroll
                    for (int v = 0; v < 8; ++v) s += lcnt[v * 64 + lane];
                    GTOT[w * 64 + lane] = s; }
                __syncthreads();
            }
            GRID_BAR();
        }
        if (IN(pb + 8)) {
            PHASE_REGS
            for (int w = vcu; w < 256; w += F.G) {
                int tot = 0, before = 0;
#pragma unroll 16
                for (int w2 = 0; w2 < 256; ++w2) { const int c = GTOT[w2 * 64 + lane]; tot += c; before += (w2 < w) ? c : 0; }
                for (int v2 = 0; v2 < F.wave; ++v2) before += WCNT[(size_t)(w * 8 + v2) * 64 + lane];
                const int pc = (tot + 255) & ~255; int incl = pc;
#pragma unroll
                for (int o = 1; o < 64; o <<= 1) { const int xv = __shfl_up(incl, o); if (lane >= o) incl += xv; }
                const int pstart = incl - pc, base = pstart + before; const int t0 = w * 128 + F.wave * 16;
#pragma unroll
                for (int it = 0; it < 2; ++it) { const int idx = it * 64 + lane, tt = t0 + (idx >> 3), k = idx & 7; const int e = ESEL[tt * 8 + k], r = RANKL[tt * 8 + k]; const float g = GATE[tt * 8 + k];
                    const int dest = __shfl(base, e) + r; TOKL[dest] = tt; GATL[dest] = g; SLOT[tt * 8 + k] = dest; }
                if (w == 0 && F.wave == 0) {
                    for (int e = 0; e < 64; ++e) { const int ps_ = __shfl(pstart, e), te = __shfl(tot, e), pe = __shfl(pc, e);
                        for (int i2 = te + lane; i2 < pe; i2 += 64) { TOKL[ps_ + i2] = 0; GATL[ps_ + i2] = 0.f; } } }
                if (w == 0 && F.wave == 1) {
                    const int nblk = __shfl(incl, 63) >> 8;
                    for (int rbk = lane; rbk < nblk; rbk += 64) { int cnt = 0;
                        for (int e = 0; e < 64; ++e) { const int pend = __shfl(incl, e); cnt += (pend <= rbk * 256) ? 1 : 0; }
                        BLKE[rbk] = cnt < 63 ? cnt : 63; }
                    if (lane == 0) BLKE[NBLK_MAX] = nblk; }
            }
            GRID_BAR();
        }
        if (IN(pb + 9)) {
            PHASE_REGS
            const int nblk = __builtin_amdgcn_readfirstlane(BLKE[NBLK_MAX]);
            SchedMoeGU S{F.G, vcu, nblk, (const char*)XB, (const char*)(args.ws + W_EGU_T), BLKE, TOKL};
            EpiMoeGU E{HB, GATL};
            GEMM_PHASE(1024, S, E);
            GRID_BAR();
        }
        if (IN(pb + 10)) {
            PHASE_REGS
            const int nblk = __builtin_amdgcn_readfirstlane(BLKE[NBLK_MAX]);
            SchedMoeDown S{F.G, vcu, nblk, (const char*)HB, (const char*)HS, (const char*)(args.ws + W_ED_T), (const char*)(args.ws + W_SD_T), BLKE};
            EpiMoeDown E{YD, X32};
            GEMM_PHASE(256, S, E);
            GRID_BAR();
        }
        if (IN(pb + 11)) {
            PHASE_REGS
            for (int m = F.gw; m < T; m += F.NGW) { f32x4 v[4];
#pragma unroll
                for (int j = 0; j < 4; ++j) v[j] = *(const f32x4*)(X32 + (size_t)m * D + 4 * lane + 256 * j);
                for (int k = 0; k < 8; ++k) { const int sl = SLOT[m * 8 + k]; const h16* yp = YD + (size_t)sl * D + 4 * lane;
#pragma unroll
                    for (int j = 0; j < 4; ++j) { const u32x2 q = *(const u32x2*)(yp + 256 * j); v[j] += (f32x4){lo16(q.x), hi16(q.x), lo16(q.y), hi16(q.y)}; } }
                ln_store(v, L_LN2G, L_LN2B, X32 + (size_t)m * D, XB + (size_t)m * D, lane); }
            if (pb + 11 != DEPTH * NPH - 1) GRID_BAR();
        }
    }
#undef IN
}

extern "C" void kernel_launch(void* const* d_in, const int* in_sizes, int n_in, void* d_out, int out_size, void* d_ws, size_t ws_size, hipStream_t stream) {
    static int grid = 0;
    if (grid == 0) {
        if (n_in != 23 || out_size != T * D || ws_size < WS_END) { fprintf(stderr, "kernel_launch: unexpected shapes (n_in %d out %d ws %zu)\n", n_in, out_size, ws_size); grid = -1; return; }
        int dev = 0, cus = 0;
        if (hipGetDevice(&dev) != hipSuccess || hipDeviceGetAttribute(&cus, hipDeviceAttributeMultiprocessorCount, dev) != hipSuccess) { grid = -1; return; }
        if (hipFuncSetAttribute((const void*)fwd_kernel, hipFuncAttributeMaxDynamicSharedMemorySize, LDS_BYTES) != hipSuccess) { fprintf(stderr, "kernel_launch: hipFuncSetAttribute failed\n"); grid = -1; return; }
        int per_cu = 0;
        if (hipOccupancyMaxActiveBlocksPerMultiprocessor(&per_cu, (const void*)fwd_kernel, 512, LDS_BYTES) != hipSuccess || per_cu < 1) { fprintf(stderr, "kernel_launch: occupancy query says %d\n", per_cu); }
        (void)hipGetLastError();
        grid = cus;
    }
    if (grid < 0) return;
    (void)hipMemsetAsync((char*)d_ws + WS_CTL, 0, CTL_ZERO_BYTES, stream);
    Args a{};
    for (int i = 0; i < 23; ++i) a.in[i] = (const float*)d_in[i];
    a.out = (float*)d_out; a.ws = (unsigned char*)d_ws;
#if MK_ONE_LAUNCH
    a.ph_lo = 0; a.ph_hi = DEPTH * NPH;
    hipLaunchKernelGGL(fwd_kernel, dim3(grid), dim3(512), LDS_BYTES, stream, a);
#else
    for (int p = 0; p < DEPTH * NPH; ++p) { a.ph_lo = p; a.ph_hi = p + 1; hipLaunchKernelGGL(fwd_kernel, dim3(grid), dim3(512), LDS_BYTES, stream, a); }
#endif
}
```

```cpp
#include <hip/hip_runtime.h>
#include <stdint.h>
#include <stdio.h>

#ifndef MK_ONE_LAUNCH
#define MK_ONE_LAUNCH 1
#endif

#define GAS __attribute__((address_space(1)))
#define LAS __attribute__((address_space(3)))
typedef unsigned short h16;
typedef short h16x8 __attribute__((ext_vector_type(8)));
typedef float f32x4 __attribute__((ext_vector_type(4)));
typedef float f32x2 __attribute__((ext_vector_type(2)));
typedef unsigned u32x4 __attribute__((ext_vector_type(4)));
typedef unsigned u32x2 __attribute__((ext_vector_type(2)));

constexpr int NB = 16, SEQ = 2048, T = NB * SEQ, D = 1024, DIN = 3328, DEPTH = 4;
constexpr int C_U = 0, C_Q = 512, C_K = 1024, C_V = 1152, C_GP = 1280, C_GA = 2304;
constexpr int NE = 64, FF = 256, TOPK = 8;
constexpr int NASSIGN = T * TOPK;
constexpr int NBLK_MAX = NASSIGN / 256 + NE;
constexpr int A_PAD = NBLK_MAX * 256;
constexpr float ALPHA = 1.6817928305074290f;
constexpr float LN_EPS = 1e-5f;
constexpr int NPH = 12;

constexpr size_t MiB = 1u << 20;
constexpr size_t WS_CTL = 0, CTL_ZERO_BYTES = 1 * MiB;
constexpr size_t WS_W = 1 * MiB;
constexpr size_t W_IN_T = WS_W + 0 * MiB;
constexpr size_t W_PE_T = WS_W + 7 * MiB;
constexpr size_t W_BA_T = WS_W + 8 * MiB;
constexpr size_t W_OUT_T = WS_W + 9 * MiB;
constexpr size_t W_R_T = WS_W + 11 * MiB;
constexpr size_t W_SGU_T = WS_W + 12 * MiB;
constexpr size_t W_SD_T = WS_W + 13 * MiB;
constexpr size_t W_EGU_T = WS_W + 14 * MiB;
constexpr size_t W_ED_T = WS_W + 78 * MiB;
constexpr size_t WS_XB = 111 * MiB;
constexpr size_t WS_HB = 175 * MiB;
constexpr size_t WS_HS = 311 * MiB;
constexpr size_t WS_MISC = 327 * MiB;
constexpr size_t MS_LOGIT = WS_MISC;
constexpr size_t MS_ESEL = WS_MISC + 8 * MiB;
constexpr size_t MS_GATE = WS_MISC + 9 * MiB;
constexpr size_t MS_RANK = WS_MISC + 10 * MiB;
constexpr size_t MS_SLOT = WS_MISC + 11 * MiB;
constexpr size_t MS_TOKL = WS_MISC + 12 * MiB;
constexpr size_t MS_GATL = WS_MISC + 13 * MiB + 256 * 1024;
constexpr size_t MS_WCNT = WS_MISC + 14 * MiB + 512 * 1024;
constexpr size_t MS_GTOT = WS_MISC + 15 * MiB;
constexpr size_t MS_BLKE = WS_MISC + 15 * MiB + 256 * 1024;
constexpr size_t WS_R = 343 * MiB;
constexpr size_t R_HH = WS_R;
constexpr size_t R_PD = WS_R + 208 * MiB;
constexpr size_t R_MG = WS_R + 240 * MiB;
constexpr size_t WS_END = WS_R + 577 * MiB;
constexpr size_t W_EGU_ALT = WS_END;
constexpr size_t W_ED_ALT = WS_END + 64 * MiB;
constexpr size_t WS_END2 = WS_END + 96 * MiB;
constexpr size_t R_YS = WS_R + 296 * MiB;
constexpr int YT_DUMP = T * 9;
static_assert((size_t)A_PAD * 4 <= 1 * MiB + 256 * 1024, "toklist");
static_assert((size_t)A_PAD * 256 * 2 <= 136 * MiB, "Hbuf");
static_assert(((size_t)T * 9 + 1) * 1024 * 2 <= 577 * MiB, "Yt");

constexpr int CW_BAR = 4096;

constexpr int RING_BYTES = 131072;
constexpr int LDSCTL_OFF = RING_BYTES, MISC_OFF = LDSCTL_OFF + 320;
constexpr int LDS_BYTES = 147456;
constexpr int LDS_BLKE = LDSCTL_OFF + 1024;
constexpr int LDS_IDX = LDS_BLKE + 4352;
constexpr int LDS_OID = LDS_IDX + 2048;
static_assert(LDS_OID + 3072 <= LDS_BYTES, "LDS map");

#define RLX_AGENT __ATOMIC_RELAXED, __HIP_MEMORY_SCOPE_AGENT
__device__ __forceinline__ int lane_id() { int l; asm volatile("v_mbcnt_lo_u32_b32 %0, -1, 0\n\tv_mbcnt_hi_u32_b32 %0, -1, %0" : "=v"(l)); return l; }
typedef _Float16 f16x2 __attribute__((ext_vector_type(2)));
typedef _Float16 f16x8 __attribute__((ext_vector_type(8)));
__device__ __forceinline__ float h2f(unsigned short h) { return (float)__builtin_bit_cast(_Float16, h); }
__device__ __forceinline__ unsigned short f2h(float f) { return __builtin_bit_cast(unsigned short, (_Float16)f); }
__device__ __forceinline__ unsigned cvt_pk_h16(float lo, float hi) { f32x2 v = {lo, hi}; return __builtin_bit_cast(unsigned, __builtin_convertvector(v, f16x2)); }
__device__ __forceinline__ float lo16(unsigned w) { return (float)__builtin_bit_cast(f16x2, w)[0]; }
__device__ __forceinline__ float hi16(unsigned w) { return (float)__builtin_bit_cast(f16x2, w)[1]; }
__device__ __forceinline__ float sigmoidf_(float x) { return __builtin_amdgcn_rcpf(1.0f + __builtin_amdgcn_exp2f(-1.4426950408889634f * x)); }
template <int CTRL> __device__ __forceinline__ float dppf(float x) { return __builtin_bit_cast(float, __builtin_amdgcn_update_dpp(0, __builtin_bit_cast(int, x), CTRL, 0xf, 0xf, true)); }
__device__ __forceinline__ float rdlane(float x, int l) { return __builtin_bit_cast(float, __builtin_amdgcn_readlane(__builtin_bit_cast(int, x), l)); }
__device__ __forceinline__ float wave_sum(float v) {
    v += dppf<0xB1>(v); v += dppf<0x4E>(v); v += dppf<0x141>(v); v += dppf<0x140>(v);
    return (rdlane(v, 0) + rdlane(v, 16)) + (rdlane(v, 32) + rdlane(v, 48));
}
__device__ __forceinline__ float wave_max(float v) {
    v = fmaxf(v, dppf<0xB1>(v)); v = fmaxf(v, dppf<0x4E>(v)); v = fmaxf(v, dppf<0x141>(v)); v = fmaxf(v, dppf<0x140>(v));
    return fmaxf(fmaxf(rdlane(v, 0), rdlane(v, 16)), fmaxf(rdlane(v, 32), rdlane(v, 48)));
}
__device__ __forceinline__ float dppf_swap32(float x) { return __shfl_xor(x, 32); }
__device__ __forceinline__ float max8(float v) {
    v = fmaxf(v, dppf<0xB1>(v)); v = fmaxf(v, dppf<0x4E>(v)); return fmaxf(v, dppf<0x141>(v));
}

#define XB_TMO      128
#define XB_XCNT(j)  (256  + 64 * (j))
#define XB_XSUB(j)  (1280 + 64 * (j))
#define XB_XGEN(j)  (2304 + 64 * (j))
#define XB_TOP      3328
#define XB_TOPGEN   3392
#define XCD_BAR_WORDS 3456
#define XB_SPIN_CAP (1u << 18)
__device__ __forceinline__ unsigned xb_ld(unsigned* p)              { return __hip_atomic_load(p, __ATOMIC_RELAXED, __HIP_MEMORY_SCOPE_AGENT); }
__device__ __forceinline__ unsigned xb_add(unsigned* p, unsigned v) { return __hip_atomic_fetch_add(p, v, __ATOMIC_RELAXED, __HIP_MEMORY_SCOPE_AGENT); }
__device__ __forceinline__ unsigned xb_xcc_id() { return (unsigned)__builtin_amdgcn_s_getreg((3 << 11) | 20) & 0xFu; }
#define XB_SPIN(cond, bar) do { unsigned _sp = 0; while (cond) { __builtin_amdgcn_s_sleep(1); \
    if ((++_sp & 255u) == 0u) { if (xb_ld(&(bar)[XB_TMO])) break; if (_sp > XB_SPIN_CAP) { atomicAdd(&(bar)[XB_TMO], 1u); break; } } } } while (0)
struct XcdBarrier { unsigned* bar; unsigned x; volatile LAS unsigned* st; };
__device__ __forceinline__ XcdBarrier xcd_barrier_post(unsigned* bar, volatile LAS unsigned* st) {
    XcdBarrier b; b.bar = bar; b.x = xb_xcc_id(); b.st = st;
    if (threadIdx.x == 0) (void)xb_add(&bar[XB_XCNT(b.x)], 1u);
    return b;
}
__device__ __forceinline__ void xcd_barrier_complete(unsigned* bar, unsigned x, unsigned& nloc, unsigned& nx) {
    const unsigned G = gridDim.x * gridDim.y * gridDim.z;
    unsigned sum, cnt, mine, sp = 0u;
    for (;;) {
        sum = 0u; cnt = 0u; mine = 0u;
#pragma unroll
        for (unsigned j = 0; j < 16; ++j) { const unsigned c = xb_ld(&bar[XB_XCNT(j)]); sum += c; cnt += (c > 0u) ? 1u : 0u; mine = (j == x) ? c : mine; }
        if (sum == G) break;
        __builtin_amdgcn_s_sleep(1);
        if ((++sp & 255u) == 0u) { if (xb_ld(&bar[XB_TMO])) break; if (sp > XB_SPIN_CAP) { atomicAdd(&bar[XB_TMO], 1u); break; } }
    }
    nloc = mine > 0u ? mine : 1u; nx = cnt > 0u ? cnt : 1u;
}
__device__ __forceinline__ void xcd_barrier(const XcdBarrier& b, const int wave) {
    asm volatile("s_waitcnt vmcnt(0)" ::: "memory");
    __syncthreads();
    if (wave == 0 && lane_id() == 0) {
        unsigned* bar = b.bar;
        __builtin_amdgcn_s_waitcnt(0);
        unsigned nloc = b.st[0], nx = b.st[1];
        if (nloc == 0u) { xcd_barrier_complete(bar, b.x, nloc, nx); b.st[0] = nloc; b.st[1] = nx; }
        const unsigned old = xb_add(&bar[XB_XSUB(b.x)], 1u);
        const unsigned gen = old / nloc;
        if (old + 1u == (gen + 1u) * nloc) {
            __builtin_amdgcn_fence(__ATOMIC_RELEASE, "agent");
            asm volatile("s_waitcnt vmcnt(0)" ::: "memory");
            const unsigned og = xb_add(&bar[XB_TOP], 1u);
            const unsigned tg = og / nx;
            if (og + 1u == (tg + 1u) * nx) xb_add(&bar[XB_TOPGEN], 1u);
            else XB_SPIN(xb_ld(&bar[XB_TOPGEN]) == tg, bar);
            __builtin_amdgcn_fence(__ATOMIC_ACQUIRE, "agent");
            xb_add(&bar[XB_XGEN(b.x)], 1u);
            asm volatile("s_waitcnt vmcnt(0)" ::: "memory");
        } else {
            XB_SPIN(xb_ld(&bar[XB_XGEN(b.x)]) == gen, bar);
            __builtin_amdgcn_fence(__ATOMIC_ACQUIRE, "agent");
            asm volatile("s_waitcnt vmcnt(0)" ::: "memory");
        }
    }
    __syncthreads();
}

struct Unit {
    const char* a;
    const char* b;
    const int* ridx;
    unsigned apitch, bpitch;
    int row0;
    int col0;
    int kind;
    const int* oidx;
    const LAS int* oidl;
    int nt;
    int keep;
};
__device__ __forceinline__ int id2tok(int id) { const int t = (int)(((unsigned long long)(unsigned)id * 954437177ull) >> 33); return t < T ? t : T - 1; }
#define ACC_T f32x4 (&acc)[2][2][4][2]

template <class Epi, class Sched>
__device__ __forceinline__ void gemm_phase_simple(const int wid, const int K, const Sched& S, const Epi& E) {
    const int lane = lane_id(), tid = wid * 64 + lane; (void)tid;
    const int  wr = wid >> 2, wc = wid & 3, fr = lane & 15, fq = lane >> 4;
    Unit u;
    for (int i = 0; S.next(i, u); ++i) {
        f32x4 acc[2][2][4][2];
#pragma unroll
        for (int a = 0; a < 2; ++a)
#pragma unroll
            for (int b = 0; b < 2; ++b)
#pragma unroll
                for (int m = 0; m < 4; ++m)
#pragma unroll
                    for (int n = 0; n < 2; ++n) acc[a][b][m][n] = (f32x4){0.f, 0.f, 0.f, 0.f};
        unsigned offA[2][4], offB[2][2];
#pragma unroll
        for (int ai = 0; ai < 2; ++ai)
#pragma unroll
            for (int m = 0; m < 4; ++m) { const int r = 128 * ai + 64 * wr + 16 * m + fr; const int row = u.ridx ? id2tok(u.ridx[r]) : u.row0 + r; offA[ai][m] = (unsigned)row * u.apitch + (unsigned)fq * 16u; }
#pragma unroll
        for (int bj = 0; bj < 2; ++bj)
#pragma unroll
            for (int n = 0; n < 2; ++n) { const int wrow = 128 * bj + 32 * wc + 8 * (fr >> 2) + 4 * n + (fr & 3); offB[bj][n] = (unsigned)wrow * u.bpitch + (unsigned)fq * 16u; }
#pragma unroll 1
        for (int k0 = 0; k0 < K; k0 += 32) {
            h16x8 b[2][2];
#pragma unroll
            for (int bj = 0; bj < 2; ++bj)
#pragma unroll
                for (int n = 0; n < 2; ++n) b[bj][n] = *(const h16x8*)(u.b + offB[bj][n] + (size_t)k0 * 2);
#pragma unroll
            for (int ai = 0; ai < 2; ++ai) {
                h16x8 a[4];
#pragma unroll
                for (int m = 0; m < 4; ++m) a[m] = *(const h16x8*)(u.a + offA[ai][m] + (size_t)k0 * 2);
#pragma unroll
                for (int bj = 0; bj < 2; ++bj)
#pragma unroll
                    for (int m = 0; m < 4; ++m)
#pragma unroll
                        for (int n = 0; n < 2; ++n) acc[ai][bj][m][n] = __builtin_amdgcn_mfma_f32_16x16x32_f16(__builtin_bit_cast(f16x8, b[bj][n]), __builtin_bit_cast(f16x8, a[m]), acc[ai][bj][m][n], 0, 0, 0);
                asm volatile("" ::: "memory");
            }
        }
        u.oidl = nullptr;
        E(acc, u, wr, wc, fr, fq);
    }
}


#ifndef FAST_GEMM
#define FAST_GEMM 1
#endif
constexpr int HTB = 128 * 64 * 2;
__device__ __forceinline__ int lds_byte(int r, int c) { const int st = (r >> 4) * 2 + (c >> 5), rr = r & 15, cc = c & 31, ob = rr * 64 + cc * 2; return st * 1024 + (ob ^ (((ob >> 9) & 1) << 5)); }
__device__ __forceinline__ void stage_rc(int b, int& R, int& C) { const int st = b / 1024, sb = b % 1024, swz = sb ^ (((sb >> 9) & 1) << 5); R = (st >> 1) * 16 + swz / 64; C = (st & 1) * 32 + (swz % 64) / 2; }
__device__ __forceinline__ int perm32(int rho) { const int n = rho >> 4, i = rho & 15; return 8 * (i >> 2) + 4 * n + (i & 3); }

__device__ __forceinline__ const char* uptr(const char* p) { const unsigned long long v = (unsigned long long)p; const unsigned lo = __builtin_amdgcn_readfirstlane((unsigned)v), hi = __builtin_amdgcn_readfirstlane((unsigned)(v >> 32)); return (const char*)(((unsigned long long)hi << 32) | lo); }
template <class Epi, class Sched>
__device__ __forceinline__ void gemm_phase(LAS unsigned char* lds, const int wid, const int K, const Sched& S, const Epi& E) {
    const int lane = lane_id(), tid = wid * 64 + lane;
    const int  wr = wid >> 2, wc = wid & 3, fr = lane & 15, fq = lane >> 4;
    int nt = K / 64;
    const unsigned ldsw = (unsigned)wid * 1024u;
    const int aoff = lds_byte(wr * 64 + fr, fq * 8), boff = lds_byte(wc * 32 + fr, fq * 8);
#define G_SA(b, h) (((b) * 2 + (h)) * HTB)
#define G_SB(b, h) ((4 + (b) * 2 + (h)) * HTB)
#define G_STAGE(bufoff, gbase, o0, o1) do { \
        __builtin_amdgcn_global_load_lds((const unsigned*)((const char*)(gbase) + (o0)), (LAS unsigned*)(lds + (bufoff) + ldsw), 16, 0, 0); \
        __builtin_amdgcn_global_load_lds((const unsigned*)((const char*)(gbase) + (o1)), (LAS unsigned*)(lds + (bufoff) + ldsw + 8192), 16, 0, 0); } while (0)
#define G_LDA(dst, b, h) do { _Pragma("unroll") for (int m = 0; m < 4; ++m) _Pragma("unroll") for (int k = 0; k < 2; ++k) dst[m][k] = *(const LAS h16x8*)(lds + G_SA(b, h) + aoff + m * 2048 + k * 1024); } while (0)
#define G_LDB(dst, b, h) do { _Pragma("unroll") for (int n = 0; n < 2; ++n) _Pragma("unroll") for (int k = 0; k < 2; ++k) dst[n][k] = *(const LAS h16x8*)(lds + G_SB(b, h) + boff + n * 2048 + k * 1024); } while (0)
#define G_MMA(ai, bj, At, Bt) do { __builtin_amdgcn_s_setprio(1); _Pragma("unroll") for (int m = 0; m < 4; ++m) _Pragma("unroll") for (int n = 0; n < 2; ++n) _Pragma("unroll") for (int k = 0; k < 2; ++k) \
        acc[ai][bj][m][n] = __builtin_amdgcn_mfma_f32_16x16x32_f16(__builtin_bit_cast(f16x8, Bt[n][k]), __builtin_bit_cast(f16x8, At[m][k]), acc[ai][bj][m][n], 0, 0, 0); __builtin_amdgcn_s_setprio(0); } while (0)
#define G_WAIT_V(n) asm volatile("s_waitcnt vmcnt(" #n ")" ::: "memory")
#define G_WAIT_L(n) asm volatile("s_waitcnt lgkmcnt(" #n ")" ::: "memory")
#define G_BAR __builtin_amdgcn_s_barrier()
#define G_SCHED __builtin_amdgcn_sched_barrier(0)
#define G_OFFS(u, OA, OB, IDXB) do { int tl_ = wid * 64 + lane_id(); _Pragma("unroll") for (int i = 0; i < 2; ++i) { int R_, C_; stage_rc(tl_ * 16 + i * 8192, R_, C_); const int Rb_ = (R_ & ~31) + perm32(R_ & 31); \
        _Pragma("unroll") for (int h = 0; h < 2; ++h) { const int r_ = h * 128 + R_; const int row_ = (u).ridx ? id2tok(((const LAS int*)(lds + LDS_IDX + (IDXB) * 1024))[r_]) : (u).row0 + r_; \
        OA[h][i] = (unsigned)row_ * (u).apitch + (unsigned)C_ * 2u; OB[h][i] = (unsigned)(h * 128 + Rb_) * (u).bpitch + (unsigned)C_ * 2u; } } } while (0)
#define G_IDX_DMA(u, IDXB, OIDB) do { if ((u).ridx && wid < 4) __builtin_amdgcn_global_load_lds((const unsigned*)((u).ridx + wid * 64 + lane), (LAS unsigned*)(lds + LDS_IDX + (IDXB) * 1024 + wid * 256), 4, 0, 0); \
        if ((u).oidx && wid < 4) __builtin_amdgcn_global_load_lds((const unsigned*)((u).oidx + wid * 64 + lane), (LAS unsigned*)(lds + LDS_OID + (OIDB) * 1024 + wid * 256), 4, 0, 0); } while (0)
    Unit cur, nxt; int ui = 0;
    if (!S.next(0, cur)) return;
    if constexpr (Sched::DYN) nt = cur.nt;
    unsigned cOA[2][2], cOB[2][2];
    G_IDX_DMA(cur, 0, 0); asm volatile("s_waitcnt vmcnt(0)" ::: "memory"); __builtin_amdgcn_s_barrier(); asm volatile("" ::: "memory");
    G_OFFS(cur, cOA, cOB, 0);
    f32x4 acc[2][2][4][2];
#pragma unroll
    for (int a = 0; a < 2; ++a)
#pragma unroll
        for (int b = 0; b < 2; ++b)
#pragma unroll
            for (int m = 0; m < 4; ++m)
#pragma unroll
                for (int n = 0; n < 2; ++n) acc[a][b][m][n] = (f32x4){0.f, 0.f, 0.f, 0.f};
    h16x8 At[4][2], B0[2][2], B1[2][2];
    const char* cA = uptr(cur.a); const char* cB = uptr(cur.b);
    G_STAGE(G_SB(0, 0), cB, cOB[0][0], cOB[0][1]); G_STAGE(G_SB(0, 1), cB, cOB[1][0], cOB[1][1]); G_STAGE(G_SA(0, 0), cA, cOA[0][0], cOA[0][1]); G_STAGE(G_SA(0, 1), cA, cOA[1][0], cOA[1][1]);
    if (wr == 1) G_BAR;
    G_WAIT_V(2); G_BAR;
    { const char* cA1 = uptr(cA + 128); const char* cB1 = uptr(cB + 128);
      G_STAGE(G_SB(1, 0), cB1, cOB[0][0], cOB[0][1]); G_STAGE(G_SA(1, 0), cA1, cOA[0][0], cOA[0][1]); G_STAGE(G_SB(1, 1), cB1, cOB[1][0], cOB[1][1]); }
    G_WAIT_V(6); G_BAR;
    for (;;) {
        const bool has_next = S.next(ui + 1, nxt); const char* nA = cA; const char* nB = cB;
        if (has_next) G_IDX_DMA(nxt, (ui + 1) & 1, (ui + 1) % 3);
#pragma unroll 1
        for (int t = 0; t < nt; t += 2) {
            const bool last = (t == nt - 2);
            const char* a1 = uptr(cA + (size_t)(t + 1) * 128);
            G_LDB(B0, 0, 0); G_LDB(B1, 0, 1); G_SCHED; G_LDA(At, 0, 0); G_STAGE(G_SA(1, 1), a1, cOA[1][0], cOA[1][1]);
            G_WAIT_V(8); G_WAIT_L(0); G_BAR; G_MMA(0, 0, At, B0); G_MMA(0, 1, At, B1); G_BAR; G_SCHED;
            if (last && has_next) { nA = uptr(nxt.a); nB = uptr(nxt.b); G_OFFS(nxt, cOA, cOB, (ui + 1) & 1); }
            const char* a2 = uptr(last ? nA : cA + (size_t)(t + 2) * 128); const char* b2 = uptr(last ? nB : cB + (size_t)(t + 2) * 128);
            const char* a3 = uptr(a2 + 128); const char* b3 = uptr(b2 + 128);
            G_LDA(At, 0, 1); G_STAGE(G_SB(0, 0), b2, cOB[0][0], cOB[0][1]); G_STAGE(G_SB(0, 1), b2, cOB[1][0], cOB[1][1]); G_STAGE(G_SA(0, 0), a2, cOA[0][0], cOA[0][1]);
            G_WAIT_V(8); G_WAIT_L(0); G_BAR; G_MMA(1, 0, At, B0); G_MMA(1, 1, At, B1); G_BAR; G_SCHED;
            G_LDB(B0, 1, 0); G_LDB(B1, 1, 1); G_SCHED; G_LDA(At, 1, 0); G_STAGE(G_SA(0, 1), a2, cOA[1][0], cOA[1][1]);
            G_WAIT_V(8); G_WAIT_L(0); G_BAR; G_MMA(0, 0, At, B0); G_MMA(0, 1, At, B1); G_BAR; G_SCHED;
            G_LDA(At, 1, 1); G_STAGE(G_SB(1, 0), b3, cOB[0][0], cOB[0][1]); G_STAGE(G_SB(1, 1), b3, cOB[1][0], cOB[1][1]); G_STAGE(G_SA(1, 0), a3, cOA[0][0], cOA[0][1]);
            G_WAIT_V(8); G_WAIT_L(0); G_BAR; G_MMA(1, 0, At, B0); G_MMA(1, 1, At, B1); G_BAR; G_SCHED;
        }
        if (wr == 0) G_BAR;
        cur.oidl = (const LAS int*)(lds + LDS_OID + (ui % 3) * 1024);
        E(acc, cur, wr, wc, fr, fq);
        if (!has_next) break;
        if (!nxt.keep) {
#pragma unroll
        for (int a = 0; a < 2; ++a)
#pragma unroll
            for (int b = 0; b < 2; ++b)
#pragma unroll
                for (int m = 0; m < 4; ++m)
#pragma unroll
                    for (int n = 0; n < 2; ++n) acc[a][b][m][n] = (f32x4){0.f, 0.f, 0.f, 0.f};
        }
        cur = nxt; cA = nA; cB = nB; ++ui;
        if constexpr (Sched::DYN) nt = cur.nt;
        if (wr == 1) G_BAR;
    }
    G_WAIT_V(0);
    G_BAR;
#undef G_SA
#undef G_SB
#undef G_STAGE
#undef G_LDA
#undef G_LDB
#undef G_MMA
#undef G_WAIT_V
#undef G_WAIT_L
#undef G_BAR
#undef G_SCHED
#undef G_OFFS
#undef G_IDX_DMA
}
#if FAST_GEMM
#define GEMM_PHASE(K, S, E) gemm_phase(F.lds, F.wave, K, S, E)
#else
#define GEMM_PHASE(K, S, E) gemm_phase_simple(F.wave, K, S, E)
#endif

constexpr int NXCD = 8, WGM = 8;
struct TileOrder {
    int nM, nN, nwg, G, c;
    __device__ void init(int M, int N, int G_, int c_) { nM = M / 256; nN = N / 256; nwg = nM * nN; G = G_; c = c_; }
    __device__ bool tile(int i, int& pm, int& pn) const {
        const long L = (long)i * G + c; if (L >= nwg) return false;
        int wgid = (int)L; { const int q = nwg / NXCD, r = nwg % NXCD, xcd = wgid % NXCD, off = wgid / NXCD; wgid = (xcd < r ? xcd * (q + 1) : r * (q + 1) + (xcd - r) * q) + off; }
        const int nig = WGM * nN, gid = wgid / nig, fm = gid * WGM, gsz = (nM - fm) < WGM ? (nM - fm) : WGM;
        pm = fm + ((wgid % nig) % gsz); pn = (wgid % nig) / gsz; return true;
    }
};
struct SchedDense { static constexpr bool DYN = false;
    TileOrder o; const char* a; const char* b; unsigned apitch, bpitch;
    __device__ bool next(int i, Unit& u) const {
        int pm, pn; if (!o.tile(i, pm, pn)) return false;
        u.a = a; u.b = b + (size_t)pn * 256 * bpitch; u.ridx = nullptr; u.apitch = apitch; u.bpitch = bpitch; u.row0 = pm * 256; u.col0 = pn * 256; u.kind = 0; u.oidx = nullptr; u.keep = 0; return true;
    }
};
struct SchedMerged { static constexpr bool DYN = false;
    TileOrder o; const char* pd; const char* oo; const char* wpe; const char* wba;
    __device__ bool next(int i, Unit& u) const {
        int pm, pn; if (!o.tile(i >> 1, pm, pn)) return false;
        const int part = i & 1;
        u.a = part ? oo : pd; u.apitch = part ? DIN * 2 : 512 * 2; u.b = (part ? wba : wpe) + (size_t)pn * 256 * 1024; u.bpitch = 1024; u.ridx = nullptr; u.row0 = pm * 256; u.col0 = pn * 256; u.kind = part; u.oidx = nullptr; u.keep = part; return true;
    }
};
struct SchedSharedRouter { static constexpr bool DYN = true;
    int G, c; const char* xb; const char* wsgu; const char* wr;
    __device__ bool next(int i, Unit& u) const {
        const int L = i * G + c; if (L >= 512) return false;
        u.apitch = 2048; u.bpitch = 2048; u.ridx = nullptr; u.oidx = nullptr; u.keep = 0;
        if (L < 256) { const int pm = L >> 1, pn = L & 1; u.a = xb; u.b = wsgu + (size_t)pn * 256 * 2048; u.row0 = pm * 256; u.col0 = pn * 128; u.kind = 0; u.nt = 16; }
        else { const int pm = (L - 256) >> 1, kh = L & 1; u.a = xb + kh * 1024; u.b = wr + kh * 1024; u.row0 = pm * 256; u.col0 = kh; u.kind = 1; u.nt = 8; }
        return true;
    }
};
struct SchedMoeGU { static constexpr bool DYN = false;
    int G, c, nblk; const char* xb; const char* wegu; const LAS int* blke; const int* tokl;
    __device__ bool next(int i, Unit& u) const {
        const int L = i * G + c; if (L >= 2 * nblk) return false;
        const int rb = L >> 1, pn = L & 1, e = __builtin_amdgcn_readfirstlane(blke[rb]);
        u.a = xb; u.apitch = 2048; u.bpitch = 2048; u.b = wegu + ((size_t)e * 512 + pn * 256) * 2048; u.ridx = tokl + rb * 256; u.row0 = rb * 256; u.col0 = pn * 128; u.kind = 0; u.oidx = nullptr; u.keep = 0; return true;
    }
};
struct SchedMoeDown { static constexpr bool DYN = false;
    int G, c, nblk; const char* hb; const char* hs; const char* wed; const char* wsd; const LAS int* blke; const int* tokl;
    __device__ bool next(int i, Unit& u) const {
        const int L = i * G + c; if (L >= 4 * nblk + 512) return false;
        u.apitch = 512; u.bpitch = 512; u.ridx = nullptr;
        if (L < 4 * nblk) { const int rb = L >> 2, pn = L & 3, e = __builtin_amdgcn_readfirstlane(blke[rb]); u.a = hb; u.b = wed + ((size_t)e * 1024 + pn * 256) * 512; u.row0 = rb * 256; u.col0 = pn * 256; u.kind = 0; u.oidx = tokl + rb * 256; u.keep = 0; }
        else { const int L2 = L - 4 * nblk, pm = L2 >> 2, pn = L2 & 3; u.a = hs; u.b = wsd + (size_t)pn * 256 * 512; u.row0 = pm * 256; u.col0 = pn * 256; u.kind = 1; u.oidx = nullptr; u.keep = 0; }
        return true;
    }
};

__device__ __forceinline__ u32x4 pack8(const f32x4& v0, const f32x4& v1) { u32x4 w; w.x = cvt_pk_h16(v0[0], v0[1]); w.y = cvt_pk_h16(v0[2], v0[3]); w.z = cvt_pk_h16(v1[0], v1[1]); w.w = cvt_pk_h16(v1[2], v1[3]); return w; }
__device__ __forceinline__ void unpack8(const u32x4& w, f32x4& v0, f32x4& v1) { v0 = (f32x4){lo16(w.x), hi16(w.x), lo16(w.y), hi16(w.y)}; v1 = (f32x4){lo16(w.z), hi16(w.z), lo16(w.w), hi16(w.w)}; }
__device__ __forceinline__ f32x4 sig4(const f32x4& v) { return (f32x4){sigmoidf_(v[0]), sigmoidf_(v[1]), sigmoidf_(v[2]), sigmoidf_(v[3])}; }
__device__ __forceinline__ f32x4 swiglu4(const f32x4& g, const f32x4& u) { return (f32x4){g[0] * sigmoidf_(g[0]) * u[0], g[1] * sigmoidf_(g[1]) * u[1], g[2] * sigmoidf_(g[2]) * u[2], g[3] * sigmoidf_(g[3]) * u[3]}; }

__device__ __forceinline__ unsigned q8x4(float a, float b, float c, float d, float inv) {
    const unsigned ua = __float_as_uint(a * inv + 12582912.0f), ub = __float_as_uint(b * inv + 12582912.0f), uc = __float_as_uint(c * inv + 12582912.0f), ud = __float_as_uint(d * inv + 12582912.0f);
    const unsigned lo = __builtin_amdgcn_perm(ub, ua, 0x0c0c0400u), hi = __builtin_amdgcn_perm(ud, uc, 0x0c0c0400u);
    return __builtin_amdgcn_perm(hi, lo, 0x05040100u);
}
struct EpiInProj {
    h16* H; const float* bias;
    __device__ __forceinline__ void operator()(const ACC_T, const Unit& u, int wr, int wc, int fr, int fq) const {
        const int pn = u.col0 >> 8; const float sc = (pn == 2 || pn == 3) ? 0.125f : 1.f; const bool sg = pn >= 5;
        f32x4 bv[2][2];
#pragma unroll
        for (int bj = 0; bj < 2; ++bj)
#pragma unroll
            for (int n = 0; n < 2; ++n) bv[bj][n] = *(const f32x4*)(bias + u.col0 + 128 * bj + 32 * wc + 8 * fq + 4 * n);
#pragma unroll
        for (int ai = 0; ai < 2; ++ai)
#pragma unroll
            for (int m = 0; m < 4; ++m) { const int row = u.row0 + 128 * ai + 64 * wr + 16 * m + fr; h16* rowp = H + (size_t)row * DIN + u.col0 + 32 * wc + 8 * fq;
#pragma unroll
                for (int bj = 0; bj < 2; ++bj) { f32x4 v0 = (acc[ai][bj][m][0] + bv[bj][0]) * sc, v1 = (acc[ai][bj][m][1] + bv[bj][1]) * sc;
                    if (sg) { v0 = sig4(v0); v1 = sig4(v1);
                        u32x2 w; w.x = q8x4(v0[0], v0[1], v0[2], v0[3], 255.0f); w.y = q8x4(v1[0], v1[1], v1[2], v1[3], 255.0f);
                        *(u32x2*)((unsigned char*)(H + (size_t)row * DIN + C_GP) + (u.col0 - C_GP) + 128 * bj + 32 * wc + 8 * fq) = w; }
                    else *(u32x4*)(rowp + 128 * bj) = pack8(v0, v1); } }
    }
};
__device__ __forceinline__ void ungate8(const u32x2& w, f32x4& v0, f32x4& v1) {
    const float k = 1.0f / 255.0f;
    v0 = (f32x4){(float)(w.x & 0xffu) * k, (float)((w.x >> 8) & 0xffu) * k, (float)((w.x >> 16) & 0xffu) * k, (float)(w.x >> 24) * k};
    v1 = (f32x4){(float)(w.y & 0xffu) * k, (float)((w.y >> 8) & 0xffu) * k, (float)((w.y >> 16) & 0xffu) * k, (float)(w.y >> 24) * k};
}
struct EpiMerged {
    h16* MG; const h16* H;
    __device__ __forceinline__ void operator()(f32x4 (&acc)[2][2][4][2], const Unit& u, int wr, int wc, int fr, int fq) const {
        const int col = u.col0 + 32 * wc + 8 * fq;
#pragma unroll
        for (int ai = 0; ai < 2; ++ai) {
            u32x2 ga[4][2], gp[4][2];
#pragma unroll
            for (int m = 0; m < 4; ++m) { const int row = u.row0 + 128 * ai + 64 * wr + 16 * m + fr;
#pragma unroll
                for (int bj = 0; bj < 2; ++bj) { const unsigned char* gb = (const unsigned char*)(H + (size_t)row * DIN + C_GP) + col + 128 * bj; ga[m][bj] = *(const u32x2*)(gb + 1024); if (u.kind == 0) gp[m][bj] = *(const u32x2*)gb; } }
#pragma unroll
            for (int m = 0; m < 4; ++m) { const int row = u.row0 + 128 * ai + 64 * wr + 16 * m + fr;
#pragma unroll
                for (int bj = 0; bj < 2; ++bj) { f32x4 a0, a1; ungate8(ga[m][bj], a0, a1);
                    if (u.kind == 0) { f32x4 p0, p1; ungate8(gp[m][bj], p0, p1);
#pragma unroll
                        for (int j = 0; j < 4; ++j) { acc[ai][bj][m][0][j] *= p0[j] * __builtin_amdgcn_rcpf(fmaxf(a0[j], 6.2e-5f)); acc[ai][bj][m][1][j] *= p1[j] * __builtin_amdgcn_rcpf(fmaxf(a1[j], 6.2e-5f)); } }
                    else *(u32x4*)(MG + (size_t)row * D + col + 128 * bj) = pack8(acc[ai][bj][m][0] * a0, acc[ai][bj][m][1] * a1); } }
        }
    }
};
struct EpiResid {
    h16* S; const h16* XBp;
    __device__ __forceinline__ void operator()(const ACC_T, const Unit& u, int wr, int wc, int fr, int fq) const {
#pragma unroll
        for (int ai = 0; ai < 2; ++ai) {
            u32x4 xw[4][2];
#pragma unroll
            for (int m = 0; m < 4; ++m) { const int row = u.row0 + 128 * ai + 64 * wr + 16 * m + fr; const size_t off = (size_t)row * D + u.col0 + 32 * wc + 8 * fq;
#pragma unroll
                for (int bj = 0; bj < 2; ++bj) xw[m][bj] = *(const u32x4*)(XBp + off + 128 * bj); }
#pragma unroll
            for (int m = 0; m < 4; ++m) { const int row = u.row0 + 128 * ai + 64 * wr + 16 * m + fr; const size_t off = (size_t)row * D + u.col0 + 32 * wc + 8 * fq;
#pragma unroll
                for (int bj = 0; bj < 2; ++bj) { f32x4 x0, x1; unpack8(xw[m][bj], x0, x1);
                    *(u32x4*)(S + off + 128 * bj) = pack8(x0 * ALPHA + acc[ai][bj][m][0], x1 * ALPHA + acc[ai][bj][m][1]); } }
        }
    }
};
struct EpiSharedRouter {
    h16* HS; float* LG;
    __device__ __forceinline__ void operator()(const ACC_T, const Unit& u, int wr, int wc, int fr, int fq) const {
#pragma unroll
        for (int ai = 0; ai < 2; ++ai)
#pragma unroll
            for (int m = 0; m < 4; ++m) { const int row = u.row0 + 128 * ai + 64 * wr + 16 * m + fr;
                if (u.kind == 0) { *(u32x4*)(HS + (size_t)row * FF + u.col0 + 32 * wc + 8 * fq) = pack8(swiglu4(acc[ai][0][m][0], acc[ai][1][m][0]), swiglu4(acc[ai][0][m][1], acc[ai][1][m][1])); }
                else if (wc < 2) {
#pragma unroll
                    for (int n = 0; n < 2; ++n) *(f32x4*)(LG + (size_t)u.col0 * T * NE + (size_t)row * NE + 32 * wc + 8 * fq + 4 * n) = acc[ai][0][m][n] + acc[ai][1][m][n]; } }
    }
};
struct EpiMoeGU {
    h16* HB; const float* gatl;
    __device__ __forceinline__ void operator()(const ACC_T, const Unit& u, int wr, int wc, int fr, int fq) const {
        float g[2][4];
#pragma unroll
        for (int ai = 0; ai < 2; ++ai)
#pragma unroll
            for (int m = 0; m < 4; ++m) g[ai][m] = gatl[u.row0 + 128 * ai + 64 * wr + 16 * m + fr];
#pragma unroll
        for (int ai = 0; ai < 2; ++ai)
#pragma unroll
            for (int m = 0; m < 4; ++m) { const int row = u.row0 + 128 * ai + 64 * wr + 16 * m + fr;
                *(u32x4*)(HB + (size_t)row * FF + u.col0 + 32 * wc + 8 * fq) = pack8(swiglu4(acc[ai][0][m][0], acc[ai][1][m][0]) * g[ai][m], swiglu4(acc[ai][0][m][1], acc[ai][1][m][1]) * g[ai][m]); }
    }
};
struct EpiMoeDown {
    unsigned char* YQ; h16* YS;
    __device__ __forceinline__ void operator()(const ACC_T, const Unit& u, int wr, int wc, int fr, int fq) const {
        int id[2][4];
#pragma unroll
        for (int ai = 0; ai < 2; ++ai)
#pragma unroll
            for (int m = 0; m < 4; ++m) { const int r = 128 * ai + 64 * wr + 16 * m + fr; id[ai][m] = u.kind ? (u.row0 + r) * 9 + 8 : u.oidl[r]; }
        const int grp = (u.col0 >> 8) * 16 + 4 * wc + fq;
#pragma unroll
        for (int ai = 0; ai < 2; ++ai)
#pragma unroll
            for (int m = 0; m < 4; ++m) {
                const f32x4 v0 = acc[ai][0][m][0], v1 = acc[ai][0][m][1], v2 = acc[ai][1][m][0], v3 = acc[ai][1][m][1];
                float mx = fmaxf(fmaxf(fabsf(v0[0]), fabsf(v0[1])), fmaxf(fabsf(v0[2]), fabsf(v0[3])));
                mx = fmaxf(mx, fmaxf(fmaxf(fabsf(v1[0]), fabsf(v1[1])), fmaxf(fabsf(v1[2]), fabsf(v1[3]))));
                mx = fmaxf(mx, fmaxf(fmaxf(fabsf(v2[0]), fabsf(v2[1])), fmaxf(fabsf(v2[2]), fabsf(v2[3]))));
                mx = fmaxf(mx, fmaxf(fmaxf(fabsf(v3[0]), fabsf(v3[1])), fmaxf(fabsf(v3[2]), fabsf(v3[3]))));
                const unsigned short sh = f2h(mx * (1.0f / 127.0f) * 1.0005f);
                const float scr = h2f(sh); const float inv = scr > 0.f ? __builtin_amdgcn_rcpf(scr) : 0.f;
                u32x4 w; w.x = q8x4(v0[0], v0[1], v0[2], v0[3], inv); w.y = q8x4(v1[0], v1[1], v1[2], v1[3], inv); w.z = q8x4(v2[0], v2[1], v2[2], v2[3], inv); w.w = q8x4(v3[0], v3[1], v3[2], v3[3], inv);
                *(u32x4*)(YQ + (size_t)id[ai][m] * 1024 + grp * 16) = w;
                *(unsigned short*)(YS + (size_t)id[ai][m] * 64 + grp) = sh; }
    }
};

struct Args { const float* in[23]; float* out; unsigned char* ws; int ph_lo, ph_hi; };
struct Frame {
    LAS unsigned char* lds; int wave, vcu, G, gw, NGW;
};

__device__ __forceinline__ void ln_store(f32x4 (&v)[4], const float* gam, const float* bet, float* o32, h16* o16, int lane) {
    float s = 0.f;
#pragma unroll
    for (int j = 0; j < 4; ++j) s += (v[j].x + v[j].y) + (v[j].z + v[j].w);
    const float mean = wave_sum(s) * (1.f / D); float s2 = 0.f;
#pragma unroll
    for (int j = 0; j < 4; ++j) { v[j] = v[j] - mean; s2 += (v[j].x * v[j].x + v[j].y * v[j].y) + (v[j].z * v[j].z + v[j].w * v[j].w); }
    const float rstd = 1.f / sqrtf(wave_sum(s2) * (1.f / D) + LN_EPS);
#pragma unroll
    for (int j = 0; j < 4; ++j) { const f32x4 g = *(const f32x4*)(gam + 4 * lane + 256 * j), b = *(const f32x4*)(bet + 4 * lane + 256 * j); const f32x4 y = v[j] * rstd * g + b;
        *(f32x4*)(o32 + 4 * lane + 256 * j) = y; u32x2 w; w.x = cvt_pk_h16(y[0], y[1]); w.y = cvt_pk_h16(y[2], y[3]); *(u32x2*)(o16 + 4 * lane + 256 * j) = w; }
}


__device__ __forceinline__ void ln_store8(f32x4 (&v)[4], const float* gam, const float* bet, float* o32, h16* o16, int lane, int c0 = -1, int c1 = -1) {
    if (c0 < 0) { c0 = 8 * lane; c1 = 512 + 8 * lane; }
    float s = 0.f;
#pragma unroll
    for (int j = 0; j < 4; ++j) s += (v[j].x + v[j].y) + (v[j].z + v[j].w);
    const float mean = wave_sum(s) * (1.f / D); float s2 = 0.f;
#pragma unroll
    for (int j = 0; j < 4; ++j) { v[j] = v[j] - mean; s2 += (v[j].x * v[j].x + v[j].y * v[j].y) + (v[j].z * v[j].z + v[j].w * v[j].w); }
    const float rstd = 1.f / sqrtf(wave_sum(s2) * (1.f / D) + LN_EPS);
    f32x4 y[4];
#pragma unroll
    for (int j = 0; j < 4; ++j) { const int c = ((j >> 1) ? c1 : c0) + 4 * (j & 1); const f32x4 g = *(const f32x4*)(gam + c), b = *(const f32x4*)(bet + c); y[j] = v[j] * rstd * g + b; if (o32) *(f32x4*)(o32 + c) = y[j]; }
    *(u32x4*)(o16 + c0) = pack8(y[0], y[1]); *(u32x4*)(o16 + c1) = pack8(y[2], y[3]);
}
__device__ __forceinline__ void tr_item(const float* W, int N, h16* WT, int ldt, int k0, int n0, int drow0, LAS float* scr, int lane) {
    float tv[32];
#pragma unroll
    for (int i = 0; i < 32; ++i) { const int kk = 2 * i + (lane >> 5); tv[i] = __builtin_nontemporal_load(W + (size_t)(k0 + kk) * N + n0 + (lane & 31)); }
#pragma unroll
    for (int i = 0; i < 32; ++i) { const int kk = 2 * i + (lane >> 5); scr[kk * 33 + (lane & 31)] = tv[i]; }
    asm volatile("s_waitcnt lgkmcnt(0)" ::: "memory");
    const int c = lane & 7;
#pragma unroll
    for (int j = 0; j < 4; ++j) { const int n = (lane >> 3) + 8 * j; const LAS float* s = scr + (8 * c) * 33 + n;
        u32x4 o; o.x = cvt_pk_h16(s[0 * 33], s[1 * 33]); o.y = cvt_pk_h16(s[2 * 33], s[3 * 33]); o.z = cvt_pk_h16(s[4 * 33], s[5 * 33]); o.w = cvt_pk_h16(s[6 * 33], s[7 * 33]);
        *(u32x4*)(WT + (size_t)(drow0 + n) * ldt + k0 + 8 * c) = o; }
    asm volatile("s_waitcnt lgkmcnt(0)" ::: "memory");
}
__device__ __forceinline__ void tr_item_hilo(const float* W, int N, h16* WT, int ldt, int k0, int n0, LAS float* scr, int lane) {
    float tv[32];
#pragma unroll
    for (int i = 0; i < 32; ++i) { const int kk = 2 * i + (lane >> 5); tv[i] = __builtin_nontemporal_load(W + (size_t)(k0 + kk) * N + n0 + (lane & 31)); }
#pragma unroll
    for (int i = 0; i < 32; ++i) { const int kk = 2 * i + (lane >> 5); scr[kk * 33 + (lane & 31)] = tv[i]; }
    asm volatile("s_waitcnt lgkmcnt(0)" ::: "memory");
    const int c = lane & 7;
#pragma unroll
    for (int j = 0; j < 4; ++j) { const int n = (lane >> 3) + 8 * j; const LAS float* s = scr + (8 * c) * 33 + n;
        float v[8], r[8];
#pragma unroll
        for (int q = 0; q < 8; ++q) { v[q] = s[q * 33]; r[q] = v[q] - h2f(f2h(v[q])); }
        u32x4 o; o.x = cvt_pk_h16(v[0], v[1]); o.y = cvt_pk_h16(v[2], v[3]); o.z = cvt_pk_h16(v[4], v[5]); o.w = cvt_pk_h16(v[6], v[7]);
        *(u32x4*)(WT + (size_t)(n0 + n) * ldt + k0 + 8 * c) = o;
        o.x = cvt_pk_h16(r[0], r[1]); o.y = cvt_pk_h16(r[2], r[3]); o.z = cvt_pk_h16(r[4], r[5]); o.w = cvt_pk_h16(r[6], r[7]);
        *(u32x4*)(WT + (size_t)(128 + n0 + n) * ldt + k0 + 8 * c) = o; }
    asm volatile("s_waitcnt lgkmcnt(0)" ::: "memory");
}


typedef float f32x16 __attribute__((ext_vector_type(16)));
constexpr int AT_KP = 144, AT_VP = 528, AT_VOFF = 256 * AT_KP;
__device__ __forceinline__ int crow(int r, int hi) { return (r & 3) + 8 * (r >> 2) + 4 * hi; }
struct KVRegs { u32x4 k[4], v[4]; };
__device__ __forceinline__ void attn_load_kv(const h16* HHp, const int b, const int n, const int hk, const int tid, KVRegs& r) {
    const int tb = b * SEQ + n * 128;
#pragma unroll
    for (int i = 0; i < 4; ++i) { const int idx = tid + 512 * i, key = idx >> 3, ch = idx & 7; const int tok = (n > 0) ? tb - 128 + key : tb + (key & 127);
        const h16* kp = HHp + (size_t)tok * DIN + C_K + hk * 64 + ch * 8; r.k[i] = *(const u32x4*)kp; r.v[i] = *(const u32x4*)(kp + 128); }
}
__device__ __forceinline__ void attn_unit(LAS unsigned char* lds, h16* HHp, h16* OUTp, const int opitch, const float* sinks, const int b, const int n, const int hk, const int tid,
                                          const int unused_ = 0) {
    const int lane = tid & 63, wid = __builtin_amdgcn_readfirstlane(tid >> 6), q32 = lane & 31, hi = lane >> 5;
    const int g = wid >> 1, qh = wid & 1, hq = hk * 4 + g;
    const int tb = b * SEQ + n * 128;
    LAS unsigned char* Ks = lds; LAS unsigned char* Vs = lds + AT_VOFF;
    KVRegs cur; attn_load_kv(HHp, b, n, hk, tid, cur);
    f16x8 qs[4];
    { const h16* qp = HHp + (size_t)(tb + 64 * qh + q32) * DIN + C_Q + hq * 64;
#pragma unroll
      for (int ks = 0; ks < 4; ++ks) qs[ks] = *(const f16x8*)(qp + 16 * ks + 8 * hi); }
#pragma unroll
    for (int i = 0; i < 4; ++i) { const int idx = tid + 512 * i, key = idx >> 3, ch = idx & 7; const u32x4 kw = cur.k[i], vw = cur.v[i];
        *(LAS u32x4*)(Ks + key * AT_KP + ch * 16) = kw;
        LAS unsigned short* vd = (LAS unsigned short*)(Vs + (ch * 8) * AT_VP + key * 2);
        vd[0 * (AT_VP / 2)] = (unsigned short)(vw.x & 0xffffu); vd[1 * (AT_VP / 2)] = (unsigned short)(vw.x >> 16); vd[2 * (AT_VP / 2)] = (unsigned short)(vw.y & 0xffffu); vd[3 * (AT_VP / 2)] = (unsigned short)(vw.y >> 16);
        vd[4 * (AT_VP / 2)] = (unsigned short)(vw.z & 0xffffu); vd[5 * (AT_VP / 2)] = (unsigned short)(vw.z >> 16); vd[6 * (AT_VP / 2)] = (unsigned short)(vw.w & 0xffffu); vd[7 * (AT_VP / 2)] = (unsigned short)(vw.w >> 16); }
    __syncthreads();
    const float slope = exp2f(-(float)(hq + 1)), sink = sinks[hq];
    float ab[16];
#pragma unroll
    for (int r = 0; r < 16; ++r) ab[r] = slope * (float)(crow(r, hi) - 128 - q32);
#pragma unroll 1
    for (int sub = 0; sub < 2; ++sub) {
        const int q0 = 64 * qh + 32 * sub, qi = q0 + q32;
        f32x16 sv[5]; float mx = -INFINITY;
#pragma unroll
        for (int j = 0; j < 5; ++j) { const int key0 = q0 + 32 * j; f32x16 c; float sl = slope; asm volatile("" : "+v"(sl)); const float aj = sl * (float)(32 * j);
#pragma unroll
            for (int r = 0; r < 16; ++r) c[r] = ab[r] + aj;
#pragma unroll
            for (int ks = 0; ks < 4; ++ks) { const f16x8 kf = *(const LAS f16x8*)(Ks + (key0 + q32) * AT_KP + (16 * ks + 8 * hi) * 2); c = __builtin_amdgcn_mfma_f32_32x32x16_f16(kf, qs[ks], c, 0, 0, 0); }
            const bool dead = (n == 0) && (key0 < 128);
            int hil = hi; asm volatile("" : "+v"(hil));
#pragma unroll
            for (int r = 0; r < 16; ++r) { float v = c[r];
                if (j == 0) v = (crow(r, hil) > q32) ? v : -INFINITY;
                if (j == 4) v = (crow(r, hil) <= q32) ? v : -INFINITY;
                if (dead) v = -INFINITY;
                c[r] = v; mx = fmaxf(mx, v); }
            sv[j] = c; __builtin_amdgcn_sched_barrier(0); }
        if (sub == 0) { const h16* qp = HHp + (size_t)(tb + 64 * qh + 32 + q32) * DIN + C_Q + hq * 64;
#pragma unroll
            for (int ks = 0; ks < 4; ++ks) qs[ks] = *(const f16x8*)(qp + 16 * ks + 8 * hi); }
        mx = fmaxf(mx, dppf_swap32(mx)); mx = fmaxf(mx, sink);
        float lsum = 0.f; f32x16 o0, o1;
#pragma unroll
        for (int r = 0; r < 16; ++r) { o0[r] = 0.f; o1[r] = 0.f; }
#pragma unroll
        for (int j = 0; j < 5; ++j) { const int key0 = q0 + 32 * j;
#pragma unroll
            for (int r = 0; r < 16; ++r) { const float pv = __expf(sv[j][r] - mx); sv[j][r] = pv; lsum += pv; }
#pragma unroll
            for (int cc = 0; cc < 2; ++cc) {
                u32x4 pw; pw.x = cvt_pk_h16(sv[j][8 * cc + 0], sv[j][8 * cc + 1]); pw.y = cvt_pk_h16(sv[j][8 * cc + 2], sv[j][8 * cc + 3]); pw.z = cvt_pk_h16(sv[j][8 * cc + 4], sv[j][8 * cc + 5]); pw.w = cvt_pk_h16(sv[j][8 * cc + 6], sv[j][8 * cc + 7]);
                const f16x8 pb = __builtin_bit_cast(f16x8, pw);
                const LAS unsigned char* vp = Vs + q32 * AT_VP + (key0 + 16 * cc + 4 * hi) * 2;
                { const u32x2 a0 = *(const LAS u32x2*)vp, a1 = *(const LAS u32x2*)(vp + 16); const u32x4 vw = {a0.x, a0.y, a1.x, a1.y}; o0 = __builtin_amdgcn_mfma_f32_32x32x16_f16(__builtin_bit_cast(f16x8, vw), pb, o0, 0, 0, 0); }
                { const u32x2 a0 = *(const LAS u32x2*)(vp + 32 * AT_VP), a1 = *(const LAS u32x2*)(vp + 32 * AT_VP + 16); const u32x4 vw = {a0.x, a0.y, a1.x, a1.y}; o1 = __builtin_amdgcn_mfma_f32_32x32x16_f16(__builtin_bit_cast(f16x8, vw), pb, o1, 0, 0, 0); }
                __builtin_amdgcn_sched_barrier(0);
            } }
        lsum += dppf_swap32(lsum); lsum += __expf(sink - mx);
        const float rl = 1.0f / lsum;
#pragma unroll
        for (int rg = 0; rg < 4; ++rg) { u32x2 w0, w1;
            w0.x = cvt_pk_h16(o0[4 * rg] * rl, o0[4 * rg + 1] * rl); w0.y = cvt_pk_h16(o0[4 * rg + 2] * rl, o0[4 * rg + 3] * rl);
            w1.x = cvt_pk_h16(o1[4 * rg] * rl, o1[4 * rg + 1] * rl); w1.y = cvt_pk_h16(o1[4 * rg + 2] * rl, o1[4 * rg + 3] * rl);
            h16* op = OUTp + (size_t)(tb + qi) * opitch + hq * 64; *(u32x2*)(op + 8 * rg + 4 * hi) = w0; *(u32x2*)(op + 32 + 8 * rg + 4 * hi) = w1; }
    }
    __syncthreads();
}
template <int W> __device__ __forceinline__ void pool_pair(const h16* HHp, h16* PDp, const int c8, const int tA, const int tB) {
    u32x4 q[2][W];
#pragma unroll
    for (int p = 0; p < 2; ++p) { const int t = p ? tB : tA; const int s = t & (SEQ - 1); const h16* up = HHp + (size_t)t * DIN + C_U + c8 * 8;
#pragma unroll
        for (int i = 0; i < W; ++i) { const int ii = (i <= s) ? i : 0; q[p][i] = *(const u32x4*)(up - (size_t)ii * DIN); } }
#pragma unroll
    for (int p = 0; p < 2; ++p) { const int t = p ? tB : tA; const int s = t & (SEQ - 1); f32x4 a0 = {0.f, 0.f, 0.f, 0.f}, a1 = {0.f, 0.f, 0.f, 0.f}, u0, u1;
#pragma unroll
        for (int i = 0; i < W; ++i) { f32x4 v0, v1; unpack8(q[p][i], v0, v1); if (i == 0) { u0 = v0; u1 = v1; } if (i <= s) { a0 += v0; a1 += v1; } }
        const float rn = 1.0f / (float)((s + 1 < W) ? s + 1 : W);
        *(u32x4*)(PDp + (size_t)t * 512 + c8 * 8) = pack8(a0 * rn - u0, a1 * rn - u1); }
}


__device__ __forceinline__ void prep_expert_items(const float* w_eg, const float* w_eu, const float* w_ed, h16* egu_t, h16* ed_t, int e_lo, int e_hi, int wrk, int nwrk, LAS float* scr, int lane) {
    for (int it = e_lo + wrk; it < e_hi; it += nwrk) {
        if (it < 2 * 8192) { const int up = it >> 13, q = it & 8191, e = q >> 7, q2 = q & 127, kb = q2 >> 3, nb = q2 & 7, n0 = 32 * nb;
            tr_item((up ? w_eu : w_eg) + (size_t)e * D * FF, FF, egu_t + (size_t)e * 512 * 1024, 1024, 64 * kb, n0, 256 * (n0 >> 7) + (n0 & 127) + 128 * up, scr, lane); }
        else { const int r = it - 2 * 8192, e = r >> 7, q2 = r & 127, kb = q2 >> 5, nb = q2 & 31; tr_item(w_ed + (size_t)e * FF * D, D, ed_t + (size_t)e * 1024 * 256, 256, 64 * kb, 32 * nb, 32 * nb, scr, lane); }
    }
}
#define W_EGU_P(lt) ((h16*)(args.ws + (((lt) & 1) ? W_EGU_ALT : W_EGU_T)))
#define W_ED_P(lt)  ((h16*)(args.ws + (((lt) & 1) ? W_ED_ALT : W_ED_T)))
#define PREP_EXPERTS(lt, e_lo, e_hi, wrk, nwrk) prep_expert_items(args.in[15] + (size_t)(lt) * NE * D * FF, args.in[16] + (size_t)(lt) * NE * D * FF, args.in[17] + (size_t)(lt) * NE * FF * D, W_EGU_P(lt), W_ED_P(lt), e_lo, e_hi, wrk, nwrk, (LAS float*)(F.lds + F.wave * 16384), lane)
constexpr int PE_A = 9830, PE_B = PE_A + 8602, PE_ALL = 3 * 8192;
#define PREP_WEIGHTS(E_LO) do { \
            LAS float* scr = (LAS float*)(F.lds + F.wave * 16384); \
            const float* w_in = L_W_IN; const float* w_br_attn = L_W_BRA; const float* w_out = L_W_OUT; const float* w_sg = L_W_SG; const float* w_su = L_W_SU; const float* w_sd = L_W_SD; \
            const float* w_eg = L_W_EG; const float* w_eu = L_W_EU; const float* w_ed = L_W_ED; const float* w_router = L_W_R; \
            constexpr int I_IN = 16 * 104, I_BA = 8 * 32, I_OUT = 16 * 32, I_SG = 16 * 8, I_SD = 4 * 32, I_EG = 64 * 128, I_ED = 64 * 128, I_R = 16 * 2; \
            constexpr int NITEMS = I_IN + I_BA + I_OUT + 2 * I_SG + I_SD + I_R; \
            for (int it = F.gw; it < NITEMS; it += F.NGW) { \
                int r = it; \
                if (r < I_IN) { const int kb = r / 104, nb = r % 104; tr_item(w_in, DIN, (h16*)(args.ws + W_IN_T), 1024, 64 * kb, 32 * nb, 32 * nb, scr, lane); continue; } r -= I_IN; \
                if (r < I_BA) { const int kb = r / 32, nb = r % 32; tr_item(w_br_attn, D, (h16*)(args.ws + W_BA_T), 512, 64 * kb, 32 * nb, 32 * nb, scr, lane); continue; } r -= I_BA; \
                if (r < I_OUT) { const int kb = r / 32, nb = r % 32; tr_item(w_out, D, (h16*)(args.ws + W_OUT_T), 1024, 64 * kb, 32 * nb, 32 * nb, scr, lane); continue; } r -= I_OUT; \
                if (r < 2 * I_SG) { const int up = r / I_SG, q = r % I_SG, kb = q / 8, nb = q % 8, n0 = 32 * nb; tr_item(up ? w_su : w_sg, FF, (h16*)(args.ws + W_SGU_T), 1024, 64 * kb, n0, 256 * (n0 >> 7) + (n0 & 127) + 128 * up, scr, lane); continue; } r -= 2 * I_SG; \
                if (r < I_SD) { const int kb = r / 32, nb = r % 32; tr_item(w_sd, D, (h16*)(args.ws + W_SD_T), 256, 64 * kb, 32 * nb, 32 * nb, scr, lane); continue; } r -= I_SD; \
                { const int kb = r / 2, nb = r % 2; tr_item_hilo(w_router, NE, (h16*)(args.ws + W_R_T), 1024, 64 * kb, 32 * nb, scr, lane); } \
            } \
            PREP_EXPERTS(l, (E_LO), PE_ALL, F.gw, F.NGW); \
            { h16* wpe = (h16*)(args.ws + W_PE_T); const float* w_pool = L_W_POOL; const float* pool_scale = L_PSCALE; const float* w_br_pool = L_W_BRP; \
              for (int idx = F.gw; idx < 512 * 16; idx += F.NGW) { const int cg = idx >> 4, n = ((idx & 15) << 6) + lane, g = cg >> 7; float s = 0.f; \
                  const float* wp = w_pool + (size_t)cg * 128; const float* ps = pool_scale + 128 * g; const float* wb = w_br_pool + (size_t)(128 * g) * D + n; \
                  float wv[128]; \
            _Pragma("unroll") \
                  for (int d = 0; d < 128; ++d) wv[d] = wb[(size_t)d * D]; \
            _Pragma("unroll") \
                  for (int d = 0; d < 128; ++d) s += wp[d] * ps[d] * wv[d]; \
                  wpe[(size_t)n * 512 + cg] = (h16)f2h(s); } } \
} while (0)
#define X32   (args.out)
#define XB    ((h16*)(args.ws + WS_XB))
#define HH    ((h16*)(args.ws + R_HH))
#define PD    ((h16*)(args.ws + R_PD))
#define MG    ((h16*)(args.ws + R_MG))
#define HB    ((h16*)(args.ws + WS_HB))
#define HS    ((h16*)(args.ws + WS_HS))
#define YD    ((h16*)(args.ws + WS_R))
#define LOGIT ((float*)(args.ws + WS_HB))
#define ESEL  ((int*)(args.ws + MS_ESEL))
#define GATE  ((float*)(args.ws + MS_GATE))
#define RANKL ((int*)(args.ws + MS_RANK))
#define SLOT  ((int*)(args.ws + MS_SLOT))
#define TOKL  ((int*)(args.ws + MS_TOKL))
#define GATL  ((float*)(args.ws + MS_GATL))
#define WCNT  ((int*)(args.ws + MS_WCNT))
#define GTOT  ((int*)(args.ws + MS_GTOT))
#define BLKE  ((int*)(args.ws + MS_BLKE))
#define L_W_IN   (args.in[3] + (size_t)l * D * DIN)
#define L_B_IN   (args.in[4] + (size_t)l * DIN)
#define L_W_POOL (args.in[5] + (size_t)l * 4 * 128 * 128)
#define L_PSCALE (args.in[6] + (size_t)l * 512)
#define L_SINKS  (args.in[7] + (size_t)l * 8)
#define L_W_BRP  (args.in[8] + (size_t)l * 512 * D)
#define L_W_BRA  (args.in[9] + (size_t)l * 512 * D)
#define L_W_OUT  (args.in[10] + (size_t)l * D * D)
#define L_LN1G   (args.in[11] + (size_t)l * D)
#define L_LN1B   (args.in[12] + (size_t)l * D)
#define L_W_R    (args.in[13] + (size_t)l * D * NE)
#define L_RBIAS  (args.in[14] + (size_t)l * NE)
#define L_W_EG   (args.in[15] + (size_t)l * NE * D * FF)
#define L_W_EU   (args.in[16] + (size_t)l * NE * D * FF)
#define L_W_ED   (args.in[17] + (size_t)l * NE * FF * D)
#define L_W_SG   (args.in[18] + (size_t)l * D * FF)
#define L_W_SU   (args.in[19] + (size_t)l * D * FF)
#define L_W_SD   (args.in[20] + (size_t)l * FF * D)
#define L_LN2G   (args.in[21] + (size_t)l * D)
#define L_LN2B   (args.in[22] + (size_t)l * D)
__global__ void __launch_bounds__(512, 2) fwd_kernel(Args args) {
    extern __shared__ __attribute__((aligned(16))) unsigned char lds_raw[];
    Frame F;
    F.lds = (LAS unsigned char*)lds_raw;
    F.wave = __builtin_amdgcn_readfirstlane((int)threadIdx.x >> 6);
    F.G = gridDim.x; { const int bx = blockIdx.x; F.vcu = (F.G % 8 == 0) ? (bx % 8) * (F.G / 8) + bx / 8 : bx; }
    F.gw = F.vcu * 8 + F.wave; F.NGW = F.G * 8;
    unsigned* ctl = (unsigned*)(args.ws + WS_CTL);
    volatile LAS unsigned* MISC = (volatile LAS unsigned*)(F.lds + MISC_OFF);
    for (int u = threadIdx.x; u < (LDS_BYTES - LDSCTL_OFF) / 4; u += 512) ((LAS unsigned*)(F.lds + LDSCTL_OFF))[u] = 0u;
    __syncthreads();
#if MK_ONE_LAUNCH
    XcdBarrier bar = xcd_barrier_post(ctl + CW_BAR, MISC + 8);
#define GRID_BAR() xcd_barrier(bar, F.wave)
#else
#define GRID_BAR() do {} while (0)
#endif
    const int lo = args.ph_lo, hi = args.ph_hi;
#ifndef PHASE_MASK
#define PHASE_MASK 0xfff
#endif
#ifndef REPEAT_MASK
#define REPEAT_MASK 0
#endif
#define REPS(p) for (int rep_ = 0; rep_ < 1 + ((REPEAT_MASK >> (p)) & 1); ++rep_)
#define IN(p) (((PHASE_MASK >> ((p) - pb)) & 1) && lo <= (p) && (p) < hi)
#define PHASE_REGS const int lane = lane_id(); const int tid = F.wave * 64 + lane; int vcu = F.vcu, bx = (int)blockIdx.x; asm volatile("" : "+s"(vcu), "+s"(bx)); (void)lane; (void)tid; (void)vcu; (void)bx;

    for (int l = 0; l < DEPTH; ++l) {
        const int pb = l * NPH;
        if (IN(pb + 0) && l == 0) {
            PHASE_REGS
            PREP_WEIGHTS(0);
            for (int m = F.gw; m < T; m += F.NGW) { f32x4 v[4];
#pragma unroll
                for (int j = 0; j < 4; ++j) v[j] = *(const f32x4*)(args.in[0] + (size_t)m * D + 8 * lane + 4 * (j & 1) + 512 * (j >> 1));
                ln_store8(v, args.in[1], args.in[2], nullptr, XB + (size_t)m * D, lane); }
            GRID_BAR();
        }
        if (IN(pb + 1)) {
            PHASE_REGS
            SchedDense S; S.o.init(T, DIN, F.G, bx); S.a = (const char*)XB; S.b = (const char*)(args.ws + W_IN_T); S.apitch = 2048; S.bpitch = 2048;
            EpiInProj E{HH, L_B_IN};
            REPS(1) GEMM_PHASE(1024, S, E);
            if (l + 1 < DEPTH && F.G == 256 && bx >= 128) PREP_EXPERTS(l + 1, 0, PE_A, (bx - 128) * 8 + F.wave, 128 * 8);
            GRID_BAR();
        }
        if (IN(pb + 2)) {
            PHASE_REGS
            { const int g = F.gw & 3, c8 = 16 * g + (lane & 15);
              for (int it = F.gw; it < T; it += 2 * F.NGW) { const int tA = (it >> 2) * 4 + (lane >> 4); const int it2 = (it + F.NGW < T) ? it + F.NGW : it; const int tB = (it2 >> 2) * 4 + (lane >> 4);
                  if (g == 0) pool_pair<2>(HH, PD, c8, tA, tB); else if (g == 1) pool_pair<4>(HH, PD, c8, tA, tB); else if (g == 2) pool_pair<8>(HH, PD, c8, tA, tB); else pool_pair<16>(HH, PD, c8, tA, tB); } }
            for (int U = vcu; U < NB * 16 * 2; U += F.G) attn_unit(F.lds, HH, HH + C_Q, DIN, L_SINKS, U >> 5, (U >> 1) & 15, U & 1, tid);
            GRID_BAR();
        }
        if (IN(pb + 3)) {
            PHASE_REGS
            SchedMerged S; S.o.init(T, D, F.G, bx); S.pd = (const char*)PD; S.oo = (const char*)(HH + C_Q); S.wpe = (const char*)(args.ws + W_PE_T); S.wba = (const char*)(args.ws + W_BA_T);
            EpiMerged E{MG, HH};
            REPS(3) GEMM_PHASE(512, S, E);
            GRID_BAR();
        }
        if (IN(pb + 4)) {
            PHASE_REGS
            SchedDense S; S.o.init(T, D, F.G, bx); S.a = (const char*)MG; S.b = (const char*)(args.ws + W_OUT_T); S.apitch = 2048; S.bpitch = 2048;
            EpiResid E{(h16*)X32, XB};
            REPS(4) GEMM_PHASE(1024, S, E);
            GRID_BAR();
        }
        if (IN(pb + 5)) {
            PHASE_REGS
            for (int m0 = F.gw; m0 < T; m0 += 4 * F.NGW) { u32x4 ra[4], rb4[4];
#pragma unroll
                for (int q = 0; q < 4; ++q) { const int m = (m0 + q * F.NGW < T) ? m0 + q * F.NGW : m0; const h16* sp = (const h16*)X32 + (size_t)m * D + 8 * lane;
                    ra[q] = __builtin_nontemporal_load((const u32x4*)sp); rb4[q] = __builtin_nontemporal_load((const u32x4*)(sp + 512)); }
#pragma unroll
                for (int q = 0; q < 4; ++q) { const int m = m0 + q * F.NGW; if (m < T) { f32x4 v[4]; unpack8(ra[q], v[0], v[1]); unpack8(rb4[q], v[2], v[3]); ln_store8(v, L_LN1G, L_LN1B, nullptr, XB + (size_t)m * D, lane); } } }
            GRID_BAR();
        }
        if (IN(pb + 6)) {
            PHASE_REGS
            SchedSharedRouter S{F.G, vcu, (const char*)XB, (const char*)(args.ws + W_SGU_T), (const char*)(args.ws + W_R_T)};
            EpiSharedRouter E{HS, LOGIT};
            REPS(6) GEMM_PHASE(1024, S, E);
            GRID_BAR();
        }
        if (IN(pb + 7)) {
            PHASE_REGS
            LAS int* lcnt = (LAS int*)(F.lds);
            const float rb = L_RBIAS[lane];
            REPS(7) for (int w = vcu; w < 256; w += F.G) {
                int mycnt = 0; const int t0 = w * 128 + F.wave * 16;
                float lgs[16];
#pragma unroll
                for (int tt = 0; tt < 16; ++tt) lgs[tt] = LOGIT[(size_t)(t0 + tt) * NE + lane] + LOGIT[(size_t)T * NE + (size_t)(t0 + tt) * NE + lane];
#pragma unroll
                for (int tt = 0; tt < 16; ++tt) { const int t = t0 + tt;
                    const float lg = lgs[tt]; const float scv = 1.0f / (1.0f + __expf(-lg)); const float bs = scv + rb;
                    const float m1 = max8(bs);
                    const unsigned long long eq = __ballot(bs == m1); const int g = lane >> 3; const unsigned gm = (unsigned)(eq >> (8 * g)) & 0xffu; const int first = __builtin_ctz(gm);
                    const float m2 = max8(((lane & 7) == first) ? -INFINITY : bs);
                    const float gs = m1 + m2; int grank = 0;
#pragma unroll
                    for (int j = 0; j < 8; ++j) { const float gj = rdlane(gs, 8 * j); grank += (gj > gs || (gj == gs && j < g)) ? 1 : 0; }
                    const bool keep = grank < 4; const float v = keep ? bs : -INFINITY; int rank = 0;
#pragma unroll
                    for (int j = 0; j < 64; ++j) { const float vj = rdlane(v, j); rank += (vj > v || (vj == v && j < lane)) ? 1 : 0; }
                    const bool sel = keep && rank < 8;
                    const float ssum = wave_sum(sel ? scv : 0.f);
                    if (sel) { ESEL[t * 8 + rank] = lane; GATE[t * 8 + rank] = scv / ssum * 2.5f; RANKL[t * 8 + rank] = mycnt; mycnt++; }
                }
                WCNT[(size_t)(w * 8 + F.wave) * 64 + lane] = mycnt;
                lcnt[F.wave * 64 + lane] = mycnt;
                __syncthreads();
                if (F.wave == 0) { int s = 0;
#pragma unroll
                    for (int v = 0; v < 8; ++v) s += lcnt[v * 64 + lane];
                    GTOT[w * 64 + lane] = s; }
                __syncthreads();
            }
            GRID_BAR();
        }
        if (IN(pb + 8)) {
            PHASE_REGS
            REPS(8) for (int w = vcu; w < 256; w += F.G) {
                int tot = 0, before = 0;
#pragma unroll 64
                for (int w2 = 0; w2 < 256; ++w2) { const int c = GTOT[w2 * 64 + lane]; tot += c; before += (w2 < w) ? c : 0; }
                for (int v2 = 0; v2 < F.wave; ++v2) before += WCNT[(size_t)(w * 8 + v2) * 64 + lane];
                const int pc = (tot + 255) & ~255; int incl = pc;
#pragma unroll
                for (int o = 1; o < 64; o <<= 1) { const int xv = __shfl_up(incl, o); if (lane >= o) incl += xv; }
                const int pstart = incl - pc, base = pstart + before; const int t0 = w * 128 + F.wave * 16;
#pragma unroll
                for (int it = 0; it < 2; ++it) { const int idx = it * 64 + lane, tt = t0 + (idx >> 3), k = idx & 7; const int e = ESEL[tt * 8 + k], r = RANKL[tt * 8 + k]; const float g = GATE[tt * 8 + k];
                    const int dest = __shfl(base, e) + r; TOKL[dest] = tt * 9 + k; GATL[dest] = g; }
                if (F.wave == 0 && w < 64) {
                    const int ps_ = __shfl(pstart, w), te = __shfl(tot, w), pe = __shfl(pc, w);
                    for (int i2 = te + lane; i2 < pe; i2 += 64) { TOKL[ps_ + i2] = YT_DUMP; GATL[ps_ + i2] = 0.f; } }
                if (F.wave == 1) {
                    const int nblk = __shfl(incl, 63) >> 8; const int rbk = 8 * w + (lane & 7); int cnt = 0;
                    for (int e = 0; e < 64; ++e) { const int pend = __shfl(incl, e); cnt += (pend <= rbk * 256) ? 1 : 0; }
                    if (lane < 8 && rbk < nblk) BLKE[rbk] = cnt < 63 ? cnt : 63;
                    if (w == 0 && lane == 0) BLKE[NBLK_MAX] = nblk; }
            }
            GRID_BAR();
        }
        if (IN(pb + 9)) {
            PHASE_REGS
            const int nblk = __builtin_amdgcn_readfirstlane(BLKE[NBLK_MAX]);
            { LAS int* bl = (LAS int*)(F.lds + LDS_BLKE); for (int i = tid; i < nblk; i += 512) bl[i] = BLKE[i]; __syncthreads(); }
            SchedMoeGU S{F.G, vcu, nblk, (const char*)XB, (const char*)W_EGU_P(l), (const LAS int*)(F.lds + LDS_BLKE), TOKL};
            EpiMoeGU E{HB, GATL};
            REPS(9) GEMM_PHASE(1024, S, E);
            { const int rounds = (2 * nblk + 255) >> 8, busy = 2 * nblk - 256 * (rounds - 1);
              if (l + 1 < DEPTH && F.G == 256 && 256 - busy >= 128 && vcu >= busy) PREP_EXPERTS(l + 1, PE_A, PE_ALL, (vcu - busy) * 8 + F.wave, (256 - busy) * 8); }
            GRID_BAR();
        }
        if (IN(pb + 10)) {
            PHASE_REGS
            const int nblk = __builtin_amdgcn_readfirstlane(BLKE[NBLK_MAX]);
            { LAS int* bl = (LAS int*)(F.lds + LDS_BLKE); for (int i = tid; i < nblk; i += 512) bl[i] = BLKE[i]; __syncthreads(); }
            SchedMoeDown S{F.G, vcu, nblk, (const char*)HB, (const char*)HS, (const char*)W_ED_P(l), (const char*)(args.ws + W_SD_T), (const LAS int*)(F.lds + LDS_BLKE), TOKL};
            REPS(10) { EpiMoeDown E{(unsigned char*)(args.ws + WS_R), (h16*)(args.ws + R_YS)};
            GEMM_PHASE(256, S, E); }
            GRID_BAR();
        }
        if (IN(pb + 11)) {
            PHASE_REGS
            { float* xo = (l == DEPTH - 1) ? X32 : nullptr;
            const unsigned char* YQ = (const unsigned char*)(args.ws + WS_R); const h16* YS = (const h16*)(args.ws + R_YS);
            const int c0 = 256 * (lane >> 4) + 32 * ((lane >> 2) & 3) + 8 * (lane & 3), c1 = c0 + 128;
            for (int m0 = F.gw; m0 < T; m0 += 3 * F.NGW) {
                u32x4 yq[3][9], xa[3], xb2[3]; unsigned short ys[3][9];
#pragma unroll
                for (int q = 0; q < 3; ++q) { const int m = (m0 + q * F.NGW < T) ? m0 + q * F.NGW : m0;
                    xa[q] = *(const u32x4*)(XB + (size_t)m * D + c0); xb2[q] = *(const u32x4*)(XB + (size_t)m * D + c1);
#pragma unroll
                    for (int k = 0; k < 9; ++k) { yq[q][k] = __builtin_nontemporal_load((const u32x4*)(YQ + ((size_t)m * 9 + k) * 1024 + lane * 16)); ys[q][k] = __builtin_nontemporal_load((const unsigned short*)(YS + ((size_t)m * 9 + k) * 64 + lane)); } }
#pragma unroll
                for (int q = 0; q < 3; ++q) { const int m = m0 + q * F.NGW; if (m < T) {
                    f32x4 v[4]; unpack8(xa[q], v[0], v[1]); unpack8(xb2[q], v[2], v[3]);
#pragma unroll
                    for (int j = 0; j < 4; ++j) v[j] = v[j] * ALPHA;
#pragma unroll
                    for (int k = 0; k < 9; ++k) { const float sc = h2f(ys[q][k]); const float bias = -128.0f * sc;
#pragma unroll
                        for (int j = 0; j < 4; ++j) { const unsigned wd = yq[q][k][j] ^ 0x80808080u;
                            v[j][0] += (float)(wd & 0xffu) * sc + bias; v[j][1] += (float)((wd >> 8) & 0xffu) * sc + bias; v[j][2] += (float)((wd >> 16) & 0xffu) * sc + bias; v[j][3] += (float)(wd >> 24) * sc + bias; } }
                    ln_store8(v, L_LN2G, L_LN2B, xo ? xo + (size_t)m * D : nullptr, XB + (size_t)m * D, lane, c0, c1); } } } }
            if (l + 1 < DEPTH) { const int nblk_ = __builtin_amdgcn_readfirstlane(BLKE[NBLK_MAX]); const int rounds_ = (2 * nblk_ + 255) >> 8, busy_ = 2 * nblk_ - 256 * (rounds_ - 1);
                const int e_lo = (F.G != 256) ? 0 : (256 - busy_ >= 128 ? PE_ALL : PE_A);
                ++l; PREP_WEIGHTS(e_lo); --l; }
            if (pb + 11 != DEPTH * NPH - 1) GRID_BAR();
        }
    }
#undef IN
}

extern "C" void kernel_launch(void* const* d_in, const int* in_sizes, int n_in, void* d_out, int out_size, void* d_ws, size_t ws_size, hipStream_t stream) {
    static int grid = 0;
    if (grid == 0) {
        if (n_in != 23 || out_size != T * D || ws_size < WS_END2) { fprintf(stderr, "kernel_launch: unexpected shapes (n_in %d out %d ws %zu)\n", n_in, out_size, ws_size); grid = -1; return; }
        int dev = 0, cus = 0;
        if (hipGetDevice(&dev) != hipSuccess || hipDeviceGetAttribute(&cus, hipDeviceAttributeMultiprocessorCount, dev) != hipSuccess) { grid = -1; return; }
        if (hipFuncSetAttribute((const void*)fwd_kernel, hipFuncAttributeMaxDynamicSharedMemorySize, LDS_BYTES) != hipSuccess) { fprintf(stderr, "kernel_launch: hipFuncSetAttribute failed\n"); grid = -1; return; }
        int per_cu = 0;
        if (hipOccupancyMaxActiveBlocksPerMultiprocessor(&per_cu, (const void*)fwd_kernel, 512, LDS_BYTES) != hipSuccess || per_cu < 1) { fprintf(stderr, "kernel_launch: occupancy query says %d\n", per_cu); }
        (void)hipGetLastError();
        grid = cus;
    }
    if (grid < 0) return;
    (void)hipMemsetAsync((char*)d_ws + WS_CTL, 0, CTL_ZERO_BYTES, stream);
    Args a{};
    for (int i = 0; i < 23; ++i) a.in[i] = (const float*)d_in[i];
    a.out = (float*)d_out; a.ws = (unsigned char*)d_ws;
#if MK_ONE_LAUNCH
    a.ph_lo = 0; a.ph_hi = DEPTH * NPH;
    hipLaunchKernelGGL(fwd_kernel, dim3(grid), dim3(512), LDS_BYTES, stream, a);
#else
    for (int p = 0; p < DEPTH * NPH; ++p) { a.ph_lo = p; a.ph_hi = p + 1; hipLaunchKernelGGL(fwd_kernel, dim3(grid), dim3(512), LDS_BYTES, stream, a); }
#endif
}
```

```cpp
#include <hip/hip_runtime.h>
#include <stdint.h>
#include <stdio.h>

#ifndef MK_ONE_LAUNCH
#define MK_ONE_LAUNCH 1
#endif

#define GAS __attribute__((address_space(1)))
#define LAS __attribute__((address_space(3)))
typedef unsigned short h16;
typedef short h16x8 __attribute__((ext_vector_type(8)));
typedef float f32x4 __attribute__((ext_vector_type(4)));
typedef float f32x2 __attribute__((ext_vector_type(2)));
typedef unsigned u32x4 __attribute__((ext_vector_type(4)));
typedef unsigned u32x2 __attribute__((ext_vector_type(2)));

constexpr int NB = 16, SEQ = 2048, T = NB * SEQ, D = 1024, DIN = 3328, DEPTH = 4;
constexpr int C_U = 0, C_Q = 512, C_K = 1024, C_V = 1152, C_GP = 1280, C_GA = 2304;
constexpr int NE = 64, FF = 256, TOPK = 8;
constexpr int NASSIGN = T * TOPK;
constexpr int NBLK_MAX = NASSIGN / 256 + NE;
constexpr int A_PAD = NBLK_MAX * 256;
constexpr float ALPHA = 1.6817928305074290f;
constexpr float LN_EPS = 1e-5f;
constexpr int NPH = 12;

constexpr size_t MiB = 1u << 20;
constexpr size_t WS_CTL = 0, CTL_ZERO_BYTES = 1 * MiB;
constexpr size_t WS_W = 1 * MiB;
constexpr size_t W_IN_T = WS_W + 0 * MiB;
constexpr size_t W_PE_T = WS_W + 7 * MiB;
constexpr size_t W_BA_T = WS_W + 8 * MiB;
constexpr size_t W_OUT_T = WS_W + 9 * MiB;
constexpr size_t W_R_T = WS_W + 11 * MiB;
constexpr size_t W_SGU_T = WS_W + 12 * MiB;
constexpr size_t W_SD_T = WS_W + 13 * MiB;
constexpr size_t W_EGU_T = WS_W + 14 * MiB;
constexpr size_t W_ED_T = WS_W + 78 * MiB;
constexpr size_t W_XB8 = W_EGU_T + 32 * MiB;
constexpr size_t WS_XB = 111 * MiB;
constexpr size_t WS_HB = 175 * MiB;
constexpr size_t WS_HS = 311 * MiB;
constexpr size_t WS_MISC = 327 * MiB;
constexpr size_t MS_LOGIT = WS_MISC;
constexpr size_t MS_ESEL = WS_MISC + 8 * MiB;
constexpr size_t MS_GATE = WS_MISC + 9 * MiB;
constexpr size_t MS_RANK = WS_MISC + 10 * MiB;
constexpr size_t MS_SLOT = WS_MISC + 11 * MiB;
constexpr size_t MS_TOKL = WS_MISC + 12 * MiB;
constexpr size_t MS_GATL = WS_MISC + 13 * MiB + 256 * 1024;
constexpr size_t MS_WCNT = WS_MISC + 14 * MiB + 512 * 1024;
constexpr size_t MS_GTOT = WS_MISC + 15 * MiB;
constexpr size_t MS_BLKE = WS_MISC + 15 * MiB + 256 * 1024;
constexpr size_t MS_WSC = WS_MISC + 15 * MiB + 512 * 1024;
constexpr size_t WS_R = 343 * MiB;
constexpr size_t R_HH = WS_R;
constexpr size_t R_PD = WS_R + 208 * MiB;
constexpr size_t R_MG = WS_R + 240 * MiB;
constexpr size_t WS_END = WS_R + 577 * MiB;
constexpr size_t W_EGU_ALT = WS_END;
constexpr size_t W_ED_ALT = WS_END + 64 * MiB;
constexpr size_t WS_END2 = WS_END + 96 * MiB;
constexpr size_t R_YS = WS_R + 296 * MiB;
constexpr int YT_DUMP = T * 9;
static_assert((size_t)A_PAD * 4 <= 1 * MiB + 256 * 1024, "toklist");
static_assert((size_t)A_PAD * 256 * 2 <= 136 * MiB, "Hbuf");
static_assert(((size_t)T * 9 + 1) * 1024 * 2 <= 577 * MiB, "Yt");

constexpr int CW_BAR = 4096;

constexpr int RING_BYTES = 131072;
constexpr int LDSCTL_OFF = RING_BYTES, MISC_OFF = LDSCTL_OFF + 320;
constexpr int LDS_BYTES = 147456;
constexpr int LDS_BLKE = LDSCTL_OFF + 1024;
constexpr int LDS_IDX = LDS_BLKE + 4352;
constexpr int LDS_OID = LDS_IDX + 2048;
static_assert(LDS_OID + 3072 <= LDS_BYTES, "LDS map");

#define RLX_AGENT __ATOMIC_RELAXED, __HIP_MEMORY_SCOPE_AGENT
__device__ __forceinline__ int lane_id() { int l; asm volatile("v_mbcnt_lo_u32_b32 %0, -1, 0\n\tv_mbcnt_hi_u32_b32 %0, -1, %0" : "=v"(l)); return l; }
typedef _Float16 f16x2 __attribute__((ext_vector_type(2)));
typedef _Float16 f16x8 __attribute__((ext_vector_type(8)));
__device__ __forceinline__ float h2f(unsigned short h) { return (float)__builtin_bit_cast(_Float16, h); }
__device__ __forceinline__ unsigned short f2h(float f) { return __builtin_bit_cast(unsigned short, (_Float16)f); }
__device__ __forceinline__ unsigned cvt_pk_h16(float lo, float hi) { f32x2 v = {lo, hi}; return __builtin_bit_cast(unsigned, __builtin_convertvector(v, f16x2)); }
__device__ __forceinline__ float lo16(unsigned w) { return (float)__builtin_bit_cast(f16x2, w)[0]; }
__device__ __forceinline__ float hi16(unsigned w) { return (float)__builtin_bit_cast(f16x2, w)[1]; }
__device__ __forceinline__ float sigmoidf_(float x) { return __builtin_amdgcn_rcpf(1.0f + __builtin_amdgcn_exp2f(-1.4426950408889634f * x)); }
template <int CTRL> __device__ __forceinline__ float dppf(float x) { return __builtin_bit_cast(float, __builtin_amdgcn_update_dpp(0, __builtin_bit_cast(int, x), CTRL, 0xf, 0xf, true)); }
__device__ __forceinline__ float rdlane(float x, int l) { return __builtin_bit_cast(float, __builtin_amdgcn_readlane(__builtin_bit_cast(int, x), l)); }
__device__ __forceinline__ float wave_sum(float v) {
    v += dppf<0xB1>(v); v += dppf<0x4E>(v); v += dppf<0x141>(v); v += dppf<0x140>(v);
    return (rdlane(v, 0) + rdlane(v, 16)) + (rdlane(v, 32) + rdlane(v, 48));
}
__device__ __forceinline__ float wave_max(float v) {
    v = fmaxf(v, dppf<0xB1>(v)); v = fmaxf(v, dppf<0x4E>(v)); v = fmaxf(v, dppf<0x141>(v)); v = fmaxf(v, dppf<0x140>(v));
    return fmaxf(fmaxf(rdlane(v, 0), rdlane(v, 16)), fmaxf(rdlane(v, 32), rdlane(v, 48)));
}
__device__ __forceinline__ float dppf_swap32(float x) { return __shfl_xor(x, 32); }
__device__ __forceinline__ float max8(float v) {
    v = fmaxf(v, dppf<0xB1>(v)); v = fmaxf(v, dppf<0x4E>(v)); return fmaxf(v, dppf<0x141>(v));
}

#define XB_TMO      128
#define XB_XCNT(j)  (256  + 64 * (j))
#define XB_XSUB(j)  (1280 + 64 * (j))
#define XB_XGEN(j)  (2304 + 64 * (j))
#define XB_TOP      3328
#define XB_TOPGEN   3392
#define XCD_BAR_WORDS 3456
#define XB_SPIN_CAP (1u << 18)
__device__ __forceinline__ unsigned xb_ld(unsigned* p)              { return __hip_atomic_load(p, __ATOMIC_RELAXED, __HIP_MEMORY_SCOPE_AGENT); }
__device__ __forceinline__ unsigned xb_add(unsigned* p, unsigned v) { return __hip_atomic_fetch_add(p, v, __ATOMIC_RELAXED, __HIP_MEMORY_SCOPE_AGENT); }
__device__ __forceinline__ unsigned xb_xcc_id() { return (unsigned)__builtin_amdgcn_s_getreg((3 << 11) | 20) & 0xFu; }
#define XB_SPIN(cond, bar) do { unsigned _sp = 0; while (cond) { __builtin_amdgcn_s_sleep(1); \
    if ((++_sp & 255u) == 0u) { if (xb_ld(&(bar)[XB_TMO])) break; if (_sp > XB_SPIN_CAP) { atomicAdd(&(bar)[XB_TMO], 1u); break; } } } } while (0)
struct XcdBarrier { unsigned* bar; unsigned x; volatile LAS unsigned* st; };
__device__ __forceinline__ XcdBarrier xcd_barrier_post(unsigned* bar, volatile LAS unsigned* st) {
    XcdBarrier b; b.bar = bar; b.x = xb_xcc_id(); b.st = st;
    if (threadIdx.x == 0) (void)xb_add(&bar[XB_XCNT(b.x)], 1u);
    return b;
}
__device__ __forceinline__ void xcd_barrier_complete(unsigned* bar, unsigned x, unsigned& nloc, unsigned& nx) {
    const unsigned G = gridDim.x * gridDim.y * gridDim.z;
    unsigned sum, cnt, mine, sp = 0u;
    for (;;) {
        sum = 0u; cnt = 0u; mine = 0u;
#pragma unroll
        for (unsigned j = 0; j < 16; ++j) { const unsigned c = xb_ld(&bar[XB_XCNT(j)]); sum += c; cnt += (c > 0u) ? 1u : 0u; mine = (j == x) ? c : mine; }
        if (sum == G) break;
        __builtin_amdgcn_s_sleep(1);
        if ((++sp & 255u) == 0u) { if (xb_ld(&bar[XB_TMO])) break; if (sp > XB_SPIN_CAP) { atomicAdd(&bar[XB_TMO], 1u); break; } }
    }
    nloc = mine > 0u ? mine : 1u; nx = cnt > 0u ? cnt : 1u;
}
__device__ __forceinline__ void xcd_barrier(const XcdBarrier& b, const int wave) {
    asm volatile("s_waitcnt vmcnt(0)" ::: "memory");
    __syncthreads();
    if (wave == 0 && lane_id() == 0) {
        unsigned* bar = b.bar;
        __builtin_amdgcn_s_waitcnt(0);
        unsigned nloc = b.st[0], nx = b.st[1];
        if (nloc == 0u) { xcd_barrier_complete(bar, b.x, nloc, nx); b.st[0] = nloc; b.st[1] = nx; }
        const unsigned old = xb_add(&bar[XB_XSUB(b.x)], 1u);
        const unsigned gen = old / nloc;
        if (old + 1u == (gen + 1u) * nloc) {
            __builtin_amdgcn_fence(__ATOMIC_RELEASE, "agent");
            asm volatile("s_waitcnt vmcnt(0)" ::: "memory");
            const unsigned og = xb_add(&bar[XB_TOP], 1u);
            const unsigned tg = og / nx;
            if (og + 1u == (tg + 1u) * nx) xb_add(&bar[XB_TOPGEN], 1u);
            else XB_SPIN(xb_ld(&bar[XB_TOPGEN]) == tg, bar);
            __builtin_amdgcn_fence(__ATOMIC_ACQUIRE, "agent");
            xb_add(&bar[XB_XGEN(b.x)], 1u);
            asm volatile("s_waitcnt vmcnt(0)" ::: "memory");
        } else {
            XB_SPIN(xb_ld(&bar[XB_XGEN(b.x)]) == gen, bar);
            __builtin_amdgcn_fence(__ATOMIC_ACQUIRE, "agent");
            asm volatile("s_waitcnt vmcnt(0)" ::: "memory");
        }
    }
    __syncthreads();
}

struct Unit {
    const char* a;
    const char* b;
    const int* ridx;
    unsigned apitch, bpitch;
    int row0;
    int col0;
    int kind;
    const int* oidx;
    const LAS int* oidl;
    int nt;
    int keep;
};
__device__ __forceinline__ int id2tok(int id) { const int t = (int)(((unsigned long long)(unsigned)id * 954437177ull) >> 33); return t < T ? t : T - 1; }
#define ACC_T f32x4 (&acc)[2][2][4][2]

template <class Epi, class Sched>
__device__ __forceinline__ void gemm_phase_simple(const int wid, const int K, const Sched& S, const Epi& E) {
    const int lane = lane_id(), tid = wid * 64 + lane; (void)tid;
    const int  wr = wid >> 2, wc = wid & 3, fr = lane & 15, fq = lane >> 4;
    Unit u;
    for (int i = 0; S.next(i, u); ++i) {
        f32x4 acc[2][2][4][2];
#pragma unroll
        for (int a = 0; a < 2; ++a)
#pragma unroll
            for (int b = 0; b < 2; ++b)
#pragma unroll
                for (int m = 0; m < 4; ++m)
#pragma unroll
                    for (int n = 0; n < 2; ++n) acc[a][b][m][n] = (f32x4){0.f, 0.f, 0.f, 0.f};
        unsigned offA[2][4], offB[2][2];
#pragma unroll
        for (int ai = 0; ai < 2; ++ai)
#pragma unroll
            for (int m = 0; m < 4; ++m) { const int r = 128 * ai + 64 * wr + 16 * m + fr; const int row = u.ridx ? id2tok(u.ridx[r]) : u.row0 + r; offA[ai][m] = (unsigned)row * u.apitch + (unsigned)fq * 16u; }
#pragma unroll
        for (int bj = 0; bj < 2; ++bj)
#pragma unroll
            for (int n = 0; n < 2; ++n) { const int wrow = 128 * bj + 32 * wc + 8 * (fr >> 2) + 4 * n + (fr & 3); offB[bj][n] = (unsigned)wrow * u.bpitch + (unsigned)fq * 16u; }
#pragma unroll 1
        for (int k0 = 0; k0 < K; k0 += 32) {
            h16x8 b[2][2];
#pragma unroll
            for (int bj = 0; bj < 2; ++bj)
#pragma unroll
                for (int n = 0; n < 2; ++n) b[bj][n] = *(const h16x8*)(u.b + offB[bj][n] + (size_t)k0 * 2);
#pragma unroll
            for (int ai = 0; ai < 2; ++ai) {
                h16x8 a[4];
#pragma unroll
                for (int m = 0; m < 4; ++m) a[m] = *(const h16x8*)(u.a + offA[ai][m] + (size_t)k0 * 2);
#pragma unroll
                for (int bj = 0; bj < 2; ++bj)
#pragma unroll
                    for (int m = 0; m < 4; ++m)
#pragma unroll
                        for (int n = 0; n < 2; ++n) acc[ai][bj][m][n] = __builtin_amdgcn_mfma_f32_16x16x32_f16(__builtin_bit_cast(f16x8, b[bj][n]), __builtin_bit_cast(f16x8, a[m]), acc[ai][bj][m][n], 0, 0, 0);
                asm volatile("" ::: "memory");
            }
        }
        u.oidl = nullptr;
        E(acc, u, wr, wc, fr, fq);
    }
}


#ifndef FAST_GEMM
#define FAST_GEMM 1
#endif
constexpr int HTB = 128 * 64 * 2;
__device__ __forceinline__ int lds_byte(int r, int c) { const int st = (r >> 4) * 2 + (c >> 5), rr = r & 15, cc = c & 31, ob = rr * 64 + cc * 2; return st * 1024 + (ob ^ (((ob >> 9) & 1) << 5)); }
__device__ __forceinline__ void stage_rc(int b, int& R, int& C) { const int st = b / 1024, sb = b % 1024, swz = sb ^ (((sb >> 9) & 1) << 5); R = (st >> 1) * 16 + swz / 64; C = (st & 1) * 32 + (swz % 64) / 2; }
__device__ __forceinline__ int perm32(int rho) { const int n = rho >> 4, i = rho & 15; return 8 * (i >> 2) + 4 * n + (i & 3); }

__device__ __forceinline__ const char* uptr(const char* p) { const unsigned long long v = (unsigned long long)p; const unsigned lo = __builtin_amdgcn_readfirstlane((unsigned)v), hi = __builtin_amdgcn_readfirstlane((unsigned)(v >> 32)); return (const char*)(((unsigned long long)hi << 32) | lo); }
typedef int i32x8 __attribute__((ext_vector_type(8)));
__device__ __forceinline__ i32x8 cat8(const u32x4 a, const u32x4 b) { return (i32x8){(int)a.x, (int)a.y, (int)a.z, (int)a.w, (int)b.x, (int)b.y, (int)b.z, (int)b.w}; }
template <int H> __device__ __forceinline__ f16x8 half8(const i32x8 v) { typedef int i32x4_ __attribute__((ext_vector_type(4))); const i32x4_ q = __builtin_shufflevector(v, v, 4 * H, 4 * H + 1, 4 * H + 2, 4 * H + 3); return __builtin_bit_cast(f16x8, q); }
template <bool F8, class Epi, class Sched>
__device__ __forceinline__ void gemm_phase(LAS unsigned char* lds, const int wid, const int K, const Sched& S, const Epi& E) {
    const int lane = lane_id(), tid = wid * 64 + lane;
    const int  wr = wid >> 2, wc = wid & 3, fr = lane & 15, fq = lane >> 4;
    int nt = K / 64;
    const unsigned ldsw = (unsigned)wid * 1024u;
    const int aoff = lds_byte(wr * 64 + fr, fq * 8), boff = lds_byte(wc * 32 + fr, fq * 8);
#define G_SA(b, h) (((b) * 2 + (h)) * HTB)
#define G_SB(b, h) ((4 + (b) * 2 + (h)) * HTB)
#define G_STAGE(bufoff, gbase, o0, o1) do { \
        __builtin_amdgcn_global_load_lds((const unsigned*)((const char*)(gbase) + (o0)), (LAS unsigned*)(lds + (bufoff) + ldsw), 16, 0, 0); \
        __builtin_amdgcn_global_load_lds((const unsigned*)((const char*)(gbase) + (o1)), (LAS unsigned*)(lds + (bufoff) + ldsw + 8192), 16, 0, 0); } while (0)
#define G_LDA(dst, b, h) do { _Pragma("unroll") for (int m = 0; m < 4; ++m) dst[m] = cat8(*(const LAS u32x4*)(lds + G_SA(b, h) + aoff + m * 2048), *(const LAS u32x4*)(lds + G_SA(b, h) + aoff + m * 2048 + 1024)); } while (0)
#define G_LDB(dst, b, h) do { _Pragma("unroll") for (int n = 0; n < 2; ++n) dst[n] = cat8(*(const LAS u32x4*)(lds + G_SB(b, h) + boff + n * 2048), *(const LAS u32x4*)(lds + G_SB(b, h) + boff + n * 2048 + 1024)); } while (0)
#define G_MMA(ai, bj, At, Bt) do { __builtin_amdgcn_s_setprio(1); _Pragma("unroll") for (int m = 0; m < 4; ++m) _Pragma("unroll") for (int n = 0; n < 2; ++n) { \
        if constexpr (F8) { acc[ai][bj][m][n] = __builtin_amdgcn_mfma_scale_f32_16x16x128_f8f6f4(Bt[n], At[m], acc[ai][bj][m][n], 0, 0, 0, 0, 0, 0); } \
        else { acc[ai][bj][m][n] = __builtin_amdgcn_mfma_f32_16x16x32_f16(half8<0>(Bt[n]), half8<0>(At[m]), acc[ai][bj][m][n], 0, 0, 0); \
               acc[ai][bj][m][n] = __builtin_amdgcn_mfma_f32_16x16x32_f16(half8<1>(Bt[n]), half8<1>(At[m]), acc[ai][bj][m][n], 0, 0, 0); } } \
        __builtin_amdgcn_s_setprio(0); } while (0)
#define G_WAIT_V(n) asm volatile("s_waitcnt vmcnt(" #n ")" ::: "memory")
#define G_WAIT_L(n) asm volatile("s_waitcnt lgkmcnt(" #n ")" ::: "memory")
#define G_BAR __builtin_amdgcn_s_barrier()
#define G_SCHED __builtin_amdgcn_sched_barrier(0)
#define G_OFFS(u, OA, OB, IDXB) do { int tl_ = wid * 64 + lane_id(); _Pragma("unroll") for (int i = 0; i < 2; ++i) { int R_, C_; stage_rc(tl_ * 16 + i * 8192, R_, C_); const int Rb_ = (R_ & ~31) + perm32(R_ & 31); \
        _Pragma("unroll") for (int h = 0; h < 2; ++h) { const int r_ = h * 128 + R_; const int row_ = (u).ridx ? id2tok(((const LAS int*)(lds + LDS_IDX + (IDXB) * 1024))[r_]) : (u).row0 + r_; \
        OA[h][i] = (unsigned)row_ * (u).apitch + (unsigned)C_ * 2u; OB[h][i] = (unsigned)(h * 128 + Rb_) * (u).bpitch + (unsigned)C_ * 2u; } } } while (0)
#define G_IDX_DMA(u, IDXB, OIDB) do { if ((u).ridx && wid < 4) __builtin_amdgcn_global_load_lds((const unsigned*)((u).ridx + wid * 64 + lane_id()), (LAS unsigned*)(lds + LDS_IDX + (IDXB) * 1024 + wid * 256), 4, 0, 0); \
        if ((u).oidx && wid < 4) __builtin_amdgcn_global_load_lds((const unsigned*)((u).oidx + wid * 64 + lane_id()), (LAS unsigned*)(lds + LDS_OID + (OIDB) * 1024 + wid * 256), 4, 0, 0); } while (0)
    Unit cur, nxt; int ui = 0;
    if (!S.next(0, cur)) return;
    if constexpr (Sched::DYN) nt = cur.nt;
    unsigned cOA[2][2], cOB[2][2];
    G_IDX_DMA(cur, 0, 0); asm volatile("s_waitcnt vmcnt(0)" ::: "memory"); __builtin_amdgcn_s_barrier(); asm volatile("" ::: "memory");
    G_OFFS(cur, cOA, cOB, 0);
    f32x4 acc[2][2][4][2];
#pragma unroll
    for (int a = 0; a < 2; ++a)
#pragma unroll
        for (int b = 0; b < 2; ++b)
#pragma unroll
            for (int m = 0; m < 4; ++m)
#pragma unroll
                for (int n = 0; n < 2; ++n) acc[a][b][m][n] = (f32x4){0.f, 0.f, 0.f, 0.f};
    i32x8 At[4], B0[2], B1[2];
    const char* cA = uptr(cur.a); const char* cB = uptr(cur.b);
    G_STAGE(G_SB(0, 0), cB, cOB[0][0], cOB[0][1]); G_STAGE(G_SB(0, 1), cB, cOB[1][0], cOB[1][1]); G_STAGE(G_SA(0, 0), cA, cOA[0][0], cOA[0][1]); G_STAGE(G_SA(0, 1), cA, cOA[1][0], cOA[1][1]);
    if (wr == 1) G_BAR;
    G_WAIT_V(2); G_BAR;
    { const char* cA1 = uptr(cA + 128); const char* cB1 = uptr(cB + 128);
      G_STAGE(G_SB(1, 0), cB1, cOB[0][0], cOB[0][1]); G_STAGE(G_SA(1, 0), cA1, cOA[0][0], cOA[0][1]); G_STAGE(G_SB(1, 1), cB1, cOB[1][0], cOB[1][1]); }
    G_WAIT_V(6); G_BAR;
    for (;;) {
        const bool has_next = S.next(ui + 1, nxt); const char* nA = cA; const char* nB = cB;
        if (has_next) G_IDX_DMA(nxt, (ui + 1) & 1, (ui + 1) % 3);
#pragma unroll 1
        for (int t = 0; t < nt; t += 2) {
            const bool last = (t == nt - 2);
            const char* a1 = uptr(cA + (size_t)(t + 1) * 128);
            G_LDB(B0, 0, 0); G_LDB(B1, 0, 1); G_SCHED; G_LDA(At, 0, 0); G_STAGE(G_SA(1, 1), a1, cOA[1][0], cOA[1][1]);
            G_WAIT_V(8); G_WAIT_L(0); G_BAR; G_MMA(0, 0, At, B0); G_MMA(0, 1, At, B1); G_BAR; G_SCHED;
            if (last && has_next) { nA = uptr(nxt.a); nB = uptr(nxt.b); G_OFFS(nxt, cOA, cOB, (ui + 1) & 1); }
            const char* a2 = uptr(last ? nA : cA + (size_t)(t + 2) * 128); const char* b2 = uptr(last ? nB : cB + (size_t)(t + 2) * 128);
            const char* a3 = uptr(a2 + 128); const char* b3 = uptr(b2 + 128);
            G_LDA(At, 0, 1); G_STAGE(G_SB(0, 0), b2, cOB[0][0], cOB[0][1]); G_STAGE(G_SB(0, 1), b2, cOB[1][0], cOB[1][1]); G_STAGE(G_SA(0, 0), a2, cOA[0][0], cOA[0][1]);
            G_WAIT_V(8); G_WAIT_L(0); G_BAR; G_MMA(1, 0, At, B0); G_MMA(1, 1, At, B1); G_BAR; G_SCHED;
            G_LDB(B0, 1, 0); G_LDB(B1, 1, 1); G_SCHED; G_LDA(At, 1, 0); G_STAGE(G_SA(0, 1), a2, cOA[1][0], cOA[1][1]);
            G_WAIT_V(8); G_WAIT_L(0); G_BAR; G_MMA(0, 0, At, B0); G_MMA(0, 1, At, B1); G_BAR; G_SCHED;
            G_LDA(At, 1, 1); G_STAGE(G_SB(1, 0), b3, cOB[0][0], cOB[0][1]); G_STAGE(G_SB(1, 1), b3, cOB[1][0], cOB[1][1]); G_STAGE(G_SA(1, 0), a3, cOA[0][0], cOA[0][1]);
            G_WAIT_V(8); G_WAIT_L(0); G_BAR; G_MMA(1, 0, At, B0); G_MMA(1, 1, At, B1); G_BAR; G_SCHED;
        }
        if (wr == 0) G_BAR;
        cur.oidl = (const LAS int*)(lds + LDS_OID + (ui % 3) * 1024);
        { const int le = lane_id(); E(acc, cur, wr, wc, le & 15, le >> 4); }
        if (!has_next) break;
        if (!nxt.keep) {
#pragma unroll
        for (int a = 0; a < 2; ++a)
#pragma unroll
            for (int b = 0; b < 2; ++b)
#pragma unroll
                for (int m = 0; m < 4; ++m)
#pragma unroll
                    for (int n = 0; n < 2; ++n) acc[a][b][m][n] = (f32x4){0.f, 0.f, 0.f, 0.f};
        }
        cur = nxt; cA = nA; cB = nB; ++ui;
        if constexpr (Sched::DYN) nt = cur.nt;
        if (wr == 1) G_BAR;
    }
    G_WAIT_V(0);
    G_BAR;
#undef G_SA
#undef G_SB
#undef G_STAGE
#undef G_LDA
#undef G_LDB
#undef G_MMA
#undef G_WAIT_V
#undef G_WAIT_L
#undef G_BAR
#undef G_SCHED
#undef G_OFFS
#undef G_IDX_DMA
}
#if FAST_GEMM
#define GEMM_PHASE(K, S, E) gemm_phase<false>(F.lds, F.wave, K, S, E)
#define GEMM_PHASE_F8(K, S, E) gemm_phase<true>(F.lds, F.wave, K, S, E)
#else
#define GEMM_PHASE(K, S, E) gemm_phase_simple(F.wave, K, S, E)
#endif

constexpr int NXCD = 8, WGM = 8;
struct TileOrder {
    int nM, nN, nwg, G, c;
    __device__ void init(int M, int N, int G_, int c_) { nM = M / 256; nN = N / 256; nwg = nM * nN; G = G_; c = c_; }
    __device__ bool tile(int i, int& pm, int& pn) const {
        const long L = (long)i * G + c; if (L >= nwg) return false;
        int wgid = (int)L; { const int q = nwg / NXCD, r = nwg % NXCD, xcd = wgid % NXCD, off = wgid / NXCD; wgid = (xcd < r ? xcd * (q + 1) : r * (q + 1) + (xcd - r) * q) + off; }
        const int nig = WGM * nN, gid = wgid / nig, fm = gid * WGM, gsz = (nM - fm) < WGM ? (nM - fm) : WGM;
        pm = fm + ((wgid % nig) % gsz); pn = (wgid % nig) / gsz; return true;
    }
};
struct SchedDense { static constexpr bool DYN = false;
    TileOrder o; const char* a; const char* b; unsigned apitch, bpitch;
    __device__ bool next(int i, Unit& u) const {
        int pm, pn; if (!o.tile(i, pm, pn)) return false;
        u.a = a; u.b = b + (size_t)pn * 256 * bpitch; u.ridx = nullptr; u.apitch = apitch; u.bpitch = bpitch; u.row0 = pm * 256; u.col0 = pn * 256; u.kind = 0; u.oidx = nullptr; u.keep = 0; return true;
    }
};
struct SchedMerged { static constexpr bool DYN = false;
    TileOrder o; const char* pd; const char* oo; const char* wpe; const char* wba;
    __device__ bool next(int i, Unit& u) const {
        int pm, pn; if (!o.tile(i >> 1, pm, pn)) return false;
        const int part = i & 1;
        u.a = part ? oo : pd; u.apitch = part ? DIN * 2 : 512 * 2; u.b = (part ? wba : wpe) + (size_t)pn * 256 * 1024; u.bpitch = 1024; u.ridx = nullptr; u.row0 = pm * 256; u.col0 = pn * 256; u.kind = part; u.oidx = nullptr; u.keep = part; return true;
    }
};
struct SchedSharedRouter { static constexpr bool DYN = true;
    int G, c; const char* xb; const char* wsgu; const char* wr;
    __device__ bool next(int i, Unit& u) const {
        const int L = i * G + c; if (L >= 512) return false;
        u.apitch = 2048; u.bpitch = 2048; u.ridx = nullptr; u.oidx = nullptr; u.keep = 0;
        if (L < 256) { const int pm = L >> 1, pn = L & 1; u.a = xb; u.b = wsgu + (size_t)pn * 256 * 2048; u.row0 = pm * 256; u.col0 = pn * 128; u.kind = 0; u.nt = 16; }
        else { const int pm = (L - 256) >> 1, kh = L & 1; u.a = xb + kh * 1024; u.b = wr + kh * 1024; u.row0 = pm * 256; u.col0 = kh; u.kind = 1; u.nt = 8; }
        return true;
    }
};
struct SchedMoeGU { static constexpr bool DYN = false;
    int G, c, nblk; const char* xb; const char* wegu; const LAS int* blke; const int* tokl;
    __device__ bool next(int i, Unit& u) const {
        const int L = i * G + c; if (L >= 2 * nblk) return false;
        const int rb = L >> 1, pn = L & 1, e = __builtin_amdgcn_readfirstlane(blke[rb]);
        u.a = xb; u.apitch = 1024; u.bpitch = 1024; u.b = wegu + ((size_t)e * 512 + pn * 256) * 1024; u.ridx = tokl + rb * 256; u.row0 = rb * 256; u.col0 = pn * 128; u.kind = e; u.oidx = nullptr; u.keep = 0; return true;
    }
};
struct SchedMoeDown { static constexpr bool DYN = false;
    int G, c, nblk; const char* hb; const char* hs; const char* wed; const char* wsd; const LAS int* blke; const int* tokl;
    __device__ bool next(int i, Unit& u) const {
        const int L = i * G + c; if (L >= 4 * nblk + 512) return false;
        u.apitch = 512; u.bpitch = 512; u.ridx = nullptr;
        if (L < 4 * nblk) { const int rb = L >> 2, pn = L & 3, e = __builtin_amdgcn_readfirstlane(blke[rb]); u.a = hb; u.b = wed + ((size_t)e * 1024 + pn * 256) * 512; u.row0 = rb * 256; u.col0 = pn * 256; u.kind = 0; u.oidx = tokl + rb * 256; u.keep = 0; }
        else { const int L2 = L - 4 * nblk, pm = L2 >> 2, pn = L2 & 3; u.a = hs; u.b = wsd + (size_t)pn * 256 * 512; u.row0 = pm * 256; u.col0 = pn * 256; u.kind = 1; u.oidx = nullptr; u.keep = 0; }
        return true;
    }
};

__device__ __forceinline__ u32x4 pack8(const f32x4& v0, const f32x4& v1) { u32x4 w; w.x = cvt_pk_h16(v0[0], v0[1]); w.y = cvt_pk_h16(v0[2], v0[3]); w.z = cvt_pk_h16(v1[0], v1[1]); w.w = cvt_pk_h16(v1[2], v1[3]); return w; }
__device__ __forceinline__ void unpack8(const u32x4& w, f32x4& v0, f32x4& v1) { v0 = (f32x4){lo16(w.x), hi16(w.x), lo16(w.y), hi16(w.y)}; v1 = (f32x4){lo16(w.z), hi16(w.z), lo16(w.w), hi16(w.w)}; }
__device__ __forceinline__ f32x4 sig4(const f32x4& v) { return (f32x4){sigmoidf_(v[0]), sigmoidf_(v[1]), sigmoidf_(v[2]), sigmoidf_(v[3])}; }
__device__ __forceinline__ f32x4 swiglu4(const f32x4& g, const f32x4& u) { return (f32x4){g[0] * sigmoidf_(g[0]) * u[0], g[1] * sigmoidf_(g[1]) * u[1], g[2] * sigmoidf_(g[2]) * u[2], g[3] * sigmoidf_(g[3]) * u[3]}; }

__device__ __forceinline__ unsigned q8x4(float a, float b, float c, float d, float inv) {
    const unsigned ua = __float_as_uint(a * inv + 12582912.0f), ub = __float_as_uint(b * inv + 12582912.0f), uc = __float_as_uint(c * inv + 12582912.0f), ud = __float_as_uint(d * inv + 12582912.0f);
    const unsigned lo = __builtin_amdgcn_perm(ub, ua, 0x0c0c0400u), hi = __builtin_amdgcn_perm(ud, uc, 0x0c0c0400u);
    return __builtin_amdgcn_perm(hi, lo, 0x05040100u);
}
struct EpiInProj {
    h16* H; const float* bias;
    __device__ __forceinline__ void operator()(const ACC_T, const Unit& u, int wr, int wc, int fr, int fq) const {
        const int pn = u.col0 >> 8; const float sc = (pn == 2 || pn == 3) ? 0.125f : 1.f; const bool sg = pn >= 5;
        f32x4 bv[2][2];
#pragma unroll
        for (int bj = 0; bj < 2; ++bj)
#pragma unroll
            for (int n = 0; n < 2; ++n) bv[bj][n] = *(const f32x4*)(bias + u.col0 + 128 * bj + 32 * wc + 8 * fq + 4 * n);
#pragma unroll
        for (int ai = 0; ai < 2; ++ai)
#pragma unroll
            for (int m = 0; m < 4; ++m) { const int row = u.row0 + 128 * ai + 64 * wr + 16 * m + fr; h16* rowp = H + (size_t)row * DIN + u.col0 + 32 * wc + 8 * fq;
#pragma unroll
                for (int bj = 0; bj < 2; ++bj) { f32x4 v0 = (acc[ai][bj][m][0] + bv[bj][0]) * sc, v1 = (acc[ai][bj][m][1] + bv[bj][1]) * sc;
                    if (sg) { v0 = sig4(v0); v1 = sig4(v1);
                        u32x2 w; w.x = q8x4(v0[0], v0[1], v0[2], v0[3], 255.0f); w.y = q8x4(v1[0], v1[1], v1[2], v1[3], 255.0f);
                        *(u32x2*)((unsigned char*)(H + (size_t)row * DIN + C_GP) + (u.col0 - C_GP) + 128 * bj + 32 * wc + 8 * fq) = w; }
                    else *(u32x4*)(rowp + 128 * bj) = pack8(v0, v1); } }
    }
};
__device__ __forceinline__ void ungate8(const u32x2& w, f32x4& v0, f32x4& v1) {
    const float k = 1.0f / 255.0f;
    v0 = (f32x4){(float)(w.x & 0xffu) * k, (float)((w.x >> 8) & 0xffu) * k, (float)((w.x >> 16) & 0xffu) * k, (float)(w.x >> 24) * k};
    v1 = (f32x4){(float)(w.y & 0xffu) * k, (float)((w.y >> 8) & 0xffu) * k, (float)((w.y >> 16) & 0xffu) * k, (float)(w.y >> 24) * k};
}
struct EpiMerged {
    h16* MG; const h16* H;
    __device__ __forceinline__ void operator()(f32x4 (&acc)[2][2][4][2], const Unit& u, int wr, int wc, int fr, int fq) const {
        const int col = u.col0 + 32 * wc + 8 * fq;
#pragma unroll
        for (int ai = 0; ai < 2; ++ai) {
            u32x2 ga[4][2], gp[4][2];
#pragma unroll
            for (int m = 0; m < 4; ++m) { const int row = u.row0 + 128 * ai + 64 * wr + 16 * m + fr;
#pragma unroll
                for (int bj = 0; bj < 2; ++bj) { const unsigned char* gb = (const unsigned char*)(H + (size_t)row * DIN + C_GP) + col + 128 * bj; ga[m][bj] = *(const u32x2*)(gb + 1024); if (u.kind == 0) gp[m][bj] = *(const u32x2*)gb; } }
#pragma unroll
            for (int m = 0; m < 4; ++m) { const int row = u.row0 + 128 * ai + 64 * wr + 16 * m + fr;
#pragma unroll
                for (int bj = 0; bj < 2; ++bj) { f32x4 a0, a1; ungate8(ga[m][bj], a0, a1);
                    if (u.kind == 0) { f32x4 p0, p1; ungate8(gp[m][bj], p0, p1);
#pragma unroll
                        for (int j = 0; j < 4; ++j) { acc[ai][bj][m][0][j] *= p0[j] * __builtin_amdgcn_rcpf(fmaxf(a0[j], 6.2e-5f)); acc[ai][bj][m][1][j] *= p1[j] * __builtin_amdgcn_rcpf(fmaxf(a1[j], 6.2e-5f)); } }
                    else *(u32x4*)(MG + (size_t)row * D + col + 128 * bj) = pack8(acc[ai][bj][m][0] * a0, acc[ai][bj][m][1] * a1); } }
        }
    }
};
struct EpiResid {
    h16* S; const h16* XBp;
    __device__ __forceinline__ void operator()(const ACC_T, const Unit& u, int wr, int wc, int fr, int fq) const {
#pragma unroll
        for (int ai = 0; ai < 2; ++ai) {
            u32x4 xw[4][2];
#pragma unroll
            for (int m = 0; m < 4; ++m) { const int row = u.row0 + 128 * ai + 64 * wr + 16 * m + fr; const size_t off = (size_t)row * D + u.col0 + 32 * wc + 8 * fq;
#pragma unroll
                for (int bj = 0; bj < 2; ++bj) xw[m][bj] = *(const u32x4*)(XBp + off + 128 * bj); }
#pragma unroll
            for (int m = 0; m < 4; ++m) { const int row = u.row0 + 128 * ai + 64 * wr + 16 * m + fr; const size_t off = (size_t)row * D + u.col0 + 32 * wc + 8 * fq;
#pragma unroll
                for (int bj = 0; bj < 2; ++bj) { f32x4 x0, x1; unpack8(xw[m][bj], x0, x1);
                    *(u32x4*)(S + off + 128 * bj) = pack8(x0 * ALPHA + acc[ai][bj][m][0], x1 * ALPHA + acc[ai][bj][m][1]); } }
        }
    }
};
struct EpiSharedRouter {
    h16* HS; float* LG;
    __device__ __forceinline__ void operator()(const ACC_T, const Unit& u, int wr, int wc, int fr, int fq) const {
#pragma unroll
        for (int ai = 0; ai < 2; ++ai)
#pragma unroll
            for (int m = 0; m < 4; ++m) { const int row = u.row0 + 128 * ai + 64 * wr + 16 * m + fr;
                if (u.kind == 0) { *(u32x4*)(HS + (size_t)row * FF + u.col0 + 32 * wc + 8 * fq) = pack8(swiglu4(acc[ai][0][m][0], acc[ai][1][m][0]), swiglu4(acc[ai][0][m][1], acc[ai][1][m][1])); }
                else if (wc < 2) {
#pragma unroll
                    for (int n = 0; n < 2; ++n) *(f32x4*)(LG + (size_t)u.col0 * T * NE + (size_t)row * NE + 32 * wc + 8 * fq + 4 * n) = acc[ai][0][m][n] + acc[ai][1][m][n]; } }
    }
};
struct EpiMoeGU {
    h16* HB; const float* gatl; const float* wsc;
    __device__ __forceinline__ void operator()(const ACC_T, const Unit& u, int wr, int wc, int fr, int fq) const {
        const float isg = wsc[2 * u.kind], isu = wsc[2 * u.kind + 1];
        float g[2][4];
#pragma unroll
        for (int ai = 0; ai < 2; ++ai)
#pragma unroll
            for (int m = 0; m < 4; ++m) g[ai][m] = gatl[u.row0 + 128 * ai + 64 * wr + 16 * m + fr];
#pragma unroll
        for (int ai = 0; ai < 2; ++ai)
#pragma unroll
            for (int m = 0; m < 4; ++m) { const int row = u.row0 + 128 * ai + 64 * wr + 16 * m + fr;
                *(u32x4*)(HB + (size_t)row * FF + u.col0 + 32 * wc + 8 * fq) = pack8(swiglu4(acc[ai][0][m][0] * isg, acc[ai][1][m][0] * isu) * g[ai][m], swiglu4(acc[ai][0][m][1] * isg, acc[ai][1][m][1] * isu) * g[ai][m]); }
    }
};
struct EpiMoeDown {
    unsigned char* YQ; h16* YS;
    __device__ __forceinline__ void operator()(const ACC_T, const Unit& u, int wr, int wc, int fr, int fq) const {
        int id[2][4];
#pragma unroll
        for (int ai = 0; ai < 2; ++ai)
#pragma unroll
            for (int m = 0; m < 4; ++m) { const int r = 128 * ai + 64 * wr + 16 * m + fr; id[ai][m] = u.kind ? (u.row0 + r) * 9 + 8 : u.oidl[r]; }
        const int grp = (u.col0 >> 8) * 16 + 4 * wc + fq;
#pragma unroll
        for (int ai = 0; ai < 2; ++ai)
#pragma unroll
            for (int m = 0; m < 4; ++m) {
                const f32x4 v0 = acc[ai][0][m][0], v1 = acc[ai][0][m][1], v2 = acc[ai][1][m][0], v3 = acc[ai][1][m][1];
                float mx = fmaxf(fmaxf(fabsf(v0[0]), fabsf(v0[1])), fmaxf(fabsf(v0[2]), fabsf(v0[3])));
                mx = fmaxf(mx, fmaxf(fmaxf(fabsf(v1[0]), fabsf(v1[1])), fmaxf(fabsf(v1[2]), fabsf(v1[3]))));
                mx = fmaxf(mx, fmaxf(fmaxf(fabsf(v2[0]), fabsf(v2[1])), fmaxf(fabsf(v2[2]), fabsf(v2[3]))));
                mx = fmaxf(mx, fmaxf(fmaxf(fabsf(v3[0]), fabsf(v3[1])), fmaxf(fabsf(v3[2]), fabsf(v3[3]))));
                const unsigned short sh = f2h(mx * (1.0f / 127.0f) * 1.0005f);
                const float scr = h2f(sh); const float inv = scr > 0.f ? __builtin_amdgcn_rcpf(scr) : 0.f;
                u32x4 w; w.x = q8x4(v0[0], v0[1], v0[2], v0[3], inv); w.y = q8x4(v1[0], v1[1], v1[2], v1[3], inv); w.z = q8x4(v2[0], v2[1], v2[2], v2[3], inv); w.w = q8x4(v3[0], v3[1], v3[2], v3[3], inv);
                *(u32x4*)(YQ + (size_t)id[ai][m] * 1024 + grp * 16) = w;
                *(unsigned short*)(YS + (size_t)id[ai][m] * 64 + grp) = sh; }
    }
};

struct Args { const float* in[23]; float* out; unsigned char* ws; int ph_lo, ph_hi; };
struct Frame {
    LAS unsigned char* lds; int wave, vcu, G, gw, NGW;
};

__device__ __forceinline__ void ln_store(f32x4 (&v)[4], const float* gam, const float* bet, float* o32, h16* o16, int lane) {
    float s = 0.f;
#pragma unroll
    for (int j = 0; j < 4; ++j) s += (v[j].x + v[j].y) + (v[j].z + v[j].w);
    const float mean = wave_sum(s) * (1.f / D); float s2 = 0.f;
#pragma unroll
    for (int j = 0; j < 4; ++j) { v[j] = v[j] - mean; s2 += (v[j].x * v[j].x + v[j].y * v[j].y) + (v[j].z * v[j].z + v[j].w * v[j].w); }
    const float rstd = 1.f / sqrtf(wave_sum(s2) * (1.f / D) + LN_EPS);
#pragma unroll
    for (int j = 0; j < 4; ++j) { const f32x4 g = *(const f32x4*)(gam + 4 * lane + 256 * j), b = *(const f32x4*)(bet + 4 * lane + 256 * j); const f32x4 y = v[j] * rstd * g + b;
        *(f32x4*)(o32 + 4 * lane + 256 * j) = y; u32x2 w; w.x = cvt_pk_h16(y[0], y[1]); w.y = cvt_pk_h16(y[2], y[3]); *(u32x2*)(o16 + 4 * lane + 256 * j) = w; }
}


__device__ __forceinline__ unsigned f8x4(const f32x4 v) {
    int w = __builtin_amdgcn_cvt_pk_fp8_f32(__builtin_amdgcn_fmed3f(v.x, -448.f, 448.f), __builtin_amdgcn_fmed3f(v.y, -448.f, 448.f), 0, false);
    w = __builtin_amdgcn_cvt_pk_fp8_f32(__builtin_amdgcn_fmed3f(v.z, -448.f, 448.f), __builtin_amdgcn_fmed3f(v.w, -448.f, 448.f), w, true); return (unsigned)w; }
__device__ __forceinline__ void ln_store8(f32x4 (&v)[4], const float* gam, const float* bet, float* o32, h16* o16, int lane, int c0 = -1, int c1 = -1, unsigned char* o8 = nullptr) {
    if (c0 < 0) { c0 = 8 * lane; c1 = 512 + 8 * lane; }
    float s = 0.f;
#pragma unroll
    for (int j = 0; j < 4; ++j) s += (v[j].x + v[j].y) + (v[j].z + v[j].w);
    const float mean = wave_sum(s) * (1.f / D); float s2 = 0.f;
#pragma unroll
    for (int j = 0; j < 4; ++j) { v[j] = v[j] - mean; s2 += (v[j].x * v[j].x + v[j].y * v[j].y) + (v[j].z * v[j].z + v[j].w * v[j].w); }
    const float rstd = 1.f / sqrtf(wave_sum(s2) * (1.f / D) + LN_EPS);
    f32x4 y[4];
#pragma unroll
    for (int j = 0; j < 4; ++j) { const int c = ((j >> 1) ? c1 : c0) + 4 * (j & 1); const f32x4 g = *(const f32x4*)(gam + c), b = *(const f32x4*)(bet + c); y[j] = v[j] * rstd * g + b; if (o32) *(f32x4*)(o32 + c) = y[j]; }
    *(u32x4*)(o16 + c0) = pack8(y[0], y[1]); *(u32x4*)(o16 + c1) = pack8(y[2], y[3]);
    if (o8) { u32x2 w; w.x = f8x4(y[0]); w.y = f8x4(y[1]); *(u32x2*)(o8 + c0) = w; w.x = f8x4(y[2]); w.y = f8x4(y[3]); *(u32x2*)(o8 + c1) = w; }
}
__device__ __forceinline__ void tr_item(const float* W, int N, h16* WT, int ldt, int k0, int n0, int drow0, LAS float* scr, int lane) {
    float tv[32];
#pragma unroll
    for (int i = 0; i < 32; ++i) { const int kk = 2 * i + (lane >> 5); tv[i] = __builtin_nontemporal_load(W + (size_t)(k0 + kk) * N + n0 + (lane & 31)); }
#pragma unroll
    for (int i = 0; i < 32; ++i) { const int kk = 2 * i + (lane >> 5); scr[kk * 33 + (lane & 31)] = tv[i]; }
    asm volatile("s_waitcnt lgkmcnt(0)" ::: "memory");
    const int c = lane & 7;
#pragma unroll
    for (int j = 0; j < 4; ++j) { const int n = (lane >> 3) + 8 * j; const LAS float* s = scr + (8 * c) * 33 + n;
        u32x4 o; o.x = cvt_pk_h16(s[0 * 33], s[1 * 33]); o.y = cvt_pk_h16(s[2 * 33], s[3 * 33]); o.z = cvt_pk_h16(s[4 * 33], s[5 * 33]); o.w = cvt_pk_h16(s[6 * 33], s[7 * 33]);
        *(u32x4*)(WT + (size_t)(drow0 + n) * ldt + k0 + 8 * c) = o; }
    asm volatile("s_waitcnt lgkmcnt(0)" ::: "memory");
}
__device__ __forceinline__ void tr_item_f8(const float* W, int N, unsigned char* WT, int ldt, int k0, int n0, int drow0, LAS float* scr, int lane, float scale) {
    float tv[32];
#pragma unroll
    for (int i = 0; i < 32; ++i) { const int kk = 2 * i + (lane >> 5); tv[i] = __builtin_nontemporal_load(W + (size_t)(k0 + kk) * N + n0 + (lane & 31)); }
#pragma unroll
    for (int i = 0; i < 32; ++i) { const int kk = 2 * i + (lane >> 5); scr[kk * 33 + (lane & 31)] = tv[i]; }
    asm volatile("s_waitcnt lgkmcnt(0)" ::: "memory");
    const int c = lane & 7;
#pragma unroll
    for (int j = 0; j < 4; ++j) { const int n = (lane >> 3) + 8 * j; const LAS float* s = scr + (8 * c) * 33 + n;
        u32x2 o; o.x = f8x4((f32x4){s[0 * 33], s[1 * 33], s[2 * 33], s[3 * 33]} * scale); o.y = f8x4((f32x4){s[4 * 33], s[5 * 33], s[6 * 33], s[7 * 33]} * scale);
        *(u32x2*)(WT + (size_t)(drow0 + n) * ldt + k0 + 8 * c) = o; }
    asm volatile("s_waitcnt lgkmcnt(0)" ::: "memory");
}
__device__ __forceinline__ float f8_scale_of(const float* W, int lane) {
    const f32x4 q = *(const f32x4*)(W + 4 * lane); const float ma = wave_sum((fabsf(q.x) + fabsf(q.y)) + (fabsf(q.z) + fabsf(q.w))) * (1.2533f / 256.f);
    float t = 32.f / fmaxf(ma, 1e-30f); t = fminf(fmaxf(t, 1.0e-18f), 1.0e18f);
    return __uint_as_float(__builtin_amdgcn_readfirstlane(__float_as_uint(t)) & 0x7f800000u);
}
__device__ __forceinline__ void tr_item_hilo(const float* W, int N, h16* WT, int ldt, int k0, int n0, LAS float* scr, int lane) {
    float tv[32];
#pragma unroll
    for (int i = 0; i < 32; ++i) { const int kk = 2 * i + (lane >> 5); tv[i] = __builtin_nontemporal_load(W + (size_t)(k0 + kk) * N + n0 + (lane & 31)); }
#pragma unroll
    for (int i = 0; i < 32; ++i) { const int kk = 2 * i + (lane >> 5); scr[kk * 33 + (lane & 31)] = tv[i]; }
    asm volatile("s_waitcnt lgkmcnt(0)" ::: "memory");
    const int c = lane & 7;
#pragma unroll
    for (int j = 0; j < 4; ++j) { const int n = (lane >> 3) + 8 * j; const LAS float* s = scr + (8 * c) * 33 + n;
        float v[8], r[8];
#pragma unroll
        for (int q = 0; q < 8; ++q) { v[q] = s[q * 33]; r[q] = v[q] - h2f(f2h(v[q])); }
        u32x4 o; o.x = cvt_pk_h16(v[0], v[1]); o.y = cvt_pk_h16(v[2], v[3]); o.z = cvt_pk_h16(v[4], v[5]); o.w = cvt_pk_h16(v[6], v[7]);
        *(u32x4*)(WT + (size_t)(n0 + n) * ldt + k0 + 8 * c) = o;
        o.x = cvt_pk_h16(r[0], r[1]); o.y = cvt_pk_h16(r[2], r[3]); o.z = cvt_pk_h16(r[4], r[5]); o.w = cvt_pk_h16(r[6], r[7]);
        *(u32x4*)(WT + (size_t)(128 + n0 + n) * ldt + k0 + 8 * c) = o; }
    asm volatile("s_waitcnt lgkmcnt(0)" ::: "memory");
}


typedef float f32x16 __attribute__((ext_vector_type(16)));
constexpr int AT_KP = 144, AT_VP = 528, AT_VOFF = 256 * AT_KP;
__device__ __forceinline__ int crow(int r, int hi) { return (r & 3) + 8 * (r >> 2) + 4 * hi; }
struct KVRegs { u32x4 k[4], v[4]; };
__device__ __forceinline__ void attn_load_kv(const h16* HHp, const int b, const int n, const int hk, const int tid, KVRegs& r) {
    const int tb = b * SEQ + n * 128;
#pragma unroll
    for (int i = 0; i < 4; ++i) { const int idx = tid + 512 * i, key = idx >> 3, ch = idx & 7; const int tok = (n > 0) ? tb - 128 + key : tb + (key & 127);
        const h16* kp = HHp + (size_t)tok * DIN + C_K + hk * 64 + ch * 8; r.k[i] = *(const u32x4*)kp; r.v[i] = *(const u32x4*)(kp + 128); }
}
__device__ __forceinline__ void attn_unit(LAS unsigned char* lds, h16* HHp, h16* OUTp, const int opitch, const float* sinks, const int b, const int n, const int hk, const int tid,
                                          const int unused_ = 0) {
    const int lane = tid & 63, wid = __builtin_amdgcn_readfirstlane(tid >> 6), q32 = lane & 31, hi = lane >> 5;
    const int g = wid >> 1, qh = wid & 1, hq = hk * 4 + g;
    const int tb = b * SEQ + n * 128;
    LAS unsigned char* Ks = lds; LAS unsigned char* Vs = lds + AT_VOFF;
    KVRegs cur; attn_load_kv(HHp, b, n, hk, tid, cur);
    f16x8 qs[4];
    { const h16* qp = HHp + (size_t)(tb + 64 * qh + q32) * DIN + C_Q + hq * 64;
#pragma unroll
      for (int ks = 0; ks < 4; ++ks) qs[ks] = *(const f16x8*)(qp + 16 * ks + 8 * hi); }
#pragma unroll
    for (int i = 0; i < 4; ++i) { const int idx = tid + 512 * i, key = idx >> 3, ch = idx & 7; const u32x4 kw = cur.k[i], vw = cur.v[i];
        *(LAS u32x4*)(Ks + key * AT_KP + ch * 16) = kw;
        LAS unsigned short* vd = (LAS unsigned short*)(Vs + (ch * 8) * AT_VP + key * 2);
        vd[0 * (AT_VP / 2)] = (unsigned short)(vw.x & 0xffffu); vd[1 * (AT_VP / 2)] = (unsigned short)(vw.x >> 16); vd[2 * (AT_VP / 2)] = (unsigned short)(vw.y & 0xffffu); vd[3 * (AT_VP / 2)] = (unsigned short)(vw.y >> 16);
        vd[4 * (AT_VP / 2)] = (unsigned short)(vw.z & 0xffffu); vd[5 * (AT_VP / 2)] = (unsigned short)(vw.z >> 16); vd[6 * (AT_VP / 2)] = (unsigned short)(vw.w & 0xffffu); vd[7 * (AT_VP / 2)] = (unsigned short)(vw.w >> 16); }
    __syncthreads();
    const float slope = exp2f(-(float)(hq + 1)), sink = sinks[hq];
    float ab[16];
#pragma unroll
    for (int r = 0; r < 16; ++r) ab[r] = slope * (float)(crow(r, hi) - 128 - q32);
#pragma unroll 1
    for (int sub = 0; sub < 2; ++sub) {
        const int q0 = 64 * qh + 32 * sub, qi = q0 + q32;
        f32x16 sv[5]; float mx = -INFINITY;
#pragma unroll
        for (int j = 0; j < 5; ++j) { const int key0 = q0 + 32 * j; f32x16 c; float sl = slope; asm volatile("" : "+v"(sl)); const float aj = sl * (float)(32 * j);
#pragma unroll
            for (int r = 0; r < 16; ++r) c[r] = ab[r] + aj;
#pragma unroll
            for (int ks = 0; ks < 4; ++ks) { const f16x8 kf = *(const LAS f16x8*)(Ks + (key0 + q32) * AT_KP + (16 * ks + 8 * hi) * 2); c = __builtin_amdgcn_mfma_f32_32x32x16_f16(kf, qs[ks], c, 0, 0, 0); }
            const bool dead = (n == 0) && (key0 < 128);
            int hil = hi; asm volatile("" : "+v"(hil));
#pragma unroll
            for (int r = 0; r < 16; ++r) { float v = c[r];
                if (j == 0) v = (crow(r, hil) > q32) ? v : -INFINITY;
                if (j == 4) v = (crow(r, hil) <= q32) ? v : -INFINITY;
                if (dead) v = -INFINITY;
                c[r] = v; mx = fmaxf(mx, v); }
            sv[j] = c; __builtin_amdgcn_sched_barrier(0); }
        if (sub == 0) { const h16* qp = HHp + (size_t)(tb + 64 * qh + 32 + q32) * DIN + C_Q + hq * 64;
#pragma unroll
            for (int ks = 0; ks < 4; ++ks) qs[ks] = *(const f16x8*)(qp + 16 * ks + 8 * hi); }
        mx = fmaxf(mx, dppf_swap32(mx)); mx = fmaxf(mx, sink);
        float lsum = 0.f; f32x16 o0, o1;
#pragma unroll
        for (int r = 0; r < 16; ++r) { o0[r] = 0.f; o1[r] = 0.f; }
#pragma unroll
        for (int j = 0; j < 5; ++j) { const int key0 = q0 + 32 * j;
#pragma unroll
            for (int r = 0; r < 16; ++r) { const float pv = __expf(sv[j][r] - mx); sv[j][r] = pv; lsum += pv; }
#pragma unroll
            for (int cc = 0; cc < 2; ++cc) {
                u32x4 pw; pw.x = cvt_pk_h16(sv[j][8 * cc + 0], sv[j][8 * cc + 1]); pw.y = cvt_pk_h16(sv[j][8 * cc + 2], sv[j][8 * cc + 3]); pw.z = cvt_pk_h16(sv[j][8 * cc + 4], sv[j][8 * cc + 5]); pw.w = cvt_pk_h16(sv[j][8 * cc + 6], sv[j][8 * cc + 7]);
                const f16x8 pb = __builtin_bit_cast(f16x8, pw);
                const LAS unsigned char* vp = Vs + q32 * AT_VP + (key0 + 16 * cc + 4 * hi) * 2;
                { const u32x2 a0 = *(const LAS u32x2*)vp, a1 = *(const LAS u32x2*)(vp + 16); const u32x4 vw = {a0.x, a0.y, a1.x, a1.y}; o0 = __builtin_amdgcn_mfma_f32_32x32x16_f16(__builtin_bit_cast(f16x8, vw), pb, o0, 0, 0, 0); }
                { const u32x2 a0 = *(const LAS u32x2*)(vp + 32 * AT_VP), a1 = *(const LAS u32x2*)(vp + 32 * AT_VP + 16); const u32x4 vw = {a0.x, a0.y, a1.x, a1.y}; o1 = __builtin_amdgcn_mfma_f32_32x32x16_f16(__builtin_bit_cast(f16x8, vw), pb, o1, 0, 0, 0); }
                __builtin_amdgcn_sched_barrier(0);
            } }
        lsum += dppf_swap32(lsum); lsum += __expf(sink - mx);
        const float rl = 1.0f / lsum;
#pragma unroll
        for (int rg = 0; rg < 4; ++rg) { u32x2 w0, w1;
            w0.x = cvt_pk_h16(o0[4 * rg] * rl, o0[4 * rg + 1] * rl); w0.y = cvt_pk_h16(o0[4 * rg + 2] * rl, o0[4 * rg + 3] * rl);
            w1.x = cvt_pk_h16(o1[4 * rg] * rl, o1[4 * rg + 1] * rl); w1.y = cvt_pk_h16(o1[4 * rg + 2] * rl, o1[4 * rg + 3] * rl);
            h16* op = OUTp + (size_t)(tb + qi) * opitch + hq * 64; *(u32x2*)(op + 8 * rg + 4 * hi) = w0; *(u32x2*)(op + 32 + 8 * rg + 4 * hi) = w1; }
    }
    __syncthreads();
}
template <int W> __device__ __forceinline__ void pool_pair(const h16* HHp, h16* PDp, const int c8, const int tA, const int tB) {
    u32x4 q[2][W];
#pragma unroll
    for (int p = 0; p < 2; ++p) { const int t = p ? tB : tA; const int s = t & (SEQ - 1); const h16* up = HHp + (size_t)t * DIN + C_U + c8 * 8;
#pragma unroll
        for (int i = 0; i < W; ++i) { const int ii = (i <= s) ? i : 0; q[p][i] = *(const u32x4*)(up - (size_t)ii * DIN); } }
#pragma unroll
    for (int p = 0; p < 2; ++p) { const int t = p ? tB : tA; const int s = t & (SEQ - 1); f32x4 a0 = {0.f, 0.f, 0.f, 0.f}, a1 = {0.f, 0.f, 0.f, 0.f}, u0, u1;
#pragma unroll
        for (int i = 0; i < W; ++i) { f32x4 v0, v1; unpack8(q[p][i], v0, v1); if (i == 0) { u0 = v0; u1 = v1; } if (i <= s) { a0 += v0; a1 += v1; } }
        const float rn = 1.0f / (float)((s + 1 < W) ? s + 1 : W);
        *(u32x4*)(PDp + (size_t)t * 512 + c8 * 8) = pack8(a0 * rn - u0, a1 * rn - u1); }
}


__device__ __forceinline__ void prep_expert_items(const float* w_eg, const float* w_eu, const float* w_ed, unsigned char* egu_t, h16* ed_t, float* wsc, int e_lo, int e_hi, int wrk, int nwrk, LAS float* scr, int lane) {
    for (int it = e_lo + wrk; it < e_hi; it += nwrk) {
        if (it < 2 * 8192) { const int up = it >> 13, q = it & 8191, e = q >> 7, q2 = q & 127, kb = q2 >> 3, nb = q2 & 7, n0 = 32 * nb;
            const float* Wm = (up ? w_eu : w_eg) + (size_t)e * D * FF; const float sc = f8_scale_of(Wm, lane); if (q2 == 0 && lane == 0) wsc[2 * e + up] = 1.0f / sc;
            tr_item_f8(Wm, FF, egu_t + (size_t)e * 512 * 1024, 1024, 64 * kb, n0, 256 * (n0 >> 7) + (n0 & 127) + 128 * up, scr, lane, sc); }
        else { const int r = it - 2 * 8192, e = r >> 7, q2 = r & 127, kb = q2 >> 5, nb = q2 & 31; tr_item(w_ed + (size_t)e * FF * D, D, ed_t + (size_t)e * 1024 * 256, 256, 64 * kb, 32 * nb, 32 * nb, scr, lane); }
    }
}
#define W_EGU_P(lt) ((unsigned char*)(args.ws + (((lt) & 1) ? W_EGU_ALT : W_EGU_T)))
#define WSC_P(lt) ((float*)(args.ws + MS_WSC) + ((lt) & 1) * 128)
#define W_ED_P(lt)  ((h16*)(args.ws + (((lt) & 1) ? W_ED_ALT : W_ED_T)))
#define PREP_EXPERTS(lt, e_lo, e_hi, wrk, nwrk) prep_expert_items(args.in[15] + (size_t)(lt) * NE * D * FF, args.in[16] + (size_t)(lt) * NE * D * FF, args.in[17] + (size_t)(lt) * NE * FF * D, W_EGU_P(lt), W_ED_P(lt), WSC_P(lt), e_lo, e_hi, wrk, nwrk, (LAS float*)(F.lds + F.wave * 16384), lane_id())
constexpr int PE_A = 9830, PE_B = PE_A + 8602, PE_ALL = 3 * 8192;
#define PREP_WEIGHTS(E_LO) do { \
            LAS float* scr = (LAS float*)(F.lds + F.wave * 16384); \
            const float* w_in = L_W_IN; const float* w_br_attn = L_W_BRA; const float* w_out = L_W_OUT; const float* w_sg = L_W_SG; const float* w_su = L_W_SU; const float* w_sd = L_W_SD; \
            const float* w_eg = L_W_EG; const float* w_eu = L_W_EU; const float* w_ed = L_W_ED; const float* w_router = L_W_R; \
            constexpr int I_IN = 16 * 104, I_BA = 8 * 32, I_OUT = 16 * 32, I_SG = 16 * 8, I_SD = 4 * 32, I_EG = 64 * 128, I_ED = 64 * 128, I_R = 16 * 2; \
            constexpr int NITEMS = I_IN + I_BA + I_OUT + 2 * I_SG + I_SD + I_R; \
            for (int it = F.gw; it < NITEMS; it += F.NGW) { \
                int r = it; \
                if (r < I_IN) { const int kb = r / 104, nb = r % 104; tr_item(w_in, DIN, (h16*)(args.ws + W_IN_T), 1024, 64 * kb, 32 * nb, 32 * nb, scr, lane); continue; } r -= I_IN; \
                if (r < I_BA) { const int kb = r / 32, nb = r % 32; tr_item(w_br_attn, D, (h16*)(args.ws + W_BA_T), 512, 64 * kb, 32 * nb, 32 * nb, scr, lane); continue; } r -= I_BA; \
                if (r < I_OUT) { const int kb = r / 32, nb = r % 32; tr_item(w_out, D, (h16*)(args.ws + W_OUT_T), 1024, 64 * kb, 32 * nb, 32 * nb, scr, lane); continue; } r -= I_OUT; \
                if (r < 2 * I_SG) { const int up = r / I_SG, q = r % I_SG, kb = q / 8, nb = q % 8, n0 = 32 * nb; tr_item(up ? w_su : w_sg, FF, (h16*)(args.ws + W_SGU_T), 1024, 64 * kb, n0, 256 * (n0 >> 7) + (n0 & 127) + 128 * up, scr, lane); continue; } r -= 2 * I_SG; \
                if (r < I_SD) { const int kb = r / 32, nb = r % 32; tr_item(w_sd, D, (h16*)(args.ws + W_SD_T), 256, 64 * kb, 32 * nb, 32 * nb, scr, lane); continue; } r -= I_SD; \
                { const int kb = r / 2, nb = r % 2; tr_item_hilo(w_router, NE, (h16*)(args.ws + W_R_T), 1024, 64 * kb, 32 * nb, scr, lane); } \
            } \
            PREP_EXPERTS(l, (E_LO), PE_ALL, F.gw, F.NGW); \
            { h16* wpe = (h16*)(args.ws + W_PE_T); const float* w_pool = L_W_POOL; const float* pool_scale = L_PSCALE; const float* w_br_pool = L_W_BRP; \
              for (int idx = F.gw; idx < 512 * 16; idx += F.NGW) { const int cg = idx >> 4, n = ((idx & 15) << 6) + lane, g = cg >> 7; float s = 0.f; \
                  const float* wp = w_pool + (size_t)cg * 128; const float* ps = pool_scale + 128 * g; const float* wb = w_br_pool + (size_t)(128 * g) * D + n; \
                  float wv[128]; \
            _Pragma("unroll") \
                  for (int d = 0; d < 128; ++d) wv[d] = wb[(size_t)d * D]; \
            _Pragma("unroll") \
                  for (int d = 0; d < 128; ++d) s += wp[d] * ps[d] * wv[d]; \
                  wpe[(size_t)n * 512 + cg] = (h16)f2h(s); } } \
} while (0)
#define X32   (args.out)
#define XB    ((h16*)(args.ws + WS_XB))
#define HH    ((h16*)(args.ws + R_HH))
#define PD    ((h16*)(args.ws + R_PD))
#define MG    ((h16*)(args.ws + R_MG))
#define HB    ((h16*)(args.ws + WS_HB))
#define HS    ((h16*)(args.ws + WS_HS))
#define YD    ((h16*)(args.ws + WS_R))
#define LOGIT ((float*)(args.ws + WS_HB))
#define ESEL  ((int*)(args.ws + MS_ESEL))
#define GATE  ((float*)(args.ws + MS_GATE))
#define RANKL ((int*)(args.ws + MS_RANK))
#define SLOT  ((int*)(args.ws + MS_SLOT))
#define TOKL  ((int*)(args.ws + MS_TOKL))
#define GATL  ((float*)(args.ws + MS_GATL))
#define WCNT  ((int*)(args.ws + MS_WCNT))
#define GTOT  ((int*)(args.ws + MS_GTOT))
#define BLKE  ((int*)(args.ws + MS_BLKE))
#define L_W_IN   (args.in[3] + (size_t)l * D * DIN)
#define L_B_IN   (args.in[4] + (size_t)l * DIN)
#define L_W_POOL (args.in[5] + (size_t)l * 4 * 128 * 128)
#define L_PSCALE (args.in[6] + (size_t)l * 512)
#define L_SINKS  (args.in[7] + (size_t)l * 8)
#define L_W_BRP  (args.in[8] + (size_t)l * 512 * D)
#define L_W_BRA  (args.in[9] + (size_t)l * 512 * D)
#define L_W_OUT  (args.in[10] + (size_t)l * D * D)
#define L_LN1G   (args.in[11] + (size_t)l * D)
#define L_LN1B   (args.in[12] + (size_t)l * D)
#define L_W_R    (args.in[13] + (size_t)l * D * NE)
#define L_RBIAS  (args.in[14] + (size_t)l * NE)
#define L_W_EG   (args.in[15] + (size_t)l * NE * D * FF)
#define L_W_EU   (args.in[16] + (size_t)l * NE * D * FF)
#define L_W_ED   (args.in[17] + (size_t)l * NE * FF * D)
#define L_W_SG   (args.in[18] + (size_t)l * D * FF)
#define L_W_SU   (args.in[19] + (size_t)l * D * FF)
#define L_W_SD   (args.in[20] + (size_t)l * FF * D)
#define L_LN2G   (args.in[21] + (size_t)l * D)
#define L_LN2B   (args.in[22] + (size_t)l * D)
__global__ void __launch_bounds__(512, 2) fwd_kernel(Args args) {
    extern __shared__ __attribute__((aligned(16))) unsigned char lds_raw[];
    Frame F;
    F.lds = (LAS unsigned char*)lds_raw;
    F.wave = __builtin_amdgcn_readfirstlane((int)threadIdx.x >> 6);
    F.G = gridDim.x; { const int bx = blockIdx.x; F.vcu = (F.G % 8 == 0) ? (bx % 8) * (F.G / 8) + bx / 8 : bx; }
    F.gw = F.vcu * 8 + F.wave; F.NGW = F.G * 8;
    unsigned* ctl = (unsigned*)(args.ws + WS_CTL);
    volatile LAS unsigned* MISC = (volatile LAS unsigned*)(F.lds + MISC_OFF);
    for (int u = threadIdx.x; u < (LDS_BYTES - LDSCTL_OFF) / 4; u += 512) ((LAS unsigned*)(F.lds + LDSCTL_OFF))[u] = 0u;
    __syncthreads();
#if MK_ONE_LAUNCH
    XcdBarrier bar = xcd_barrier_post(ctl + CW_BAR, MISC + 8);
#define GRID_BAR() xcd_barrier(bar, F.wave)
#else
#define GRID_BAR() do {} while (0)
#endif
    const int lo = args.ph_lo, hi = args.ph_hi;
#ifndef PHASE_MASK
#define PHASE_MASK 0xfff
#endif
#ifndef REPEAT_MASK
#define REPEAT_MASK 0
#endif
#define REPS(p) for (int rep_ = 0; rep_ < 1 + ((REPEAT_MASK >> (p)) & 1); ++rep_)
#define IN(p) (((PHASE_MASK >> ((p) - pb)) & 1) && lo <= (p) && (p) < hi)
#define PHASE_REGS const int lane = lane_id(); const int tid = F.wave * 64 + lane; int vcu = F.vcu, bx = (int)blockIdx.x; asm volatile("" : "+s"(vcu), "+s"(bx)); (void)lane; (void)tid; (void)vcu; (void)bx;

    for (int l = 0; l < DEPTH; ++l) {
        const int pb = l * NPH;
        if (IN(pb + 0) && l == 0) {
            PHASE_REGS
            PREP_WEIGHTS(0);
            for (int m = F.gw; m < T; m += F.NGW) { f32x4 v[4];
#pragma unroll
                for (int j = 0; j < 4; ++j) v[j] = *(const f32x4*)(args.in[0] + (size_t)m * D + 8 * lane + 4 * (j & 1) + 512 * (j >> 1));
                ln_store8(v, args.in[1], args.in[2], nullptr, XB + (size_t)m * D, lane); }
            GRID_BAR();
        }
        if (IN(pb + 1)) {
            PHASE_REGS
            SchedDense S; S.o.init(T, DIN, F.G, bx); S.a = (const char*)XB; S.b = (const char*)(args.ws + W_IN_T); S.apitch = 2048; S.bpitch = 2048;
            EpiInProj E{HH, L_B_IN};
            REPS(1) GEMM_PHASE(1024, S, E);
            if (l + 1 < DEPTH && F.G == 256 && bx >= 128) PREP_EXPERTS(l + 1, 0, PE_A, (bx - 128) * 8 + F.wave, 128 * 8);
            GRID_BAR();
        }
        if (IN(pb + 2)) {
            PHASE_REGS
            { const int g = F.gw & 3, c8 = 16 * g + (lane & 15);
              for (int it = F.gw; it < T; it += 2 * F.NGW) { const int tA = (it >> 2) * 4 + (lane >> 4); const int it2 = (it + F.NGW < T) ? it + F.NGW : it; const int tB = (it2 >> 2) * 4 + (lane >> 4);
                  if (g == 0) pool_pair<2>(HH, PD, c8, tA, tB); else if (g == 1) pool_pair<4>(HH, PD, c8, tA, tB); else if (g == 2) pool_pair<8>(HH, PD, c8, tA, tB); else pool_pair<16>(HH, PD, c8, tA, tB); } }
            for (int U = vcu; U < NB * 16 * 2; U += F.G) attn_unit(F.lds, HH, HH + C_Q, DIN, L_SINKS, U >> 5, (U >> 1) & 15, U & 1, tid);
            GRID_BAR();
        }
        if (IN(pb + 3)) {
            PHASE_REGS
            SchedMerged S; S.o.init(T, D, F.G, bx); S.pd = (const char*)PD; S.oo = (const char*)(HH + C_Q); S.wpe = (const char*)(args.ws + W_PE_T); S.wba = (const char*)(args.ws + W_BA_T);
            EpiMerged E{MG, HH};
            REPS(3) GEMM_PHASE(512, S, E);
            GRID_BAR();
        }
        if (IN(pb + 4)) {
            PHASE_REGS
            SchedDense S; S.o.init(T, D, F.G, bx); S.a = (const char*)MG; S.b = (const char*)(args.ws + W_OUT_T); S.apitch = 2048; S.bpitch = 2048;
            EpiResid E{(h16*)X32, XB};
            REPS(4) GEMM_PHASE(1024, S, E);
            GRID_BAR();
        }
        if (IN(pb + 5)) {
            PHASE_REGS
            for (int m0 = F.gw; m0 < T; m0 += 4 * F.NGW) { u32x4 ra[4], rb4[4];
#pragma unroll
                for (int q = 0; q < 4; ++q) { const int m = (m0 + q * F.NGW < T) ? m0 + q * F.NGW : m0; const h16* sp = (const h16*)X32 + (size_t)m * D + 8 * lane;
                    ra[q] = __builtin_nontemporal_load((const u32x4*)sp); rb4[q] = __builtin_nontemporal_load((const u32x4*)(sp + 512)); }
#pragma unroll
                for (int q = 0; q < 4; ++q) { const int m = m0 + q * F.NGW; if (m < T) { f32x4 v[4]; unpack8(ra[q], v[0], v[1]); unpack8(rb4[q], v[2], v[3]); ln_store8(v, L_LN1G, L_LN1B, nullptr, XB + (size_t)m * D, lane, -1, -1, (unsigned char*)(args.ws + W_XB8) + (size_t)m * D); } } }
            GRID_BAR();
        }
        if (IN(pb + 6)) {
            PHASE_REGS
            SchedSharedRouter S{F.G, vcu, (const char*)XB, (const char*)(args.ws + W_SGU_T), (const char*)(args.ws + W_R_T)};
            EpiSharedRouter E{HS, LOGIT};
            REPS(6) GEMM_PHASE(1024, S, E);
            GRID_BAR();
        }
        if (IN(pb + 7)) {
            PHASE_REGS
            LAS int* lcnt = (LAS int*)(F.lds);
            const float rb = L_RBIAS[lane];
            REPS(7) for (int w = vcu; w < 256; w += F.G) {
                int mycnt = 0; const int t0 = w * 128 + F.wave * 16;
                float lgs[16];
#pragma unroll
                for (int tt = 0; tt < 16; ++tt) lgs[tt] = LOGIT[(size_t)(t0 + tt) * NE + lane] + LOGIT[(size_t)T * NE + (size_t)(t0 + tt) * NE + lane];
#pragma unroll
                for (int tt = 0; tt < 16; ++tt) { const int t = t0 + tt;
                    const float lg = lgs[tt]; const float scv = 1.0f / (1.0f + __expf(-lg)); const float bs = scv + rb;
                    const float m1 = max8(bs);
                    const unsigned long long eq = __ballot(bs == m1); const int g = lane >> 3; const unsigned gm = (unsigned)(eq >> (8 * g)) & 0xffu; const int first = __builtin_ctz(gm);
                    const float m2 = max8(((lane & 7) == first) ? -INFINITY : bs);
                    const float gs = m1 + m2; int grank = 0;
#pragma unroll
                    for (int j = 0; j < 8; ++j) { const float gj = rdlane(gs, 8 * j); grank += (gj > gs || (gj == gs && j < g)) ? 1 : 0; }
                    const bool keep = grank < 4; const float v = keep ? bs : -INFINITY; int rank = 0;
#pragma unroll
                    for (int j = 0; j < 64; ++j) { const float vj = rdlane(v, j); rank += (vj > v || (vj == v && j < lane)) ? 1 : 0; }
                    const bool sel = keep && rank < 8;
                    const float ssum = wave_sum(sel ? scv : 0.f);
                    if (sel) { ESEL[t * 8 + rank] = lane; GATE[t * 8 + rank] = scv / ssum * 2.5f; RANKL[t * 8 + rank] = mycnt; mycnt++; }
                }
                WCNT[(size_t)(w * 8 + F.wave) * 64 + lane] = mycnt;
                lcnt[F.wave * 64 + lane] = mycnt;
                __syncthreads();
                if (F.wave == 0) { int s = 0;
#pragma unroll
                    for (int v = 0; v < 8; ++v) s += lcnt[v * 64 + lane];
                    GTOT[w * 64 + lane] = s; }
                __syncthreads();
            }
            GRID_BAR();
        }
        if (IN(pb + 8)) {
            PHASE_REGS
            REPS(8) for (int w = vcu; w < 256; w += F.G) {
                int tot = 0, before = 0;
#pragma unroll 64
                for (int w2 = 0; w2 < 256; ++w2) { const int c = GTOT[w2 * 64 + lane]; tot += c; before += (w2 < w) ? c : 0; }
                for (int v2 = 0; v2 < F.wave; ++v2) before += WCNT[(size_t)(w * 8 + v2) * 64 + lane];
                const int pc = (tot + 255) & ~255; int incl = pc;
#pragma unroll
                for (int o = 1; o < 64; o <<= 1) { const int xv = __shfl_up(incl, o); if (lane >= o) incl += xv; }
                const int pstart = incl - pc, base = pstart + before; const int t0 = w * 128 + F.wave * 16;
#pragma unroll
                for (int it = 0; it < 2; ++it) { const int idx = it * 64 + lane, tt = t0 + (idx >> 3), k = idx & 7; const int e = ESEL[tt * 8 + k], r = RANKL[tt * 8 + k]; const float g = GATE[tt * 8 + k];
                    const int dest = __shfl(base, e) + r; TOKL[dest] = tt * 9 + k; GATL[dest] = g; }
                if (F.wave == 0 && w < 64) {
                    const int ps_ = __shfl(pstart, w), te = __shfl(tot, w), pe = __shfl(pc, w);
                    for (int i2 = te + lane; i2 < pe; i2 += 64) { TOKL[ps_ + i2] = YT_DUMP; GATL[ps_ + i2] = 0.f; } }
                if (F.wave == 1) {
                    const int nblk = __shfl(incl, 63) >> 8; const int rbk = 8 * w + (lane & 7); int cnt = 0;
                    for (int e = 0; e < 64; ++e) { const int pend = __shfl(incl, e); cnt += (pend <= rbk * 256) ? 1 : 0; }
                    if (lane < 8 && rbk < nblk) BLKE[rbk] = cnt < 63 ? cnt : 63;
                    if (w == 0 && lane == 0) BLKE[NBLK_MAX] = nblk; }
            }
            GRID_BAR();
        }
        if (IN(pb + 9)) {
            PHASE_REGS
            const int nblk = __builtin_amdgcn_readfirstlane(BLKE[NBLK_MAX]);
            { LAS int* bl = (LAS int*)(F.lds + LDS_BLKE); for (int i = tid; i < nblk; i += 512) bl[i] = BLKE[i]; __syncthreads(); }
            SchedMoeGU S{F.G, vcu, nblk, (const char*)(args.ws + W_XB8), (const char*)W_EGU_P(l), (const LAS int*)(F.lds + LDS_BLKE), TOKL};
            EpiMoeGU E{HB, GATL, WSC_P(l)};
            REPS(9) GEMM_PHASE_F8(512, S, E);
            { const int rounds = (2 * nblk + 255) >> 8, busy = 2 * nblk - 256 * (rounds - 1);
              if (l + 1 < DEPTH && F.G == 256 && 256 - busy >= 128 && vcu >= busy) PREP_EXPERTS(l + 1, PE_A, PE_ALL, (vcu - busy) * 8 + F.wave, (256 - busy) * 8); }
            GRID_BAR();
        }
        if (IN(pb + 10)) {
            PHASE_REGS
            const int nblk = __builtin_amdgcn_readfirstlane(BLKE[NBLK_MAX]);
            { LAS int* bl = (LAS int*)(F.lds + LDS_BLKE); for (int i = tid; i < nblk; i += 512) bl[i] = BLKE[i]; __syncthreads(); }
            SchedMoeDown S{F.G, vcu, nblk, (const char*)HB, (const char*)HS, (const char*)W_ED_P(l), (const char*)(args.ws + W_SD_T), (const LAS int*)(F.lds + LDS_BLKE), TOKL};
            REPS(10) { EpiMoeDown E{(unsigned char*)(args.ws + WS_R), (h16*)(args.ws + R_YS)};
            GEMM_PHASE(256, S, E); }
            GRID_BAR();
        }
        if (IN(pb + 11)) {
            PHASE_REGS
            { float* xo = (l == DEPTH - 1) ? X32 : nullptr;
            const unsigned char* YQ = (const unsigned char*)(args.ws + WS_R); const h16* YS = (const h16*)(args.ws + R_YS);
            const int c0 = 256 * (lane >> 4) + 32 * ((lane >> 2) & 3) + 8 * (lane & 3), c1 = c0 + 128;
            for (int m0 = F.gw; m0 < T; m0 += 3 * F.NGW) {
                u32x4 yq[3][9], xa[3], xb2[3]; unsigned short ys[3][9];
#pragma unroll
                for (int q = 0; q < 3; ++q) { const int m = (m0 + q * F.NGW < T) ? m0 + q * F.NGW : m0;
                    xa[q] = *(const u32x4*)(XB + (size_t)m * D + c0); xb2[q] = *(const u32x4*)(XB + (size_t)m * D + c1);
#pragma unroll
                    for (int k = 0; k < 9; ++k) { yq[q][k] = __builtin_nontemporal_load((const u32x4*)(YQ + ((size_t)m * 9 + k) * 1024 + lane * 16)); ys[q][k] = __builtin_nontemporal_load((const unsigned short*)(YS + ((size_t)m * 9 + k) * 64 + lane)); } }
#pragma unroll
                for (int q = 0; q < 3; ++q) { const int m = m0 + q * F.NGW; if (m < T) {
                    f32x4 v[4]; unpack8(xa[q], v[0], v[1]); unpack8(xb2[q], v[2], v[3]);
#pragma unroll
                    for (int j = 0; j < 4; ++j) v[j] = v[j] * ALPHA;
#pragma unroll
                    for (int k = 0; k < 9; ++k) { const float sc = h2f(ys[q][k]); const float bias = -128.0f * sc;
#pragma unroll
                        for (int j = 0; j < 4; ++j) { const unsigned wd = yq[q][k][j] ^ 0x80808080u;
                            v[j][0] += (float)(wd & 0xffu) * sc + bias; v[j][1] += (float)((wd >> 8) & 0xffu) * sc + bias; v[j][2] += (float)((wd >> 16) & 0xffu) * sc + bias; v[j][3] += (float)(wd >> 24) * sc + bias; } }
                    ln_store8(v, L_LN2G, L_LN2B, xo ? xo + (size_t)m * D : nullptr, XB + (size_t)m * D, lane, c0, c1); } } } }
            if (l + 1 < DEPTH) { const int nblk_ = __builtin_amdgcn_readfirstlane(BLKE[NBLK_MAX]); const int rounds_ = (2 * nblk_ + 255) >> 8, busy_ = 2 * nblk_ - 256 * (rounds_ - 1);
                const int e_lo = (F.G != 256) ? 0 : (256 - busy_ >= 128 ? PE_ALL : PE_A);
                ++l; PREP_WEIGHTS(e_lo); --l; }
            if (pb + 11 != DEPTH * NPH - 1) GRID_BAR();
        }
    }
#undef IN
}

extern "C" void kernel_launch(void* const* d_in, const int* in_sizes, int n_in, void* d_out, int out_size, void* d_ws, size_t ws_size, hipStream_t stream) {
    static int grid = 0;
    if (grid == 0) {
        if (n_in != 23 || out_size != T * D || ws_size < WS_END2) { fprintf(stderr, "kernel_launch: unexpected shapes (n_in %d out %d ws %zu)\n", n_in, out_size, ws_size); grid = -1; return; }
        int dev = 0, cus = 0;
        if (hipGetDevice(&dev) != hipSuccess || hipDeviceGetAttribute(&cus, hipDeviceAttributeMultiprocessorCount, dev) != hipSuccess) { grid = -1; return; }
        if (hipFuncSetAttribute((const void*)fwd_kernel, hipFuncAttributeMaxDynamicSharedMemorySize, LDS_BYTES) != hipSuccess) { fprintf(stderr, "kernel_launch: hipFuncSetAttribute failed\n"); grid = -1; return; }
        int per_cu = 0;
        if (hipOccupancyMaxActiveBlocksPerMultiprocessor(&per_cu, (const void*)fwd_kernel, 512, LDS_BYTES) != hipSuccess || per_cu < 1) { fprintf(stderr, "kernel_launch: occupancy query says %d\n", per_cu); }
        (void)hipGetLastError();
        grid = cus;
    }
    if (grid < 0) return;
    (void)hipMemsetAsync((char*)d_ws + WS_CTL, 0, CTL_ZERO_BYTES, stream);
    Args a{};
    for (int i = 0; i < 23; ++i) a.in[i] = (const float*)d_in[i];
    a.out = (float*)d_out; a.ws = (unsigned char*)d_ws;
#if MK_ONE_LAUNCH
    a.ph_lo = 0; a.ph_hi = DEPTH * NPH;
    hipLaunchKernelGGL(fwd_kernel, dim3(grid), dim3(512), LDS_BYTES, stream, a);
#else
    for (int p = 0; p < DEPTH * NPH; ++p) { a.ph_lo = p; a.ph_hi = p + 1; hipLaunchKernelGGL(fwd_kernel, dim3(grid), dim3(512), LDS_BYTES, stream, a); }
#endif
}
```

```cpp
#include <hip/hip_runtime.h>
#include <stdint.h>
#include <stdio.h>

#ifndef MK_ONE_LAUNCH
#define MK_ONE_LAUNCH 1
#endif

#define GAS __attribute__((address_space(1)))
#define LAS __attribute__((address_space(3)))
typedef unsigned short h16;
typedef short h16x8 __attribute__((ext_vector_type(8)));
typedef float f32x4 __attribute__((ext_vector_type(4)));
typedef float f32x2 __attribute__((ext_vector_type(2)));
typedef unsigned u32x4 __attribute__((ext_vector_type(4)));
typedef unsigned u32x2 __attribute__((ext_vector_type(2)));

constexpr int NB = 16, SEQ = 2048, T = NB * SEQ, D = 1024, DIN = 3328, DEPTH = 4;
constexpr int C_U = 0, C_Q = 512, C_K = 1024, C_V = 1152, C_GP = 1280, C_GA = 2304;
constexpr int NE = 64, FF = 256, TOPK = 8;
constexpr int NASSIGN = T * TOPK;
constexpr int NBLK_MAX = NASSIGN / 256 + NE;
constexpr int A_PAD = NBLK_MAX * 256;
constexpr float ALPHA = 1.6817928305074290f;
constexpr float LN_EPS = 1e-5f;
constexpr int NPH = 12;

constexpr size_t MiB = 1u << 20;
constexpr size_t WS_CTL = 0, CTL_ZERO_BYTES = 1 * MiB;
constexpr size_t WS_W = 1 * MiB;
constexpr size_t W_IN_T = WS_W + 0 * MiB;
constexpr size_t W_PE_T = WS_W + 7 * MiB;
constexpr size_t W_BA_T = WS_W + 8 * MiB;
constexpr size_t W_OUT_T = WS_W + 9 * MiB;
constexpr size_t W_R_T = WS_W + 11 * MiB;
constexpr size_t W_SGU_T = WS_W + 12 * MiB;
constexpr size_t W_SD_T = WS_W + 13 * MiB;
constexpr size_t W_EGU_T = WS_W + 14 * MiB;
constexpr size_t W_ED_T = WS_W + 78 * MiB;
constexpr size_t W_XB8 = W_EGU_T + 32 * MiB;
constexpr size_t WS_XB = 111 * MiB;
constexpr size_t WS_HB = 175 * MiB;
constexpr size_t WS_HS = 311 * MiB;
constexpr size_t WS_MISC = 327 * MiB;
constexpr size_t MS_LOGIT = WS_MISC;
constexpr size_t MS_ESEL = WS_MISC + 8 * MiB;
constexpr size_t MS_GATE = WS_MISC + 9 * MiB;
constexpr size_t MS_RANK = WS_MISC + 10 * MiB;
constexpr size_t MS_SLOT = WS_MISC + 11 * MiB;
constexpr size_t MS_TOKL = WS_MISC + 12 * MiB;
constexpr size_t MS_GATL = WS_MISC + 13 * MiB + 256 * 1024;
constexpr size_t MS_WCNT = WS_MISC + 14 * MiB + 512 * 1024;
constexpr size_t MS_GTOT = WS_MISC + 15 * MiB;
constexpr size_t MS_BLKE = WS_MISC + 15 * MiB + 256 * 1024;
constexpr size_t MS_WSC = WS_MISC + 15 * MiB + 512 * 1024;
constexpr size_t WS_R = 343 * MiB;
constexpr size_t R_HH = WS_R;
constexpr size_t R_PD = WS_R + 208 * MiB;
constexpr size_t R_MG = WS_R + 240 * MiB;
constexpr size_t WS_END = WS_R + 577 * MiB;
constexpr size_t W_EGU_ALT = WS_END;
constexpr size_t W_ED_ALT = WS_END + 64 * MiB;
constexpr size_t WS_END2 = WS_END + 96 * MiB;
constexpr size_t R_YS = WS_R + 296 * MiB;
constexpr int YT_DUMP = T * 9;
static_assert((size_t)A_PAD * 4 <= 1 * MiB + 256 * 1024, "toklist");
static_assert((size_t)A_PAD * 256 * 2 <= 136 * MiB, "Hbuf");
static_assert(((size_t)T * 9 + 1) * 1024 * 2 <= 577 * MiB, "Yt");

constexpr int CW_BAR = 4096;

constexpr int RING_BYTES = 131072;
constexpr int LDSCTL_OFF = RING_BYTES, MISC_OFF = LDSCTL_OFF + 320;
constexpr int LDS_BYTES = 147456;
constexpr int LDS_BLKE = LDSCTL_OFF + 1024;
constexpr int LDS_IDX = LDS_BLKE + 4352;
constexpr int LDS_OID = LDS_IDX + 2048;
static_assert(LDS_OID + 3072 <= LDS_BYTES, "LDS map");

#define RLX_AGENT __ATOMIC_RELAXED, __HIP_MEMORY_SCOPE_AGENT
__device__ __forceinline__ int lane_id() { int l; asm volatile("v_mbcnt_lo_u32_b32 %0, -1, 0\n\tv_mbcnt_hi_u32_b32 %0, -1, %0" : "=v"(l)); return l; }
typedef _Float16 f16x2 __attribute__((ext_vector_type(2)));
typedef _Float16 f16x8 __attribute__((ext_vector_type(8)));
__device__ __forceinline__ float h2f(unsigned short h) { return (float)__builtin_bit_cast(_Float16, h); }
__device__ __forceinline__ unsigned short f2h(float f) { return __builtin_bit_cast(unsigned short, (_Float16)f); }
__device__ __forceinline__ unsigned cvt_pk_h16(float lo, float hi) { f32x2 v = {lo, hi}; return __builtin_bit_cast(unsigned, __builtin_convertvector(v, f16x2)); }
__device__ __forceinline__ float lo16(unsigned w) { return (float)__builtin_bit_cast(f16x2, w)[0]; }
__device__ __forceinline__ float hi16(unsigned w) { return (float)__builtin_bit_cast(f16x2, w)[1]; }
__device__ __forceinline__ float sigmoidf_(float x) { return __builtin_amdgcn_rcpf(1.0f + __builtin_amdgcn_exp2f(-1.4426950408889634f * x)); }
template <int CTRL> __device__ __forceinline__ float dppf(float x) { return __builtin_bit_cast(float, __builtin_amdgcn_update_dpp(0, __builtin_bit_cast(int, x), CTRL, 0xf, 0xf, true)); }
__device__ __forceinline__ float rdlane(float x, int l) { return __builtin_bit_cast(float, __builtin_amdgcn_readlane(__builtin_bit_cast(int, x), l)); }
__device__ __forceinline__ float wave_sum(float v) {
    v += dppf<0xB1>(v); v += dppf<0x4E>(v); v += dppf<0x141>(v); v += dppf<0x140>(v);
    return (rdlane(v, 0) + rdlane(v, 16)) + (rdlane(v, 32) + rdlane(v, 48));
}
__device__ __forceinline__ float wave_max(float v) {
    v = fmaxf(v, dppf<0xB1>(v)); v = fmaxf(v, dppf<0x4E>(v)); v = fmaxf(v, dppf<0x141>(v)); v = fmaxf(v, dppf<0x140>(v));
    return fmaxf(fmaxf(rdlane(v, 0), rdlane(v, 16)), fmaxf(rdlane(v, 32), rdlane(v, 48)));
}
__device__ __forceinline__ float dppf_swap32(float x) { return __shfl_xor(x, 32); }
__device__ __forceinline__ float max8(float v) {
    v = fmaxf(v, dppf<0xB1>(v)); v = fmaxf(v, dppf<0x4E>(v)); return fmaxf(v, dppf<0x141>(v));
}

#define XB_TMO      128
#define XB_XCNT(j)  (256  + 64 * (j))
#define XB_XSUB(j)  (1280 + 64 * (j))
#define XB_XGEN(j)  (2304 + 64 * (j))
#define XB_TOP      3328
#define XB_TOPGEN   3392
#define XCD_BAR_WORDS 3456
#define XB_SPIN_CAP (1u << 18)
__device__ __forceinline__ unsigned xb_ld(unsigned* p)              { return __hip_atomic_load(p, __ATOMIC_RELAXED, __HIP_MEMORY_SCOPE_AGENT); }
__device__ __forceinline__ unsigned xb_add(unsigned* p, unsigned v) { return __hip_atomic_fetch_add(p, v, __ATOMIC_RELAXED, __HIP_MEMORY_SCOPE_AGENT); }
__device__ __forceinline__ unsigned xb_xcc_id() { return (unsigned)__builtin_amdgcn_s_getreg((3 << 11) | 20) & 0xFu; }
#define XB_SPIN(cond, bar) do { unsigned _sp = 0; while (cond) { __builtin_amdgcn_s_sleep(1); \
    if ((++_sp & 255u) == 0u) { if (xb_ld(&(bar)[XB_TMO])) break; if (_sp > XB_SPIN_CAP) { atomicAdd(&(bar)[XB_TMO], 1u); break; } } } } while (0)
struct XcdBarrier { unsigned* bar; unsigned x; volatile LAS unsigned* st; };
__device__ __forceinline__ XcdBarrier xcd_barrier_post(unsigned* bar, volatile LAS unsigned* st) {
    XcdBarrier b; b.bar = bar; b.x = xb_xcc_id(); b.st = st;
    if (threadIdx.x == 0) (void)xb_add(&bar[XB_XCNT(b.x)], 1u);
    return b;
}
__device__ __forceinline__ void xcd_barrier_complete(unsigned* bar, unsigned x, unsigned& nloc, unsigned& nx) {
    const unsigned G = gridDim.x * gridDim.y * gridDim.z;
    unsigned sum, cnt, mine, sp = 0u;
    for (;;) {
        sum = 0u; cnt = 0u; mine = 0u;
#pragma unroll
        for (unsigned j = 0; j < 16; ++j) { const unsigned c = xb_ld(&bar[XB_XCNT(j)]); sum += c; cnt += (c > 0u) ? 1u : 0u; mine = (j == x) ? c : mine; }
        if (sum == G) break;
        __builtin_amdgcn_s_sleep(1);
        if ((++sp & 255u) == 0u) { if (xb_ld(&bar[XB_TMO])) break; if (sp > XB_SPIN_CAP) { atomicAdd(&bar[XB_TMO], 1u); break; } }
    }
    nloc = mine > 0u ? mine : 1u; nx = cnt > 0u ? cnt : 1u;
}
__device__ __forceinline__ void xcd_barrier(const XcdBarrier& b, const int wave) {
    asm volatile("s_waitcnt vmcnt(0)" ::: "memory");
    __syncthreads();
    if (wave == 0 && lane_id() == 0) {
        unsigned* bar = b.bar;
        __builtin_amdgcn_s_waitcnt(0);
        unsigned nloc = b.st[0], nx = b.st[1];
        if (nloc == 0u) { xcd_barrier_complete(bar, b.x, nloc, nx); b.st[0] = nloc; b.st[1] = nx; }
        const unsigned old = xb_add(&bar[XB_XSUB(b.x)], 1u);
        const unsigned gen = old / nloc;
        if (old + 1u == (gen + 1u) * nloc) {
            __builtin_amdgcn_fence(__ATOMIC_RELEASE, "agent");
            asm volatile("s_waitcnt vmcnt(0)" ::: "memory");
            const unsigned og = xb_add(&bar[XB_TOP], 1u);
            const unsigned tg = og / nx;
            if (og + 1u == (tg + 1u) * nx) xb_add(&bar[XB_TOPGEN], 1u);
            else XB_SPIN(xb_ld(&bar[XB_TOPGEN]) == tg, bar);
            __builtin_amdgcn_fence(__ATOMIC_ACQUIRE, "agent");
            xb_add(&bar[XB_XGEN(b.x)], 1u);
            asm volatile("s_waitcnt vmcnt(0)" ::: "memory");
        } else {
            XB_SPIN(xb_ld(&bar[XB_XGEN(b.x)]) == gen, bar);
            __builtin_amdgcn_fence(__ATOMIC_ACQUIRE, "agent");
            asm volatile("s_waitcnt vmcnt(0)" ::: "memory");
        }
    }
    __syncthreads();
}

struct Unit {
    const char* a;
    const char* b;
    const int* ridx;
    unsigned apitch, bpitch;
    int row0;
    int col0;
    int kind;
    const int* oidx;
    const LAS int* oidl;
    int nt;
    int keep;
};
__device__ __forceinline__ int id2tok(int id) { const int t = (int)(((unsigned long long)(unsigned)id * 954437177ull) >> 33); return t < T ? t : T - 1; }
#define ACC_T f32x4 (&acc)[2][2][4][2]

template <class Epi, class Sched>
__device__ __forceinline__ void gemm_phase_simple(const int wid, const int K, const Sched& S, const Epi& E) {
    const int lane = lane_id(), tid = wid * 64 + lane; (void)tid;
    const int  wr = wid >> 2, wc = wid & 3, fr = lane & 15, fq = lane >> 4;
    Unit u;
    for (int i = 0; S.next(i, u); ++i) {
        f32x4 acc[2][2][4][2];
#pragma unroll
        for (int a = 0; a < 2; ++a)
#pragma unroll
            for (int b = 0; b < 2; ++b)
#pragma unroll
                for (int m = 0; m < 4; ++m)
#pragma unroll
                    for (int n = 0; n < 2; ++n) acc[a][b][m][n] = (f32x4){0.f, 0.f, 0.f, 0.f};
        unsigned offA[2][4], offB[2][2];
#pragma unroll
        for (int ai = 0; ai < 2; ++ai)
#pragma unroll
            for (int m = 0; m < 4; ++m) { const int r = 128 * ai + 64 * wr + 16 * m + fr; const int row = u.ridx ? id2tok(u.ridx[r]) : u.row0 + r; offA[ai][m] = (unsigned)row * u.apitch + (unsigned)fq * 16u; }
#pragma unroll
        for (int bj = 0; bj < 2; ++bj)
#pragma unroll
            for (int n = 0; n < 2; ++n) { const int wrow = 128 * bj + 32 * wc + 8 * (fr >> 2) + 4 * n + (fr & 3); offB[bj][n] = (unsigned)wrow * u.bpitch + (unsigned)fq * 16u; }
#pragma unroll 1
        for (int k0 = 0; k0 < K; k0 += 32) {
            h16x8 b[2][2];
#pragma unroll
            for (int bj = 0; bj < 2; ++bj)
#pragma unroll
                for (int n = 0; n < 2; ++n) b[bj][n] = *(const h16x8*)(u.b + offB[bj][n] + (size_t)k0 * 2);
#pragma unroll
            for (int ai = 0; ai < 2; ++ai) {
                h16x8 a[4];
#pragma unroll
                for (int m = 0; m < 4; ++m) a[m] = *(const h16x8*)(u.a + offA[ai][m] + (size_t)k0 * 2);
#pragma unroll
                for (int bj = 0; bj < 2; ++bj)
#pragma unroll
                    for (int m = 0; m < 4; ++m)
#pragma unroll
                        for (int n = 0; n < 2; ++n) acc[ai][bj][m][n] = __builtin_amdgcn_mfma_f32_16x16x32_f16(__builtin_bit_cast(f16x8, b[bj][n]), __builtin_bit_cast(f16x8, a[m]), acc[ai][bj][m][n], 0, 0, 0);
                asm volatile("" ::: "memory");
            }
        }
        u.oidl = nullptr;
        E(acc, u, wr, wc, fr, fq);
    }
}


#ifndef FAST_GEMM
#define FAST_GEMM 1
#endif
constexpr int HTB = 128 * 64 * 2;
__device__ __forceinline__ int lds_byte(int r, int c) { const int st = (r >> 4) * 2 + (c >> 5), rr = r & 15, cc = c & 31, ob = rr * 64 + cc * 2; return st * 1024 + (ob ^ (((ob >> 9) & 1) << 5)); }
__device__ __forceinline__ void stage_rc(int b, int& R, int& C) { const int st = b / 1024, sb = b % 1024, swz = sb ^ (((sb >> 9) & 1) << 5); R = (st >> 1) * 16 + swz / 64; C = (st & 1) * 32 + (swz % 64) / 2; }
__device__ __forceinline__ int perm32(int rho) { const int n = rho >> 4, i = rho & 15; return 8 * (i >> 2) + 4 * n + (i & 3); }

__device__ __forceinline__ const char* uptr(const char* p) { const unsigned long long v = (unsigned long long)p; const unsigned lo = __builtin_amdgcn_readfirstlane((unsigned)v), hi = __builtin_amdgcn_readfirstlane((unsigned)(v >> 32)); return (const char*)(((unsigned long long)hi << 32) | lo); }
typedef int i32x8 __attribute__((ext_vector_type(8)));
__device__ __forceinline__ i32x8 cat8(const u32x4 a, const u32x4 b) { return (i32x8){(int)a.x, (int)a.y, (int)a.z, (int)a.w, (int)b.x, (int)b.y, (int)b.z, (int)b.w}; }
template <int H> __device__ __forceinline__ f16x8 half8(const i32x8 v) { typedef int i32x4_ __attribute__((ext_vector_type(4))); const i32x4_ q = __builtin_shufflevector(v, v, 4 * H, 4 * H + 1, 4 * H + 2, 4 * H + 3); return __builtin_bit_cast(f16x8, q); }
template <bool F8, class Epi, class Sched>
__device__ __forceinline__ void gemm_phase(LAS unsigned char* lds, const int wid, const int K, const Sched& S, const Epi& E) {
    const int lane = lane_id(), tid = wid * 64 + lane;
    const int  wr = wid >> 2, wc = wid & 3, fr = lane & 15, fq = lane >> 4;
    int nt = K / 64;
    const unsigned ldsw = (unsigned)wid * 1024u;
    const int aoff = lds_byte(wr * 64 + fr, fq * 8), boff = lds_byte(wc * 32 + fr, fq * 8);
#define G_SA(b, h) (((b) * 2 + (h)) * HTB)
#define G_SB(b, h) ((4 + (b) * 2 + (h)) * HTB)
#define G_STAGE(bufoff, gbase, o0, o1) do { \
        __builtin_amdgcn_global_load_lds((const unsigned*)((const char*)(gbase) + (o0)), (LAS unsigned*)(lds + (bufoff) + ldsw), 16, 0, 0); \
        __builtin_amdgcn_global_load_lds((const unsigned*)((const char*)(gbase) + (o1)), (LAS unsigned*)(lds + (bufoff) + ldsw + 8192), 16, 0, 0); } while (0)
#define G_LDA(dst, b, h) do { _Pragma("unroll") for (int m = 0; m < 4; ++m) dst[m] = cat8(*(const LAS u32x4*)(lds + G_SA(b, h) + aoff + m * 2048), *(const LAS u32x4*)(lds + G_SA(b, h) + aoff + m * 2048 + 1024)); } while (0)
#define G_LDB(dst, b, h) do { _Pragma("unroll") for (int n = 0; n < 2; ++n) dst[n] = cat8(*(const LAS u32x4*)(lds + G_SB(b, h) + boff + n * 2048), *(const LAS u32x4*)(lds + G_SB(b, h) + boff + n * 2048 + 1024)); } while (0)
#define G_MMA(ai, bj, At, Bt) do { __builtin_amdgcn_s_setprio(1); _Pragma("unroll") for (int m = 0; m < 4; ++m) _Pragma("unroll") for (int n = 0; n < 2; ++n) { \
        if constexpr (F8) { acc[ai][bj][m][n] = __builtin_amdgcn_mfma_scale_f32_16x16x128_f8f6f4(Bt[n], At[m], acc[ai][bj][m][n], 0, 0, 0, 0, 0, 0); } \
        else { acc[ai][bj][m][n] = __builtin_amdgcn_mfma_f32_16x16x32_f16(half8<0>(Bt[n]), half8<0>(At[m]), acc[ai][bj][m][n], 0, 0, 0); \
               acc[ai][bj][m][n] = __builtin_amdgcn_mfma_f32_16x16x32_f16(half8<1>(Bt[n]), half8<1>(At[m]), acc[ai][bj][m][n], 0, 0, 0); } } \
        __builtin_amdgcn_s_setprio(0); } while (0)
#define G_WAIT_V(n) asm volatile("s_waitcnt vmcnt(" #n ")" ::: "memory")
#define G_WAIT_L(n) asm volatile("s_waitcnt lgkmcnt(" #n ")" ::: "memory")
#define G_BAR __builtin_amdgcn_s_barrier()
#define G_SCHED __builtin_amdgcn_sched_barrier(0)
#define G_OFFS(u, OA, OB, IDXB) do { int tl_ = wid * 64 + lane_id(); _Pragma("unroll") for (int i = 0; i < 2; ++i) { int R_, C_; stage_rc(tl_ * 16 + i * 8192, R_, C_); const int Rb_ = (R_ & ~31) + perm32(R_ & 31); \
        _Pragma("unroll") for (int h = 0; h < 2; ++h) { const int r_ = h * 128 + R_; const int row_ = (u).ridx ? id2tok(((const LAS int*)(lds + LDS_IDX + (IDXB) * 1024))[r_]) : (u).row0 + r_; \
        OA[h][i] = (unsigned)row_ * (u).apitch + (unsigned)C_ * 2u; OB[h][i] = (unsigned)(h * 128 + Rb_) * (u).bpitch + (unsigned)C_ * 2u; } } } while (0)
#define G_IDX_DMA(u, IDXB, OIDB) do { if ((u).ridx && wid < 4) __builtin_amdgcn_global_load_lds((const unsigned*)((u).ridx + wid * 64 + lane_id()), (LAS unsigned*)(lds + LDS_IDX + (IDXB) * 1024 + wid * 256), 4, 0, 0); \
        if ((u).oidx && wid < 4) __builtin_amdgcn_global_load_lds((const unsigned*)((u).oidx + wid * 64 + lane_id()), (LAS unsigned*)(lds + LDS_OID + (OIDB) * 1024 + wid * 256), 4, 0, 0); } while (0)
    Unit cur, nxt; int ui = 0;
    if (!S.next(0, cur)) return;
    if constexpr (Sched::DYN) nt = cur.nt;
    unsigned cOA[2][2], cOB[2][2];
    G_IDX_DMA(cur, 0, 0); asm volatile("s_waitcnt vmcnt(0)" ::: "memory"); __builtin_amdgcn_s_barrier(); asm volatile("" ::: "memory");
    G_OFFS(cur, cOA, cOB, 0);
    f32x4 acc[2][2][4][2];
#pragma unroll
    for (int a = 0; a < 2; ++a)
#pragma unroll
        for (int b = 0; b < 2; ++b)
#pragma unroll
            for (int m = 0; m < 4; ++m)
#pragma unroll
                for (int n = 0; n < 2; ++n) acc[a][b][m][n] = (f32x4){0.f, 0.f, 0.f, 0.f};
    i32x8 At[4], B0[2], B1[2];
    const char* cA = uptr(cur.a); const char* cB = uptr(cur.b);
    G_STAGE(G_SB(0, 0), cB, cOB[0][0], cOB[0][1]); G_STAGE(G_SB(0, 1), cB, cOB[1][0], cOB[1][1]); G_STAGE(G_SA(0, 0), cA, cOA[0][0], cOA[0][1]); G_STAGE(G_SA(0, 1), cA, cOA[1][0], cOA[1][1]);
    if (wr == 1) G_BAR;
    G_WAIT_V(2); G_BAR;
    { const char* cA1 = uptr(cA + 128); const char* cB1 = uptr(cB + 128);
      G_STAGE(G_SB(1, 0), cB1, cOB[0][0], cOB[0][1]); G_STAGE(G_SA(1, 0), cA1, cOA[0][0], cOA[0][1]); G_STAGE(G_SB(1, 1), cB1, cOB[1][0], cOB[1][1]); }
    G_WAIT_V(6); G_BAR;
    for (;;) {
        const bool has_next = S.next(ui + 1, nxt); const char* nA = cA; const char* nB = cB;
        if (has_next) G_IDX_DMA(nxt, (ui + 1) & 1, (ui + 1) % 3);
#pragma unroll 1
        for (int t = 0; t < nt; t += 2) {
            const bool last = (t == nt - 2);
            const char* a1 = uptr(cA + (size_t)(t + 1) * 128);
            G_LDB(B0, 0, 0); G_LDB(B1, 0, 1); G_SCHED; G_LDA(At, 0, 0); G_STAGE(G_SA(1, 1), a1, cOA[1][0], cOA[1][1]);
            G_WAIT_V(8); G_WAIT_L(0); G_BAR; G_MMA(0, 0, At, B0); G_MMA(0, 1, At, B1); G_BAR; G_SCHED;
            if (last && has_next) { nA = uptr(nxt.a); nB = uptr(nxt.b); G_OFFS(nxt, cOA, cOB, (ui + 1) & 1); }
            const char* a2 = uptr(last ? nA : cA + (size_t)(t + 2) * 128); const char* b2 = uptr(last ? nB : cB + (size_t)(t + 2) * 128);
            const char* a3 = uptr(a2 + 128); const char* b3 = uptr(b2 + 128);
            G_LDA(At, 0, 1); G_STAGE(G_SB(0, 0), b2, cOB[0][0], cOB[0][1]); G_STAGE(G_SB(0, 1), b2, cOB[1][0], cOB[1][1]); G_STAGE(G_SA(0, 0), a2, cOA[0][0], cOA[0][1]);
            G_WAIT_V(8); G_WAIT_L(0); G_BAR; G_MMA(1, 0, At, B0); G_MMA(1, 1, At, B1); G_BAR; G_SCHED;
            G_LDB(B0, 1, 0); G_LDB(B1, 1, 1); G_SCHED; G_LDA(At, 1, 0); G_STAGE(G_SA(0, 1), a2, cOA[1][0], cOA[1][1]);
            G_WAIT_V(8); G_WAIT_L(0); G_BAR; G_MMA(0, 0, At, B0); G_MMA(0, 1, At, B1); G_BAR; G_SCHED;
            G_LDA(At, 1, 1); G_STAGE(G_SB(1, 0), b3, cOB[0][0], cOB[0][1]); G_STAGE(G_SB(1, 1), b3, cOB[1][0], cOB[1][1]); G_STAGE(G_SA(1, 0), a3, cOA[0][0], cOA[0][1]);
            G_WAIT_V(8); G_WAIT_L(0); G_BAR; G_MMA(1, 0, At, B0); G_MMA(1, 1, At, B1); G_BAR; G_SCHED;
        }
        if (wr == 0) G_BAR;
        cur.oidl = (const LAS int*)(lds + LDS_OID + (ui % 3) * 1024);
        { const int le = lane_id(); E(acc, cur, wr, wc, le & 15, le >> 4); }
        if (!has_next) break;
        if (!nxt.keep) {
#pragma unroll
        for (int a = 0; a < 2; ++a)
#pragma unroll
            for (int b = 0; b < 2; ++b)
#pragma unroll
                for (int m = 0; m < 4; ++m)
#pragma unroll
                    for (int n = 0; n < 2; ++n) acc[a][b][m][n] = (f32x4){0.f, 0.f, 0.f, 0.f};
        }
        cur = nxt; cA = nA; cB = nB; ++ui;
        if constexpr (Sched::DYN) nt = cur.nt;
        if (wr == 1) G_BAR;
    }
    G_WAIT_V(0);
    G_BAR;
#undef G_SA
#undef G_SB
#undef G_STAGE
#undef G_LDA
#undef G_LDB
#undef G_MMA
#undef G_WAIT_V
#undef G_WAIT_L
#undef G_BAR
#undef G_SCHED
#undef G_OFFS
#undef G_IDX_DMA
}
#if FAST_GEMM
#define GEMM_PHASE(K, S, E) gemm_phase<false>(F.lds, F.wave, K, S, E)
#define GEMM_PHASE_F8(K, S, E) gemm_phase<true>(F.lds, F.wave, K, S, E)
#else
#define GEMM_PHASE(K, S, E) gemm_phase_simple(F.wave, K, S, E)
#endif

constexpr int NXCD = 8, WGM = 8;
struct TileOrder {
    int nM, nN, nwg, G, c;
    __device__ void init(int M, int N, int G_, int c_) { nM = M / 256; nN = N / 256; nwg = nM * nN; G = G_; c = c_; }
    __device__ bool tile(int i, int& pm, int& pn) const {
        const long L = (long)i * G + c; if (L >= nwg) return false;
        int wgid = (int)L; { const int q = nwg / NXCD, r = nwg % NXCD, xcd = wgid % NXCD, off = wgid / NXCD; wgid = (xcd < r ? xcd * (q + 1) : r * (q + 1) + (xcd - r) * q) + off; }
        const int nig = WGM * nN, gid = wgid / nig, fm = gid * WGM, gsz = (nM - fm) < WGM ? (nM - fm) : WGM;
        pm = fm + ((wgid % nig) % gsz); pn = (wgid % nig) / gsz; return true;
    }
};
struct SchedDense { static constexpr bool DYN = false;
    TileOrder o; const char* a; const char* b; unsigned apitch, bpitch;
    __device__ bool next(int i, Unit& u) const {
        int pm, pn; if (!o.tile(i, pm, pn)) return false;
        u.a = a; u.b = b + (size_t)pn * 256 * bpitch; u.ridx = nullptr; u.apitch = apitch; u.bpitch = bpitch; u.row0 = pm * 256; u.col0 = pn * 256; u.kind = 0; u.oidx = nullptr; u.keep = 0; return true;
    }
};
struct SchedMerged { static constexpr bool DYN = false;
    TileOrder o; const char* pd; const char* oo; const char* wpe; const char* wba;
    __device__ bool next(int i, Unit& u) const {
        int pm, pn; if (!o.tile(i >> 1, pm, pn)) return false;
        const int part = i & 1;
        u.a = part ? oo : pd; u.apitch = part ? DIN * 2 : 512 * 2; u.b = (part ? wba : wpe) + (size_t)pn * 256 * 1024; u.bpitch = 1024; u.ridx = nullptr; u.row0 = pm * 256; u.col0 = pn * 256; u.kind = part; u.oidx = nullptr; u.keep = part; return true;
    }
};
struct SchedSharedRouter { static constexpr bool DYN = true;
    int G, c; const char* xb; const char* wsgu; const char* wr;
    __device__ bool next(int i, Unit& u) const {
        const int L = i * G + c; if (L >= 512) return false;
        u.apitch = 2048; u.bpitch = 2048; u.ridx = nullptr; u.oidx = nullptr; u.keep = 0;
        if (L < 256) { const int pm = L >> 1, pn = L & 1; u.a = xb; u.b = wsgu + (size_t)pn * 256 * 2048; u.row0 = pm * 256; u.col0 = pn * 128; u.kind = 0; u.nt = 16; }
        else { const int pm = (L - 256) >> 1, kh = L & 1; u.a = xb + kh * 1024; u.b = wr + kh * 1024; u.row0 = pm * 256; u.col0 = kh; u.kind = 1; u.nt = 8; }
        return true;
    }
};
struct SchedMoeGU { static constexpr bool DYN = false;
    int G, c, nblk; const char* xb; const char* wegu; const LAS int* blke; const int* tokl;
    __device__ bool next(int i, Unit& u) const {
        const int L = i * G + c; if (L >= 2 * nblk) return false;
        const int rb = L >> 1, pn = L & 1, e = __builtin_amdgcn_readfirstlane(blke[rb]);
        u.a = xb; u.apitch = 1024; u.bpitch = 1024; u.b = wegu + ((size_t)e * 512 + pn * 256) * 1024; u.ridx = tokl + rb * 256; u.row0 = rb * 256; u.col0 = pn * 128; u.kind = e; u.oidx = nullptr; u.keep = 0; return true;
    }
};
struct SchedMoeDown { static constexpr bool DYN = false;
    int G, c, nblk; const char* hb; const char* hs; const char* wed; const char* wsd; const LAS int* blke; const int* tokl;
    __device__ bool next(int i, Unit& u) const {
        const int L = i * G + c; if (L >= 4 * nblk + 512) return false;
        u.apitch = 512; u.bpitch = 512; u.ridx = nullptr;
        if (L < 4 * nblk) { const int rb = L >> 2, pn = L & 3, e = __builtin_amdgcn_readfirstlane(blke[rb]); u.a = hb; u.b = wed + ((size_t)e * 1024 + pn * 256) * 512; u.row0 = rb * 256; u.col0 = pn * 256; u.kind = 0; u.oidx = tokl + rb * 256; u.keep = 0; }
        else { const int L2 = L - 4 * nblk, pm = L2 >> 2, pn = L2 & 3; u.a = hs; u.b = wsd + (size_t)pn * 256 * 512; u.row0 = pm * 256; u.col0 = pn * 256; u.kind = 1; u.oidx = nullptr; u.keep = 0; }
        return true;
    }
};

__device__ __forceinline__ u32x4 pack8(const f32x4& v0, const f32x4& v1) { u32x4 w; w.x = cvt_pk_h16(v0[0], v0[1]); w.y = cvt_pk_h16(v0[2], v0[3]); w.z = cvt_pk_h16(v1[0], v1[1]); w.w = cvt_pk_h16(v1[2], v1[3]); return w; }
__device__ __forceinline__ void unpack8(const u32x4& w, f32x4& v0, f32x4& v1) { v0 = (f32x4){lo16(w.x), hi16(w.x), lo16(w.y), hi16(w.y)}; v1 = (f32x4){lo16(w.z), hi16(w.z), lo16(w.w), hi16(w.w)}; }
__device__ __forceinline__ f32x4 sig4(const f32x4& v) { return (f32x4){sigmoidf_(v[0]), sigmoidf_(v[1]), sigmoidf_(v[2]), sigmoidf_(v[3])}; }
__device__ __forceinline__ f32x4 swiglu4(const f32x4& g, const f32x4& u) { return (f32x4){g[0] * sigmoidf_(g[0]) * u[0], g[1] * sigmoidf_(g[1]) * u[1], g[2] * sigmoidf_(g[2]) * u[2], g[3] * sigmoidf_(g[3]) * u[3]}; }

__device__ __forceinline__ unsigned q8x4(float a, float b, float c, float d, float inv) {
    const unsigned ua = __float_as_uint(a * inv + 12582912.0f), ub = __float_as_uint(b * inv + 12582912.0f), uc = __float_as_uint(c * inv + 12582912.0f), ud = __float_as_uint(d * inv + 12582912.0f);
    const unsigned lo = __builtin_amdgcn_perm(ub, ua, 0x0c0c0400u), hi = __builtin_amdgcn_perm(ud, uc, 0x0c0c0400u);
    return __builtin_amdgcn_perm(hi, lo, 0x05040100u);
}
struct EpiInProj {
    h16* H; const float* bias; float isc;
    __device__ __forceinline__ void operator()(const ACC_T, const Unit& u, int wr, int wc, int fr, int fq) const {
        const int pn = u.col0 >> 8; const float sc = (pn == 2 || pn == 3) ? 0.125f : 1.f; const bool sg = pn >= 5;
        f32x4 bv[2][2];
#pragma unroll
        for (int bj = 0; bj < 2; ++bj)
#pragma unroll
            for (int n = 0; n < 2; ++n) bv[bj][n] = *(const f32x4*)(bias + u.col0 + 128 * bj + 32 * wc + 8 * fq + 4 * n);
#pragma unroll
        for (int ai = 0; ai < 2; ++ai)
#pragma unroll
            for (int m = 0; m < 4; ++m) { const int row = u.row0 + 128 * ai + 64 * wr + 16 * m + fr; h16* rowp = H + (size_t)row * DIN + u.col0 + 32 * wc + 8 * fq;
#pragma unroll
                for (int bj = 0; bj < 2; ++bj) { f32x4 v0 = (acc[ai][bj][m][0] * isc + bv[bj][0]) * sc, v1 = (acc[ai][bj][m][1] * isc + bv[bj][1]) * sc;
                    if (sg) { v0 = sig4(v0); v1 = sig4(v1);
                        u32x2 w; w.x = q8x4(v0[0], v0[1], v0[2], v0[3], 255.0f); w.y = q8x4(v1[0], v1[1], v1[2], v1[3], 255.0f);
                        *(u32x2*)((unsigned char*)(H + (size_t)row * DIN + C_GP) + (u.col0 - C_GP) + 128 * bj + 32 * wc + 8 * fq) = w; }
                    else *(u32x4*)(rowp + 128 * bj) = pack8(v0, v1); } }
    }
};
__device__ __forceinline__ void ungate8(const u32x2& w, f32x4& v0, f32x4& v1) {
    const float k = 1.0f / 255.0f;
    v0 = (f32x4){(float)(w.x & 0xffu) * k, (float)((w.x >> 8) & 0xffu) * k, (float)((w.x >> 16) & 0xffu) * k, (float)(w.x >> 24) * k};
    v1 = (f32x4){(float)(w.y & 0xffu) * k, (float)((w.y >> 8) & 0xffu) * k, (float)((w.y >> 16) & 0xffu) * k, (float)(w.y >> 24) * k};
}
struct EpiMerged {
    h16* MG; const h16* H;
    __device__ __forceinline__ void operator()(f32x4 (&acc)[2][2][4][2], const Unit& u, int wr, int wc, int fr, int fq) const {
        const int col = u.col0 + 32 * wc + 8 * fq;
#pragma unroll
        for (int ai = 0; ai < 2; ++ai) {
            u32x2 ga[4][2], gp[4][2];
#pragma unroll
            for (int m = 0; m < 4; ++m) { const int row = u.row0 + 128 * ai + 64 * wr + 16 * m + fr;
#pragma unroll
                for (int bj = 0; bj < 2; ++bj) { const unsigned char* gb = (const unsigned char*)(H + (size_t)row * DIN + C_GP) + col + 128 * bj; ga[m][bj] = *(const u32x2*)(gb + 1024); if (u.kind == 0) gp[m][bj] = *(const u32x2*)gb; } }
#pragma unroll
            for (int m = 0; m < 4; ++m) { const int row = u.row0 + 128 * ai + 64 * wr + 16 * m + fr;
#pragma unroll
                for (int bj = 0; bj < 2; ++bj) { f32x4 a0, a1; ungate8(ga[m][bj], a0, a1);
                    if (u.kind == 0) { f32x4 p0, p1; ungate8(gp[m][bj], p0, p1);
#pragma unroll
                        for (int j = 0; j < 4; ++j) { acc[ai][bj][m][0][j] *= p0[j] * __builtin_amdgcn_rcpf(fmaxf(a0[j], 6.2e-5f)); acc[ai][bj][m][1][j] *= p1[j] * __builtin_amdgcn_rcpf(fmaxf(a1[j], 6.2e-5f)); } }
                    else *(u32x4*)(MG + (size_t)row * D + col + 128 * bj) = pack8(acc[ai][bj][m][0] * a0, acc[ai][bj][m][1] * a1); } }
        }
    }
};
struct EpiResid {
    h16* S; const h16* XBp;
    __device__ __forceinline__ void operator()(const ACC_T, const Unit& u, int wr, int wc, int fr, int fq) const {
#pragma unroll
        for (int ai = 0; ai < 2; ++ai) {
            u32x4 xw[4][2];
#pragma unroll
            for (int m = 0; m < 4; ++m) { const int row = u.row0 + 128 * ai + 64 * wr + 16 * m + fr; const size_t off = (size_t)row * D + u.col0 + 32 * wc + 8 * fq;
#pragma unroll
                for (int bj = 0; bj < 2; ++bj) xw[m][bj] = *(const u32x4*)(XBp + off + 128 * bj); }
#pragma unroll
            for (int m = 0; m < 4; ++m) { const int row = u.row0 + 128 * ai + 64 * wr + 16 * m + fr; const size_t off = (size_t)row * D + u.col0 + 32 * wc + 8 * fq;
#pragma unroll
                for (int bj = 0; bj < 2; ++bj) { f32x4 x0, x1; unpack8(xw[m][bj], x0, x1);
                    *(u32x4*)(S + off + 128 * bj) = pack8(x0 * ALPHA + acc[ai][bj][m][0], x1 * ALPHA + acc[ai][bj][m][1]); } }
        }
    }
};
struct EpiSharedRouter {
    h16* HS; float* LG;
    __device__ __forceinline__ void operator()(const ACC_T, const Unit& u, int wr, int wc, int fr, int fq) const {
#pragma unroll
        for (int ai = 0; ai < 2; ++ai)
#pragma unroll
            for (int m = 0; m < 4; ++m) { const int row = u.row0 + 128 * ai + 64 * wr + 16 * m + fr;
                if (u.kind == 0) { *(u32x4*)(HS + (size_t)row * FF + u.col0 + 32 * wc + 8 * fq) = pack8(swiglu4(acc[ai][0][m][0], acc[ai][1][m][0]), swiglu4(acc[ai][0][m][1], acc[ai][1][m][1])); }
                else if (wc < 2) {
#pragma unroll
                    for (int n = 0; n < 2; ++n) *(f32x4*)(LG + (size_t)u.col0 * T * NE + (size_t)row * NE + 32 * wc + 8 * fq + 4 * n) = acc[ai][0][m][n] + acc[ai][1][m][n]; } }
    }
};
struct EpiMoeGU {
    h16* HB; const float* gatl; const float* wsc;
    __device__ __forceinline__ void operator()(const ACC_T, const Unit& u, int wr, int wc, int fr, int fq) const {
        const float isg = wsc[2 * u.kind], isu = wsc[2 * u.kind + 1];
        float g[2][4];
#pragma unroll
        for (int ai = 0; ai < 2; ++ai)
#pragma unroll
            for (int m = 0; m < 4; ++m) g[ai][m] = gatl[u.row0 + 128 * ai + 64 * wr + 16 * m + fr];
#pragma unroll
        for (int ai = 0; ai < 2; ++ai)
#pragma unroll
            for (int m = 0; m < 4; ++m) { const int row = u.row0 + 128 * ai + 64 * wr + 16 * m + fr;
                *(u32x4*)(HB + (size_t)row * FF + u.col0 + 32 * wc + 8 * fq) = pack8(swiglu4(acc[ai][0][m][0] * isg, acc[ai][1][m][0] * isu) * g[ai][m], swiglu4(acc[ai][0][m][1] * isg, acc[ai][1][m][1] * isu) * g[ai][m]); }
    }
};
struct EpiMoeDown {
    unsigned char* YQ; h16* YS;
    __device__ __forceinline__ void operator()(const ACC_T, const Unit& u, int wr, int wc, int fr, int fq) const {
        int id[2][4];
#pragma unroll
        for (int ai = 0; ai < 2; ++ai)
#pragma unroll
            for (int m = 0; m < 4; ++m) { const int r = 128 * ai + 64 * wr + 16 * m + fr; id[ai][m] = u.kind ? (u.row0 + r) * 9 + 8 : u.oidl[r]; }
        const int grp = (u.col0 >> 8) * 16 + 4 * wc + fq;
#pragma unroll
        for (int ai = 0; ai < 2; ++ai)
#pragma unroll
            for (int m = 0; m < 4; ++m) {
                const f32x4 v0 = acc[ai][0][m][0], v1 = acc[ai][0][m][1], v2 = acc[ai][1][m][0], v3 = acc[ai][1][m][1];
                float mx = fmaxf(fmaxf(fabsf(v0[0]), fabsf(v0[1])), fmaxf(fabsf(v0[2]), fabsf(v0[3])));
                mx = fmaxf(mx, fmaxf(fmaxf(fabsf(v1[0]), fabsf(v1[1])), fmaxf(fabsf(v1[2]), fabsf(v1[3]))));
                mx = fmaxf(mx, fmaxf(fmaxf(fabsf(v2[0]), fabsf(v2[1])), fmaxf(fabsf(v2[2]), fabsf(v2[3]))));
                mx = fmaxf(mx, fmaxf(fmaxf(fabsf(v3[0]), fabsf(v3[1])), fmaxf(fabsf(v3[2]), fabsf(v3[3]))));
                const unsigned short sh = f2h(mx * (1.0f / 127.0f) * 1.0005f);
                const float scr = h2f(sh); const float inv = scr > 0.f ? __builtin_amdgcn_rcpf(scr) : 0.f;
                u32x4 w; w.x = q8x4(v0[0], v0[1], v0[2], v0[3], inv); w.y = q8x4(v1[0], v1[1], v1[2], v1[3], inv); w.z = q8x4(v2[0], v2[1], v2[2], v2[3], inv); w.w = q8x4(v3[0], v3[1], v3[2], v3[3], inv);
                *(u32x4*)(YQ + (size_t)id[ai][m] * 1024 + grp * 16) = w;
                *(unsigned short*)(YS + (size_t)id[ai][m] * 64 + grp) = sh; }
    }
};

struct Args { const float* in[23]; float* out; unsigned char* ws; int ph_lo, ph_hi; };
struct Frame {
    LAS unsigned char* lds; int wave, vcu, G, gw, NGW;
};

__device__ __forceinline__ void ln_store(f32x4 (&v)[4], const float* gam, const float* bet, float* o32, h16* o16, int lane) {
    float s = 0.f;
#pragma unroll
    for (int j = 0; j < 4; ++j) s += (v[j].x + v[j].y) + (v[j].z + v[j].w);
    const float mean = wave_sum(s) * (1.f / D); float s2 = 0.f;
#pragma unroll
    for (int j = 0; j < 4; ++j) { v[j] = v[j] - mean; s2 += (v[j].x * v[j].x + v[j].y * v[j].y) + (v[j].z * v[j].z + v[j].w * v[j].w); }
    const float rstd = 1.f / sqrtf(wave_sum(s2) * (1.f / D) + LN_EPS);
#pragma unroll
    for (int j = 0; j < 4; ++j) { const f32x4 g = *(const f32x4*)(gam + 4 * lane + 256 * j), b = *(const f32x4*)(bet + 4 * lane + 256 * j); const f32x4 y = v[j] * rstd * g + b;
        *(f32x4*)(o32 + 4 * lane + 256 * j) = y; u32x2 w; w.x = cvt_pk_h16(y[0], y[1]); w.y = cvt_pk_h16(y[2], y[3]); *(u32x2*)(o16 + 4 * lane + 256 * j) = w; }
}


__device__ __forceinline__ unsigned f8x4(const f32x4 v) {
    int w = __builtin_amdgcn_cvt_pk_fp8_f32(__builtin_amdgcn_fmed3f(v.x, -448.f, 448.f), __builtin_amdgcn_fmed3f(v.y, -448.f, 448.f), 0, false);
    w = __builtin_amdgcn_cvt_pk_fp8_f32(__builtin_amdgcn_fmed3f(v.z, -448.f, 448.f), __builtin_amdgcn_fmed3f(v.w, -448.f, 448.f), w, true); return (unsigned)w; }
__device__ __forceinline__ void ln_store8(f32x4 (&v)[4], const float* gam, const float* bet, float* o32, h16* o16, int lane, int c0 = -1, int c1 = -1, unsigned char* o8 = nullptr) {
    if (c0 < 0) { c0 = 8 * lane; c1 = 512 + 8 * lane; }
    float s = 0.f;
#pragma unroll
    for (int j = 0; j < 4; ++j) s += (v[j].x + v[j].y) + (v[j].z + v[j].w);
    const float mean = wave_sum(s) * (1.f / D); float s2 = 0.f;
#pragma unroll
    for (int j = 0; j < 4; ++j) { v[j] = v[j] - mean; s2 += (v[j].x * v[j].x + v[j].y * v[j].y) + (v[j].z * v[j].z + v[j].w * v[j].w); }
    const float rstd = 1.f / sqrtf(wave_sum(s2) * (1.f / D) + LN_EPS);
    f32x4 y[4];
#pragma unroll
    for (int j = 0; j < 4; ++j) { const int c = ((j >> 1) ? c1 : c0) + 4 * (j & 1); const f32x4 g = *(const f32x4*)(gam + c), b = *(const f32x4*)(bet + c); y[j] = v[j] * rstd * g + b; if (o32) *(f32x4*)(o32 + c) = y[j]; }
    *(u32x4*)(o16 + c0) = pack8(y[0], y[1]); *(u32x4*)(o16 + c1) = pack8(y[2], y[3]);
    if (o8) { u32x2 w; w.x = f8x4(y[0]); w.y = f8x4(y[1]); *(u32x2*)(o8 + c0) = w; w.x = f8x4(y[2]); w.y = f8x4(y[3]); *(u32x2*)(o8 + c1) = w; }
}
__device__ __forceinline__ void tr_item(const float* W, int N, h16* WT, int ldt, int k0, int n0, int drow0, LAS float* scr, int lane) {
    float tv[32];
#pragma unroll
    for (int i = 0; i < 32; ++i) { const int kk = 2 * i + (lane >> 5); tv[i] = __builtin_nontemporal_load(W + (size_t)(k0 + kk) * N + n0 + (lane & 31)); }
#pragma unroll
    for (int i = 0; i < 32; ++i) { const int kk = 2 * i + (lane >> 5); scr[kk * 33 + (lane & 31)] = tv[i]; }
    asm volatile("s_waitcnt lgkmcnt(0)" ::: "memory");
    const int c = lane & 7;
#pragma unroll
    for (int j = 0; j < 4; ++j) { const int n = (lane >> 3) + 8 * j; const LAS float* s = scr + (8 * c) * 33 + n;
        u32x4 o; o.x = cvt_pk_h16(s[0 * 33], s[1 * 33]); o.y = cvt_pk_h16(s[2 * 33], s[3 * 33]); o.z = cvt_pk_h16(s[4 * 33], s[5 * 33]); o.w = cvt_pk_h16(s[6 * 33], s[7 * 33]);
        *(u32x4*)(WT + (size_t)(drow0 + n) * ldt + k0 + 8 * c) = o; }
    asm volatile("s_waitcnt lgkmcnt(0)" ::: "memory");
}
__device__ __forceinline__ void tr_item_f8(const float* W, int N, unsigned char* WT, int ldt, int k0, int n0, int drow0, LAS float* scr, int lane, float scale) {
    float tv[32];
#pragma unroll
    for (int i = 0; i < 32; ++i) { const int kk = 2 * i + (lane >> 5); tv[i] = __builtin_nontemporal_load(W + (size_t)(k0 + kk) * N + n0 + (lane & 31)); }
#pragma unroll
    for (int i = 0; i < 32; ++i) { const int kk = 2 * i + (lane >> 5); scr[kk * 33 + (lane & 31)] = tv[i]; }
    asm volatile("s_waitcnt lgkmcnt(0)" ::: "memory");
    const int c = lane & 7;
#pragma unroll
    for (int j = 0; j < 4; ++j) { const int n = (lane >> 3) + 8 * j; const LAS float* s = scr + (8 * c) * 33 + n;
        u32x2 o; o.x = f8x4((f32x4){s[0 * 33], s[1 * 33], s[2 * 33], s[3 * 33]} * scale); o.y = f8x4((f32x4){s[4 * 33], s[5 * 33], s[6 * 33], s[7 * 33]} * scale);
        *(u32x2*)(WT + (size_t)(drow0 + n) * ldt + k0 + 8 * c) = o; }
    asm volatile("s_waitcnt lgkmcnt(0)" ::: "memory");
}
__device__ __forceinline__ float f8_scale_of(const float* W, int lane) {
    const f32x4 q = *(const f32x4*)(W + 4 * lane); const float ma = wave_sum((fabsf(q.x) + fabsf(q.y)) + (fabsf(q.z) + fabsf(q.w))) * (1.2533f / 256.f);
    float t = 32.f / fmaxf(ma, 1e-30f); t = fminf(fmaxf(t, 1.0e-18f), 1.0e18f);
    return __uint_as_float(__builtin_amdgcn_readfirstlane(__float_as_uint(t)) & 0x7f800000u);
}
__device__ __forceinline__ void tr_item_hilo(const float* W, int N, h16* WT, int ldt, int k0, int n0, LAS float* scr, int lane) {
    float tv[32];
#pragma unroll
    for (int i = 0; i < 32; ++i) { const int kk = 2 * i + (lane >> 5); tv[i] = __builtin_nontemporal_load(W + (size_t)(k0 + kk) * N + n0 + (lane & 31)); }
#pragma unroll
    for (int i = 0; i < 32; ++i) { const int kk = 2 * i + (lane >> 5); scr[kk * 33 + (lane & 31)] = tv[i]; }
    asm volatile("s_waitcnt lgkmcnt(0)" ::: "memory");
    const int c = lane & 7;
#pragma unroll
    for (int j = 0; j < 4; ++j) { const int n = (lane >> 3) + 8 * j; const LAS float* s = scr + (8 * c) * 33 + n;
        float v[8], r[8];
#pragma unroll
        for (int q = 0; q < 8; ++q) { v[q] = s[q * 33]; r[q] = v[q] - h2f(f2h(v[q])); }
        u32x4 o; o.x = cvt_pk_h16(v[0], v[1]); o.y = cvt_pk_h16(v[2], v[3]); o.z = cvt_pk_h16(v[4], v[5]); o.w = cvt_pk_h16(v[6], v[7]);
        *(u32x4*)(WT + (size_t)(n0 + n) * ldt + k0 + 8 * c) = o;
        o.x = cvt_pk_h16(r[0], r[1]); o.y = cvt_pk_h16(r[2], r[3]); o.z = cvt_pk_h16(r[4], r[5]); o.w = cvt_pk_h16(r[6], r[7]);
        *(u32x4*)(WT + (size_t)(128 + n0 + n) * ldt + k0 + 8 * c) = o; }
    asm volatile("s_waitcnt lgkmcnt(0)" ::: "memory");
}


typedef float f32x16 __attribute__((ext_vector_type(16)));
constexpr int AT_KP = 144, AT_VP = 528, AT_VOFF = 256 * AT_KP;
__device__ __forceinline__ int crow(int r, int hi) { return (r & 3) + 8 * (r >> 2) + 4 * hi; }
struct KVRegs { u32x4 k[4], v[4]; };
__device__ __forceinline__ void attn_load_kv(const h16* HHp, const int b, const int n, const int hk, const int tid, KVRegs& r) {
    const int tb = b * SEQ + n * 128;
#pragma unroll
    for (int i = 0; i < 4; ++i) { const int idx = tid + 512 * i, key = idx >> 3, ch = idx & 7; const int tok = (n > 0) ? tb - 128 + key : tb + (key & 127);
        const h16* kp = HHp + (size_t)tok * DIN + C_K + hk * 64 + ch * 8; r.k[i] = *(const u32x4*)kp; r.v[i] = *(const u32x4*)(kp + 128); }
}
__device__ __forceinline__ void attn_unit(LAS unsigned char* lds, h16* HHp, h16* OUTp, const int opitch, const float* sinks, const int b, const int n, const int hk, const int tid,
                                          const int unused_ = 0) {
    const int lane = tid & 63, wid = __builtin_amdgcn_readfirstlane(tid >> 6), q32 = lane & 31, hi = lane >> 5;
    const int g = wid >> 1, qh = wid & 1, hq = hk * 4 + g;
    const int tb = b * SEQ + n * 128;
    LAS unsigned char* Ks = lds; LAS unsigned char* Vs = lds + AT_VOFF;
    KVRegs cur; attn_load_kv(HHp, b, n, hk, tid, cur);
    f16x8 qs[4];
    { const h16* qp = HHp + (size_t)(tb + 64 * qh + q32) * DIN + C_Q + hq * 64;
#pragma unroll
      for (int ks = 0; ks < 4; ++ks) qs[ks] = *(const f16x8*)(qp + 16 * ks + 8 * hi); }
#pragma unroll
    for (int i = 0; i < 4; ++i) { const int idx = tid + 512 * i, key = idx >> 3, ch = idx & 7; const u32x4 kw = cur.k[i], vw = cur.v[i];
        *(LAS u32x4*)(Ks + key * AT_KP + ch * 16) = kw;
        LAS unsigned short* vd = (LAS unsigned short*)(Vs + (ch * 8) * AT_VP + key * 2);
        vd[0 * (AT_VP / 2)] = (unsigned short)(vw.x & 0xffffu); vd[1 * (AT_VP / 2)] = (unsigned short)(vw.x >> 16); vd[2 * (AT_VP / 2)] = (unsigned short)(vw.y & 0xffffu); vd[3 * (AT_VP / 2)] = (unsigned short)(vw.y >> 16);
        vd[4 * (AT_VP / 2)] = (unsigned short)(vw.z & 0xffffu); vd[5 * (AT_VP / 2)] = (unsigned short)(vw.z >> 16); vd[6 * (AT_VP / 2)] = (unsigned short)(vw.w & 0xffffu); vd[7 * (AT_VP / 2)] = (unsigned short)(vw.w >> 16); }
    __syncthreads();
    const float slope = exp2f(-(float)(hq + 1)), sink = sinks[hq];
    float ab[16];
#pragma unroll
    for (int r = 0; r < 16; ++r) ab[r] = slope * (float)(crow(r, hi) - 128 - q32);
#pragma unroll 1
    for (int sub = 0; sub < 2; ++sub) {
        const int q0 = 64 * qh + 32 * sub, qi = q0 + q32;
        f32x16 sv[5]; float mx = -INFINITY;
#pragma unroll
        for (int j = 0; j < 5; ++j) { const int key0 = q0 + 32 * j; f32x16 c; float sl = slope; asm volatile("" : "+v"(sl)); const float aj = sl * (float)(32 * j);
#pragma unroll
            for (int r = 0; r < 16; ++r) c[r] = ab[r] + aj;
#pragma unroll
            for (int ks = 0; ks < 4; ++ks) { const f16x8 kf = *(const LAS f16x8*)(Ks + (key0 + q32) * AT_KP + (16 * ks + 8 * hi) * 2); c = __builtin_amdgcn_mfma_f32_32x32x16_f16(kf, qs[ks], c, 0, 0, 0); }
            const bool dead = (n == 0) && (key0 < 128);
            int hil = hi; asm volatile("" : "+v"(hil));
#pragma unroll
            for (int r = 0; r < 16; ++r) { float v = c[r];
                if (j == 0) v = (crow(r, hil) > q32) ? v : -INFINITY;
                if (j == 4) v = (crow(r, hil) <= q32) ? v : -INFINITY;
                if (dead) v = -INFINITY;
                c[r] = v; mx = fmaxf(mx, v); }
            sv[j] = c; __builtin_amdgcn_sched_barrier(0); }
        if (sub == 0) { const h16* qp = HHp + (size_t)(tb + 64 * qh + 32 + q32) * DIN + C_Q + hq * 64;
#pragma unroll
            for (int ks = 0; ks < 4; ++ks) qs[ks] = *(const f16x8*)(qp + 16 * ks + 8 * hi); }
        mx = fmaxf(mx, dppf_swap32(mx)); mx = fmaxf(mx, sink);
        float lsum = 0.f; f32x16 o0, o1;
#pragma unroll
        for (int r = 0; r < 16; ++r) { o0[r] = 0.f; o1[r] = 0.f; }
#pragma unroll
        for (int j = 0; j < 5; ++j) { const int key0 = q0 + 32 * j;
#pragma unroll
            for (int r = 0; r < 16; ++r) { const float pv = __expf(sv[j][r] - mx); sv[j][r] = pv; lsum += pv; }
#pragma unroll
            for (int cc = 0; cc < 2; ++cc) {
                u32x4 pw; pw.x = cvt_pk_h16(sv[j][8 * cc + 0], sv[j][8 * cc + 1]); pw.y = cvt_pk_h16(sv[j][8 * cc + 2], sv[j][8 * cc + 3]); pw.z = cvt_pk_h16(sv[j][8 * cc + 4], sv[j][8 * cc + 5]); pw.w = cvt_pk_h16(sv[j][8 * cc + 6], sv[j][8 * cc + 7]);
                const f16x8 pb = __builtin_bit_cast(f16x8, pw);
                const LAS unsigned char* vp = Vs + q32 * AT_VP + (key0 + 16 * cc + 4 * hi) * 2;
                { const u32x2 a0 = *(const LAS u32x2*)vp, a1 = *(const LAS u32x2*)(vp + 16); const u32x4 vw = {a0.x, a0.y, a1.x, a1.y}; o0 = __builtin_amdgcn_mfma_f32_32x32x16_f16(__builtin_bit_cast(f16x8, vw), pb, o0, 0, 0, 0); }
                { const u32x2 a0 = *(const LAS u32x2*)(vp + 32 * AT_VP), a1 = *(const LAS u32x2*)(vp + 32 * AT_VP + 16); const u32x4 vw = {a0.x, a0.y, a1.x, a1.y}; o1 = __builtin_amdgcn_mfma_f32_32x32x16_f16(__builtin_bit_cast(f16x8, vw), pb, o1, 0, 0, 0); }
                __builtin_amdgcn_sched_barrier(0);
            } }
        lsum += dppf_swap32(lsum); lsum += __expf(sink - mx);
        const float rl = 1.0f / lsum;
#pragma unroll
        for (int rg = 0; rg < 4; ++rg) { u32x2 w0, w1;
            w0.x = cvt_pk_h16(o0[4 * rg] * rl, o0[4 * rg + 1] * rl); w0.y = cvt_pk_h16(o0[4 * rg + 2] * rl, o0[4 * rg + 3] * rl);
            w1.x = cvt_pk_h16(o1[4 * rg] * rl, o1[4 * rg + 1] * rl); w1.y = cvt_pk_h16(o1[4 * rg + 2] * rl, o1[4 * rg + 3] * rl);
            h16* op = OUTp + (size_t)(tb + qi) * opitch + hq * 64; *(u32x2*)(op + 8 * rg + 4 * hi) = w0; *(u32x2*)(op + 32 + 8 * rg + 4 * hi) = w1; }
    }
    __syncthreads();
}
template <int W> __device__ __forceinline__ void pool_pair(const h16* HHp, h16* PDp, const int c8, const int tA, const int tB) {
    u32x4 q[2][W];
#pragma unroll
    for (int p = 0; p < 2; ++p) { const int t = p ? tB : tA; const int s = t & (SEQ - 1); const h16* up = HHp + (size_t)t * DIN + C_U + c8 * 8;
#pragma unroll
        for (int i = 0; i < W; ++i) { const int ii = (i <= s) ? i : 0; q[p][i] = *(const u32x4*)(up - (size_t)ii * DIN); } }
#pragma unroll
    for (int p = 0; p < 2; ++p) { const int t = p ? tB : tA; const int s = t & (SEQ - 1); f32x4 a0 = {0.f, 0.f, 0.f, 0.f}, a1 = {0.f, 0.f, 0.f, 0.f}, u0, u1;
#pragma unroll
        for (int i = 0; i < W; ++i) { f32x4 v0, v1; unpack8(q[p][i], v0, v1); if (i == 0) { u0 = v0; u1 = v1; } if (i <= s) { a0 += v0; a1 += v1; } }
        const float rn = 1.0f / (float)((s + 1 < W) ? s + 1 : W);
        *(u32x4*)(PDp + (size_t)t * 512 + c8 * 8) = pack8(a0 * rn - u0, a1 * rn - u1); }
}


__device__ __forceinline__ void prep_expert_items(const float* w_eg, const float* w_eu, const float* w_ed, unsigned char* egu_t, h16* ed_t, float* wsc, int e_lo, int e_hi, int wrk, int nwrk, LAS float* scr, int lane) {
    for (int it = e_lo + wrk; it < e_hi; it += nwrk) {
        if (it < 2 * 8192) { const int up = it >> 13, q = it & 8191, e = q >> 7, q2 = q & 127, kb = q2 >> 3, nb = q2 & 7, n0 = 32 * nb;
            const float* Wm = (up ? w_eu : w_eg) + (size_t)e * D * FF; const float sc = f8_scale_of(Wm, lane); if (q2 == 0 && lane == 0) wsc[2 * e + up] = 1.0f / sc;
            tr_item_f8(Wm, FF, egu_t + (size_t)e * 512 * 1024, 1024, 64 * kb, n0, 256 * (n0 >> 7) + (n0 & 127) + 128 * up, scr, lane, sc); }
        else { const int r = it - 2 * 8192, e = r >> 7, q2 = r & 127, kb = q2 >> 5, nb = q2 & 31; tr_item(w_ed + (size_t)e * FF * D, D, ed_t + (size_t)e * 1024 * 256, 256, 64 * kb, 32 * nb, 32 * nb, scr, lane); }
    }
}
#define W_EGU_P(lt) ((unsigned char*)(args.ws + (((lt) & 1) ? W_EGU_ALT : W_EGU_T)))
#define WSC_P(lt) ((float*)(args.ws + MS_WSC) + ((lt) & 1) * 128)
#define W_ED_P(lt)  ((h16*)(args.ws + (((lt) & 1) ? W_ED_ALT : W_ED_T)))
#define PREP_EXPERTS(lt, e_lo, e_hi, wrk, nwrk) prep_expert_items(args.in[15] + (size_t)(lt) * NE * D * FF, args.in[16] + (size_t)(lt) * NE * D * FF, args.in[17] + (size_t)(lt) * NE * FF * D, W_EGU_P(lt), W_ED_P(lt), WSC_P(lt), e_lo, e_hi, wrk, nwrk, (LAS float*)(F.lds + F.wave * 16384), lane_id())
#ifndef P9_IPW
#define P9_IPW 5
#endif
constexpr int PE_A = 9830, PE_B = PE_A + 8602, PE_ALL = 3 * 8192;
#define PREP_WEIGHTS(E_LO) do { \
            LAS float* scr = (LAS float*)(F.lds + F.wave * 16384); \
            const float* w_in = L_W_IN; const float* w_br_attn = L_W_BRA; const float* w_out = L_W_OUT; const float* w_sg = L_W_SG; const float* w_su = L_W_SU; const float* w_sd = L_W_SD; \
            const float* w_eg = L_W_EG; const float* w_eu = L_W_EU; const float* w_ed = L_W_ED; const float* w_router = L_W_R; \
            constexpr int I_IN = 16 * 104, I_BA = 8 * 32, I_OUT = 16 * 32, I_SG = 16 * 8, I_SD = 4 * 32, I_EG = 64 * 128, I_ED = 64 * 128, I_R = 16 * 2; \
            constexpr int NITEMS = I_IN + I_BA + I_OUT + 2 * I_SG + I_SD + I_R; \
            for (int it = F.gw; it < NITEMS; it += F.NGW) { \
                int r = it; \
                if (r < I_IN) { const int kb = r / 104, nb = r % 104; const float sc = f8_scale_of(w_in, lane); if (r == 0 && lane == 0) *WSC_IN = 1.0f / sc; tr_item_f8(w_in, DIN, (unsigned char*)(args.ws + W_IN_T), 1024, 64 * kb, 32 * nb, 32 * nb, scr, lane, sc); continue; } r -= I_IN; \
                if (r < I_BA) { const int kb = r / 32, nb = r % 32; tr_item(w_br_attn, D, (h16*)(args.ws + W_BA_T), 512, 64 * kb, 32 * nb, 32 * nb, scr, lane); continue; } r -= I_BA; \
                if (r < I_OUT) { const int kb = r / 32, nb = r % 32; tr_item(w_out, D, (h16*)(args.ws + W_OUT_T), 1024, 64 * kb, 32 * nb, 32 * nb, scr, lane); continue; } r -= I_OUT; \
                if (r < 2 * I_SG) { const int up = r / I_SG, q = r % I_SG, kb = q / 8, nb = q % 8, n0 = 32 * nb; tr_item(up ? w_su : w_sg, FF, (h16*)(args.ws + W_SGU_T), 1024, 64 * kb, n0, 256 * (n0 >> 7) + (n0 & 127) + 128 * up, scr, lane); continue; } r -= 2 * I_SG; \
                if (r < I_SD) { const int kb = r / 32, nb = r % 32; tr_item(w_sd, D, (h16*)(args.ws + W_SD_T), 256, 64 * kb, 32 * nb, 32 * nb, scr, lane); continue; } r -= I_SD; \
                { const int kb = r / 2, nb = r % 2; tr_item_hilo(w_router, NE, (h16*)(args.ws + W_R_T), 1024, 64 * kb, 32 * nb, scr, lane); } \
            } \
            PREP_EXPERTS(l, (E_LO), PE_ALL, F.gw, F.NGW); \
            { h16* wpe = (h16*)(args.ws + W_PE_T); const float* w_pool = L_W_POOL; const float* pool_scale = L_PSCALE; const float* w_br_pool = L_W_BRP; \
              for (int idx = F.gw; idx < 512 * 16; idx += F.NGW) { const int cg = idx >> 4, n = ((idx & 15) << 6) + lane, g = cg >> 7; float s = 0.f; \
                  const float* wp = w_pool + (size_t)cg * 128; const float* ps = pool_scale + 128 * g; const float* wb = w_br_pool + (size_t)(128 * g) * D + n; \
                  float wv[128]; \
            _Pragma("unroll") \
                  for (int d = 0; d < 128; ++d) wv[d] = wb[(size_t)d * D]; \
            _Pragma("unroll") \
                  for (int d = 0; d < 128; ++d) s += wp[d] * ps[d] * wv[d]; \
                  wpe[(size_t)n * 512 + cg] = (h16)f2h(s); } } \
} while (0)
#define X32   (args.out)
#define XB    ((h16*)(args.ws + WS_XB))
#define XB8   ((unsigned char*)(args.ws + W_XB8))
#define WSC_IN ((float*)(args.ws + MS_WSC) + 256)
#define HH    ((h16*)(args.ws + R_HH))
#define PD    ((h16*)(args.ws + R_PD))
#define MG    ((h16*)(args.ws + R_MG))
#define HB    ((h16*)(args.ws + WS_HB))
#define HS    ((h16*)(args.ws + WS_HS))
#define YD    ((h16*)(args.ws + WS_R))
#define LOGIT ((float*)(args.ws + WS_HB))
#define ESEL  ((int*)(args.ws + MS_ESEL))
#define GATE  ((float*)(args.ws + MS_GATE))
#define RANKL ((int*)(args.ws + MS_RANK))
#define SLOT  ((int*)(args.ws + MS_SLOT))
#define TOKL  ((int*)(args.ws + MS_TOKL))
#define GATL  ((float*)(args.ws + MS_GATL))
#define WCNT  ((int*)(args.ws + MS_WCNT))
#define GTOT  ((int*)(args.ws + MS_GTOT))
#define BLKE  ((int*)(args.ws + MS_BLKE))
#define L_W_IN   (args.in[3] + (size_t)l * D * DIN)
#define L_B_IN   (args.in[4] + (size_t)l * DIN)
#define L_W_POOL (args.in[5] + (size_t)l * 4 * 128 * 128)
#define L_PSCALE (args.in[6] + (size_t)l * 512)
#define L_SINKS  (args.in[7] + (size_t)l * 8)
#define L_W_BRP  (args.in[8] + (size_t)l * 512 * D)
#define L_W_BRA  (args.in[9] + (size_t)l * 512 * D)
#define L_W_OUT  (args.in[10] + (size_t)l * D * D)
#define L_LN1G   (args.in[11] + (size_t)l * D)
#define L_LN1B   (args.in[12] + (size_t)l * D)
#define L_W_R    (args.in[13] + (size_t)l * D * NE)
#define L_RBIAS  (args.in[14] + (size_t)l * NE)
#define L_W_EG   (args.in[15] + (size_t)l * NE * D * FF)
#define L_W_EU   (args.in[16] + (size_t)l * NE * D * FF)
#define L_W_ED   (args.in[17] + (size_t)l * NE * FF * D)
#define L_W_SG   (args.in[18] + (size_t)l * D * FF)
#define L_W_SU   (args.in[19] + (size_t)l * D * FF)
#define L_W_SD   (args.in[20] + (size_t)l * FF * D)
#define L_LN2G   (args.in[21] + (size_t)l * D)
#define L_LN2B   (args.in[22] + (size_t)l * D)
__global__ void __launch_bounds__(512, 2) fwd_kernel(Args args) {
    extern __shared__ __attribute__((aligned(16))) unsigned char lds_raw[];
    Frame F;
    F.lds = (LAS unsigned char*)lds_raw;
    F.wave = __builtin_amdgcn_readfirstlane((int)threadIdx.x >> 6);
    F.G = gridDim.x; { const int bx = blockIdx.x; F.vcu = (F.G % 8 == 0) ? (bx % 8) * (F.G / 8) + bx / 8 : bx; }
    F.gw = F.vcu * 8 + F.wave; F.NGW = F.G * 8;
    unsigned* ctl = (unsigned*)(args.ws + WS_CTL);
    volatile LAS unsigned* MISC = (volatile LAS unsigned*)(F.lds + MISC_OFF);
    for (int u = threadIdx.x; u < (LDS_BYTES - LDSCTL_OFF) / 4; u += 512) ((LAS unsigned*)(F.lds + LDSCTL_OFF))[u] = 0u;
    __syncthreads();
#if MK_ONE_LAUNCH
    XcdBarrier bar = xcd_barrier_post(ctl + CW_BAR, MISC + 8);
#define GRID_BAR() xcd_barrier(bar, F.wave)
#else
#define GRID_BAR() do {} while (0)
#endif
    const int lo = args.ph_lo, hi = args.ph_hi;
#ifndef PHASE_MASK
#define PHASE_MASK 0xfff
#endif
#ifndef REPEAT_MASK
#define REPEAT_MASK 0
#endif
#define REPS(p) for (int rep_ = 0; rep_ < 1 + ((REPEAT_MASK >> (p)) & 1); ++rep_)
#define IN(p) (((PHASE_MASK >> ((p) - pb)) & 1) && lo <= (p) && (p) < hi)
#define PHASE_REGS const int lane = lane_id(); const int tid = F.wave * 64 + lane; int vcu = F.vcu, bx = (int)blockIdx.x; asm volatile("" : "+s"(vcu), "+s"(bx)); (void)lane; (void)tid; (void)vcu; (void)bx;

    for (int l = 0; l < DEPTH; ++l) {
        const int pb = l * NPH;
        if (IN(pb + 0) && l == 0) {
            PHASE_REGS
            PREP_WEIGHTS(0);
            for (int m = F.gw; m < T; m += F.NGW) { f32x4 v[4];
#pragma unroll
                for (int j = 0; j < 4; ++j) v[j] = *(const f32x4*)(args.in[0] + (size_t)m * D + 8 * lane + 4 * (j & 1) + 512 * (j >> 1));
                ln_store8(v, args.in[1], args.in[2], nullptr, XB + (size_t)m * D, lane, -1, -1, XB8 + (size_t)m * D); }
            GRID_BAR();
        }
        if (IN(pb + 1)) {
            PHASE_REGS
            SchedDense S; S.o.init(T, DIN, F.G, bx); S.a = (const char*)XB8; S.b = (const char*)(args.ws + W_IN_T); S.apitch = 1024; S.bpitch = 1024;
            EpiInProj E{HH, L_B_IN, *WSC_IN};
            REPS(1) GEMM_PHASE_F8(512, S, E);
            if (l + 1 < DEPTH && F.G == 256 && bx >= 128) PREP_EXPERTS(l + 1, 0, PE_A, (bx - 128) * 8 + F.wave, 128 * 8);
            GRID_BAR();
        }
        if (IN(pb + 2)) {
            PHASE_REGS
            { const int g = F.gw & 3, c8 = 16 * g + (lane & 15);
              for (int it = F.gw; it < T; it += 2 * F.NGW) { const int tA = (it >> 2) * 4 + (lane >> 4); const int it2 = (it + F.NGW < T) ? it + F.NGW : it; const int tB = (it2 >> 2) * 4 + (lane >> 4);
                  if (g == 0) pool_pair<2>(HH, PD, c8, tA, tB); else if (g == 1) pool_pair<4>(HH, PD, c8, tA, tB); else if (g == 2) pool_pair<8>(HH, PD, c8, tA, tB); else pool_pair<16>(HH, PD, c8, tA, tB); } }
            for (int U = vcu; U < NB * 16 * 2; U += F.G) attn_unit(F.lds, HH, HH + C_Q, DIN, L_SINKS, U >> 5, (U >> 1) & 15, U & 1, tid);
            GRID_BAR();
        }
        if (IN(pb + 3)) {
            PHASE_REGS
            SchedMerged S; S.o.init(T, D, F.G, bx); S.pd = (const char*)PD; S.oo = (const char*)(HH + C_Q); S.wpe = (const char*)(args.ws + W_PE_T); S.wba = (const char*)(args.ws + W_BA_T);
            EpiMerged E{MG, HH};
            REPS(3) GEMM_PHASE(512, S, E);
            GRID_BAR();
        }
        if (IN(pb + 4)) {
            PHASE_REGS
            SchedDense S; S.o.init(T, D, F.G, bx); S.a = (const char*)MG; S.b = (const char*)(args.ws + W_OUT_T); S.apitch = 2048; S.bpitch = 2048;
            EpiResid E{(h16*)X32, XB};
            REPS(4) GEMM_PHASE(1024, S, E);
            GRID_BAR();
        }
        if (IN(pb + 5)) {
            PHASE_REGS
            for (int m0 = F.gw; m0 < T; m0 += 4 * F.NGW) { u32x4 ra[4], rb4[4];
#pragma unroll
                for (int q = 0; q < 4; ++q) { const int m = (m0 + q * F.NGW < T) ? m0 + q * F.NGW : m0; const h16* sp = (const h16*)X32 + (size_t)m * D + 8 * lane;
                    ra[q] = __builtin_nontemporal_load((const u32x4*)sp); rb4[q] = __builtin_nontemporal_load((const u32x4*)(sp + 512)); }
#pragma unroll
                for (int q = 0; q < 4; ++q) { const int m = m0 + q * F.NGW; if (m < T) { f32x4 v[4]; unpack8(ra[q], v[0], v[1]); unpack8(rb4[q], v[2], v[3]); ln_store8(v, L_LN1G, L_LN1B, nullptr, XB + (size_t)m * D, lane, -1, -1, XB8 + (size_t)m * D); } } }
            GRID_BAR();
        }
        if (IN(pb + 6)) {
            PHASE_REGS
            SchedSharedRouter S{F.G, vcu, (const char*)XB, (const char*)(args.ws + W_SGU_T), (const char*)(args.ws + W_R_T)};
            EpiSharedRouter E{HS, LOGIT};
            REPS(6) GEMM_PHASE(1024, S, E);
            GRID_BAR();
        }
        if (IN(pb + 7)) {
            PHASE_REGS
            LAS int* lcnt = (LAS int*)(F.lds);
            const float rb = L_RBIAS[lane];
            REPS(7) for (int w = vcu; w < 256; w += F.G) {
                int mycnt = 0; const int t0 = w * 128 + F.wave * 16;
                float lgs[16];
#pragma unroll
                for (int tt = 0; tt < 16; ++tt) lgs[tt] = LOGIT[(size_t)(t0 + tt) * NE + lane] + LOGIT[(size_t)T * NE + (size_t)(t0 + tt) * NE + lane];
#pragma unroll
                for (int tt = 0; tt < 16; ++tt) { const int t = t0 + tt;
                    const float lg = lgs[tt]; const float scv = 1.0f / (1.0f + __expf(-lg)); const float bs = scv + rb;
                    const float m1 = max8(bs);
                    const unsigned long long eq = __ballot(bs == m1); const int g = lane >> 3; const unsigned gm = (unsigned)(eq >> (8 * g)) & 0xffu; const int first = __builtin_ctz(gm);
                    const float m2 = max8(((lane & 7) == first) ? -INFINITY : bs);
                    const float gs = m1 + m2; int grank = 0;
#pragma unroll
                    for (int j = 0; j < 8; ++j) { const float gj = rdlane(gs, 8 * j); grank += (gj > gs || (gj == gs && j < g)) ? 1 : 0; }
                    const bool keep = grank < 4; const float v = keep ? bs : -INFINITY; int rank = 0;
#pragma unroll
                    for (int j = 0; j < 64; ++j) { const float vj = rdlane(v, j); rank += (vj > v || (vj == v && j < lane)) ? 1 : 0; }
                    const bool sel = keep && rank < 8;
                    const float ssum = wave_sum(sel ? scv : 0.f);
                    if (sel) { ESEL[t * 8 + rank] = lane; GATE[t * 8 + rank] = scv / ssum * 2.5f; RANKL[t * 8 + rank] = mycnt; mycnt++; }
                }
                WCNT[(size_t)(w * 8 + F.wave) * 64 + lane] = mycnt;
                lcnt[F.wave * 64 + lane] = mycnt;
                __syncthreads();
                if (F.wave == 0) { int s = 0;
#pragma unroll
                    for (int v = 0; v < 8; ++v) s += lcnt[v * 64 + lane];
                    GTOT[w * 64 + lane] = s; }
                __syncthreads();
            }
            GRID_BAR();
        }
        if (IN(pb + 8)) {
            PHASE_REGS
            REPS(8) for (int w = vcu; w < 256; w += F.G) {
                int tot = 0, before = 0;
#pragma unroll 64
                for (int w2 = 0; w2 < 256; ++w2) { const int c = GTOT[w2 * 64 + lane]; tot += c; before += (w2 < w) ? c : 0; }
                for (int v2 = 0; v2 < F.wave; ++v2) before += WCNT[(size_t)(w * 8 + v2) * 64 + lane];
                const int pc = (tot + 255) & ~255; int incl = pc;
#pragma unroll
                for (int o = 1; o < 64; o <<= 1) { const int xv = __shfl_up(incl, o); if (lane >= o) incl += xv; }
                const int pstart = incl - pc, base = pstart + before; const int t0 = w * 128 + F.wave * 16;
#pragma unroll
                for (int it = 0; it < 2; ++it) { const int idx = it * 64 + lane, tt = t0 + (idx >> 3), k = idx & 7; const int e = ESEL[tt * 8 + k], r = RANKL[tt * 8 + k]; const float g = GATE[tt * 8 + k];
                    const int dest = __shfl(base, e) + r; TOKL[dest] = tt * 9 + k; GATL[dest] = g; }
                if (F.wave == 0 && w < 64) {
                    const int ps_ = __shfl(pstart, w), te = __shfl(tot, w), pe = __shfl(pc, w);
                    for (int i2 = te + lane; i2 < pe; i2 += 64) { TOKL[ps_ + i2] = YT_DUMP; GATL[ps_ + i2] = 0.f; } }
                if (F.wave == 1) {
                    const int nblk = __shfl(incl, 63) >> 8; const int rbk = 8 * w + (lane & 7); int cnt = 0;
                    for (int e = 0; e < 64; ++e) { const int pend = __shfl(incl, e); cnt += (pend <= rbk * 256) ? 1 : 0; }
                    if (lane < 8 && rbk < nblk) BLKE[rbk] = cnt < 63 ? cnt : 63;
                    if (w == 0 && lane == 0) BLKE[NBLK_MAX] = nblk; }
            }
            GRID_BAR();
        }
        if (IN(pb + 9)) {
            PHASE_REGS
            const int nblk = __builtin_amdgcn_readfirstlane(BLKE[NBLK_MAX]);
            { LAS int* bl = (LAS int*)(F.lds + LDS_BLKE); for (int i = tid; i < nblk; i += 512) bl[i] = BLKE[i]; __syncthreads(); }
            SchedMoeGU S{F.G, vcu, nblk, (const char*)(args.ws + W_XB8), (const char*)W_EGU_P(l), (const LAS int*)(F.lds + LDS_BLKE), TOKL};
            EpiMoeGU E{HB, GATL, WSC_P(l)};
            REPS(9) GEMM_PHASE_F8(512, S, E);
            { const int rounds = (2 * nblk + 255) >> 8, busy = 2 * nblk - 256 * (rounds - 1);
              const int n9 = min(PE_ALL - PE_A, (256 - busy) * 8 * P9_IPW);
              if (l + 1 < DEPTH && F.G == 256 && vcu >= busy) PREP_EXPERTS(l + 1, PE_A, PE_A + n9, (vcu - busy) * 8 + F.wave, (256 - busy) * 8); }
            GRID_BAR();
        }
        if (IN(pb + 10)) {
            PHASE_REGS
            const int nblk = __builtin_amdgcn_readfirstlane(BLKE[NBLK_MAX]);
            { LAS int* bl = (LAS int*)(F.lds + LDS_BLKE); for (int i = tid; i < nblk; i += 512) bl[i] = BLKE[i]; __syncthreads(); }
            SchedMoeDown S{F.G, vcu, nblk, (const char*)HB, (const char*)HS, (const char*)W_ED_P(l), (const char*)(args.ws + W_SD_T), (const LAS int*)(F.lds + LDS_BLKE), TOKL};
            REPS(10) { EpiMoeDown E{(unsigned char*)(args.ws + WS_R), (h16*)(args.ws + R_YS)};
            GEMM_PHASE(256, S, E); }
            GRID_BAR();
        }
        if (IN(pb + 11)) {
            PHASE_REGS
            { float* xo = (l == DEPTH - 1) ? X32 : nullptr;
            const unsigned char* YQ = (const unsigned char*)(args.ws + WS_R); const h16* YS = (const h16*)(args.ws + R_YS);
            const int c0 = 256 * (lane >> 4) + 32 * ((lane >> 2) & 3) + 8 * (lane & 3), c1 = c0 + 128;
            for (int m0 = F.gw; m0 < T; m0 += 3 * F.NGW) {
                u32x4 yq[3][9], xa[3], xb2[3]; unsigned short ys[3][9];
#pragma unroll
                for (int q = 0; q < 3; ++q) { const int m = (m0 + q * F.NGW < T) ? m0 + q * F.NGW : m0;
                    xa[q] = *(const u32x4*)(XB + (size_t)m * D + c0); xb2[q] = *(const u32x4*)(XB + (size_t)m * D + c1);
#pragma unroll
                    for (int k = 0; k < 9; ++k) { yq[q][k] = __builtin_nontemporal_load((const u32x4*)(YQ + ((size_t)m * 9 + k) * 1024 + lane * 16)); ys[q][k] = __builtin_nontemporal_load((const unsigned short*)(YS + ((size_t)m * 9 + k) * 64 + lane)); } }
#pragma unroll
                for (int q = 0; q < 3; ++q) { const int m = m0 + q * F.NGW; if (m < T) {
                    f32x4 v[4]; unpack8(xa[q], v[0], v[1]); unpack8(xb2[q], v[2], v[3]);
#pragma unroll
                    for (int j = 0; j < 4; ++j) v[j] = v[j] * ALPHA;
#pragma unroll
                    for (int k = 0; k < 9; ++k) { const float sc = h2f(ys[q][k]); const float bias = -128.0f * sc;
#pragma unroll
                        for (int j = 0; j < 4; ++j) { const unsigned wd = yq[q][k][j] ^ 0x80808080u;
                            v[j][0] += (float)(wd & 0xffu) * sc + bias; v[j][1] += (float)((wd >> 8) & 0xffu) * sc + bias; v[j][2] += (float)((wd >> 16) & 0xffu) * sc + bias; v[j][3] += (float)(wd >> 24) * sc + bias; } }
                    ln_store8(v, L_LN2G, L_LN2B, xo ? xo + (size_t)m * D : nullptr, XB + (size_t)m * D, lane, c0, c1, XB8 + (size_t)m * D); } } } }
            if (l + 1 < DEPTH) { const int nblk_ = __builtin_amdgcn_readfirstlane(BLKE[NBLK_MAX]); const int rounds_ = (2 * nblk_ + 255) >> 8, busy_ = 2 * nblk_ - 256 * (rounds_ - 1);
                const int e_lo = (F.G != 256) ? 0 : PE_A + min(PE_ALL - PE_A, (256 - busy_) * 8 * P9_IPW);
                ++l; PREP_WEIGHTS(e_lo); --l; }
            if (pb + 11 != DEPTH * NPH - 1) GRID_BAR();
        }
    }
#undef IN
}

extern "C" void kernel_launch(void* const* d_in, const int* in_sizes, int n_in, void* d_out, int out_size, void* d_ws, size_t ws_size, hipStream_t stream) {
    static int grid = 0;
    if (grid == 0) {
        if (n_in != 23 || out_size != T * D || ws_size < WS_END2) { fprintf(stderr, "kernel_launch: unexpected shapes (n_in %d out %d ws %zu)\n", n_in, out_size, ws_size); grid = -1; return; }
        int dev = 0, cus = 0;
        if (hipGetDevice(&dev) != hipSuccess || hipDeviceGetAttribute(&cus, hipDeviceAttributeMultiprocessorCount, dev) != hipSuccess) { grid = -1; return; }
        if (hipFuncSetAttribute((const void*)fwd_kernel, hipFuncAttributeMaxDynamicSharedMemorySize, LDS_BYTES) != hipSuccess) { fprintf(stderr, "kernel_launch: hipFuncSetAttribute failed\n"); grid = -1; return; }
        int per_cu = 0;
        if (hipOccupancyMaxActiveBlocksPerMultiprocessor(&per_cu, (const void*)fwd_kernel, 512, LDS_BYTES) != hipSuccess || per_cu < 1) { fprintf(stderr, "kernel_launch: occupancy query says %d\n", per_cu); }
        (void)hipGetLastError();
        grid = cus;
    }
    if (grid < 0) return;
    (void)hipMemsetAsync((char*)d_ws + WS_CTL, 0, CTL_ZERO_BYTES, stream);
    Args a{};
    for (int i = 0; i < 23; ++i) a.in[i] = (const float*)d_in[i];
    a.out = (float*)d_out; a.ws = (unsigned char*)d_ws;
#if MK_ONE_LAUNCH
    a.ph_lo = 0; a.ph_hi = DEPTH * NPH;
    hipLaunchKernelGGL(fwd_kernel, dim3(grid), dim3(512), LDS_BYTES, stream, a);
#else
    for (int p = 0; p < DEPTH * NPH; ++p) { a.ph_lo = p; a.ph_hi = p + 1; hipLaunchKernelGGL(fwd_kernel, dim3(grid), dim3(512), LDS_BYTES, stream, a); }
#endif
}
```

```cpp
#include <hip/hip_runtime.h>
#include <stdint.h>
#include <stdio.h>

#ifndef MK_ONE_LAUNCH
#define MK_ONE_LAUNCH 1
#endif

#define GAS __attribute__((address_space(1)))
#define LAS __attribute__((address_space(3)))
typedef unsigned short h16;
typedef short h16x8 __attribute__((ext_vector_type(8)));
typedef float f32x4 __attribute__((ext_vector_type(4)));
typedef float f32x2 __attribute__((ext_vector_type(2)));
typedef unsigned u32x4 __attribute__((ext_vector_type(4)));
typedef unsigned u32x2 __attribute__((ext_vector_type(2)));

constexpr int NB = 16, SEQ = 2048, T = NB * SEQ, D = 1024, DIN = 3328, DEPTH = 4;
constexpr int C_U = 0, C_Q = 512, C_K = 1024, C_V = 1152, C_GP = 1280, C_GA = 2304;
constexpr int NE = 64, FF = 256, TOPK = 8;
constexpr int NASSIGN = T * TOPK;
constexpr int NBLK_MAX = NASSIGN / 256 + NE;
constexpr int A_PAD = NBLK_MAX * 256;
constexpr float ALPHA = 1.6817928305074290f;
constexpr float LN_EPS = 1e-5f;
constexpr int NPH = 12;

constexpr size_t MiB = 1u << 20;
constexpr size_t WS_CTL = 0, CTL_ZERO_BYTES = 1 * MiB;
constexpr size_t WS_W = 1 * MiB;
constexpr size_t W_IN_T = WS_W + 0 * MiB;
constexpr size_t W_PE_T = WS_W + 7 * MiB;
constexpr size_t W_BA_T = WS_W + 8 * MiB;
constexpr size_t W_OUT_T = WS_W + 9 * MiB;
constexpr size_t W_R_T = WS_W + 11 * MiB;
constexpr size_t W_SGU_T = WS_W + 12 * MiB;
constexpr size_t W_SD_T = WS_W + 13 * MiB;
constexpr size_t W_EGU_T = WS_W + 14 * MiB;
constexpr size_t W_ED_T = WS_W + 78 * MiB;
constexpr size_t W_XB8 = W_EGU_T + 32 * MiB;
constexpr size_t WS_XB = 111 * MiB;
constexpr size_t WS_HB = 175 * MiB;
constexpr size_t WS_HS = 311 * MiB;
constexpr size_t WS_MISC = 327 * MiB;
constexpr size_t MS_LOGIT = WS_MISC;
constexpr size_t MS_ESEL = WS_MISC + 8 * MiB;
constexpr size_t MS_GATE = WS_MISC + 9 * MiB;
constexpr size_t MS_RANK = WS_MISC + 10 * MiB;
constexpr size_t MS_SLOT = WS_MISC + 11 * MiB;
constexpr size_t MS_TOKL = WS_MISC + 12 * MiB;
constexpr size_t MS_GATL = WS_MISC + 13 * MiB + 256 * 1024;
constexpr size_t MS_WCNT = WS_MISC + 14 * MiB + 512 * 1024;
constexpr size_t MS_GTOT = WS_MISC + 15 * MiB;
constexpr size_t MS_BLKE = WS_MISC + 15 * MiB + 256 * 1024;
constexpr size_t MS_WSC = WS_MISC + 15 * MiB + 512 * 1024;
constexpr size_t WS_R = 343 * MiB;
constexpr size_t R_HH = WS_R;
constexpr size_t R_PD = WS_R + 208 * MiB;
constexpr size_t R_MG = WS_R + 240 * MiB;
constexpr size_t WS_END = WS_R + 577 * MiB;
constexpr size_t W_EGU_ALT = WS_END;
constexpr size_t W_ED_ALT = WS_END + 64 * MiB;
constexpr size_t WS_END2 = WS_END + 96 * MiB;
constexpr size_t R_YS = WS_R + 296 * MiB;
constexpr int YT_DUMP = T * 9;
static_assert((size_t)A_PAD * 4 <= 1 * MiB + 256 * 1024, "toklist");
static_assert((size_t)A_PAD * 256 * 2 <= 136 * MiB, "Hbuf");
static_assert(((size_t)T * 9 + 1) * 1024 * 2 <= 577 * MiB, "Yt");

constexpr int CW_BAR = 4096;

constexpr int RING_BYTES = 131072;
constexpr int LDSCTL_OFF = RING_BYTES, MISC_OFF = LDSCTL_OFF + 320;
constexpr int LDS_BYTES = 147456;
constexpr int LDS_BLKE = LDSCTL_OFF + 1024;
constexpr int LDS_IDX = LDS_BLKE + 4352;
constexpr int LDS_OID = LDS_IDX + 2048;
static_assert(LDS_OID + 3072 <= LDS_BYTES, "LDS map");

#define RLX_AGENT __ATOMIC_RELAXED, __HIP_MEMORY_SCOPE_AGENT
__device__ __forceinline__ int lane_id() { int l; asm volatile("v_mbcnt_lo_u32_b32 %0, -1, 0\n\tv_mbcnt_hi_u32_b32 %0, -1, %0" : "=v"(l)); return l; }
typedef _Float16 f16x2 __attribute__((ext_vector_type(2)));
typedef _Float16 f16x8 __attribute__((ext_vector_type(8)));
__device__ __forceinline__ float h2f(unsigned short h) { return (float)__builtin_bit_cast(_Float16, h); }
__device__ __forceinline__ unsigned short f2h(float f) { return __builtin_bit_cast(unsigned short, (_Float16)f); }
__device__ __forceinline__ unsigned cvt_pk_h16(float lo, float hi) { f32x2 v = {lo, hi}; return __builtin_bit_cast(unsigned, __builtin_convertvector(v, f16x2)); }
__device__ __forceinline__ float lo16(unsigned w) { return (float)__builtin_bit_cast(f16x2, w)[0]; }
__device__ __forceinline__ float hi16(unsigned w) { return (float)__builtin_bit_cast(f16x2, w)[1]; }
__device__ __forceinline__ float sigmoidf_(float x) { return __builtin_amdgcn_rcpf(1.0f + __builtin_amdgcn_exp2f(-1.4426950408889634f * x)); }
template <int CTRL> __device__ __forceinline__ float dppf(float x) { return __builtin_bit_cast(float, __builtin_amdgcn_update_dpp(0, __builtin_bit_cast(int, x), CTRL, 0xf, 0xf, true)); }
__device__ __forceinline__ float rdlane(float x, int l) { return __builtin_bit_cast(float, __builtin_amdgcn_readlane(__builtin_bit_cast(int, x), l)); }
__device__ __forceinline__ float wave_sum(float v) {
    v += dppf<0xB1>(v); v += dppf<0x4E>(v); v += dppf<0x141>(v); v += dppf<0x140>(v);
    return (rdlane(v, 0) + rdlane(v, 16)) + (rdlane(v, 32) + rdlane(v, 48));
}
__device__ __forceinline__ float wave_max(float v) {
    v = fmaxf(v, dppf<0xB1>(v)); v = fmaxf(v, dppf<0x4E>(v)); v = fmaxf(v, dppf<0x141>(v)); v = fmaxf(v, dppf<0x140>(v));
    return fmaxf(fmaxf(rdlane(v, 0), rdlane(v, 16)), fmaxf(rdlane(v, 32), rdlane(v, 48)));
}
__device__ __forceinline__ float dppf_swap32(float x) { return __shfl_xor(x, 32); }
__device__ __forceinline__ float max8(float v) {
    v = fmaxf(v, dppf<0xB1>(v)); v = fmaxf(v, dppf<0x4E>(v)); return fmaxf(v, dppf<0x141>(v));
}

#define XB_TMO      128
#define XB_XCNT(j)  (256  + 64 * (j))
#define XB_XSUB(j)  (1280 + 64 * (j))
#define XB_XGEN(j)  (2304 + 64 * (j))
#define XB_TOP      3328
#define XB_TOPGEN   3392
#define XCD_BAR_WORDS 3456
#define XB_SPIN_CAP (1u << 18)
__device__ __forceinline__ unsigned xb_ld(unsigned* p)              { return __hip_atomic_load(p, __ATOMIC_RELAXED, __HIP_MEMORY_SCOPE_AGENT); }
__device__ __forceinline__ unsigned xb_add(unsigned* p, unsigned v) { return __hip_atomic_fetch_add(p, v, __ATOMIC_RELAXED, __HIP_MEMORY_SCOPE_AGENT); }
__device__ __forceinline__ unsigned xb_xcc_id() { return (unsigned)__builtin_amdgcn_s_getreg((3 << 11) | 20) & 0xFu; }
#define XB_SPIN(cond, bar) do { unsigned _sp = 0; while (cond) { __builtin_amdgcn_s_sleep(1); \
    if ((++_sp & 255u) == 0u) { if (xb_ld(&(bar)[XB_TMO])) break; if (_sp > XB_SPIN_CAP) { atomicAdd(&(bar)[XB_TMO], 1u); break; } } } } while (0)
struct XcdBarrier { unsigned* bar; unsigned x; volatile LAS unsigned* st; };
__device__ __forceinline__ XcdBarrier xcd_barrier_post(unsigned* bar, volatile LAS unsigned* st) {
    XcdBarrier b; b.bar = bar; b.x = xb_xcc_id(); b.st = st;
    if (threadIdx.x == 0) (void)xb_add(&bar[XB_XCNT(b.x)], 1u);
    return b;
}
__device__ __forceinline__ void xcd_barrier_complete(unsigned* bar, unsigned x, unsigned& nloc, unsigned& nx) {
    const unsigned G = gridDim.x * gridDim.y * gridDim.z;
    unsigned sum, cnt, mine, sp = 0u;
    for (;;) {
        sum = 0u; cnt = 0u; mine = 0u;
#pragma unroll
        for (unsigned j = 0; j < 16; ++j) { const unsigned c = xb_ld(&bar[XB_XCNT(j)]); sum += c; cnt += (c > 0u) ? 1u : 0u; mine = (j == x) ? c : mine; }
        if (sum == G) break;
        __builtin_amdgcn_s_sleep(1);
        if ((++sp & 255u) == 0u) { if (xb_ld(&bar[XB_TMO])) break; if (sp > XB_SPIN_CAP) { atomicAdd(&bar[XB_TMO], 1u); break; } }
    }
    nloc = mine > 0u ? mine : 1u; nx = cnt > 0u ? cnt : 1u;
}
__device__ __forceinline__ void xcd_barrier(const XcdBarrier& b, const int wave) {
    asm volatile("s_waitcnt vmcnt(0)" ::: "memory");
    __syncthreads();
    if (wave == 0 && lane_id() == 0) {
        unsigned* bar = b.bar;
        __builtin_amdgcn_s_waitcnt(0);
        unsigned nloc = b.st[0], nx = b.st[1];
        if (nloc == 0u) { xcd_barrier_complete(bar, b.x, nloc, nx); b.st[0] = nloc; b.st[1] = nx; }
        const unsigned old = xb_add(&bar[XB_XSUB(b.x)], 1u);
        const unsigned gen = old / nloc;
        if (old + 1u == (gen + 1u) * nloc) {
            __builtin_amdgcn_fence(__ATOMIC_RELEASE, "agent");
            asm volatile("s_waitcnt vmcnt(0)" ::: "memory");
            const unsigned og = xb_add(&bar[XB_TOP], 1u);
            const unsigned tg = og / nx;
            if (og + 1u == (tg + 1u) * nx) xb_add(&bar[XB_TOPGEN], 1u);
            else XB_SPIN(xb_ld(&bar[XB_TOPGEN]) == tg, bar);
            __builtin_amdgcn_fence(__ATOMIC_ACQUIRE, "agent");
            xb_add(&bar[XB_XGEN(b.x)], 1u);
            asm volatile("s_waitcnt vmcnt(0)" ::: "memory");
        } else {
            XB_SPIN(xb_ld(&bar[XB_XGEN(b.x)]) == gen, bar);
            __builtin_amdgcn_fence(__ATOMIC_ACQUIRE, "agent");
            asm volatile("s_waitcnt vmcnt(0)" ::: "memory");
        }
    }
    __syncthreads();
}

struct Unit {
    const char* a;
    const char* b;
    const int* ridx;
    unsigned apitch, bpitch;
    int row0;
    int col0;
    int kind;
    const int* oidx;
    const LAS int* oidl;
    int nt;
    int keep;
};
__device__ __forceinline__ int id2tok(int id) { const int t = (int)(((unsigned long long)(unsigned)id * 954437177ull) >> 33); return t < T ? t : T - 1; }
#define ACC_T f32x4 (&acc)[2][2][4][2]

template <class Epi, class Sched>
__device__ __forceinline__ void gemm_phase_simple(const int wid, const int K, const Sched& S, const Epi& E) {
    const int lane = lane_id(), tid = wid * 64 + lane; (void)tid;
    const int  wr = wid >> 2, wc = wid & 3, fr = lane & 15, fq = lane >> 4;
    Unit u;
    for (int i = 0; S.next(i, u); ++i) {
        f32x4 acc[2][2][4][2];
#pragma unroll
        for (int a = 0; a < 2; ++a)
#pragma unroll
            for (int b = 0; b < 2; ++b)
#pragma unroll
                for (int m = 0; m < 4; ++m)
#pragma unroll
                    for (int n = 0; n < 2; ++n) acc[a][b][m][n] = (f32x4){0.f, 0.f, 0.f, 0.f};
        unsigned offA[2][4], offB[2][2];
#pragma unroll
        for (int ai = 0; ai < 2; ++ai)
#pragma unroll
            for (int m = 0; m < 4; ++m) { const int r = 128 * ai + 64 * wr + 16 * m + fr; const int row = u.ridx ? id2tok(u.ridx[r]) : u.row0 + r; offA[ai][m] = (unsigned)row * u.apitch + (unsigned)fq * 16u; }
#pragma unroll
        for (int bj = 0; bj < 2; ++bj)
#pragma unroll
            for (int n = 0; n < 2; ++n) { const int wrow = 128 * bj + 32 * wc + 8 * (fr >> 2) + 4 * n + (fr & 3); offB[bj][n] = (unsigned)wrow * u.bpitch + (unsigned)fq * 16u; }
#pragma unroll 1
        for (int k0 = 0; k0 < K; k0 += 32) {
            h16x8 b[2][2];
#pragma unroll
            for (int bj = 0; bj < 2; ++bj)
#pragma unroll
                for (int n = 0; n < 2; ++n) b[bj][n] = *(const h16x8*)(u.b + offB[bj][n] + (size_t)k0 * 2);
#pragma unroll
            for (int ai = 0; ai < 2; ++ai) {
                h16x8 a[4];
#pragma unroll
                for (int m = 0; m < 4; ++m) a[m] = *(const h16x8*)(u.a + offA[ai][m] + (size_t)k0 * 2);
#pragma unroll
                for (int bj = 0; bj < 2; ++bj)
#pragma unroll
                    for (int m = 0; m < 4; ++m)
#pragma unroll
                        for (int n = 0; n < 2; ++n) acc[ai][bj][m][n] = __builtin_amdgcn_mfma_f32_16x16x32_f16(__builtin_bit_cast(f16x8, b[bj][n]), __builtin_bit_cast(f16x8, a[m]), acc[ai][bj][m][n], 0, 0, 0);
                asm volatile("" ::: "memory");
            }
        }
        u.oidl = nullptr;
        E(acc, u, wr, wc, fr, fq);
    }
}


#ifndef FAST_GEMM
#define FAST_GEMM 1
#endif
constexpr int HTB = 128 * 64 * 2;
__device__ __forceinline__ int lds_byte(int r, int c) { const int st = (r >> 4) * 2 + (c >> 5), rr = r & 15, cc = c & 31, ob = rr * 64 + cc * 2; return st * 1024 + (ob ^ (((ob >> 9) & 1) << 5)); }
__device__ __forceinline__ void stage_rc(int b, int& R, int& C) { const int st = b / 1024, sb = b % 1024, swz = sb ^ (((sb >> 9) & 1) << 5); R = (st >> 1) * 16 + swz / 64; C = (st & 1) * 32 + (swz % 64) / 2; }
__device__ __forceinline__ int perm32(int rho) { const int n = rho >> 4, i = rho & 15; return 8 * (i >> 2) + 4 * n + (i & 3); }

__device__ __forceinline__ const char* uptr(const char* p) { const unsigned long long v = (unsigned long long)p; const unsigned lo = __builtin_amdgcn_readfirstlane((unsigned)v), hi = __builtin_amdgcn_readfirstlane((unsigned)(v >> 32)); return (const char*)(((unsigned long long)hi << 32) | lo); }
typedef int i32x8 __attribute__((ext_vector_type(8)));
__device__ __forceinline__ i32x8 cat8(const u32x4 a, const u32x4 b) { return (i32x8){(int)a.x, (int)a.y, (int)a.z, (int)a.w, (int)b.x, (int)b.y, (int)b.z, (int)b.w}; }
template <int H> __device__ __forceinline__ f16x8 half8(const i32x8 v) { typedef int i32x4_ __attribute__((ext_vector_type(4))); const i32x4_ q = __builtin_shufflevector(v, v, 4 * H, 4 * H + 1, 4 * H + 2, 4 * H + 3); return __builtin_bit_cast(f16x8, q); }
template <bool F8, class Epi, class Sched>
__device__ __forceinline__ void gemm_phase(LAS unsigned char* lds, const int wid, const int K, const Sched& S, const Epi& E) {
    const int lane = lane_id(), tid = wid * 64 + lane;
    const int  wr = wid >> 2, wc = wid & 3, fr = lane & 15, fq = lane >> 4;
    int nt = K / 64; asm volatile("" : "+s"(nt));
    const unsigned ldsw = (unsigned)wid * 1024u;
    const int aoff = lds_byte(wr * 64 + fr, fq * 8), boff = lds_byte(wc * 32 + fr, fq * 8);
#define G_SA(b, h) (((b) * 2 + (h)) * HTB)
#define G_SB(b, h) ((4 + (b) * 2 + (h)) * HTB)
#define G_STAGE(bufoff, gbase, o0, o1) do { \
        __builtin_amdgcn_global_load_lds((const unsigned*)((const char*)(gbase) + (o0)), (LAS unsigned*)(lds + (bufoff) + ldsw), 16, 0, 0); \
        __builtin_amdgcn_global_load_lds((const unsigned*)((const char*)(gbase) + (o1)), (LAS unsigned*)(lds + (bufoff) + ldsw + 8192), 16, 0, 0); } while (0)
#define G_LDA(dst, b, h) do { _Pragma("unroll") for (int m = 0; m < 4; ++m) dst[m] = cat8(*(const LAS u32x4*)(lds + G_SA(b, h) + aoff + m * 2048), *(const LAS u32x4*)(lds + G_SA(b, h) + aoff + m * 2048 + 1024)); } while (0)
#define G_LDB(dst, b, h) do { _Pragma("unroll") for (int n = 0; n < 2; ++n) dst[n] = cat8(*(const LAS u32x4*)(lds + G_SB(b, h) + boff + n * 2048), *(const LAS u32x4*)(lds + G_SB(b, h) + boff + n * 2048 + 1024)); } while (0)
#define G_MMA(ai, bj, At, Bt) do { __builtin_amdgcn_s_setprio(1); _Pragma("unroll") for (int m = 0; m < 4; ++m) _Pragma("unroll") for (int n = 0; n < 2; ++n) { \
        if constexpr (F8) { acc[ai][bj][m][n] = __builtin_amdgcn_mfma_scale_f32_16x16x128_f8f6f4(Bt[n], At[m], acc[ai][bj][m][n], 0, 0, 0, 0, 0, 0); } \
        else { acc[ai][bj][m][n] = __builtin_amdgcn_mfma_f32_16x16x32_f16(half8<0>(Bt[n]), half8<0>(At[m]), acc[ai][bj][m][n], 0, 0, 0); \
               acc[ai][bj][m][n] = __builtin_amdgcn_mfma_f32_16x16x32_f16(half8<1>(Bt[n]), half8<1>(At[m]), acc[ai][bj][m][n], 0, 0, 0); } } \
        __builtin_amdgcn_s_setprio(0); } while (0)
#define G_WAIT_V(n) asm volatile("s_waitcnt vmcnt(" #n ")" ::: "memory")
#define G_WAIT_L(n) asm volatile("s_waitcnt lgkmcnt(" #n ")" ::: "memory")
#define G_BAR __builtin_amdgcn_s_barrier()
#define G_SCHED __builtin_amdgcn_sched_barrier(0)
#define G_OFFS(u, OA, OB, IDXB) do { int tl_ = wid * 64 + lane_id(); _Pragma("unroll") for (int i = 0; i < 2; ++i) { int R_, C_; stage_rc(tl_ * 16 + i * 8192, R_, C_); const int Rb_ = (R_ & ~31) + perm32(R_ & 31); \
        _Pragma("unroll") for (int h = 0; h < 2; ++h) { const int r_ = h * 128 + R_; const int row_ = (u).ridx ? id2tok(((const LAS int*)(lds + LDS_IDX + (IDXB) * 1024))[r_]) : (u).row0 + r_; \
        OA[h][i] = (unsigned)row_ * (u).apitch + (unsigned)C_ * 2u; OB[h][i] = (unsigned)(h * 128 + Rb_) * (u).bpitch + (unsigned)C_ * 2u; } } } while (0)
#define G_IDX_DMA(u, IDXB, OIDB) do { if ((u).ridx && wid < 4) __builtin_amdgcn_global_load_lds((const unsigned*)((u).ridx + wid * 64 + lane_id()), (LAS unsigned*)(lds + LDS_IDX + (IDXB) * 1024 + wid * 256), 4, 0, 0); \
        if ((u).oidx && wid < 4) __builtin_amdgcn_global_load_lds((const unsigned*)((u).oidx + wid * 64 + lane_id()), (LAS unsigned*)(lds + LDS_OID + (OIDB) * 1024 + wid * 256), 4, 0, 0); } while (0)
    Unit cur, nxt; int ui = 0;
    if (!S.next(0, cur)) return;
    if constexpr (Sched::DYN) nt = cur.nt;
    unsigned cOA[2][2], cOB[2][2];
    G_IDX_DMA(cur, 0, 0); asm volatile("s_waitcnt vmcnt(0)" ::: "memory"); __builtin_amdgcn_s_barrier(); asm volatile("" ::: "memory");
    G_OFFS(cur, cOA, cOB, 0);
    f32x4 acc[2][2][4][2];
#pragma unroll
    for (int a = 0; a < 2; ++a)
#pragma unroll
        for (int b = 0; b < 2; ++b)
#pragma unroll
            for (int m = 0; m < 4; ++m)
#pragma unroll
                for (int n = 0; n < 2; ++n) acc[a][b][m][n] = (f32x4){0.f, 0.f, 0.f, 0.f};
    i32x8 At[4], B0[2], B1[2];
    const char* cA = uptr(cur.a); const char* cB = uptr(cur.b);
    G_STAGE(G_SB(0, 0), cB, cOB[0][0], cOB[0][1]); G_STAGE(G_SB(0, 1), cB, cOB[1][0], cOB[1][1]); G_STAGE(G_SA(0, 0), cA, cOA[0][0], cOA[0][1]); G_STAGE(G_SA(0, 1), cA, cOA[1][0], cOA[1][1]);
    if (wr == 1) G_BAR;
    G_WAIT_V(2); G_BAR;
    { const char* cA1 = uptr(cA + 128); const char* cB1 = uptr(cB + 128);
      G_STAGE(G_SB(1, 0), cB1, cOB[0][0], cOB[0][1]); G_STAGE(G_SA(1, 0), cA1, cOA[0][0], cOA[0][1]); G_STAGE(G_SB(1, 1), cB1, cOB[1][0], cOB[1][1]); }
    G_WAIT_V(6); G_BAR;
    for (;;) {
        const bool has_next = S.next(ui + 1, nxt); const char* nA = cA; const char* nB = cB;
        if (has_next) G_IDX_DMA(nxt, (ui + 1) & 1, (ui + 1) % 3);
#pragma unroll 1
        for (int t = 0; t < nt; t += 2) {
            const bool last = (t == nt - 2);
            const char* a1 = uptr(cA + (size_t)(t + 1) * 128);
            G_LDB(B0, 0, 0); G_LDB(B1, 0, 1); G_SCHED; G_LDA(At, 0, 0); G_STAGE(G_SA(1, 1), a1, cOA[1][0], cOA[1][1]);
            G_WAIT_V(8); G_WAIT_L(0); G_BAR; G_MMA(0, 0, At, B0); G_MMA(0, 1, At, B1); G_BAR; G_SCHED;
            if (last && has_next) { nA = uptr(nxt.a); nB = uptr(nxt.b); G_OFFS(nxt, cOA, cOB, (ui + 1) & 1); }
            const char* a2 = uptr(last ? nA : cA + (size_t)(t + 2) * 128); const char* b2 = uptr(last ? nB : cB + (size_t)(t + 2) * 128);
            const char* a3 = uptr(a2 + 128); const char* b3 = uptr(b2 + 128);
            G_LDA(At, 0, 1); G_STAGE(G_SB(0, 0), b2, cOB[0][0], cOB[0][1]); G_STAGE(G_SB(0, 1), b2, cOB[1][0], cOB[1][1]); G_STAGE(G_SA(0, 0), a2, cOA[0][0], cOA[0][1]);
            G_WAIT_V(8); G_WAIT_L(0); G_BAR; G_MMA(1, 0, At, B0); G_MMA(1, 1, At, B1); G_BAR; G_SCHED;
            G_LDB(B0, 1, 0); G_LDB(B1, 1, 1); G_SCHED; G_LDA(At, 1, 0); G_STAGE(G_SA(0, 1), a2, cOA[1][0], cOA[1][1]);
            G_WAIT_V(8); G_WAIT_L(0); G_BAR; G_MMA(0, 0, At, B0); G_MMA(0, 1, At, B1); G_BAR; G_SCHED;
            G_LDA(At, 1, 1); G_STAGE(G_SB(1, 0), b3, cOB[0][0], cOB[0][1]); G_STAGE(G_SB(1, 1), b3, cOB[1][0], cOB[1][1]); G_STAGE(G_SA(1, 0), a3, cOA[0][0], cOA[0][1]);
            G_WAIT_V(8); G_WAIT_L(0); G_BAR; G_MMA(1, 0, At, B0); G_MMA(1, 1, At, B1); G_BAR; G_SCHED;
        }
        if (wr == 0) G_BAR;
        cur.oidl = (const LAS int*)(lds + LDS_OID + (ui % 3) * 1024);
        { const int le = lane_id(); E(acc, cur, wr, wc, le & 15, le >> 4); }
        if (!has_next) break;
        if (!nxt.keep) {
#pragma unroll
        for (int a = 0; a < 2; ++a)
#pragma unroll
            for (int b = 0; b < 2; ++b)
#pragma unroll
                for (int m = 0; m < 4; ++m)
#pragma unroll
                    for (int n = 0; n < 2; ++n) acc[a][b][m][n] = (f32x4){0.f, 0.f, 0.f, 0.f};
        }
        cur = nxt; cA = nA; cB = nB; ++ui;
        if constexpr (Sched::DYN) nt = cur.nt;
        if (wr == 1) G_BAR;
    }
    G_WAIT_V(0);
    G_BAR;
#undef G_SA
#undef G_SB
#undef G_STAGE
#undef G_LDA
#undef G_LDB
#undef G_MMA
#undef G_WAIT_V
#undef G_WAIT_L
#undef G_BAR
#undef G_SCHED
#undef G_OFFS
#undef G_IDX_DMA
}
#if FAST_GEMM
#define GEMM_PHASE(K, S, E) gemm_phase<false>(F.lds, F.wave, K, S, E)
#define GEMM_PHASE_F8(K, S, E) gemm_phase<true>(F.lds, F.wave, K, S, E)
#else
#define GEMM_PHASE(K, S, E) gemm_phase_simple(F.wave, K, S, E)
#endif

constexpr int NXCD = 8, WGM = 8;
struct TileOrder {
    int nM, nN, nwg, G, c;
    __device__ void init(int M, int N, int G_, int c_) { nM = M / 256; nN = N / 256; nwg = nM * nN; G = G_; c = c_; }
    __device__ bool tile(int i, int& pm, int& pn) const {
        const long L = (long)i * G + c; if (L >= nwg) return false;
        int wgid = (int)L; { const int q = nwg / NXCD, r = nwg % NXCD, xcd = wgid % NXCD, off = wgid / NXCD; wgid = (xcd < r ? xcd * (q + 1) : r * (q + 1) + (xcd - r) * q) + off; }
        const int nig = WGM * nN, gid = wgid / nig, fm = gid * WGM, gsz = (nM - fm) < WGM ? (nM - fm) : WGM;
        pm = fm + ((wgid % nig) % gsz); pn = (wgid % nig) / gsz; return true;
    }
};
struct SchedDense { static constexpr bool DYN = false;
    TileOrder o; const char* a; const char* b; unsigned apitch, bpitch;
    __device__ bool next(int i, Unit& u) const {
        int pm, pn; if (!o.tile(i, pm, pn)) return false;
        u.a = a; u.b = b + (size_t)pn * 256 * bpitch; u.ridx = nullptr; u.apitch = apitch; u.bpitch = bpitch; u.row0 = pm * 256; u.col0 = pn * 256; u.kind = 0; u.oidx = nullptr; u.keep = 0; return true;
    }
};
struct SchedMerged { static constexpr bool DYN = false;
    TileOrder o; const char* pd; const char* oo; const char* wpe; const char* wba;
    __device__ bool next(int i, Unit& u) const {
        int pm, pn; if (!o.tile(i >> 1, pm, pn)) return false;
        const int part = i & 1;
        u.a = part ? oo : pd; u.apitch = part ? DIN * 2 : 512 * 2; u.b = (part ? wba : wpe) + (size_t)pn * 256 * 1024; u.bpitch = 1024; u.ridx = nullptr; u.row0 = pm * 256; u.col0 = pn * 256; u.kind = part; u.oidx = nullptr; u.keep = part; return true;
    }
};
struct SchedSharedRouter { static constexpr bool DYN = true;
    int G, c; const char* xb; const char* wsgu; const char* wr;
    __device__ bool next(int i, Unit& u) const {
        const int L = i * G + c; if (L >= 512) return false;
        u.apitch = 2048; u.bpitch = 2048; u.ridx = nullptr; u.oidx = nullptr; u.keep = 0;
        if (L < 256) { const int pm = L >> 1, pn = L & 1; u.a = xb; u.b = wsgu + (size_t)pn * 256 * 2048; u.row0 = pm * 256; u.col0 = pn * 128; u.kind = 0; u.nt = 16; }
        else { const int pm = (L - 256) >> 1, kh = L & 1; u.a = xb + kh * 1024; u.b = wr + kh * 1024; u.row0 = pm * 256; u.col0 = kh; u.kind = 1; u.nt = 8; }
        return true;
    }
};
struct SchedMoeGU { static constexpr bool DYN = false;
    int G, c, nblk; const char* xb; const char* wegu; const LAS int* blke; const int* tokl;
    __device__ bool next(int i, Unit& u) const {
        const int L = i * G + c; if (L >= 2 * nblk) return false;
        const int rb = L >> 1, pn = L & 1, e = __builtin_amdgcn_readfirstlane(blke[rb]);
        u.a = xb; u.apitch = 1024; u.bpitch = 1024; u.b = wegu + ((size_t)e * 512 + pn * 256) * 1024; u.ridx = tokl + rb * 256; u.row0 = rb * 256; u.col0 = pn * 128; u.kind = e; u.oidx = nullptr; u.keep = 0; return true;
    }
};
struct SchedMoeDownR { static constexpr bool DYN = false;
    int G, c, nblk; const char* hb; const char* wed; const LAS int* blke; const int* tokl;
    __device__ bool next(int i, Unit& u) const {
        const int L = i * G + c; if (L >= 4 * nblk) return false;
        const int rb = L >> 2, pn = L & 3, e = __builtin_amdgcn_readfirstlane(blke[rb]);
        u.apitch = 256; u.bpitch = 256; u.ridx = nullptr; u.a = hb; u.b = wed + ((size_t)e * 1024 + pn * 256) * 256; u.row0 = rb * 256; u.col0 = pn * 256; u.kind = e; u.oidx = tokl + rb * 256; u.keep = 0; return true;
    }
};
struct SchedShDown { static constexpr bool DYN = false;
    int G, c; const char* hs; const char* wsd;
    __device__ bool next(int i, Unit& u) const {
        const int L = i * G + c; if (L >= 512) return false;
        const int pm = L >> 2, pn = L & 3; u.apitch = 512; u.bpitch = 512; u.ridx = nullptr; u.a = hs; u.b = wsd + (size_t)pn * 256 * 512; u.row0 = pm * 256; u.col0 = pn * 256; u.kind = 64; u.oidx = nullptr; u.keep = 0; return true;
    }
};

__device__ __forceinline__ u32x4 pack8(const f32x4& v0, const f32x4& v1) { u32x4 w; w.x = cvt_pk_h16(v0[0], v0[1]); w.y = cvt_pk_h16(v0[2], v0[3]); w.z = cvt_pk_h16(v1[0], v1[1]); w.w = cvt_pk_h16(v1[2], v1[3]); return w; }
__device__ __forceinline__ void unpack8(const u32x4& w, f32x4& v0, f32x4& v1) { v0 = (f32x4){lo16(w.x), hi16(w.x), lo16(w.y), hi16(w.y)}; v1 = (f32x4){lo16(w.z), hi16(w.z), lo16(w.w), hi16(w.w)}; }
__device__ __forceinline__ f32x4 sig4(const f32x4& v) { return (f32x4){sigmoidf_(v[0]), sigmoidf_(v[1]), sigmoidf_(v[2]), sigmoidf_(v[3])}; }
__device__ __forceinline__ f32x4 swiglu4(const f32x4& g, const f32x4& u) { return (f32x4){g[0] * sigmoidf_(g[0]) * u[0], g[1] * sigmoidf_(g[1]) * u[1], g[2] * sigmoidf_(g[2]) * u[2], g[3] * sigmoidf_(g[3]) * u[3]}; }

__device__ __forceinline__ unsigned q8x4(float a, float b, float c, float d, float inv) {
    const unsigned ua = __float_as_uint(a * inv + 12582912.0f), ub = __float_as_uint(b * inv + 12582912.0f), uc = __float_as_uint(c * inv + 12582912.0f), ud = __float_as_uint(d * inv + 12582912.0f);
    const unsigned lo = __builtin_amdgcn_perm(ub, ua, 0x0c0c0400u), hi = __builtin_amdgcn_perm(ud, uc, 0x0c0c0400u);
    return __builtin_amdgcn_perm(hi, lo, 0x05040100u);
}
__device__ __forceinline__ unsigned f8x4(const f32x4 v) {
    int w = __builtin_amdgcn_cvt_pk_fp8_f32(__builtin_amdgcn_fmed3f(v.x, -448.f, 448.f), __builtin_amdgcn_fmed3f(v.y, -448.f, 448.f), 0, false);
    w = __builtin_amdgcn_cvt_pk_fp8_f32(__builtin_amdgcn_fmed3f(v.z, -448.f, 448.f), __builtin_amdgcn_fmed3f(v.w, -448.f, 448.f), w, true); return (unsigned)w; }
struct EpiInProj {
    h16* H; const float* bias; float isc;
    __device__ __forceinline__ void operator()(const ACC_T, const Unit& u, int wr, int wc, int fr, int fq) const {
        const int pn = u.col0 >> 8; const float sc = (pn == 2 || pn == 3) ? 0.125f : 1.f; const bool sg = pn >= 5;
        f32x4 bv[2][2];
#pragma unroll
        for (int bj = 0; bj < 2; ++bj)
#pragma unroll
            for (int n = 0; n < 2; ++n) bv[bj][n] = *(const f32x4*)(bias + u.col0 + 128 * bj + 32 * wc + 8 * fq + 4 * n);
#pragma unroll
        for (int ai = 0; ai < 2; ++ai)
#pragma unroll
            for (int m = 0; m < 4; ++m) { const int row = u.row0 + 128 * ai + 64 * wr + 16 * m + fr; h16* rowp = H + (size_t)row * DIN + u.col0 + 32 * wc + 8 * fq;
#pragma unroll
                for (int bj = 0; bj < 2; ++bj) { f32x4 v0 = (acc[ai][bj][m][0] * isc + bv[bj][0]) * sc, v1 = (acc[ai][bj][m][1] * isc + bv[bj][1]) * sc;
                    if (sg) { v0 = sig4(v0); v1 = sig4(v1);
                        u32x2 w; w.x = q8x4(v0[0], v0[1], v0[2], v0[3], 255.0f); w.y = q8x4(v1[0], v1[1], v1[2], v1[3], 255.0f);
                        *(u32x2*)((unsigned char*)(H + (size_t)row * DIN + C_GP) + (u.col0 - C_GP) + 128 * bj + 32 * wc + 8 * fq) = w; }
                    else *(u32x4*)(rowp + 128 * bj) = pack8(v0, v1); } }
    }
};
__device__ __forceinline__ void ungate8(const u32x2& w, f32x4& v0, f32x4& v1) {
    const float k = 1.0f / 255.0f;
    v0 = (f32x4){(float)(w.x & 0xffu) * k, (float)((w.x >> 8) & 0xffu) * k, (float)((w.x >> 16) & 0xffu) * k, (float)(w.x >> 24) * k};
    v1 = (f32x4){(float)(w.y & 0xffu) * k, (float)((w.y >> 8) & 0xffu) * k, (float)((w.y >> 16) & 0xffu) * k, (float)(w.y >> 24) * k};
}
struct EpiMerged {
    h16* MG; const h16* H;
    __device__ __forceinline__ void operator()(f32x4 (&acc)[2][2][4][2], const Unit& u, int wr, int wc, int fr, int fq) const {
        const int col = u.col0 + 32 * wc + 8 * fq;
#pragma unroll
        for (int ai = 0; ai < 2; ++ai) {
            u32x2 ga[4][2], gp[4][2];
#pragma unroll
            for (int m = 0; m < 4; ++m) { const int row = u.row0 + 128 * ai + 64 * wr + 16 * m + fr;
#pragma unroll
                for (int bj = 0; bj < 2; ++bj) { const unsigned char* gb = (const unsigned char*)(H + (size_t)row * DIN + C_GP) + col + 128 * bj; ga[m][bj] = *(const u32x2*)(gb + 1024); if (u.kind == 0) gp[m][bj] = *(const u32x2*)gb; } }
#pragma unroll
            for (int m = 0; m < 4; ++m) { const int row = u.row0 + 128 * ai + 64 * wr + 16 * m + fr;
#pragma unroll
                for (int bj = 0; bj < 2; ++bj) { f32x4 a0, a1; ungate8(ga[m][bj], a0, a1);
                    if (u.kind == 0) { f32x4 p0, p1; ungate8(gp[m][bj], p0, p1);
#pragma unroll
                        for (int j = 0; j < 4; ++j) { acc[ai][bj][m][0][j] *= p0[j] * __builtin_amdgcn_rcpf(fmaxf(a0[j], 6.2e-5f)); acc[ai][bj][m][1][j] *= p1[j] * __builtin_amdgcn_rcpf(fmaxf(a1[j], 6.2e-5f)); } }
                    else *(u32x4*)(MG + (size_t)row * D + col + 128 * bj) = pack8(acc[ai][bj][m][0] * a0, acc[ai][bj][m][1] * a1); } }
        }
    }
};
struct EpiResid {
    h16* S; const h16* XBp;
    __device__ __forceinline__ void operator()(const ACC_T, const Unit& u, int wr, int wc, int fr, int fq) const {
#pragma unroll
        for (int ai = 0; ai < 2; ++ai) {
            u32x4 xw[4][2];
#pragma unroll
            for (int m = 0; m < 4; ++m) { const int row = u.row0 + 128 * ai + 64 * wr + 16 * m + fr; const size_t off = (size_t)row * D + u.col0 + 32 * wc + 8 * fq;
#pragma unroll
                for (int bj = 0; bj < 2; ++bj) xw[m][bj] = *(const u32x4*)(XBp + off + 128 * bj); }
#pragma unroll
            for (int m = 0; m < 4; ++m) { const int row = u.row0 + 128 * ai + 64 * wr + 16 * m + fr; const size_t off = (size_t)row * D + u.col0 + 32 * wc + 8 * fq;
#pragma unroll
                for (int bj = 0; bj < 2; ++bj) { f32x4 x0, x1; unpack8(xw[m][bj], x0, x1);
                    *(u32x4*)(S + off + 128 * bj) = pack8(x0 * ALPHA + acc[ai][bj][m][0], x1 * ALPHA + acc[ai][bj][m][1]); } }
        }
    }
};
struct EpiSharedRouter {
    h16* HS; float* LG;
    __device__ __forceinline__ void operator()(const ACC_T, const Unit& u, int wr, int wc, int fr, int fq) const {
#pragma unroll
        for (int ai = 0; ai < 2; ++ai)
#pragma unroll
            for (int m = 0; m < 4; ++m) { const int row = u.row0 + 128 * ai + 64 * wr + 16 * m + fr;
                if (u.kind == 0) { *(u32x4*)(HS + (size_t)row * FF + u.col0 + 32 * wc + 8 * fq) = pack8(swiglu4(acc[ai][0][m][0], acc[ai][1][m][0]), swiglu4(acc[ai][0][m][1], acc[ai][1][m][1])); }
                else if (wc < 2) {
#pragma unroll
                    for (int n = 0; n < 2; ++n) *(f32x4*)(LG + (size_t)u.col0 * T * NE + (size_t)row * NE + 32 * wc + 8 * fq + 4 * n) = acc[ai][0][m][n] + acc[ai][1][m][n]; } }
    }
};
struct EpiMoeGU {
    unsigned char* HB; const float* wsc;
    __device__ __forceinline__ void operator()(const ACC_T, const Unit& u, int wr, int wc, int fr, int fq) const {
        const float isg = wsc[4 * u.kind], isu = wsc[4 * u.kind + 1], hsc = 1.52587890625e-05f / (isg * isu);
#pragma unroll
        for (int ai = 0; ai < 2; ++ai)
#pragma unroll
            for (int m = 0; m < 4; ++m) { const int row = u.row0 + 128 * ai + 64 * wr + 16 * m + fr;
                u32x2 w; w.x = f8x4(swiglu4(acc[ai][0][m][0] * isg, acc[ai][1][m][0] * isu) * hsc); w.y = f8x4(swiglu4(acc[ai][0][m][1] * isg, acc[ai][1][m][1] * isu) * hsc);
                *(u32x2*)(HB + (size_t)row * FF + u.col0 + 32 * wc + 8 * fq) = w; }
    }
};
template <bool ROUTED> struct EpiMoeDown {
    unsigned char* YQ; h16* YS; const float* wsc;
    __device__ __forceinline__ void operator()(const ACC_T, const Unit& u, int wr, int wc, int fr, int fq) const {
        float cs = 1.f;
        if constexpr (ROUTED) cs = wsc[4 * u.kind] * wsc[4 * u.kind + 1] * wsc[4 * u.kind + 2] * 65536.0f;
        const int grp = (u.col0 >> 8) * 16 + 4 * wc + fq;
#pragma unroll
        for (int ai = 0; ai < 2; ++ai)
#pragma unroll
            for (int m = 0; m < 4; ++m) {
                const int r = 128 * ai + 64 * wr + 16 * m + fr; int id; if constexpr (ROUTED) id = u.oidl[r]; else id = (u.row0 + r) * 9 + 8;
                f32x4 v0 = acc[ai][0][m][0], v1 = acc[ai][0][m][1], v2 = acc[ai][1][m][0], v3 = acc[ai][1][m][1];
                if constexpr (ROUTED) { v0 = v0 * cs; v1 = v1 * cs; v2 = v2 * cs; v3 = v3 * cs; }
                float mx = fmaxf(fmaxf(fabsf(v0[0]), fabsf(v0[1])), fmaxf(fabsf(v0[2]), fabsf(v0[3])));
                mx = fmaxf(mx, fmaxf(fmaxf(fabsf(v1[0]), fabsf(v1[1])), fmaxf(fabsf(v1[2]), fabsf(v1[3]))));
                mx = fmaxf(mx, fmaxf(fmaxf(fabsf(v2[0]), fabsf(v2[1])), fmaxf(fabsf(v2[2]), fabsf(v2[3]))));
                mx = fmaxf(mx, fmaxf(fmaxf(fabsf(v3[0]), fabsf(v3[1])), fmaxf(fabsf(v3[2]), fabsf(v3[3]))));
                const unsigned short sh = f2h(mx * (1.0f / 127.0f) * 1.0005f);
                const float scr = h2f(sh); const float inv = scr > 0.f ? __builtin_amdgcn_rcpf(scr) : 0.f;
                u32x4 w; w.x = q8x4(v0[0], v0[1], v0[2], v0[3], inv); w.y = q8x4(v1[0], v1[1], v1[2], v1[3], inv); w.z = q8x4(v2[0], v2[1], v2[2], v2[3], inv); w.w = q8x4(v3[0], v3[1], v3[2], v3[3], inv);
                *(u32x4*)(YQ + (size_t)id * 1024 + grp * 16) = w;
                *(unsigned short*)(YS + (size_t)id * 64 + grp) = sh; }
    }
};

struct Args { const float* in[23]; float* out; unsigned char* ws; int ph_lo, ph_hi; };
struct Frame {
    LAS unsigned char* lds; int wave, vcu, G, gw, NGW;
};

__device__ __forceinline__ void ln_store(f32x4 (&v)[4], const float* gam, const float* bet, float* o32, h16* o16, int lane) {
    float s = 0.f;
#pragma unroll
    for (int j = 0; j < 4; ++j) s += (v[j].x + v[j].y) + (v[j].z + v[j].w);
    const float mean = wave_sum(s) * (1.f / D); float s2 = 0.f;
#pragma unroll
    for (int j = 0; j < 4; ++j) { v[j] = v[j] - mean; s2 += (v[j].x * v[j].x + v[j].y * v[j].y) + (v[j].z * v[j].z + v[j].w * v[j].w); }
    const float rstd = 1.f / sqrtf(wave_sum(s2) * (1.f / D) + LN_EPS);
#pragma unroll
    for (int j = 0; j < 4; ++j) { const f32x4 g = *(const f32x4*)(gam + 4 * lane + 256 * j), b = *(const f32x4*)(bet + 4 * lane + 256 * j); const f32x4 y = v[j] * rstd * g + b;
        *(f32x4*)(o32 + 4 * lane + 256 * j) = y; u32x2 w; w.x = cvt_pk_h16(y[0], y[1]); w.y = cvt_pk_h16(y[2], y[3]); *(u32x2*)(o16 + 4 * lane + 256 * j) = w; }
}


__device__ __forceinline__ void ln_store8(f32x4 (&v)[4], const float* gam, const float* bet, float* o32, h16* o16, int lane, int c0 = -1, int c1 = -1, unsigned char* o8 = nullptr) {
    if (c0 < 0) { c0 = 8 * lane; c1 = 512 + 8 * lane; }
    float s = 0.f;
#pragma unroll
    for (int j = 0; j < 4; ++j) s += (v[j].x + v[j].y) + (v[j].z + v[j].w);
    const float mean = wave_sum(s) * (1.f / D); float s2 = 0.f;
#pragma unroll
    for (int j = 0; j < 4; ++j) { v[j] = v[j] - mean; s2 += (v[j].x * v[j].x + v[j].y * v[j].y) + (v[j].z * v[j].z + v[j].w * v[j].w); }
    const float rstd = 1.f / sqrtf(wave_sum(s2) * (1.f / D) + LN_EPS);
    f32x4 y[4];
#pragma unroll
    for (int j = 0; j < 4; ++j) { const int c = ((j >> 1) ? c1 : c0) + 4 * (j & 1); const f32x4 g = *(const f32x4*)(gam + c), b = *(const f32x4*)(bet + c); y[j] = v[j] * rstd * g + b; if (o32) *(f32x4*)(o32 + c) = y[j]; }
    *(u32x4*)(o16 + c0) = pack8(y[0], y[1]); *(u32x4*)(o16 + c1) = pack8(y[2], y[3]);
    if (o8) { u32x2 w; w.x = f8x4(y[0]); w.y = f8x4(y[1]); *(u32x2*)(o8 + c0) = w; w.x = f8x4(y[2]); w.y = f8x4(y[3]); *(u32x2*)(o8 + c1) = w; }
}
__device__ __forceinline__ void tr_item(const float* W, int N, h16* WT, int ldt, int k0, int n0, int drow0, LAS float* scr, int lane) {
    float tv[32];
#pragma unroll
    for (int i = 0; i < 32; ++i) { const int kk = 2 * i + (lane >> 5); tv[i] = __builtin_nontemporal_load(W + (size_t)(k0 + kk) * N + n0 + (lane & 31)); }
#pragma unroll
    for (int i = 0; i < 32; ++i) { const int kk = 2 * i + (lane >> 5); scr[kk * 33 + (lane & 31)] = tv[i]; }
    asm volatile("s_waitcnt lgkmcnt(0)" ::: "memory");
    const int c = lane & 7;
#pragma unroll
    for (int j = 0; j < 4; ++j) { const int n = (lane >> 3) + 8 * j; const LAS float* s = scr + (8 * c) * 33 + n;
        u32x4 o; o.x = cvt_pk_h16(s[0 * 33], s[1 * 33]); o.y = cvt_pk_h16(s[2 * 33], s[3 * 33]); o.z = cvt_pk_h16(s[4 * 33], s[5 * 33]); o.w = cvt_pk_h16(s[6 * 33], s[7 * 33]);
        *(u32x4*)(WT + (size_t)(drow0 + n) * ldt + k0 + 8 * c) = o; }
    asm volatile("s_waitcnt lgkmcnt(0)" ::: "memory");
}
__device__ __forceinline__ void tr_item_f8(const float* W, int N, unsigned char* WT, int ldt, int k0, int n0, int drow0, LAS float* scr, int lane, float scale) {
    float tv[32];
#pragma unroll
    for (int i = 0; i < 32; ++i) { const int kk = 2 * i + (lane >> 5); tv[i] = __builtin_nontemporal_load(W + (size_t)(k0 + kk) * N + n0 + (lane & 31)); }
#pragma unroll
    for (int i = 0; i < 32; ++i) { const int kk = 2 * i + (lane >> 5); scr[kk * 33 + (lane & 31)] = tv[i]; }
    asm volatile("s_waitcnt lgkmcnt(0)" ::: "memory");
    const int c = lane & 7;
#pragma unroll
    for (int j = 0; j < 4; ++j) { const int n = (lane >> 3) + 8 * j; const LAS float* s = scr + (8 * c) * 33 + n;
        u32x2 o; o.x = f8x4((f32x4){s[0 * 33], s[1 * 33], s[2 * 33], s[3 * 33]} * scale); o.y = f8x4((f32x4){s[4 * 33], s[5 * 33], s[6 * 33], s[7 * 33]} * scale);
        *(u32x2*)(WT + (size_t)(drow0 + n) * ldt + k0 + 8 * c) = o; }
    asm volatile("s_waitcnt lgkmcnt(0)" ::: "memory");
}
__device__ __forceinline__ float f8_scale_of(const float* W, int lane) {
    const f32x4 q = *(const f32x4*)(W + 4 * lane); const float ma = wave_sum((fabsf(q.x) + fabsf(q.y)) + (fabsf(q.z) + fabsf(q.w))) * (1.2533f / 256.f);
    float t = 32.f / fmaxf(ma, 1e-30f); t = fminf(fmaxf(t, 1.0e-18f), 1.0e18f);
    return __uint_as_float(__builtin_amdgcn_readfirstlane(__float_as_uint(t)) & 0x7f800000u);
}
__device__ __forceinline__ void tr_item_hilo(const float* W, int N, h16* WT, int ldt, int k0, int n0, LAS float* scr, int lane) {
    float tv[32];
#pragma unroll
    for (int i = 0; i < 32; ++i) { const int kk = 2 * i + (lane >> 5); tv[i] = __builtin_nontemporal_load(W + (size_t)(k0 + kk) * N + n0 + (lane & 31)); }
#pragma unroll
    for (int i = 0; i < 32; ++i) { const int kk = 2 * i + (lane >> 5); scr[kk * 33 + (lane & 31)] = tv[i]; }
    asm volatile("s_waitcnt lgkmcnt(0)" ::: "memory");
    const int c = lane & 7;
#pragma unroll
    for (int j = 0; j < 4; ++j) { const int n = (lane >> 3) + 8 * j; const LAS float* s = scr + (8 * c) * 33 + n;
        float v[8], r[8];
#pragma unroll
        for (int q = 0; q < 8; ++q) { v[q] = s[q * 33]; r[q] = v[q] - h2f(f2h(v[q])); }
        u32x4 o; o.x = cvt_pk_h16(v[0], v[1]); o.y = cvt_pk_h16(v[2], v[3]); o.z = cvt_pk_h16(v[4], v[5]); o.w = cvt_pk_h16(v[6], v[7]);
        *(u32x4*)(WT + (size_t)(n0 + n) * ldt + k0 + 8 * c) = o;
        o.x = cvt_pk_h16(r[0], r[1]); o.y = cvt_pk_h16(r[2], r[3]); o.z = cvt_pk_h16(r[4], r[5]); o.w = cvt_pk_h16(r[6], r[7]);
        *(u32x4*)(WT + (size_t)(128 + n0 + n) * ldt + k0 + 8 * c) = o; }
    asm volatile("s_waitcnt lgkmcnt(0)" ::: "memory");
}


typedef float f32x16 __attribute__((ext_vector_type(16)));
constexpr int AT_KP = 144, AT_VP = 528, AT_VOFF = 256 * AT_KP;
__device__ __forceinline__ int crow(int r, int hi) { return (r & 3) + 8 * (r >> 2) + 4 * hi; }
struct KVRegs { u32x4 k[4], v[4]; };
__device__ __forceinline__ void attn_load_kv(const h16* HHp, const int b, const int n, const int hk, const int tid, KVRegs& r) {
    const int tb = b * SEQ + n * 128;
#pragma unroll
    for (int i = 0; i < 4; ++i) { const int idx = tid + 512 * i, key = idx >> 3, ch = idx & 7; const int tok = (n > 0) ? tb - 128 + key : tb + (key & 127);
        const h16* kp = HHp + (size_t)tok * DIN + C_K + hk * 64 + ch * 8; r.k[i] = *(const u32x4*)kp; r.v[i] = *(const u32x4*)(kp + 128); }
}
__device__ __forceinline__ void attn_unit(LAS unsigned char* lds, h16* HHp, h16* OUTp, const int opitch, const float* sinks, const int b, const int n, const int hk, const int tid,
                                          const int unused_ = 0) {
    const int lane = tid & 63, wid = __builtin_amdgcn_readfirstlane(tid >> 6), q32 = lane & 31, hi = lane >> 5;
    const int g = wid >> 1, qh = wid & 1, hq = hk * 4 + g;
    const int tb = b * SEQ + n * 128;
    LAS unsigned char* Ks = lds; LAS unsigned char* Vs = lds + AT_VOFF;
    KVRegs cur; attn_load_kv(HHp, b, n, hk, tid, cur);
    f16x8 qs[4];
    { const h16* qp = HHp + (size_t)(tb + 64 * qh + q32) * DIN + C_Q + hq * 64;
#pragma unroll
      for (int ks = 0; ks < 4; ++ks) qs[ks] = *(const f16x8*)(qp + 16 * ks + 8 * hi); }
#pragma unroll
    for (int i = 0; i < 4; ++i) { const int idx = tid + 512 * i, key = idx >> 3, ch = idx & 7; const u32x4 kw = cur.k[i], vw = cur.v[i];
        *(LAS u32x4*)(Ks + key * AT_KP + ch * 16) = kw;
        LAS unsigned short* vd = (LAS unsigned short*)(Vs + (ch * 8) * AT_VP + key * 2);
        vd[0 * (AT_VP / 2)] = (unsigned short)(vw.x & 0xffffu); vd[1 * (AT_VP / 2)] = (unsigned short)(vw.x >> 16); vd[2 * (AT_VP / 2)] = (unsigned short)(vw.y & 0xffffu); vd[3 * (AT_VP / 2)] = (unsigned short)(vw.y >> 16);
        vd[4 * (AT_VP / 2)] = (unsigned short)(vw.z & 0xffffu); vd[5 * (AT_VP / 2)] = (unsigned short)(vw.z >> 16); vd[6 * (AT_VP / 2)] = (unsigned short)(vw.w & 0xffffu); vd[7 * (AT_VP / 2)] = (unsigned short)(vw.w >> 16); }
    __syncthreads();
    const float slope = exp2f(-(float)(hq + 1)), sink = sinks[hq];
    float ab[16];
#pragma unroll
    for (int r = 0; r < 16; ++r) ab[r] = slope * (float)(crow(r, hi) - 128 - q32);
#pragma unroll 1
    for (int sub = 0; sub < 2; ++sub) {
        const int q0 = 64 * qh + 32 * sub, qi = q0 + q32;
        f32x16 sv[5]; float mx = -INFINITY;
#pragma unroll
        for (int j = 0; j < 5; ++j) { const int key0 = q0 + 32 * j; f32x16 c; float sl = slope; asm volatile("" : "+v"(sl)); const float aj = sl * (float)(32 * j);
#pragma unroll
            for (int r = 0; r < 16; ++r) c[r] = ab[r] + aj;
#pragma unroll
            for (int ks = 0; ks < 4; ++ks) { const f16x8 kf = *(const LAS f16x8*)(Ks + (key0 + q32) * AT_KP + (16 * ks + 8 * hi) * 2); c = __builtin_amdgcn_mfma_f32_32x32x16_f16(kf, qs[ks], c, 0, 0, 0); }
            const bool dead = (n == 0) && (key0 < 128);
            int hil = hi; asm volatile("" : "+v"(hil));
#pragma unroll
            for (int r = 0; r < 16; ++r) { float v = c[r];
                if (j == 0) v = (crow(r, hil) > q32) ? v : -INFINITY;
                if (j == 4) v = (crow(r, hil) <= q32) ? v : -INFINITY;
                if (dead) v = -INFINITY;
                c[r] = v; mx = fmaxf(mx, v); }
            sv[j] = c; __builtin_amdgcn_sched_barrier(0); }
        if (sub == 0) { const h16* qp = HHp + (size_t)(tb + 64 * qh + 32 + q32) * DIN + C_Q + hq * 64;
#pragma unroll
            for (int ks = 0; ks < 4; ++ks) qs[ks] = *(const f16x8*)(qp + 16 * ks + 8 * hi); }
        mx = fmaxf(mx, dppf_swap32(mx)); mx = fmaxf(mx, sink);
        float lsum = 0.f; f32x16 o0, o1;
#pragma unroll
        for (int r = 0; r < 16; ++r) { o0[r] = 0.f; o1[r] = 0.f; }
#pragma unroll
        for (int j = 0; j < 5; ++j) { const int key0 = q0 + 32 * j;
#pragma unroll
            for (int r = 0; r < 16; ++r) { const float pv = __expf(sv[j][r] - mx); sv[j][r] = pv; lsum += pv; }
#pragma unroll
            for (int cc = 0; cc < 2; ++cc) {
                u32x4 pw; pw.x = cvt_pk_h16(sv[j][8 * cc + 0], sv[j][8 * cc + 1]); pw.y = cvt_pk_h16(sv[j][8 * cc + 2], sv[j][8 * cc + 3]); pw.z = cvt_pk_h16(sv[j][8 * cc + 4], sv[j][8 * cc + 5]); pw.w = cvt_pk_h16(sv[j][8 * cc + 6], sv[j][8 * cc + 7]);
                const f16x8 pb = __builtin_bit_cast(f16x8, pw);
                const LAS unsigned char* vp = Vs + q32 * AT_VP + (key0 + 16 * cc + 4 * hi) * 2;
                { const u32x2 a0 = *(const LAS u32x2*)vp, a1 = *(const LAS u32x2*)(vp + 16); const u32x4 vw = {a0.x, a0.y, a1.x, a1.y}; o0 = __builtin_amdgcn_mfma_f32_32x32x16_f16(__builtin_bit_cast(f16x8, vw), pb, o0, 0, 0, 0); }
                { const u32x2 a0 = *(const LAS u32x2*)(vp + 32 * AT_VP), a1 = *(const LAS u32x2*)(vp + 32 * AT_VP + 16); const u32x4 vw = {a0.x, a0.y, a1.x, a1.y}; o1 = __builtin_amdgcn_mfma_f32_32x32x16_f16(__builtin_bit_cast(f16x8, vw), pb, o1, 0, 0, 0); }
                __builtin_amdgcn_sched_barrier(0);
            } }
        lsum += dppf_swap32(lsum); lsum += __expf(sink - mx);
        const float rl = 1.0f / lsum;
#pragma unroll
        for (int rg = 0; rg < 4; ++rg) { u32x2 w0, w1;
            w0.x = cvt_pk_h16(o0[4 * rg] * rl, o0[4 * rg + 1] * rl); w0.y = cvt_pk_h16(o0[4 * rg + 2] * rl, o0[4 * rg + 3] * rl);
            w1.x = cvt_pk_h16(o1[4 * rg] * rl, o1[4 * rg + 1] * rl); w1.y = cvt_pk_h16(o1[4 * rg + 2] * rl, o1[4 * rg + 3] * rl);
            h16* op = OUTp + (size_t)(tb + qi) * opitch + hq * 64; *(u32x2*)(op + 8 * rg + 4 * hi) = w0; *(u32x2*)(op + 32 + 8 * rg + 4 * hi) = w1; }
    }
    __syncthreads();
}
template <int W> __device__ __forceinline__ void pool_pair(const h16* HHp, h16* PDp, const int c8, const int tA, const int tB) {
    u32x4 q[2][W];
#pragma unroll
    for (int p = 0; p < 2; ++p) { const int t = p ? tB : tA; const int s = t & (SEQ - 1); const h16* up = HHp + (size_t)t * DIN + C_U + c8 * 8;
#pragma unroll
        for (int i = 0; i < W; ++i) { const int ii = (i <= s) ? i : 0; q[p][i] = *(const u32x4*)(up - (size_t)ii * DIN); } }
#pragma unroll
    for (int p = 0; p < 2; ++p) { const int t = p ? tB : tA; const int s = t & (SEQ - 1); f32x4 a0 = {0.f, 0.f, 0.f, 0.f}, a1 = {0.f, 0.f, 0.f, 0.f}, u0, u1;
#pragma unroll
        for (int i = 0; i < W; ++i) { f32x4 v0, v1; unpack8(q[p][i], v0, v1); if (i == 0) { u0 = v0; u1 = v1; } if (i <= s) { a0 += v0; a1 += v1; } }
        const float rn = 1.0f / (float)((s + 1 < W) ? s + 1 : W);
        *(u32x4*)(PDp + (size_t)t * 512 + c8 * 8) = pack8(a0 * rn - u0, a1 * rn - u1); }
}


__device__ __forceinline__ void prep_expert_items(const float* w_eg, const float* w_eu, const float* w_ed, unsigned char* egu_t, unsigned char* ed_t, float* wsc, int e_lo, int e_hi, int wrk, int nwrk, LAS float* scr, int lane) {
    for (int it = e_lo + wrk; it < e_hi; it += nwrk) {
        if (it < 2 * 8192) { const int up = it >> 13, q = it & 8191, e = q >> 7, q2 = q & 127, kb = q2 >> 3, nb = q2 & 7, n0 = 32 * nb;
            const float* Wm = (up ? w_eu : w_eg) + (size_t)e * D * FF; const float sc = f8_scale_of(Wm, lane); if (q2 == 0 && lane == 0) wsc[4 * e + up] = 1.0f / sc;
            tr_item_f8(Wm, FF, egu_t + (size_t)e * 512 * 1024, 1024, 64 * kb, n0, 256 * (n0 >> 7) + (n0 & 127) + 128 * up, scr, lane, sc); }
        else { const int r = it - 2 * 8192, e = r >> 7, q2 = r & 127, kb = q2 >> 5, nb = q2 & 31; const float* Wm = w_ed + (size_t)e * FF * D; const float sc = f8_scale_of(Wm, lane); if (q2 == 0 && lane == 0) wsc[4 * e + 2] = 1.0f / sc;
            tr_item_f8(Wm, D, ed_t + (size_t)e * 1024 * 256, 256, 64 * kb, 32 * nb, 32 * nb, scr, lane, sc); }
    }
}
#define W_EGU_P(lt) ((unsigned char*)(args.ws + (((lt) & 1) ? W_EGU_ALT : W_EGU_T)))
#define WSC_P(lt) ((float*)(args.ws + MS_WSC) + ((lt) & 1) * 256)
#define W_ED_P(lt)  ((unsigned char*)(args.ws + (((lt) & 1) ? W_ED_ALT : W_ED_T)))
#define PREP_EXPERTS(lt, e_lo, e_hi, wrk, nwrk) prep_expert_items(args.in[15] + (size_t)(lt) * NE * D * FF, args.in[16] + (size_t)(lt) * NE * D * FF, args.in[17] + (size_t)(lt) * NE * FF * D, W_EGU_P(lt), W_ED_P(lt), WSC_P(lt), e_lo, e_hi, wrk, nwrk, (LAS float*)(F.lds + F.wave * 16384), lane_id())
#ifndef P9_IPW
#define P9_IPW 5
#endif
constexpr int PE_A = 9830, PE_B = PE_A + 8602, PE_ALL = 3 * 8192;
#define PREP_WEIGHTS(E_LO) do { \
            LAS float* scr = (LAS float*)(F.lds + F.wave * 16384); \
            const float* w_in = L_W_IN; const float* w_br_attn = L_W_BRA; const float* w_out = L_W_OUT; const float* w_sg = L_W_SG; const float* w_su = L_W_SU; const float* w_sd = L_W_SD; \
            const float* w_eg = L_W_EG; const float* w_eu = L_W_EU; const float* w_ed = L_W_ED; const float* w_router = L_W_R; \
            constexpr int I_IN = 16 * 104, I_BA = 8 * 32, I_OUT = 16 * 32, I_SG = 16 * 8, I_SD = 4 * 32, I_EG = 64 * 128, I_ED = 64 * 128, I_R = 16 * 2; \
            constexpr int NITEMS = I_IN + I_BA + I_OUT + 2 * I_SG + I_SD + I_R; \
            for (int it = F.gw; it < NITEMS; it += F.NGW) { \
                int r = it; \
                if (r < I_IN) { const int kb = r / 104, nb = r % 104; const float sc = f8_scale_of(w_in, lane); if (r == 0 && lane == 0) *WSC_IN = 1.0f / sc; tr_item_f8(w_in, DIN, (unsigned char*)(args.ws + W_IN_T), 1024, 64 * kb, 32 * nb, 32 * nb, scr, lane, sc); continue; } r -= I_IN; \
                if (r < I_BA) { const int kb = r / 32, nb = r % 32; tr_item(w_br_attn, D, (h16*)(args.ws + W_BA_T), 512, 64 * kb, 32 * nb, 32 * nb, scr, lane); continue; } r -= I_BA; \
                if (r < I_OUT) { const int kb = r / 32, nb = r % 32; tr_item(w_out, D, (h16*)(args.ws + W_OUT_T), 1024, 64 * kb, 32 * nb, 32 * nb, scr, lane); continue; } r -= I_OUT; \
                if (r < 2 * I_SG) { const int up = r / I_SG, q = r % I_SG, kb = q / 8, nb = q % 8, n0 = 32 * nb; tr_item(up ? w_su : w_sg, FF, (h16*)(args.ws + W_SGU_T), 1024, 64 * kb, n0, 256 * (n0 >> 7) + (n0 & 127) + 128 * up, scr, lane); continue; } r -= 2 * I_SG; \
                if (r < I_SD) { const int kb = r / 32, nb = r % 32; tr_item(w_sd, D, (h16*)(args.ws + W_SD_T), 256, 64 * kb, 32 * nb, 32 * nb, scr, lane); continue; } r -= I_SD; \
                { const int kb = r / 2, nb = r % 2; tr_item_hilo(w_router, NE, (h16*)(args.ws + W_R_T), 1024, 64 * kb, 32 * nb, scr, lane); } \
            } \
            PREP_EXPERTS(l, (E_LO), PE_ALL, F.gw, F.NGW); \
            { h16* wpe = (h16*)(args.ws + W_PE_T); const float* w_pool = L_W_POOL; const float* pool_scale = L_PSCALE; const float* w_br_pool = L_W_BRP; \
              for (int idx = F.gw; idx < 512 * 16; idx += F.NGW) { const int cg = idx >> 4, n = ((idx & 15) << 6) + lane, g = cg >> 7; float s = 0.f; \
                  const float* wp = w_pool + (size_t)cg * 128; const float* ps = pool_scale + 128 * g; const float* wb = w_br_pool + (size_t)(128 * g) * D + n; \
                  float wv[128]; \
            _Pragma("unroll") \
                  for (int d = 0; d < 128; ++d) wv[d] = wb[(size_t)d * D]; \
            _Pragma("unroll") \
                  for (int d = 0; d < 128; ++d) s += wp[d] * ps[d] * wv[d]; \
                  wpe[(size_t)n * 512 + cg] = (h16)f2h(s); } } \
} while (0)
#define X32   (args.out)
#define XB    ((h16*)(args.ws + WS_XB))
#define XB8   ((unsigned char*)(args.ws + W_XB8))
#define WSC_IN ((float*)(args.ws + MS_WSC) + 512)
#define HH    ((h16*)(args.ws + R_HH))
#define PD    ((h16*)(args.ws + R_PD))
#define MG    ((h16*)(args.ws + R_MG))
#define HB    ((h16*)(args.ws + WS_HB))
#define HS    ((h16*)(args.ws + WS_HS))
#define YD    ((h16*)(args.ws + WS_R))
#define LOGIT ((float*)(args.ws + WS_HB))
#define ESEL  ((int*)(args.ws + MS_ESEL))
#define GATE  ((float*)(args.ws + MS_GATE))
#define RANKL ((int*)(args.ws + MS_RANK))
#define SLOT  ((int*)(args.ws + MS_SLOT))
#define TOKL  ((int*)(args.ws + MS_TOKL))
#define GATL  ((float*)(args.ws + MS_GATL))
#define WCNT  ((int*)(args.ws + MS_WCNT))
#define GTOT  ((int*)(args.ws + MS_GTOT))
#define BLKE  ((int*)(args.ws + MS_BLKE))
#define L_W_IN   (args.in[3] + (size_t)l * D * DIN)
#define L_B_IN   (args.in[4] + (size_t)l * DIN)
#define L_W_POOL (args.in[5] + (size_t)l * 4 * 128 * 128)
#define L_PSCALE (args.in[6] + (size_t)l * 512)
#define L_SINKS  (args.in[7] + (size_t)l * 8)
#define L_W_BRP  (args.in[8] + (size_t)l * 512 * D)
#define L_W_BRA  (args.in[9] + (size_t)l * 512 * D)
#define L_W_OUT  (args.in[10] + (size_t)l * D * D)
#define L_LN1G   (args.in[11] + (size_t)l * D)
#define L_LN1B   (args.in[12] + (size_t)l * D)
#define L_W_R    (args.in[13] + (size_t)l * D * NE)
#define L_RBIAS  (args.in[14] + (size_t)l * NE)
#define L_W_EG   (args.in[15] + (size_t)l * NE * D * FF)
#define L_W_EU   (args.in[16] + (size_t)l * NE * D * FF)
#define L_W_ED   (args.in[17] + (size_t)l * NE * FF * D)
#define L_W_SG   (args.in[18] + (size_t)l * D * FF)
#define L_W_SU   (args.in[19] + (size_t)l * D * FF)
#define L_W_SD   (args.in[20] + (size_t)l * FF * D)
#define L_LN2G   (args.in[21] + (size_t)l * D)
#define L_LN2B   (args.in[22] + (size_t)l * D)
__global__ void __launch_bounds__(512, 2) fwd_kernel(Args args) {
    extern __shared__ __attribute__((aligned(16))) unsigned char lds_raw[];
    Frame F;
    F.lds = (LAS unsigned char*)lds_raw;
    F.wave = __builtin_amdgcn_readfirstlane((int)threadIdx.x >> 6);
    F.G = gridDim.x; { const int bx = blockIdx.x; F.vcu = (F.G % 8 == 0) ? (bx % 8) * (F.G / 8) + bx / 8 : bx; }
    F.gw = F.vcu * 8 + F.wave; F.NGW = F.G * 8;
    unsigned* ctl = (unsigned*)(args.ws + WS_CTL);
    volatile LAS unsigned* MISC = (volatile LAS unsigned*)(F.lds + MISC_OFF);
    for (int u = threadIdx.x; u < (LDS_BYTES - LDSCTL_OFF) / 4; u += 512) ((LAS unsigned*)(F.lds + LDSCTL_OFF))[u] = 0u;
    __syncthreads();
#if MK_ONE_LAUNCH
    XcdBarrier bar = xcd_barrier_post(ctl + CW_BAR, MISC + 8);
#define GRID_BAR() xcd_barrier(bar, F.wave)
#else
#define GRID_BAR() do {} while (0)
#endif
    const int lo = args.ph_lo, hi = args.ph_hi;
#ifndef PHASE_MASK
#define PHASE_MASK 0xfff
#endif
#ifndef REPEAT_MASK
#define REPEAT_MASK 0
#endif
#define REPS(p) for (int rep_ = 0; rep_ < 1 + ((REPEAT_MASK >> (p)) & 1); ++rep_)
#define IN(p) (((PHASE_MASK >> ((p) - pb)) & 1) && lo <= (p) && (p) < hi)
#define PHASE_REGS const int lane = lane_id(); const int tid = F.wave * 64 + lane; int vcu = F.vcu, bx = (int)blockIdx.x; asm volatile("" : "+s"(vcu), "+s"(bx)); (void)lane; (void)tid; (void)vcu; (void)bx;

    for (int l = 0; l < DEPTH; ++l) {
        const int pb = l * NPH;
        if (IN(pb + 0) && l == 0) {
            PHASE_REGS
            PREP_WEIGHTS(0);
            for (int m = F.gw; m < T; m += F.NGW) { f32x4 v[4];
#pragma unroll
                for (int j = 0; j < 4; ++j) v[j] = *(const f32x4*)(args.in[0] + (size_t)m * D + 8 * lane + 4 * (j & 1) + 512 * (j >> 1));
                ln_store8(v, args.in[1], args.in[2], nullptr, XB + (size_t)m * D, lane, -1, -1, XB8 + (size_t)m * D); }
            GRID_BAR();
        }
        if (IN(pb + 1)) {
            PHASE_REGS
            SchedDense S; S.o.init(T, DIN, F.G, bx); S.a = (const char*)XB8; S.b = (const char*)(args.ws + W_IN_T); S.apitch = 1024; S.bpitch = 1024;
            EpiInProj E{HH, L_B_IN, *WSC_IN};
            REPS(1) GEMM_PHASE_F8(512, S, E);
            if (l + 1 < DEPTH && F.G == 256 && bx >= 128) PREP_EXPERTS(l + 1, 0, PE_A, (bx - 128) * 8 + F.wave, 128 * 8);
            GRID_BAR();
        }
        if (IN(pb + 2)) {
            PHASE_REGS
            { const int g = F.gw & 3, c8 = 16 * g + (lane & 15);
              for (int it = F.gw; it < T; it += 2 * F.NGW) { const int tA = (it >> 2) * 4 + (lane >> 4); const int it2 = (it + F.NGW < T) ? it + F.NGW : it; const int tB = (it2 >> 2) * 4 + (lane >> 4);
                  if (g == 0) pool_pair<2>(HH, PD, c8, tA, tB); else if (g == 1) pool_pair<4>(HH, PD, c8, tA, tB); else if (g == 2) pool_pair<8>(HH, PD, c8, tA, tB); else pool_pair<16>(HH, PD, c8, tA, tB); } }
            for (int U = vcu; U < NB * 16 * 2; U += F.G) attn_unit(F.lds, HH, HH + C_Q, DIN, L_SINKS, U >> 5, (U >> 1) & 15, U & 1, tid);
            GRID_BAR();
        }
        if (IN(pb + 3)) {
            PHASE_REGS
            SchedMerged S; S.o.init(T, D, F.G, bx); S.pd = (const char*)PD; S.oo = (const char*)(HH + C_Q); S.wpe = (const char*)(args.ws + W_PE_T); S.wba = (const char*)(args.ws + W_BA_T);
            EpiMerged E{MG, HH};
            REPS(3) GEMM_PHASE(512, S, E);
            GRID_BAR();
        }
        if (IN(pb + 4)) {
            PHASE_REGS
            SchedDense S; S.o.init(T, D, F.G, bx); S.a = (const char*)MG; S.b = (const char*)(args.ws + W_OUT_T); S.apitch = 2048; S.bpitch = 2048;
            EpiResid E{(h16*)X32, XB};
            REPS(4) GEMM_PHASE(1024, S, E);
            GRID_BAR();
        }
        if (IN(pb + 5)) {
            PHASE_REGS
            for (int m0 = F.gw; m0 < T; m0 += 4 * F.NGW) { u32x4 ra[4], rb4[4];
#pragma unroll
                for (int q = 0; q < 4; ++q) { const int m = (m0 + q * F.NGW < T) ? m0 + q * F.NGW : m0; const h16* sp = (const h16*)X32 + (size_t)m * D + 8 * lane;
                    ra[q] = __builtin_nontemporal_load((const u32x4*)sp); rb4[q] = __builtin_nontemporal_load((const u32x4*)(sp + 512)); }
#pragma unroll
                for (int q = 0; q < 4; ++q) { const int m = m0 + q * F.NGW; if (m < T) { f32x4 v[4]; unpack8(ra[q], v[0], v[1]); unpack8(rb4[q], v[2], v[3]); ln_store8(v, L_LN1G, L_LN1B, nullptr, XB + (size_t)m * D, lane, -1, -1, XB8 + (size_t)m * D); } } }
            GRID_BAR();
        }
        if (IN(pb + 6)) {
            PHASE_REGS
            SchedSharedRouter S{F.G, vcu, (const char*)XB, (const char*)(args.ws + W_SGU_T), (const char*)(args.ws + W_R_T)};
            EpiSharedRouter E{HS, LOGIT};
            REPS(6) GEMM_PHASE(1024, S, E);
            GRID_BAR();
        }
        if (IN(pb + 7)) {
            PHASE_REGS
            LAS int* lcnt = (LAS int*)(F.lds);
            const float rb = L_RBIAS[lane];
            REPS(7) for (int w = vcu; w < 256; w += F.G) {
                int mycnt = 0; const int t0 = w * 128 + F.wave * 16;
                float lgs[16];
#pragma unroll
                for (int tt = 0; tt < 16; ++tt) lgs[tt] = LOGIT[(size_t)(t0 + tt) * NE + lane] + LOGIT[(size_t)T * NE + (size_t)(t0 + tt) * NE + lane];
#pragma unroll
                for (int tt = 0; tt < 16; ++tt) { const int t = t0 + tt;
                    const float lg = lgs[tt]; const float scv = 1.0f / (1.0f + __expf(-lg)); const float bs = scv + rb;
                    const float m1 = max8(bs);
                    const unsigned long long eq = __ballot(bs == m1); const int g = lane >> 3; const unsigned gm = (unsigned)(eq >> (8 * g)) & 0xffu; const int first = __builtin_ctz(gm);
                    const float m2 = max8(((lane & 7) == first) ? -INFINITY : bs);
                    const float gs = m1 + m2; int grank = 0;
#pragma unroll
                    for (int j = 0; j < 8; ++j) { const float gj = rdlane(gs, 8 * j); grank += (gj > gs || (gj == gs && j < g)) ? 1 : 0; }
                    const bool keep = grank < 4; const float v = keep ? bs : -INFINITY; int rank = 0;
#pragma unroll
                    for (int j = 0; j < 64; ++j) { const float vj = rdlane(v, j); rank += (vj > v || (vj == v && j < lane)) ? 1 : 0; }
                    const bool sel = keep && rank < 8;
                    const float ssum = wave_sum(sel ? scv : 0.f);
                    if (sel) { ESEL[t * 8 + rank] = lane; GATE[t * 8 + rank] = scv / ssum * 2.5f; RANKL[t * 8 + rank] = mycnt; mycnt++; }
                }
                WCNT[(size_t)(w * 8 + F.wave) * 64 + lane] = mycnt;
                lcnt[F.wave * 64 + lane] = mycnt;
                __syncthreads();
                if (F.wave == 0) { int s = 0;
#pragma unroll
                    for (int v = 0; v < 8; ++v) s += lcnt[v * 64 + lane];
                    GTOT[w * 64 + lane] = s; }
                __syncthreads();
            }
            GRID_BAR();
        }
        if (IN(pb + 8)) {
            PHASE_REGS
            REPS(8) for (int w = vcu; w < 256; w += F.G) {
                int tot = 0, before = 0;
#pragma unroll 64
                for (int w2 = 0; w2 < 256; ++w2) { const int c = GTOT[w2 * 64 + lane]; tot += c; before += (w2 < w) ? c : 0; }
                for (int v2 = 0; v2 < F.wave; ++v2) before += WCNT[(size_t)(w * 8 + v2) * 64 + lane];
                const int pc = (tot + 255) & ~255; int incl = pc;
#pragma unroll
                for (int o = 1; o < 64; o <<= 1) { const int xv = __shfl_up(incl, o); if (lane >= o) incl += xv; }
                const int pstart = incl - pc, base = pstart + before; const int t0 = w * 128 + F.wave * 16;
#pragma unroll
                for (int it = 0; it < 2; ++it) { const int idx = it * 64 + lane, tt = t0 + (idx >> 3), k = idx & 7; const int e = ESEL[tt * 8 + k], r = RANKL[tt * 8 + k]; const float g = GATE[tt * 8 + k];
                    const int dest = __shfl(base, e) + r; TOKL[dest] = tt * 9 + k; GATL[dest] = g; }
                if (F.wave == 0 && w < 64) {
                    const int ps_ = __shfl(pstart, w), te = __shfl(tot, w), pe = __shfl(pc, w);
                    for (int i2 = te + lane; i2 < pe; i2 += 64) { TOKL[ps_ + i2] = YT_DUMP; GATL[ps_ + i2] = 0.f; } }
                if (F.wave == 1) {
                    const int nblk = __shfl(incl, 63) >> 8; const int rbk = 8 * w + (lane & 7); int cnt = 0;
                    for (int e = 0; e < 64; ++e) { const int pend = __shfl(incl, e); cnt += (pend <= rbk * 256) ? 1 : 0; }
                    if (lane < 8 && rbk < nblk) BLKE[rbk] = cnt < 63 ? cnt : 63;
                    if (w == 0 && lane == 0) BLKE[NBLK_MAX] = nblk; }
            }
            GRID_BAR();
        }
        if (IN(pb + 9)) {
            PHASE_REGS
            const int nblk = __builtin_amdgcn_readfirstlane(BLKE[NBLK_MAX]);
            { LAS int* bl = (LAS int*)(F.lds + LDS_BLKE); for (int i = tid; i < nblk; i += 512) bl[i] = BLKE[i]; __syncthreads(); }
            SchedMoeGU S{F.G, vcu, nblk, (const char*)(args.ws + W_XB8), (const char*)W_EGU_P(l), (const LAS int*)(F.lds + LDS_BLKE), TOKL};
            EpiMoeGU E{(unsigned char*)HB, WSC_P(l)};
            REPS(9) GEMM_PHASE_F8(512, S, E);
            { const int rounds = (2 * nblk + 255) >> 8, busy = 2 * nblk - 256 * (rounds - 1);
              const int n9 = min(PE_ALL - PE_A, (256 - busy) * 8 * P9_IPW);
              if (l + 1 < DEPTH && F.G == 256 && vcu >= busy) PREP_EXPERTS(l + 1, PE_A, PE_A + n9, (vcu - busy) * 8 + F.wave, (256 - busy) * 8); }
            GRID_BAR();
        }
        if (IN(pb + 10)) {
            PHASE_REGS
            const int nblk = __builtin_amdgcn_readfirstlane(BLKE[NBLK_MAX]);
            { LAS int* bl = (LAS int*)(F.lds + LDS_BLKE); for (int i = tid; i < nblk; i += 512) bl[i] = BLKE[i]; __syncthreads(); }
            { SchedShDown S{F.G, vcu, (const char*)HS, (const char*)(args.ws + W_SD_T)};
              EpiMoeDown<false> E{(unsigned char*)(args.ws + WS_R), (h16*)(args.ws + R_YS), WSC_P(l)};
              GEMM_PHASE(256, S, E); }
            __syncthreads();
            { SchedMoeDownR S{F.G, vcu, nblk, (const char*)HB, (const char*)W_ED_P(l), (const LAS int*)(F.lds + LDS_BLKE), TOKL};
              EpiMoeDown<true> E{(unsigned char*)(args.ws + WS_R), (h16*)(args.ws + R_YS), WSC_P(l)};
              REPS(10) GEMM_PHASE_F8(128, S, E); }
            GRID_BAR();
        }
        if (IN(pb + 11)) {
            PHASE_REGS
            { float* xo = (l == DEPTH - 1) ? X32 : nullptr;
            const unsigned char* YQ = (const unsigned char*)(args.ws + WS_R); const h16* YS = (const h16*)(args.ws + R_YS);
            const int c0 = 256 * (lane >> 4) + 32 * ((lane >> 2) & 3) + 8 * (lane & 3), c1 = c0 + 128;
            for (int m0 = F.gw; m0 < T; m0 += 3 * F.NGW) {
                u32x4 yq[3][9], xa[3], xb2[3]; unsigned short ys[3][9]; float gt[3];
#pragma unroll
                for (int q = 0; q < 3; ++q) { const int m = (m0 + q * F.NGW < T) ? m0 + q * F.NGW : m0;
                    xa[q] = *(const u32x4*)(XB + (size_t)m * D + c0); xb2[q] = *(const u32x4*)(XB + (size_t)m * D + c1); gt[q] = GATE[(size_t)m * 8 + (lane & 7)];
#pragma unroll
                    for (int k = 0; k < 9; ++k) { yq[q][k] = __builtin_nontemporal_load((const u32x4*)(YQ + ((size_t)m * 9 + k) * 1024 + lane * 16)); ys[q][k] = __builtin_nontemporal_load((const unsigned short*)(YS + ((size_t)m * 9 + k) * 64 + lane)); } }
#pragma unroll
                for (int q = 0; q < 3; ++q) { const int m = m0 + q * F.NGW; if (m < T) {
                    f32x4 v[4]; unpack8(xa[q], v[0], v[1]); unpack8(xb2[q], v[2], v[3]);
#pragma unroll
                    for (int j = 0; j < 4; ++j) v[j] = v[j] * ALPHA;
#pragma unroll
                    for (int k = 0; k < 9; ++k) { const float sc = h2f(ys[q][k]) * (k < 8 ? rdlane(gt[q], k & 7) : 1.f); const float bias = -128.0f * sc;
#pragma unroll
                        for (int j = 0; j < 4; ++j) { const unsigned wd = yq[q][k][j] ^ 0x80808080u;
                            v[j][0] += (float)(wd & 0xffu) * sc + bias; v[j][1] += (float)((wd >> 8) & 0xffu) * sc + bias; v[j][2] += (float)((wd >> 16) & 0xffu) * sc + bias; v[j][3] += (float)(wd >> 24) * sc + bias; } }
                    ln_store8(v, L_LN2G, L_LN2B, xo ? xo + (size_t)m * D : nullptr, XB + (size_t)m * D, lane, c0, c1, XB8 + (size_t)m * D); } } } }
            if (l + 1 < DEPTH) { const int nblk_ = __builtin_amdgcn_readfirstlane(BLKE[NBLK_MAX]); const int rounds_ = (2 * nblk_ + 255) >> 8, busy_ = 2 * nblk_ - 256 * (rounds_ - 1);
                const int e_lo = (F.G != 256) ? 0 : PE_A + min(PE_ALL - PE_A, (256 - busy_) * 8 * P9_IPW);
                ++l; PREP_WEIGHTS(e_lo); --l; }
            if (pb + 11 != DEPTH * NPH - 1) GRID_BAR();
        }
    }
#undef IN
}

extern "C" void kernel_launch(void* const* d_in, const int* in_sizes, int n_in, void* d_out, int out_size, void* d_ws, size_t ws_size, hipStream_t stream) {
    static int grid = 0;
    if (grid == 0) {
        if (n_in != 23 || out_size != T * D || ws_size < WS_END2) { fprintf(stderr, "kernel_launch: unexpected shapes (n_in %d out %d ws %zu)\n", n_in, out_size, ws_size); grid = -1; return; }
        int dev = 0, cus = 0;
        if (hipGetDevice(&dev) != hipSuccess || hipDeviceGetAttribute(&cus, hipDeviceAttributeMultiprocessorCount, dev) != hipSuccess) { grid = -1; return; }
        if (hipFuncSetAttribute((const void*)fwd_kernel, hipFuncAttributeMaxDynamicSharedMemorySize, LDS_BYTES) != hipSuccess) { fprintf(stderr, "kernel_launch: hipFuncSetAttribute failed\n"); grid = -1; return; }
        int per_cu = 0;
        if (hipOccupancyMaxActiveBlocksPerMultiprocessor(&per_cu, (const void*)fwd_kernel, 512, LDS_BYTES) != hipSuccess || per_cu < 1) { fprintf(stderr, "kernel_launch: occupancy query says %d\n", per_cu); }
        (void)hipGetLastError();
        grid = cus;
    }
    if (grid < 0) return;
    (void)hipMemsetAsync((char*)d_ws + WS_CTL, 0, CTL_ZERO_BYTES, stream);
    Args a{};
    for (int i = 0; i < 23; ++i) a.in[i] = (const float*)d_in[i];
    a.out = (float*)d_out; a.ws = (unsigned char*)d_ws;
#if MK_ONE_LAUNCH
    a.ph_lo = 0; a.ph_hi = DEPTH * NPH;
    hipLaunchKernelGGL(fwd_kernel, dim3(grid), dim3(512), LDS_BYTES, stream, a);
#else
    for (int p = 0; p < DEPTH * NPH; ++p) { a.ph_lo = p; a.ph_hi = p + 1; hipLaunchKernelGGL(fwd_kernel, dim3(grid), dim3(512), LDS_BYTES, stream, a); }
#endif
}
```

```cpp
#include <hip/hip_runtime.h>
#include <stdint.h>
#include <stdio.h>

#ifndef MK_ONE_LAUNCH
#define MK_ONE_LAUNCH 1
#endif

#define GAS __attribute__((address_space(1)))
#define LAS __attribute__((address_space(3)))
typedef unsigned short h16;
typedef short h16x8 __attribute__((ext_vector_type(8)));
typedef float f32x4 __attribute__((ext_vector_type(4)));
typedef float f32x2 __attribute__((ext_vector_type(2)));
typedef unsigned u32x4 __attribute__((ext_vector_type(4)));
typedef unsigned u32x2 __attribute__((ext_vector_type(2)));

constexpr int NB = 16, SEQ = 2048, T = NB * SEQ, D = 1024, DIN = 3328, DEPTH = 4;
constexpr int C_U = 0, C_Q = 512, C_K = 1024, C_V = 1152, C_GP = 1280, C_GA = 2304;
constexpr int NE = 64, FF = 256, TOPK = 8;
constexpr int NASSIGN = T * TOPK;
constexpr int NBLK_MAX = NASSIGN / 256 + NE;
constexpr int A_PAD = NBLK_MAX * 256;
constexpr float ALPHA = 1.6817928305074290f;
constexpr float LN_EPS = 1e-5f;
constexpr int NPH = 12;

constexpr size_t MiB = 1u << 20;
constexpr size_t WS_CTL = 0, CTL_ZERO_BYTES = 1 * MiB;
constexpr size_t WS_W = 1 * MiB;
constexpr size_t W_IN_T = WS_W + 0 * MiB;
constexpr size_t W_PE_T = WS_W + 7 * MiB;
constexpr size_t W_BA_T = WS_W + 8 * MiB;
constexpr size_t W_OUT_T = WS_W + 9 * MiB;
constexpr size_t W_R_T = WS_W + 11 * MiB;
constexpr size_t W_SGU_T = WS_W + 12 * MiB;
constexpr size_t W_SD_T = WS_W + 13 * MiB;
constexpr size_t W_EGU_T = WS_W + 14 * MiB;
constexpr size_t W_ED_T = WS_W + 78 * MiB;
constexpr size_t W_XB8 = W_EGU_T + 32 * MiB;
constexpr size_t WS_XB = 111 * MiB;
constexpr size_t WS_HB = 175 * MiB;
constexpr size_t WS_HS = 311 * MiB;
constexpr size_t WS_MISC = 327 * MiB;
constexpr size_t MS_LOGIT = WS_MISC;
constexpr size_t MS_ESEL = WS_MISC + 8 * MiB;
constexpr size_t MS_GATE = WS_MISC + 9 * MiB;
constexpr size_t MS_RANK = WS_MISC + 10 * MiB;
constexpr size_t MS_SLOT = WS_MISC + 11 * MiB;
constexpr size_t MS_TOKL = WS_MISC + 12 * MiB;
constexpr size_t MS_GATL = WS_MISC + 13 * MiB + 256 * 1024;
constexpr size_t MS_WCNT = WS_MISC + 14 * MiB + 512 * 1024;
constexpr size_t MS_GTOT = WS_MISC + 15 * MiB;
constexpr size_t MS_BLKE = WS_MISC + 15 * MiB + 256 * 1024;
constexpr size_t MS_WSC = WS_MISC + 15 * MiB + 512 * 1024;
constexpr size_t WS_R = 343 * MiB;
constexpr size_t R_HH = WS_R;
constexpr size_t R_PD = WS_R + 208 * MiB;
constexpr size_t R_MG = WS_R + 240 * MiB;
constexpr size_t WS_END = WS_R + 577 * MiB;
constexpr size_t W_EGU_ALT = WS_END;
constexpr size_t W_ED_ALT = WS_END + 64 * MiB;
constexpr size_t WS_END2 = WS_END + 96 * MiB;
constexpr size_t R_YS = WS_R + 296 * MiB;
constexpr int YT_DUMP = T * 9;
static_assert((size_t)A_PAD * 4 <= 1 * MiB + 256 * 1024, "toklist");
static_assert((size_t)A_PAD * 256 * 2 <= 136 * MiB, "Hbuf");
static_assert(((size_t)T * 9 + 1) * 1024 * 2 <= 577 * MiB, "Yt");

constexpr int CW_BAR = 4096;

constexpr int RING_BYTES = 131072;
constexpr int LDSCTL_OFF = RING_BYTES, MISC_OFF = LDSCTL_OFF + 320;
constexpr int LDS_BYTES = 147456;
constexpr int LDS_BLKE = LDSCTL_OFF + 1024;
constexpr int LDS_IDX = LDS_BLKE + 4352;
constexpr int LDS_OID = LDS_IDX + 2048;
static_assert(LDS_OID + 3072 <= LDS_BYTES, "LDS map");

#define RLX_AGENT __ATOMIC_RELAXED, __HIP_MEMORY_SCOPE_AGENT
__device__ __forceinline__ int lane_id() { int l; asm volatile("v_mbcnt_lo_u32_b32 %0, -1, 0\n\tv_mbcnt_hi_u32_b32 %0, -1, %0" : "=v"(l)); return l; }
typedef _Float16 f16x2 __attribute__((ext_vector_type(2)));
typedef _Float16 f16x8 __attribute__((ext_vector_type(8)));
__device__ __forceinline__ float h2f(unsigned short h) { return (float)__builtin_bit_cast(_Float16, h); }
__device__ __forceinline__ unsigned short f2h(float f) { return __builtin_bit_cast(unsigned short, (_Float16)f); }
__device__ __forceinline__ unsigned cvt_pk_h16(float lo, float hi) { f32x2 v = {lo, hi}; return __builtin_bit_cast(unsigned, __builtin_convertvector(v, f16x2)); }
__device__ __forceinline__ float lo16(unsigned w) { return (float)__builtin_bit_cast(f16x2, w)[0]; }
__device__ __forceinline__ float hi16(unsigned w) { return (float)__builtin_bit_cast(f16x2, w)[1]; }
__device__ __forceinline__ float sigmoidf_(float x) { return __builtin_amdgcn_rcpf(1.0f + __builtin_amdgcn_exp2f(-1.4426950408889634f * x)); }
template <int CTRL> __device__ __forceinline__ float dppf(float x) { return __builtin_bit_cast(float, __builtin_amdgcn_update_dpp(0, __builtin_bit_cast(int, x), CTRL, 0xf, 0xf, true)); }
__device__ __forceinline__ float rdlane(float x, int l) { return __builtin_bit_cast(float, __builtin_amdgcn_readlane(__builtin_bit_cast(int, x), l)); }
__device__ __forceinline__ float wave_sum(float v) {
    v += dppf<0xB1>(v); v += dppf<0x4E>(v); v += dppf<0x141>(v); v += dppf<0x140>(v);
    return (rdlane(v, 0) + rdlane(v, 16)) + (rdlane(v, 32) + rdlane(v, 48));
}
__device__ __forceinline__ float wave_max(float v) {
    v = fmaxf(v, dppf<0xB1>(v)); v = fmaxf(v, dppf<0x4E>(v)); v = fmaxf(v, dppf<0x141>(v)); v = fmaxf(v, dppf<0x140>(v));
    return fmaxf(fmaxf(rdlane(v, 0), rdlane(v, 16)), fmaxf(rdlane(v, 32), rdlane(v, 48)));
}
__device__ __forceinline__ float dppf_swap32(float x) { return __shfl_xor(x, 32); }
__device__ __forceinline__ float max8(float v) {
    v = fmaxf(v, dppf<0xB1>(v)); v = fmaxf(v, dppf<0x4E>(v)); return fmaxf(v, dppf<0x141>(v));
}

#define XB_TMO      128
#define XB_XCNT(j)  (256  + 64 * (j))
#define XB_XSUB(j)  (1280 + 64 * (j))
#define XB_XGEN(j)  (2304 + 64 * (j))
#define XB_TOP      3328
#define XB_TOPGEN   3392
#define XCD_BAR_WORDS 3456
#define XB_SPIN_CAP (1u << 18)
__device__ __forceinline__ unsigned xb_ld(unsigned* p)              { return __hip_atomic_load(p, __ATOMIC_RELAXED, __HIP_MEMORY_SCOPE_AGENT); }
__device__ __forceinline__ unsigned xb_add(unsigned* p, unsigned v) { return __hip_atomic_fetch_add(p, v, __ATOMIC_RELAXED, __HIP_MEMORY_SCOPE_AGENT); }
__device__ __forceinline__ unsigned xb_xcc_id() { return (unsigned)__builtin_amdgcn_s_getreg((3 << 11) | 20) & 0xFu; }
#define XB_SPIN(cond, bar) do { unsigned _sp = 0; while (cond) { __builtin_amdgcn_s_sleep(1); \
    if ((++_sp & 255u) == 0u) { if (xb_ld(&(bar)[XB_TMO])) break; if (_sp > XB_SPIN_CAP) { atomicAdd(&(bar)[XB_TMO], 1u); break; } } } } while (0)
struct XcdBarrier { unsigned* bar; unsigned x; volatile LAS unsigned* st; };
__device__ __forceinline__ XcdBarrier xcd_barrier_post(unsigned* bar, volatile LAS unsigned* st) {
    XcdBarrier b; b.bar = bar; b.x = xb_xcc_id(); b.st = st;
    if (threadIdx.x == 0) (void)xb_add(&bar[XB_XCNT(b.x)], 1u);
    return b;
}
__device__ __forceinline__ void xcd_barrier_complete(unsigned* bar, unsigned x, unsigned& nloc, unsigned& nx) {
    const unsigned G = gridDim.x * gridDim.y * gridDim.z;
    unsigned sum, cnt, mine, sp = 0u;
    for (;;) {
        sum = 0u; cnt = 0u; mine = 0u;
#pragma unroll
        for (unsigned j = 0; j < 16; ++j) { const unsigned c = xb_ld(&bar[XB_XCNT(j)]); sum += c; cnt += (c > 0u) ? 1u : 0u; mine = (j == x) ? c : mine; }
        if (sum == G) break;
        __builtin_amdgcn_s_sleep(1);
        if ((++sp & 255u) == 0u) { if (xb_ld(&bar[XB_TMO])) break; if (sp > XB_SPIN_CAP) { atomicAdd(&bar[XB_TMO], 1u); break; } }
    }
    nloc = mine > 0u ? mine : 1u; nx = cnt > 0u ? cnt : 1u;
}
__device__ __forceinline__ void xcd_barrier(const XcdBarrier& b, const int wave) {
    asm volatile("s_waitcnt vmcnt(0)" ::: "memory");
    __syncthreads();
    if (wave == 0 && lane_id() == 0) {
        unsigned* bar = b.bar;
        __builtin_amdgcn_s_waitcnt(0);
        unsigned nloc = b.st[0], nx = b.st[1];
        if (nloc == 0u) { xcd_barrier_complete(bar, b.x, nloc, nx); b.st[0] = nloc; b.st[1] = nx; }
        const unsigned old = xb_add(&bar[XB_XSUB(b.x)], 1u);
        const unsigned gen = old / nloc;
        if (old + 1u == (gen + 1u) * nloc) {
            __builtin_amdgcn_fence(__ATOMIC_RELEASE, "agent");
            asm volatile("s_waitcnt vmcnt(0)" ::: "memory");
            const unsigned og = xb_add(&bar[XB_TOP], 1u);
            const unsigned tg = og / nx;
            if (og + 1u == (tg + 1u) * nx) xb_add(&bar[XB_TOPGEN], 1u);
            else XB_SPIN(xb_ld(&bar[XB_TOPGEN]) == tg, bar);
            __builtin_amdgcn_fence(__ATOMIC_ACQUIRE, "agent");
            xb_add(&bar[XB_XGEN(b.x)], 1u);
            asm volatile("s_waitcnt vmcnt(0)" ::: "memory");
        } else {
            XB_SPIN(xb_ld(&bar[XB_XGEN(b.x)]) == gen, bar);
            __builtin_amdgcn_fence(__ATOMIC_ACQUIRE, "agent");
            asm volatile("s_waitcnt vmcnt(0)" ::: "memory");
        }
    }
    __syncthreads();
}

struct Unit {
    const char* a;
    const char* b;
    const int* ridx;
    unsigned apitch, bpitch;
    int row0;
    int col0;
    int kind;
    const int* oidx;
    const LAS int* oidl;
    int nt;
    int keep;
};
__device__ __forceinline__ int id2tok(int id) { const int t = (int)(((unsigned long long)(unsigned)id * 954437177ull) >> 33); return t < T ? t : T - 1; }
#define ACC_T f32x4 (&acc)[2][2][4][2]

template <class Epi, class Sched>
__device__ __forceinline__ void gemm_phase_simple(const int wid, const int K, const Sched& S, const Epi& E) {
    const int lane = lane_id(), tid = wid * 64 + lane; (void)tid;
    const int  wr = wid >> 2, wc = wid & 3, fr = lane & 15, fq = lane >> 4;
    Unit u;
    for (int i = 0; S.next(i, u); ++i) {
        f32x4 acc[2][2][4][2];
#pragma unroll
        for (int a = 0; a < 2; ++a)
#pragma unroll
            for (int b = 0; b < 2; ++b)
#pragma unroll
                for (int m = 0; m < 4; ++m)
#pragma unroll
                    for (int n = 0; n < 2; ++n) acc[a][b][m][n] = (f32x4){0.f, 0.f, 0.f, 0.f};
        unsigned offA[2][4], offB[2][2];
#pragma unroll
        for (int ai = 0; ai < 2; ++ai)
#pragma unroll
            for (int m = 0; m < 4; ++m) { const int r = 128 * ai + 64 * wr + 16 * m + fr; const int row = u.ridx ? id2tok(u.ridx[r]) : u.row0 + r; offA[ai][m] = (unsigned)row * u.apitch + (unsigned)fq * 16u; }
#pragma unroll
        for (int bj = 0; bj < 2; ++bj)
#pragma unroll
            for (int n = 0; n < 2; ++n) { const int wrow = 128 * bj + 32 * wc + 8 * (fr >> 2) + 4 * n + (fr & 3); offB[bj][n] = (unsigned)wrow * u.bpitch + (unsigned)fq * 16u; }
#pragma unroll 1
        for (int k0 = 0; k0 < K; k0 += 32) {
            h16x8 b[2][2];
#pragma unroll
            for (int bj = 0; bj < 2; ++bj)
#pragma unroll
                for (int n = 0; n < 2; ++n) b[bj][n] = *(const h16x8*)(u.b + offB[bj][n] + (size_t)k0 * 2);
#pragma unroll
            for (int ai = 0; ai < 2; ++ai) {
                h16x8 a[4];
#pragma unroll
                for (int m = 0; m < 4; ++m) a[m] = *(const h16x8*)(u.a + offA[ai][m] + (size_t)k0 * 2);
#pragma unroll
                for (int bj = 0; bj < 2; ++bj)
#pragma unroll
                    for (int m = 0; m < 4; ++m)
#pragma unroll
                        for (int n = 0; n < 2; ++n) acc[ai][bj][m][n] = __builtin_amdgcn_mfma_f32_16x16x32_f16(__builtin_bit_cast(f16x8, b[bj][n]), __builtin_bit_cast(f16x8, a[m]), acc[ai][bj][m][n], 0, 0, 0);
                asm volatile("" ::: "memory");
            }
        }
        u.oidl = nullptr;
        E(acc, u, wr, wc, fr, fq);
    }
}


#ifndef FAST_GEMM
#define FAST_GEMM 1
#endif
constexpr int HTB = 128 * 64 * 2;
__device__ __forceinline__ int lds_byte(int r, int c) { const int st = (r >> 4) * 2 + (c >> 5), rr = r & 15, cc = c & 31, ob = rr * 64 + cc * 2; return st * 1024 + (ob ^ (((ob >> 9) & 1) << 5)); }
__device__ __forceinline__ void stage_rc(int b, int& R, int& C) { const int st = b / 1024, sb = b % 1024, swz = sb ^ (((sb >> 9) & 1) << 5); R = (st >> 1) * 16 + swz / 64; C = (st & 1) * 32 + (swz % 64) / 2; }
__device__ __forceinline__ int perm32(int rho) { const int n = rho >> 4, i = rho & 15; return 8 * (i >> 2) + 4 * n + (i & 3); }

__device__ __forceinline__ const char* uptr(const char* p) { const unsigned long long v = (unsigned long long)p; const unsigned lo = __builtin_amdgcn_readfirstlane((unsigned)v), hi = __builtin_amdgcn_readfirstlane((unsigned)(v >> 32)); return (const char*)(((unsigned long long)hi << 32) | lo); }
typedef int i32x8 __attribute__((ext_vector_type(8)));
__device__ __forceinline__ i32x8 cat8(const u32x4 a, const u32x4 b) { return (i32x8){(int)a.x, (int)a.y, (int)a.z, (int)a.w, (int)b.x, (int)b.y, (int)b.z, (int)b.w}; }
template <int H> __device__ __forceinline__ f16x8 half8(const i32x8 v) { typedef int i32x4_ __attribute__((ext_vector_type(4))); const i32x4_ q = __builtin_shufflevector(v, v, 4 * H, 4 * H + 1, 4 * H + 2, 4 * H + 3); return __builtin_bit_cast(f16x8, q); }
template <bool F8, class Epi, class Sched>
__device__ __forceinline__ void gemm_phase(LAS unsigned char* lds, const int wid, const int K, const Sched& S, const Epi& E) {
    const int lane = lane_id(), tid = wid * 64 + lane;
    const int  wr = wid >> 2, wc = wid & 3, fr = lane & 15, fq = lane >> 4;
    int nt = K / 64; asm volatile("" : "+s"(nt));
    const unsigned ldsw = (unsigned)wid * 1024u;
    const int aoff = lds_byte(wr * 64 + fr, fq * 8), boff = lds_byte(wc * 32 + fr, fq * 8);
#define G_SA(b, h) (((b) * 2 + (h)) * HTB)
#define G_SB(b, h) ((4 + (b) * 2 + (h)) * HTB)
#define G_STAGE(bufoff, gbase, o0, o1) do { \
        __builtin_amdgcn_global_load_lds((const unsigned*)((const char*)(gbase) + (o0)), (LAS unsigned*)(lds + (bufoff) + ldsw), 16, 0, 0); \
        __builtin_amdgcn_global_load_lds((const unsigned*)((const char*)(gbase) + (o1)), (LAS unsigned*)(lds + (bufoff) + ldsw + 8192), 16, 0, 0); } while (0)
#define G_LDA(dst, b, h) do { _Pragma("unroll") for (int m = 0; m < 4; ++m) dst[m] = cat8(*(const LAS u32x4*)(lds + G_SA(b, h) + aoff + m * 2048), *(const LAS u32x4*)(lds + G_SA(b, h) + aoff + m * 2048 + 1024)); } while (0)
#define G_LDB(dst, b, h) do { _Pragma("unroll") for (int n = 0; n < 2; ++n) dst[n] = cat8(*(const LAS u32x4*)(lds + G_SB(b, h) + boff + n * 2048), *(const LAS u32x4*)(lds + G_SB(b, h) + boff + n * 2048 + 1024)); } while (0)
#define G_MMA(ai, bj, At, Bt) do { __builtin_amdgcn_s_setprio(1); _Pragma("unroll") for (int m = 0; m < 4; ++m) _Pragma("unroll") for (int n = 0; n < 2; ++n) { \
        if constexpr (F8) { acc[ai][bj][m][n] = __builtin_amdgcn_mfma_scale_f32_16x16x128_f8f6f4(Bt[n], At[m], acc[ai][bj][m][n], 0, 0, 0, 0, 0, 0); } \
        else { acc[ai][bj][m][n] = __builtin_amdgcn_mfma_f32_16x16x32_f16(half8<0>(Bt[n]), half8<0>(At[m]), acc[ai][bj][m][n], 0, 0, 0); \
               acc[ai][bj][m][n] = __builtin_amdgcn_mfma_f32_16x16x32_f16(half8<1>(Bt[n]), half8<1>(At[m]), acc[ai][bj][m][n], 0, 0, 0); } } \
        __builtin_amdgcn_s_setprio(0); } while (0)
#define G_WAIT_V(n) asm volatile("s_waitcnt vmcnt(" #n ")" ::: "memory")
#define G_WAIT_L(n) asm volatile("s_waitcnt lgkmcnt(" #n ")" ::: "memory")
#define G_BAR __builtin_amdgcn_s_barrier()
#define G_SCHED __builtin_amdgcn_sched_barrier(0)
#define G_OFFS(u, OA, OB, IDXB) do { int tl_ = wid * 64 + lane_id(); _Pragma("unroll") for (int i = 0; i < 2; ++i) { int R_, C_; stage_rc(tl_ * 16 + i * 8192, R_, C_); const int Rb_ = (R_ & ~31) + perm32(R_ & 31); \
        _Pragma("unroll") for (int h = 0; h < 2; ++h) { const int r_ = h * 128 + R_; const int row_ = (u).ridx ? id2tok(((const LAS int*)(lds + LDS_IDX + (IDXB) * 1024))[r_]) : (u).row0 + r_; \
        OA[h][i] = (unsigned)row_ * (u).apitch + (unsigned)C_ * 2u; OB[h][i] = (unsigned)(h * 128 + Rb_) * (u).bpitch + (unsigned)C_ * 2u; } } } while (0)
#define G_IDX_DMA(u, IDXB, OIDB) do { if ((u).ridx && wid < 4) __builtin_amdgcn_global_load_lds((const unsigned*)((u).ridx + wid * 64 + lane_id()), (LAS unsigned*)(lds + LDS_IDX + (IDXB) * 1024 + wid * 256), 4, 0, 0); \
        if ((u).oidx && wid < 4) __builtin_amdgcn_global_load_lds((const unsigned*)((u).oidx + wid * 64 + lane_id()), (LAS unsigned*)(lds + LDS_OID + (OIDB) * 1024 + wid * 256), 4, 0, 0); } while (0)
    Unit cur, nxt; int ui = 0;
    if (!S.next(0, cur)) return;
    if constexpr (Sched::DYN) nt = cur.nt;
    unsigned cOA[2][2], cOB[2][2];
    G_IDX_DMA(cur, 0, 0); asm volatile("s_waitcnt vmcnt(0)" ::: "memory"); __builtin_amdgcn_s_barrier(); asm volatile("" ::: "memory");
    G_OFFS(cur, cOA, cOB, 0);
    f32x4 acc[2][2][4][2];
#pragma unroll
    for (int a = 0; a < 2; ++a)
#pragma unroll
        for (int b = 0; b < 2; ++b)
#pragma unroll
            for (int m = 0; m < 4; ++m)
#pragma unroll
                for (int n = 0; n < 2; ++n) acc[a][b][m][n] = (f32x4){0.f, 0.f, 0.f, 0.f};
    i32x8 At[4], B0[2], B1[2];
    const char* cA = uptr(cur.a); const char* cB = uptr(cur.b);
    G_STAGE(G_SB(0, 0), cB, cOB[0][0], cOB[0][1]); G_STAGE(G_SB(0, 1), cB, cOB[1][0], cOB[1][1]); G_STAGE(G_SA(0, 0), cA, cOA[0][0], cOA[0][1]); G_STAGE(G_SA(0, 1), cA, cOA[1][0], cOA[1][1]);
    if (wr == 1) G_BAR;
    G_WAIT_V(2); G_BAR;
    { const char* cA1 = uptr(cA + 128); const char* cB1 = uptr(cB + 128);
      G_STAGE(G_SB(1, 0), cB1, cOB[0][0], cOB[0][1]); G_STAGE(G_SA(1, 0), cA1, cOA[0][0], cOA[0][1]); G_STAGE(G_SB(1, 1), cB1, cOB[1][0], cOB[1][1]); }
    G_WAIT_V(6); G_BAR;
    for (;;) {
        const bool has_next = S.next(ui + 1, nxt); const char* nA = cA; const char* nB = cB;
        if (has_next) G_IDX_DMA(nxt, (ui + 1) & 1, (ui + 1) % 3);
#pragma unroll 1
        for (int t = 0; t < nt; t += 2) {
            const bool last = (t == nt - 2);
            const char* a1 = uptr(cA + (size_t)(t + 1) * 128);
            G_LDB(B0, 0, 0); G_LDB(B1, 0, 1); G_SCHED; G_LDA(At, 0, 0); G_STAGE(G_SA(1, 1), a1, cOA[1][0], cOA[1][1]);
            G_WAIT_V(8); G_WAIT_L(0); G_BAR; G_MMA(0, 0, At, B0); G_MMA(0, 1, At, B1); G_BAR; G_SCHED;
            if (last && has_next) { nA = uptr(nxt.a); nB = uptr(nxt.b); G_OFFS(nxt, cOA, cOB, (ui + 1) & 1); }
            const char* a2 = uptr(last ? nA : cA + (size_t)(t + 2) * 128); const char* b2 = uptr(last ? nB : cB + (size_t)(t + 2) * 128);
            const char* a3 = uptr(a2 + 128); const char* b3 = uptr(b2 + 128);
            G_LDA(At, 0, 1); G_STAGE(G_SB(0, 0), b2, cOB[0][0], cOB[0][1]); G_STAGE(G_SB(0, 1), b2, cOB[1][0], cOB[1][1]); G_STAGE(G_SA(0, 0), a2, cOA[0][0], cOA[0][1]);
            G_WAIT_V(8); G_WAIT_L(0); G_BAR; G_MMA(1, 0, At, B0); G_MMA(1, 1, At, B1); G_BAR; G_SCHED;
            G_LDB(B0, 1, 0); G_LDB(B1, 1, 1); G_SCHED; G_LDA(At, 1, 0); G_STAGE(G_SA(0, 1), a2, cOA[1][0], cOA[1][1]);
            G_WAIT_V(8); G_WAIT_L(0); G_BAR; G_MMA(0, 0, At, B0); G_MMA(0, 1, At, B1); G_BAR; G_SCHED;
            G_LDA(At, 1, 1); G_STAGE(G_SB(1, 0), b3, cOB[0][0], cOB[0][1]); G_STAGE(G_SB(1, 1), b3, cOB[1][0], cOB[1][1]); G_STAGE(G_SA(1, 0), a3, cOA[0][0], cOA[0][1]);
            G_WAIT_V(8); G_WAIT_L(0); G_BAR; G_MMA(1, 0, At, B0); G_MMA(1, 1, At, B1); G_BAR; G_SCHED;
        }
        if (wr == 0) G_BAR;
        cur.oidl = (const LAS int*)(lds + LDS_OID + (ui % 3) * 1024);
        { const int le = lane_id(); E(acc, cur, wr, wc, le & 15, le >> 4); }
        if (!has_next) break;
        if (!nxt.keep) {
#pragma unroll
        for (int a = 0; a < 2; ++a)
#pragma unroll
            for (int b = 0; b < 2; ++b)
#pragma unroll
                for (int m = 0; m < 4; ++m)
#pragma unroll
                    for (int n = 0; n < 2; ++n) acc[a][b][m][n] = (f32x4){0.f, 0.f, 0.f, 0.f};
        }
        cur = nxt; cA = nA; cB = nB; ++ui;
        if constexpr (Sched::DYN) nt = cur.nt;
        if (wr == 1) G_BAR;
    }
    G_WAIT_V(0);
    G_BAR;
#undef G_SA
#undef G_SB
#undef G_STAGE
#undef G_LDA
#undef G_LDB
#undef G_MMA
#undef G_WAIT_V
#undef G_WAIT_L
#undef G_BAR
#undef G_SCHED
#undef G_OFFS
#undef G_IDX_DMA
}
#if FAST_GEMM
#define GEMM_PHASE(K, S, E) gemm_phase<false>(F.lds, F.wave, K, S, E)
#define GEMM_PHASE_F8(K, S, E) gemm_phase<true>(F.lds, F.wave, K, S, E)
#else
#define GEMM_PHASE(K, S, E) gemm_phase_simple(F.wave, K, S, E)
#endif

constexpr int NXCD = 8, WGM = 8;
struct TileOrder {
    int nM, nN, nwg, G, c;
    __device__ void init(int M, int N, int G_, int c_) { nM = M / 256; nN = N / 256; nwg = nM * nN; G = G_; c = c_; }
    __device__ bool tile(int i, int& pm, int& pn) const {
        const long L = (long)i * G + c; if (L >= nwg) return false;
        int wgid = (int)L; { const int q = nwg / NXCD, r = nwg % NXCD, xcd = wgid % NXCD, off = wgid / NXCD; wgid = (xcd < r ? xcd * (q + 1) : r * (q + 1) + (xcd - r) * q) + off; }
        const int nig = WGM * nN, gid = wgid / nig, fm = gid * WGM, gsz = (nM - fm) < WGM ? (nM - fm) : WGM;
        pm = fm + ((wgid % nig) % gsz); pn = (wgid % nig) / gsz; return true;
    }
};
struct SchedDense { static constexpr bool DYN = false;
    TileOrder o; const char* a; const char* b; unsigned apitch, bpitch;
    __device__ bool next(int i, Unit& u) const {
        int pm, pn; if (!o.tile(i, pm, pn)) return false;
        u.a = a; u.b = b + (size_t)pn * 256 * bpitch; u.ridx = nullptr; u.apitch = apitch; u.bpitch = bpitch; u.row0 = pm * 256; u.col0 = pn * 256; u.kind = 0; u.oidx = nullptr; u.keep = 0; return true;
    }
};
struct SchedMerged { static constexpr bool DYN = false;
    TileOrder o; const char* pd; const char* oo; const char* wpe; const char* wba;
    __device__ bool next(int i, Unit& u) const {
        int pm, pn; if (!o.tile(i >> 1, pm, pn)) return false;
        const int part = i & 1;
        u.a = part ? oo : pd; u.apitch = part ? DIN * 2 : 512 * 2; u.b = (part ? wba : wpe) + (size_t)pn * 256 * 1024; u.bpitch = 1024; u.ridx = nullptr; u.row0 = pm * 256; u.col0 = pn * 256; u.kind = part; u.oidx = nullptr; u.keep = part; return true;
    }
};
struct SchedSharedRouter { static constexpr bool DYN = true;
    int G, c; const char* xb; const char* wsgu; const char* wr;
    __device__ bool next(int i, Unit& u) const {
        const int L = i * G + c; if (L >= 512) return false;
        u.apitch = 2048; u.bpitch = 2048; u.ridx = nullptr; u.oidx = nullptr; u.keep = 0;
        if (L < 256) { const int pm = L >> 1, pn = L & 1; u.a = xb; u.b = wsgu + (size_t)pn * 256 * 2048; u.row0 = pm * 256; u.col0 = pn * 128; u.kind = 0; u.nt = 16; }
        else { const int pm = (L - 256) >> 1, kh = L & 1; u.a = xb + kh * 1024; u.b = wr + kh * 1024; u.row0 = pm * 256; u.col0 = kh; u.kind = 1; u.nt = 8; }
        return true;
    }
};
struct SchedMoeGU { static constexpr bool DYN = false;
    int G, c, nblk; const char* xb; const char* wegu; const LAS int* blke; const int* tokl;
    __device__ bool next(int i, Unit& u) const {
        const int L = i * G + c; if (L >= 2 * nblk) return false;
        const int rb = L >> 1, pn = L & 1, e = __builtin_amdgcn_readfirstlane(blke[rb]);
        u.a = xb; u.apitch = 1024; u.bpitch = 1024; u.b = wegu + ((size_t)e * 512 + pn * 256) * 1024; u.ridx = tokl + rb * 256; u.row0 = rb * 256; u.col0 = pn * 128; u.kind = e; u.oidx = nullptr; u.keep = 0; return true;
    }
};
struct SchedMoeDownR { static constexpr bool DYN = false;
    int G, c, nblk; const char* hb; const char* wed; const LAS int* blke; const int* tokl;
    __device__ bool next(int i, Unit& u) const {
        const int L = i * G + c; if (L >= 4 * nblk) return false;
        const int rb = L >> 2, pn = L & 3, e = __builtin_amdgcn_readfirstlane(blke[rb]);
        u.apitch = 256; u.bpitch = 256; u.ridx = nullptr; u.a = hb; u.b = wed + ((size_t)e * 1024 + pn * 256) * 256; u.row0 = rb * 256; u.col0 = pn * 256; u.kind = e; u.oidx = tokl + rb * 256; u.keep = 0; return true;
    }
};
struct SchedShDown { static constexpr bool DYN = false;
    int G, c; const char* hs; const char* wsd;
    __device__ bool next(int i, Unit& u) const {
        const int L = i * G + c; if (L >= 512) return false;
        const int pm = L >> 2, pn = L & 3; u.apitch = 512; u.bpitch = 512; u.ridx = nullptr; u.a = hs; u.b = wsd + (size_t)pn * 256 * 512; u.row0 = pm * 256; u.col0 = pn * 256; u.kind = 64; u.oidx = nullptr; u.keep = 0; return true;
    }
};

__device__ __forceinline__ u32x4 pack8(const f32x4& v0, const f32x4& v1) { u32x4 w; w.x = cvt_pk_h16(v0[0], v0[1]); w.y = cvt_pk_h16(v0[2], v0[3]); w.z = cvt_pk_h16(v1[0], v1[1]); w.w = cvt_pk_h16(v1[2], v1[3]); return w; }
__device__ __forceinline__ void unpack8(const u32x4& w, f32x4& v0, f32x4& v1) { v0 = (f32x4){lo16(w.x), hi16(w.x), lo16(w.y), hi16(w.y)}; v1 = (f32x4){lo16(w.z), hi16(w.z), lo16(w.w), hi16(w.w)}; }
__device__ __forceinline__ f32x4 sig4(const f32x4& v) { return (f32x4){sigmoidf_(v[0]), sigmoidf_(v[1]), sigmoidf_(v[2]), sigmoidf_(v[3])}; }
__device__ __forceinline__ f32x4 swiglu4(const f32x4& g, const f32x4& u) { return (f32x4){g[0] * sigmoidf_(g[0]) * u[0], g[1] * sigmoidf_(g[1]) * u[1], g[2] * sigmoidf_(g[2]) * u[2], g[3] * sigmoidf_(g[3]) * u[3]}; }

__device__ __forceinline__ unsigned q8x4(float a, float b, float c, float d, float inv) {
    const unsigned ua = __float_as_uint(a * inv + 12582912.0f), ub = __float_as_uint(b * inv + 12582912.0f), uc = __float_as_uint(c * inv + 12582912.0f), ud = __float_as_uint(d * inv + 12582912.0f);
    const unsigned lo = __builtin_amdgcn_perm(ub, ua, 0x0c0c0400u), hi = __builtin_amdgcn_perm(ud, uc, 0x0c0c0400u);
    return __builtin_amdgcn_perm(hi, lo, 0x05040100u);
}
__device__ __forceinline__ unsigned f8x4(const f32x4 v) {
    int w = __builtin_amdgcn_cvt_pk_fp8_f32(__builtin_amdgcn_fmed3f(v.x, -448.f, 448.f), __builtin_amdgcn_fmed3f(v.y, -448.f, 448.f), 0, false);
    w = __builtin_amdgcn_cvt_pk_fp8_f32(__builtin_amdgcn_fmed3f(v.z, -448.f, 448.f), __builtin_amdgcn_fmed3f(v.w, -448.f, 448.f), w, true); return (unsigned)w; }
struct EpiInProj {
    h16* H; const float* bias; float isc;
    __device__ __forceinline__ void operator()(const ACC_T, const Unit& u, int wr, int wc, int fr, int fq) const {
        const int pn = u.col0 >> 8; const float sc = (pn == 2 || pn == 3) ? 0.125f : 1.f; const bool sg = pn >= 5;
        f32x4 bv[2][2];
#pragma unroll
        for (int bj = 0; bj < 2; ++bj)
#pragma unroll
            for (int n = 0; n < 2; ++n) bv[bj][n] = *(const f32x4*)(bias + u.col0 + 128 * bj + 32 * wc + 8 * fq + 4 * n);
#pragma unroll
        for (int ai = 0; ai < 2; ++ai)
#pragma unroll
            for (int m = 0; m < 4; ++m) { const int row = u.row0 + 128 * ai + 64 * wr + 16 * m + fr; h16* rowp = H + (size_t)row * DIN + u.col0 + 32 * wc + 8 * fq;
#pragma unroll
                for (int bj = 0; bj < 2; ++bj) { f32x4 v0 = (acc[ai][bj][m][0] * isc + bv[bj][0]) * sc, v1 = (acc[ai][bj][m][1] * isc + bv[bj][1]) * sc;
                    if (sg) { v0 = sig4(v0); v1 = sig4(v1);
                        u32x2 w; w.x = q8x4(v0[0], v0[1], v0[2], v0[3], 255.0f); w.y = q8x4(v1[0], v1[1], v1[2], v1[3], 255.0f);
                        *(u32x2*)((unsigned char*)(H + (size_t)row * DIN + C_GP) + (u.col0 - C_GP) + 128 * bj + 32 * wc + 8 * fq) = w; }
                    else *(u32x4*)(rowp + 128 * bj) = pack8(v0, v1); } }
    }
};
__device__ __forceinline__ void ungate8(const u32x2& w, f32x4& v0, f32x4& v1) {
    const float k = 1.0f / 255.0f;
    v0 = (f32x4){(float)(w.x & 0xffu) * k, (float)((w.x >> 8) & 0xffu) * k, (float)((w.x >> 16) & 0xffu) * k, (float)(w.x >> 24) * k};
    v1 = (f32x4){(float)(w.y & 0xffu) * k, (float)((w.y >> 8) & 0xffu) * k, (float)((w.y >> 16) & 0xffu) * k, (float)(w.y >> 24) * k};
}
struct EpiMerged {
    h16* MG; const h16* H;
    __device__ __forceinline__ void operator()(f32x4 (&acc)[2][2][4][2], const Unit& u, int wr, int wc, int fr, int fq) const {
        const int col = u.col0 + 32 * wc + 8 * fq;
#pragma unroll
        for (int ai = 0; ai < 2; ++ai) {
            u32x2 ga[4][2], gp[4][2];
#pragma unroll
            for (int m = 0; m < 4; ++m) { const int row = u.row0 + 128 * ai + 64 * wr + 16 * m + fr;
#pragma unroll
                for (int bj = 0; bj < 2; ++bj) { const unsigned char* gb = (const unsigned char*)(H + (size_t)row * DIN + C_GP) + col + 128 * bj; ga[m][bj] = *(const u32x2*)(gb + 1024); if (u.kind == 0) gp[m][bj] = *(const u32x2*)gb; } }
#pragma unroll
            for (int m = 0; m < 4; ++m) { const int row = u.row0 + 128 * ai + 64 * wr + 16 * m + fr;
#pragma unroll
                for (int bj = 0; bj < 2; ++bj) { f32x4 a0, a1; ungate8(ga[m][bj], a0, a1);
                    if (u.kind == 0) { f32x4 p0, p1; ungate8(gp[m][bj], p0, p1);
#pragma unroll
                        for (int j = 0; j < 4; ++j) { acc[ai][bj][m][0][j] *= p0[j] * __builtin_amdgcn_rcpf(fmaxf(a0[j], 6.2e-5f)); acc[ai][bj][m][1][j] *= p1[j] * __builtin_amdgcn_rcpf(fmaxf(a1[j], 6.2e-5f)); } }
                    else *(u32x4*)(MG + (size_t)row * D + col + 128 * bj) = pack8(acc[ai][bj][m][0] * a0, acc[ai][bj][m][1] * a1); } }
        }
    }
};
struct EpiResid {
    h16* S; const h16* XBp;
    __device__ __forceinline__ void operator()(const ACC_T, const Unit& u, int wr, int wc, int fr, int fq) const {
#pragma unroll
        for (int ai = 0; ai < 2; ++ai) {
            u32x4 xw[4][2];
#pragma unroll
            for (int m = 0; m < 4; ++m) { const int row = u.row0 + 128 * ai + 64 * wr + 16 * m + fr; const size_t off = (size_t)row * D + u.col0 + 32 * wc + 8 * fq;
#pragma unroll
                for (int bj = 0; bj < 2; ++bj) xw[m][bj] = *(const u32x4*)(XBp + off + 128 * bj); }
#pragma unroll
            for (int m = 0; m < 4; ++m) { const int row = u.row0 + 128 * ai + 64 * wr + 16 * m + fr; const size_t off = (size_t)row * D + u.col0 + 32 * wc + 8 * fq;
#pragma unroll
                for (int bj = 0; bj < 2; ++bj) { f32x4 x0, x1; unpack8(xw[m][bj], x0, x1);
                    *(u32x4*)(S + off + 128 * bj) = pack8(x0 * ALPHA + acc[ai][bj][m][0], x1 * ALPHA + acc[ai][bj][m][1]); } }
        }
    }
};
struct EpiSharedRouter {
    h16* HS; float* LG;
    __device__ __forceinline__ void operator()(const ACC_T, const Unit& u, int wr, int wc, int fr, int fq) const {
#pragma unroll
        for (int ai = 0; ai < 2; ++ai)
#pragma unroll
            for (int m = 0; m < 4; ++m) { const int row = u.row0 + 128 * ai + 64 * wr + 16 * m + fr;
                if (u.kind == 0) { *(u32x4*)(HS + (size_t)row * FF + u.col0 + 32 * wc + 8 * fq) = pack8(swiglu4(acc[ai][0][m][0], acc[ai][1][m][0]), swiglu4(acc[ai][0][m][1], acc[ai][1][m][1])); }
                else if (wc < 2) {
#pragma unroll
                    for (int n = 0; n < 2; ++n) *(f32x4*)(LG + (size_t)u.col0 * T * NE + (size_t)row * NE + 32 * wc + 8 * fq + 4 * n) = acc[ai][0][m][n] + acc[ai][1][m][n]; } }
    }
};
struct EpiMoeGU {
    unsigned char* HB; const float* wsc;
    __device__ __forceinline__ void operator()(const ACC_T, const Unit& u, int wr, int wc, int fr, int fq) const {
        const float isg = wsc[4 * u.kind], isu = wsc[4 * u.kind + 1], hsc = 1.52587890625e-05f / (isg * isu);
#pragma unroll
        for (int ai = 0; ai < 2; ++ai)
#pragma unroll
            for (int m = 0; m < 4; ++m) { const int row = u.row0 + 128 * ai + 64 * wr + 16 * m + fr;
                u32x2 w; w.x = f8x4(swiglu4(acc[ai][0][m][0] * isg, acc[ai][1][m][0] * isu) * hsc); w.y = f8x4(swiglu4(acc[ai][0][m][1] * isg, acc[ai][1][m][1] * isu) * hsc);
                *(u32x2*)(HB + (size_t)row * FF + u.col0 + 32 * wc + 8 * fq) = w; }
    }
};
template <bool ROUTED> struct EpiMoeDown {
    unsigned char* YQ; h16* YS;
    __device__ __forceinline__ void operator()(const ACC_T, const Unit& u, int wr, int wc, int fr, int fq) const {
        const int grp = (u.col0 >> 8) * 16 + 4 * wc + fq;
#pragma unroll
        for (int ai = 0; ai < 2; ++ai)
#pragma unroll
            for (int m = 0; m < 4; ++m) {
                const int r = 128 * ai + 64 * wr + 16 * m + fr; int id; if constexpr (ROUTED) id = u.oidl[r]; else id = (u.row0 + r) * 9 + 8;
                const f32x4 v0 = acc[ai][0][m][0], v1 = acc[ai][0][m][1], v2 = acc[ai][1][m][0], v3 = acc[ai][1][m][1];
                if constexpr (ROUTED) { u32x4 w; w.x = f8x4(v0 * 0.015625f); w.y = f8x4(v1 * 0.015625f); w.z = f8x4(v2 * 0.015625f); w.w = f8x4(v3 * 0.015625f);
                    *(u32x4*)(YQ + (size_t)id * 1024 + grp * 16) = w; }
                else {
                float mx = fmaxf(fmaxf(fabsf(v0[0]), fabsf(v0[1])), fmaxf(fabsf(v0[2]), fabsf(v0[3])));
                mx = fmaxf(mx, fmaxf(fmaxf(fabsf(v1[0]), fabsf(v1[1])), fmaxf(fabsf(v1[2]), fabsf(v1[3]))));
                mx = fmaxf(mx, fmaxf(fmaxf(fabsf(v2[0]), fabsf(v2[1])), fmaxf(fabsf(v2[2]), fabsf(v2[3]))));
                mx = fmaxf(mx, fmaxf(fmaxf(fabsf(v3[0]), fabsf(v3[1])), fmaxf(fabsf(v3[2]), fabsf(v3[3]))));
                const unsigned short sh = f2h(mx * (1.0f / 127.0f) * 1.0005f);
                const float scr = h2f(sh); const float inv = scr > 0.f ? __builtin_amdgcn_rcpf(scr) : 0.f;
                u32x4 w; w.x = q8x4(v0[0], v0[1], v0[2], v0[3], inv); w.y = q8x4(v1[0], v1[1], v1[2], v1[3], inv); w.z = q8x4(v2[0], v2[1], v2[2], v2[3], inv); w.w = q8x4(v3[0], v3[1], v3[2], v3[3], inv);
                *(u32x4*)(YQ + (size_t)id * 1024 + grp * 16) = w;
                *(unsigned short*)(YS + (size_t)id * 64 + grp) = sh; } }
    }
};

struct Args { const float* in[23]; float* out; unsigned char* ws; int ph_lo, ph_hi; };
struct Frame {
    LAS unsigned char* lds; int wave, vcu, G, gw, NGW;
};

__device__ __forceinline__ void ln_store(f32x4 (&v)[4], const float* gam, const float* bet, float* o32, h16* o16, int lane) {
    float s = 0.f;
#pragma unroll
    for (int j = 0; j < 4; ++j) s += (v[j].x + v[j].y) + (v[j].z + v[j].w);
    const float mean = wave_sum(s) * (1.f / D); float s2 = 0.f;
#pragma unroll
    for (int j = 0; j < 4; ++j) { v[j] = v[j] - mean; s2 += (v[j].x * v[j].x + v[j].y * v[j].y) + (v[j].z * v[j].z + v[j].w * v[j].w); }
    const float rstd = 1.f / sqrtf(wave_sum(s2) * (1.f / D) + LN_EPS);
#pragma unroll
    for (int j = 0; j < 4; ++j) { const f32x4 g = *(const f32x4*)(gam + 4 * lane + 256 * j), b = *(const f32x4*)(bet + 4 * lane + 256 * j); const f32x4 y = v[j] * rstd * g + b;
        *(f32x4*)(o32 + 4 * lane + 256 * j) = y; u32x2 w; w.x = cvt_pk_h16(y[0], y[1]); w.y = cvt_pk_h16(y[2], y[3]); *(u32x2*)(o16 + 4 * lane + 256 * j) = w; }
}


__device__ __forceinline__ void ln_store8(f32x4 (&v)[4], const float* gam, const float* bet, float* o32, h16* o16, int lane, int c0 = -1, int c1 = -1, unsigned char* o8 = nullptr) {
    if (c0 < 0) { c0 = 8 * lane; c1 = 512 + 8 * lane; }
    float s = 0.f;
#pragma unroll
    for (int j = 0; j < 4; ++j) s += (v[j].x + v[j].y) + (v[j].z + v[j].w);
    const float mean = wave_sum(s) * (1.f / D); float s2 = 0.f;
#pragma unroll
    for (int j = 0; j < 4; ++j) { v[j] = v[j] - mean; s2 += (v[j].x * v[j].x + v[j].y * v[j].y) + (v[j].z * v[j].z + v[j].w * v[j].w); }
    const float rstd = 1.f / sqrtf(wave_sum(s2) * (1.f / D) + LN_EPS);
    f32x4 y[4];
#pragma unroll
    for (int j = 0; j < 4; ++j) { const int c = ((j >> 1) ? c1 : c0) + 4 * (j & 1); const f32x4 g = *(const f32x4*)(gam + c), b = *(const f32x4*)(bet + c); y[j] = v[j] * rstd * g + b; if (o32) *(f32x4*)(o32 + c) = y[j]; }
    *(u32x4*)(o16 + c0) = pack8(y[0], y[1]); *(u32x4*)(o16 + c1) = pack8(y[2], y[3]);
    if (o8) { u32x2 w; w.x = f8x4(y[0]); w.y = f8x4(y[1]); *(u32x2*)(o8 + c0) = w; w.x = f8x4(y[2]); w.y = f8x4(y[3]); *(u32x2*)(o8 + c1) = w; }
}
__device__ __forceinline__ void tr_item(const float* W, int N, h16* WT, int ldt, int k0, int n0, int drow0, LAS float* scr, int lane) {
    float tv[32];
#pragma unroll
    for (int i = 0; i < 32; ++i) { const int kk = 2 * i + (lane >> 5); tv[i] = __builtin_nontemporal_load(W + (size_t)(k0 + kk) * N + n0 + (lane & 31)); }
#pragma unroll
    for (int i = 0; i < 32; ++i) { const int kk = 2 * i + (lane >> 5); scr[kk * 33 + (lane & 31)] = tv[i]; }
    asm volatile("s_waitcnt lgkmcnt(0)" ::: "memory");
    const int c = lane & 7;
#pragma unroll
    for (int j = 0; j < 4; ++j) { const int n = (lane >> 3) + 8 * j; const LAS float* s = scr + (8 * c) * 33 + n;
        u32x4 o; o.x = cvt_pk_h16(s[0 * 33], s[1 * 33]); o.y = cvt_pk_h16(s[2 * 33], s[3 * 33]); o.z = cvt_pk_h16(s[4 * 33], s[5 * 33]); o.w = cvt_pk_h16(s[6 * 33], s[7 * 33]);
        *(u32x4*)(WT + (size_t)(drow0 + n) * ldt + k0 + 8 * c) = o; }
    asm volatile("s_waitcnt lgkmcnt(0)" ::: "memory");
}
__device__ __forceinline__ void tr_item_f8(const float* W, int N, unsigned char* WT, int ldt, int k0, int n0, int drow0, LAS float* scr, int lane, float scale) {
    float tv[32];
#pragma unroll
    for (int i = 0; i < 32; ++i) { const int kk = 2 * i + (lane >> 5); tv[i] = __builtin_nontemporal_load(W + (size_t)(k0 + kk) * N + n0 + (lane & 31)); }
#pragma unroll
    for (int i = 0; i < 32; ++i) { const int kk = 2 * i + (lane >> 5); scr[kk * 33 + (lane & 31)] = tv[i]; }
    asm volatile("s_waitcnt lgkmcnt(0)" ::: "memory");
    const int c = lane & 7;
#pragma unroll
    for (int j = 0; j < 4; ++j) { const int n = (lane >> 3) + 8 * j; const LAS float* s = scr + (8 * c) * 33 + n;
        u32x2 o; o.x = f8x4((f32x4){s[0 * 33], s[1 * 33], s[2 * 33], s[3 * 33]} * scale); o.y = f8x4((f32x4){s[4 * 33], s[5 * 33], s[6 * 33], s[7 * 33]} * scale);
        *(u32x2*)(WT + (size_t)(drow0 + n) * ldt + k0 + 8 * c) = o; }
    asm volatile("s_waitcnt lgkmcnt(0)" ::: "memory");
}
__device__ __forceinline__ float f8_scale_of(const float* W, int lane) {
    const f32x4 q = *(const f32x4*)(W + 4 * lane); const float ma = wave_sum((fabsf(q.x) + fabsf(q.y)) + (fabsf(q.z) + fabsf(q.w))) * (1.2533f / 256.f);
    float t = 32.f / fmaxf(ma, 1e-30f); t = fminf(fmaxf(t, 1.0e-18f), 1.0e18f);
    return __uint_as_float(__builtin_amdgcn_readfirstlane(__float_as_uint(t)) & 0x7f800000u);
}
__device__ __forceinline__ void tr_item_hilo(const float* W, int N, h16* WT, int ldt, int k0, int n0, LAS float* scr, int lane) {
    float tv[32];
#pragma unroll
    for (int i = 0; i < 32; ++i) { const int kk = 2 * i + (lane >> 5); tv[i] = __builtin_nontemporal_load(W + (size_t)(k0 + kk) * N + n0 + (lane & 31)); }
#pragma unroll
    for (int i = 0; i < 32; ++i) { const int kk = 2 * i + (lane >> 5); scr[kk * 33 + (lane & 31)] = tv[i]; }
    asm volatile("s_waitcnt lgkmcnt(0)" ::: "memory");
    const int c = lane & 7;
#pragma unroll
    for (int j = 0; j < 4; ++j) { const int n = (lane >> 3) + 8 * j; const LAS float* s = scr + (8 * c) * 33 + n;
        float v[8], r[8];
#pragma unroll
        for (int q = 0; q < 8; ++q) { v[q] = s[q * 33]; r[q] = v[q] - h2f(f2h(v[q])); }
        u32x4 o; o.x = cvt_pk_h16(v[0], v[1]); o.y = cvt_pk_h16(v[2], v[3]); o.z = cvt_pk_h16(v[4], v[5]); o.w = cvt_pk_h16(v[6], v[7]);
        *(u32x4*)(WT + (size_t)(n0 + n) * ldt + k0 + 8 * c) = o;
        o.x = cvt_pk_h16(r[0], r[1]); o.y = cvt_pk_h16(r[2], r[3]); o.z = cvt_pk_h16(r[4], r[5]); o.w = cvt_pk_h16(r[6], r[7]);
        *(u32x4*)(WT + (size_t)(128 + n0 + n) * ldt + k0 + 8 * c) = o; }
    asm volatile("s_waitcnt lgkmcnt(0)" ::: "memory");
}


typedef float f32x16 __attribute__((ext_vector_type(16)));
constexpr int AT_KP = 144, AT_VP = 528, AT_VOFF = 256 * AT_KP;
__device__ __forceinline__ int crow(int r, int hi) { return (r & 3) + 8 * (r >> 2) + 4 * hi; }
struct KVRegs { u32x4 k[4], v[4]; };
__device__ __forceinline__ void attn_load_kv(const h16* HHp, const int b, const int n, const int hk, const int tid, KVRegs& r) {
    const int tb = b * SEQ + n * 128;
#pragma unroll
    for (int i = 0; i < 4; ++i) { const int idx = tid + 512 * i, key = idx >> 3, ch = idx & 7; const int tok = (n > 0) ? tb - 128 + key : tb + (key & 127);
        const h16* kp = HHp + (size_t)tok * DIN + C_K + hk * 64 + ch * 8; r.k[i] = *(const u32x4*)kp; r.v[i] = *(const u32x4*)(kp + 128); }
}
__device__ __forceinline__ void attn_unit(LAS unsigned char* lds, h16* HHp, h16* OUTp, const int opitch, const float* sinks, const int b, const int n, const int hk, const int tid,
                                          const int unused_ = 0) {
    const int lane = tid & 63, wid = __builtin_amdgcn_readfirstlane(tid >> 6), q32 = lane & 31, hi = lane >> 5;
    const int g = wid >> 1, qh = wid & 1, hq = hk * 4 + g;
    const int tb = b * SEQ + n * 128;
    LAS unsigned char* Ks = lds; LAS unsigned char* Vs = lds + AT_VOFF;
    KVRegs cur; attn_load_kv(HHp, b, n, hk, tid, cur);
    f16x8 qs[4];
    { const h16* qp = HHp + (size_t)(tb + 64 * qh + q32) * DIN + C_Q + hq * 64;
#pragma unroll
      for (int ks = 0; ks < 4; ++ks) qs[ks] = *(const f16x8*)(qp + 16 * ks + 8 * hi); }
#pragma unroll
    for (int i = 0; i < 4; ++i) { const int idx = tid + 512 * i, key = idx >> 3, ch = idx & 7; const u32x4 kw = cur.k[i], vw = cur.v[i];
        *(LAS u32x4*)(Ks + key * AT_KP + ch * 16) = kw;
        LAS unsigned short* vd = (LAS unsigned short*)(Vs + (ch * 8) * AT_VP + key * 2);
        vd[0 * (AT_VP / 2)] = (unsigned short)(vw.x & 0xffffu); vd[1 * (AT_VP / 2)] = (unsigned short)(vw.x >> 16); vd[2 * (AT_VP / 2)] = (unsigned short)(vw.y & 0xffffu); vd[3 * (AT_VP / 2)] = (unsigned short)(vw.y >> 16);
        vd[4 * (AT_VP / 2)] = (unsigned short)(vw.z & 0xffffu); vd[5 * (AT_VP / 2)] = (unsigned short)(vw.z >> 16); vd[6 * (AT_VP / 2)] = (unsigned short)(vw.w & 0xffffu); vd[7 * (AT_VP / 2)] = (unsigned short)(vw.w >> 16); }
    __syncthreads();
    const float slope = exp2f(-(float)(hq + 1)), sink = sinks[hq];
    float ab[16];
#pragma unroll
    for (int r = 0; r < 16; ++r) ab[r] = slope * (float)(crow(r, hi) - 128 - q32);
#pragma unroll 1
    for (int sub = 0; sub < 2; ++sub) {
        const int q0 = 64 * qh + 32 * sub, qi = q0 + q32;
        f32x16 sv[5]; float mx = -INFINITY;
#pragma unroll
        for (int j = 0; j < 5; ++j) { const int key0 = q0 + 32 * j; f32x16 c; float sl = slope; asm volatile("" : "+v"(sl)); const float aj = sl * (float)(32 * j);
#pragma unroll
            for (int r = 0; r < 16; ++r) c[r] = ab[r] + aj;
#pragma unroll
            for (int ks = 0; ks < 4; ++ks) { const f16x8 kf = *(const LAS f16x8*)(Ks + (key0 + q32) * AT_KP + (16 * ks + 8 * hi) * 2); c = __builtin_amdgcn_mfma_f32_32x32x16_f16(kf, qs[ks], c, 0, 0, 0); }
            const bool dead = (n == 0) && (key0 < 128);
            int hil = hi; asm volatile("" : "+v"(hil));
#pragma unroll
            for (int r = 0; r < 16; ++r) { float v = c[r];
                if (j == 0) v = (crow(r, hil) > q32) ? v : -INFINITY;
                if (j == 4) v = (crow(r, hil) <= q32) ? v : -INFINITY;
                if (dead) v = -INFINITY;
                c[r] = v; mx = fmaxf(mx, v); }
            sv[j] = c; __builtin_amdgcn_sched_barrier(0); }
        if (sub == 0) { const h16* qp = HHp + (size_t)(tb + 64 * qh + 32 + q32) * DIN + C_Q + hq * 64;
#pragma unroll
            for (int ks = 0; ks < 4; ++ks) qs[ks] = *(const f16x8*)(qp + 16 * ks + 8 * hi); }
        mx = fmaxf(mx, dppf_swap32(mx)); mx = fmaxf(mx, sink);
        float lsum = 0.f; f32x16 o0, o1;
#pragma unroll
        for (int r = 0; r < 16; ++r) { o0[r] = 0.f; o1[r] = 0.f; }
#pragma unroll
        for (int j = 0; j < 5; ++j) { const int key0 = q0 + 32 * j;
#pragma unroll
            for (int r = 0; r < 16; ++r) { const float pv = __expf(sv[j][r] - mx); sv[j][r] = pv; lsum += pv; }
#pragma unroll
            for (int cc = 0; cc < 2; ++cc) {
                u32x4 pw; pw.x = cvt_pk_h16(sv[j][8 * cc + 0], sv[j][8 * cc + 1]); pw.y = cvt_pk_h16(sv[j][8 * cc + 2], sv[j][8 * cc + 3]); pw.z = cvt_pk_h16(sv[j][8 * cc + 4], sv[j][8 * cc + 5]); pw.w = cvt_pk_h16(sv[j][8 * cc + 6], sv[j][8 * cc + 7]);
                const f16x8 pb = __builtin_bit_cast(f16x8, pw);
                const LAS unsigned char* vp = Vs + q32 * AT_VP + (key0 + 16 * cc + 4 * hi) * 2;
                { const u32x2 a0 = *(const LAS u32x2*)vp, a1 = *(const LAS u32x2*)(vp + 16); const u32x4 vw = {a0.x, a0.y, a1.x, a1.y}; o0 = __builtin_amdgcn_mfma_f32_32x32x16_f16(__builtin_bit_cast(f16x8, vw), pb, o0, 0, 0, 0); }
                { const u32x2 a0 = *(const LAS u32x2*)(vp + 32 * AT_VP), a1 = *(const LAS u32x2*)(vp + 32 * AT_VP + 16); const u32x4 vw = {a0.x, a0.y, a1.x, a1.y}; o1 = __builtin_amdgcn_mfma_f32_32x32x16_f16(__builtin_bit_cast(f16x8, vw), pb, o1, 0, 0, 0); }
                __builtin_amdgcn_sched_barrier(0);
            } }
        lsum += dppf_swap32(lsum); lsum += __expf(sink - mx);
        const float rl = 1.0f / lsum;
#pragma unroll
        for (int rg = 0; rg < 4; ++rg) { u32x2 w0, w1;
            w0.x = cvt_pk_h16(o0[4 * rg] * rl, o0[4 * rg + 1] * rl); w0.y = cvt_pk_h16(o0[4 * rg + 2] * rl, o0[4 * rg + 3] * rl);
            w1.x = cvt_pk_h16(o1[4 * rg] * rl, o1[4 * rg + 1] * rl); w1.y = cvt_pk_h16(o1[4 * rg + 2] * rl, o1[4 * rg + 3] * rl);
            h16* op = OUTp + (size_t)(tb + qi) * opitch + hq * 64; *(u32x2*)(op + 8 * rg + 4 * hi) = w0; *(u32x2*)(op + 32 + 8 * rg + 4 * hi) = w1; }
    }
    __syncthreads();
}
template <int W> __device__ __forceinline__ void pool_pair(const h16* HHp, h16* PDp, const int c8, const int tA, const int tB) {
    u32x4 q[2][W];
#pragma unroll
    for (int p = 0; p < 2; ++p) { const int t = p ? tB : tA; const int s = t & (SEQ - 1); const h16* up = HHp + (size_t)t * DIN + C_U + c8 * 8;
#pragma unroll
        for (int i = 0; i < W; ++i) { const int ii = (i <= s) ? i : 0; q[p][i] = *(const u32x4*)(up - (size_t)ii * DIN); } }
#pragma unroll
    for (int p = 0; p < 2; ++p) { const int t = p ? tB : tA; const int s = t & (SEQ - 1); f32x4 a0 = {0.f, 0.f, 0.f, 0.f}, a1 = {0.f, 0.f, 0.f, 0.f}, u0, u1;
#pragma unroll
        for (int i = 0; i < W; ++i) { f32x4 v0, v1; unpack8(q[p][i], v0, v1); if (i == 0) { u0 = v0; u1 = v1; } if (i <= s) { a0 += v0; a1 += v1; } }
        const float rn = 1.0f / (float)((s + 1 < W) ? s + 1 : W);
        *(u32x4*)(PDp + (size_t)t * 512 + c8 * 8) = pack8(a0 * rn - u0, a1 * rn - u1); }
}


__device__ __forceinline__ void prep_expert_items(const float* w_eg, const float* w_eu, const float* w_ed, unsigned char* egu_t, unsigned char* ed_t, float* wsc, int e_lo, int e_hi, int wrk, int nwrk, LAS float* scr, int lane) {
    for (int it = e_lo + wrk; it < e_hi; it += nwrk) {
        if (it < 2 * 8192) { const int up = it >> 13, q = it & 8191, e = q >> 7, q2 = q & 127, kb = q2 >> 3, nb = q2 & 7, n0 = 32 * nb;
            const float* Wm = (up ? w_eu : w_eg) + (size_t)e * D * FF; const float sc = f8_scale_of(Wm, lane); if (q2 == 0 && lane == 0) wsc[4 * e + up] = 1.0f / sc;
            tr_item_f8(Wm, FF, egu_t + (size_t)e * 512 * 1024, 1024, 64 * kb, n0, 256 * (n0 >> 7) + (n0 & 127) + 128 * up, scr, lane, sc); }
        else { const int r = it - 2 * 8192, e = r >> 7, q2 = r & 127, kb = q2 >> 5, nb = q2 & 31; const float* Wm = w_ed + (size_t)e * FF * D; const float sc = f8_scale_of(Wm, lane); if (q2 == 0 && lane == 0) wsc[4 * e + 2] = 1.0f / sc;
            tr_item_f8(Wm, D, ed_t + (size_t)e * 1024 * 256, 256, 64 * kb, 32 * nb, 32 * nb, scr, lane, sc); }
    }
}
#define W_EGU_P(lt) ((unsigned char*)(args.ws + (((lt) & 1) ? W_EGU_ALT : W_EGU_T)))
#define WSC_P(lt) ((float*)(args.ws + MS_WSC) + ((lt) & 1) * 256)
#define W_ED_P(lt)  ((unsigned char*)(args.ws + (((lt) & 1) ? W_ED_ALT : W_ED_T)))
#define PREP_EXPERTS(lt, e_lo, e_hi, wrk, nwrk) prep_expert_items(args.in[15] + (size_t)(lt) * NE * D * FF, args.in[16] + (size_t)(lt) * NE * D * FF, args.in[17] + (size_t)(lt) * NE * FF * D, W_EGU_P(lt), W_ED_P(lt), WSC_P(lt), e_lo, e_hi, wrk, nwrk, (LAS float*)(F.lds + F.wave * 16384), lane_id())
#ifndef P9_IPW
#define P9_IPW 5
#endif
constexpr int PE_A = 9830, PE_B = PE_A + 8602, PE_ALL = 3 * 8192;
#define PREP_WEIGHTS(E_LO) do { \
            LAS float* scr = (LAS float*)(F.lds + F.wave * 16384); \
            const float* w_in = L_W_IN; const float* w_br_attn = L_W_BRA; const float* w_out = L_W_OUT; const float* w_sg = L_W_SG; const float* w_su = L_W_SU; const float* w_sd = L_W_SD; \
            const float* w_eg = L_W_EG; const float* w_eu = L_W_EU; const float* w_ed = L_W_ED; const float* w_router = L_W_R; \
            constexpr int I_IN = 16 * 104, I_BA = 8 * 32, I_OUT = 16 * 32, I_SG = 16 * 8, I_SD = 4 * 32, I_EG = 64 * 128, I_ED = 64 * 128, I_R = 16 * 2; \
            constexpr int NITEMS = I_IN + I_BA + I_OUT + 2 * I_SG + I_SD + I_R; \
            for (int it = F.gw; it < NITEMS; it += F.NGW) { \
                int r = it; \
                if (r < I_IN) { const int kb = r / 104, nb = r % 104; const float sc = f8_scale_of(w_in, lane); if (r == 0 && lane == 0) *WSC_IN = 1.0f / sc; tr_item_f8(w_in, DIN, (unsigned char*)(args.ws + W_IN_T), 1024, 64 * kb, 32 * nb, 32 * nb, scr, lane, sc); continue; } r -= I_IN; \
                if (r < I_BA) { const int kb = r / 32, nb = r % 32; tr_item(w_br_attn, D, (h16*)(args.ws + W_BA_T), 512, 64 * kb, 32 * nb, 32 * nb, scr, lane); continue; } r -= I_BA; \
                if (r < I_OUT) { const int kb = r / 32, nb = r % 32; tr_item(w_out, D, (h16*)(args.ws + W_OUT_T), 1024, 64 * kb, 32 * nb, 32 * nb, scr, lane); continue; } r -= I_OUT; \
                if (r < 2 * I_SG) { const int up = r / I_SG, q = r % I_SG, kb = q / 8, nb = q % 8, n0 = 32 * nb; tr_item(up ? w_su : w_sg, FF, (h16*)(args.ws + W_SGU_T), 1024, 64 * kb, n0, 256 * (n0 >> 7) + (n0 & 127) + 128 * up, scr, lane); continue; } r -= 2 * I_SG; \
                if (r < I_SD) { const int kb = r / 32, nb = r % 32; tr_item(w_sd, D, (h16*)(args.ws + W_SD_T), 256, 64 * kb, 32 * nb, 32 * nb, scr, lane); continue; } r -= I_SD; \
                { const int kb = r / 2, nb = r % 2; tr_item_hilo(w_router, NE, (h16*)(args.ws + W_R_T), 1024, 64 * kb, 32 * nb, scr, lane); } \
            } \
            PREP_EXPERTS(l, (E_LO), PE_ALL, F.gw, F.NGW); \
            { h16* wpe = (h16*)(args.ws + W_PE_T); const float* w_pool = L_W_POOL; const float* pool_scale = L_PSCALE; const float* w_br_pool = L_W_BRP; \
              for (int idx = F.gw; idx < 512 * 16; idx += F.NGW) { const int cg = idx >> 4, n = ((idx & 15) << 6) + lane, g = cg >> 7; float s = 0.f; \
                  const float* wp = w_pool + (size_t)cg * 128; const float* ps = pool_scale + 128 * g; const float* wb = w_br_pool + (size_t)(128 * g) * D + n; \
                  float wv[128]; \
            _Pragma("unroll") \
                  for (int d = 0; d < 128; ++d) wv[d] = wb[(size_t)d * D]; \
            _Pragma("unroll") \
                  for (int d = 0; d < 128; ++d) s += wp[d] * ps[d] * wv[d]; \
                  wpe[(size_t)n * 512 + cg] = (h16)f2h(s); } } \
} while (0)
#define X32   (args.out)
#define XB    ((h16*)(args.ws + WS_XB))
#define XB8   ((unsigned char*)(args.ws + W_XB8))
#define WSC_IN ((float*)(args.ws + MS_WSC) + 512)
#define HH    ((h16*)(args.ws + R_HH))
#define PD    ((h16*)(args.ws + R_PD))
#define MG    ((h16*)(args.ws + R_MG))
#define HB    ((h16*)(args.ws + WS_HB))
#define HS    ((h16*)(args.ws + WS_HS))
#define YD    ((h16*)(args.ws + WS_R))
#define LOGIT ((float*)(args.ws + WS_HB))
#define ESEL  ((int*)(args.ws + MS_ESEL))
#define GATE  ((float*)(args.ws + MS_GATE))
#define RANKL ((int*)(args.ws + MS_RANK))
#define SLOT  ((int*)(args.ws + MS_SLOT))
#define TOKL  ((int*)(args.ws + MS_TOKL))
#define GATL  ((float*)(args.ws + MS_GATL))
#define WCNT  ((int*)(args.ws + MS_WCNT))
#define GTOT  ((int*)(args.ws + MS_GTOT))
#define BLKE  ((int*)(args.ws + MS_BLKE))
#define L_W_IN   (args.in[3] + (size_t)l * D * DIN)
#define L_B_IN   (args.in[4] + (size_t)l * DIN)
#define L_W_POOL (args.in[5] + (size_t)l * 4 * 128 * 128)
#define L_PSCALE (args.in[6] + (size_t)l * 512)
#define L_SINKS  (args.in[7] + (size_t)l * 8)
#define L_W_BRP  (args.in[8] + (size_t)l * 512 * D)
#define L_W_BRA  (args.in[9] + (size_t)l * 512 * D)
#define L_W_OUT  (args.in[10] + (size_t)l * D * D)
#define L_LN1G   (args.in[11] + (size_t)l * D)
#define L_LN1B   (args.in[12] + (size_t)l * D)
#define L_W_R    (args.in[13] + (size_t)l * D * NE)
#define L_RBIAS  (args.in[14] + (size_t)l * NE)
#define L_W_EG   (args.in[15] + (size_t)l * NE * D * FF)
#define L_W_EU   (args.in[16] + (size_t)l * NE * D * FF)
#define L_W_ED   (args.in[17] + (size_t)l * NE * FF * D)
#define L_W_SG   (args.in[18] + (size_t)l * D * FF)
#define L_W_SU   (args.in[19] + (size_t)l * D * FF)
#define L_W_SD   (args.in[20] + (size_t)l * FF * D)
#define L_LN2G   (args.in[21] + (size_t)l * D)
#define L_LN2B   (args.in[22] + (size_t)l * D)
__global__ void __launch_bounds__(512, 2) fwd_kernel(Args args) {
    extern __shared__ __attribute__((aligned(16))) unsigned char lds_raw[];
    Frame F;
    F.lds = (LAS unsigned char*)lds_raw;
    F.wave = __builtin_amdgcn_readfirstlane((int)threadIdx.x >> 6);
    F.G = gridDim.x; { const int bx = blockIdx.x; F.vcu = (F.G % 8 == 0) ? (bx % 8) * (F.G / 8) + bx / 8 : bx; }
    F.gw = F.vcu * 8 + F.wave; F.NGW = F.G * 8;
    unsigned* ctl = (unsigned*)(args.ws + WS_CTL);
    volatile LAS unsigned* MISC = (volatile LAS unsigned*)(F.lds + MISC_OFF);
    for (int u = threadIdx.x; u < (LDS_BYTES - LDSCTL_OFF) / 4; u += 512) ((LAS unsigned*)(F.lds + LDSCTL_OFF))[u] = 0u;
    __syncthreads();
#if MK_ONE_LAUNCH
    XcdBarrier bar = xcd_barrier_post(ctl + CW_BAR, MISC + 8);
#define GRID_BAR() xcd_barrier(bar, F.wave)
#else
#define GRID_BAR() do {} while (0)
#endif
    const int lo = args.ph_lo, hi = args.ph_hi;
#ifndef PHASE_MASK
#define PHASE_MASK 0xfff
#endif
#ifndef REPEAT_MASK
#define REPEAT_MASK 0
#endif
#define REPS(p) for (int rep_ = 0; rep_ < 1 + ((REPEAT_MASK >> (p)) & 1); ++rep_)
#define IN(p) (((PHASE_MASK >> ((p) - pb)) & 1) && lo <= (p) && (p) < hi)
#define PHASE_REGS const int lane = lane_id(); const int tid = F.wave * 64 + lane; int vcu = F.vcu, bx = (int)blockIdx.x; asm volatile("" : "+s"(vcu), "+s"(bx)); (void)lane; (void)tid; (void)vcu; (void)bx;

    for (int l = 0; l < DEPTH; ++l) {
        const int pb = l * NPH;
        if (IN(pb + 0) && l == 0) {
            PHASE_REGS
            PREP_WEIGHTS(0);
            for (int m = F.gw; m < T; m += F.NGW) { f32x4 v[4];
#pragma unroll
                for (int j = 0; j < 4; ++j) v[j] = *(const f32x4*)(args.in[0] + (size_t)m * D + 8 * lane + 4 * (j & 1) + 512 * (j >> 1));
                ln_store8(v, args.in[1], args.in[2], nullptr, XB + (size_t)m * D, lane, -1, -1, XB8 + (size_t)m * D); }
            GRID_BAR();
        }
        if (IN(pb + 1)) {
            PHASE_REGS
            SchedDense S; S.o.init(T, DIN, F.G, bx); S.a = (const char*)XB8; S.b = (const char*)(args.ws + W_IN_T); S.apitch = 1024; S.bpitch = 1024;
            EpiInProj E{HH, L_B_IN, *WSC_IN};
            REPS(1) GEMM_PHASE_F8(512, S, E);
            if (l + 1 < DEPTH && F.G == 256 && bx >= 128) PREP_EXPERTS(l + 1, 0, PE_A, (bx - 128) * 8 + F.wave, 128 * 8);
            GRID_BAR();
        }
        if (IN(pb + 2)) {
            PHASE_REGS
            { const int g = F.gw & 3, c8 = 16 * g + (lane & 15);
              for (int it = F.gw; it < T; it += 2 * F.NGW) { const int tA = (it >> 2) * 4 + (lane >> 4); const int it2 = (it + F.NGW < T) ? it + F.NGW : it; const int tB = (it2 >> 2) * 4 + (lane >> 4);
                  if (g == 0) pool_pair<2>(HH, PD, c8, tA, tB); else if (g == 1) pool_pair<4>(HH, PD, c8, tA, tB); else if (g == 2) pool_pair<8>(HH, PD, c8, tA, tB); else pool_pair<16>(HH, PD, c8, tA, tB); } }
            for (int U = vcu; U < NB * 16 * 2; U += F.G) attn_unit(F.lds, HH, HH + C_Q, DIN, L_SINKS, U >> 5, (U >> 1) & 15, U & 1, tid);
            GRID_BAR();
        }
        if (IN(pb + 3)) {
            PHASE_REGS
            SchedMerged S; S.o.init(T, D, F.G, bx); S.pd = (const char*)PD; S.oo = (const char*)(HH + C_Q); S.wpe = (const char*)(args.ws + W_PE_T); S.wba = (const char*)(args.ws + W_BA_T);
            EpiMerged E{MG, HH};
            REPS(3) GEMM_PHASE(512, S, E);
            GRID_BAR();
        }
        if (IN(pb + 4)) {
            PHASE_REGS
            SchedDense S; S.o.init(T, D, F.G, bx); S.a = (const char*)MG; S.b = (const char*)(args.ws + W_OUT_T); S.apitch = 2048; S.bpitch = 2048;
            EpiResid E{(h16*)X32, XB};
            REPS(4) GEMM_PHASE(1024, S, E);
            GRID_BAR();
        }
        if (IN(pb + 5)) {
            PHASE_REGS
            for (int m0 = F.gw; m0 < T; m0 += 4 * F.NGW) { u32x4 ra[4], rb4[4];
#pragma unroll
                for (int q = 0; q < 4; ++q) { const int m = (m0 + q * F.NGW < T) ? m0 + q * F.NGW : m0; const h16* sp = (const h16*)X32 + (size_t)m * D + 8 * lane;
                    ra[q] = __builtin_nontemporal_load((const u32x4*)sp); rb4[q] = __builtin_nontemporal_load((const u32x4*)(sp + 512)); }
#pragma unroll
                for (int q = 0; q < 4; ++q) { const int m = m0 + q * F.NGW; if (m < T) { f32x4 v[4]; unpack8(ra[q], v[0], v[1]); unpack8(rb4[q], v[2], v[3]); ln_store8(v, L_LN1G, L_LN1B, nullptr, XB + (size_t)m * D, lane, -1, -1, XB8 + (size_t)m * D); } } }
            GRID_BAR();
        }
        if (IN(pb + 6)) {
            PHASE_REGS
            SchedSharedRouter S{F.G, vcu, (const char*)XB, (const char*)(args.ws + W_SGU_T), (const char*)(args.ws + W_R_T)};
            EpiSharedRouter E{HS, LOGIT};
            REPS(6) GEMM_PHASE(1024, S, E);
            GRID_BAR();
        }
        if (IN(pb + 7)) {
            PHASE_REGS
            LAS int* lcnt = (LAS int*)(F.lds);
            const float rb = L_RBIAS[lane];
            const float dsc = WSC_P(l)[4 * lane] * WSC_P(l)[4 * lane + 1] * WSC_P(l)[4 * lane + 2] * 4194304.0f;
            REPS(7) for (int w = vcu; w < 256; w += F.G) {
                int mycnt = 0; const int t0 = w * 128 + F.wave * 16;
                float lgs[16];
#pragma unroll
                for (int tt = 0; tt < 16; ++tt) lgs[tt] = LOGIT[(size_t)(t0 + tt) * NE + lane] + LOGIT[(size_t)T * NE + (size_t)(t0 + tt) * NE + lane];
#pragma unroll
                for (int tt = 0; tt < 16; ++tt) { const int t = t0 + tt;
                    const float lg = lgs[tt]; const float scv = 1.0f / (1.0f + __expf(-lg)); const float bs = scv + rb;
                    const float m1 = max8(bs);
                    const unsigned long long eq = __ballot(bs == m1); const int g = lane >> 3; const unsigned gm = (unsigned)(eq >> (8 * g)) & 0xffu; const int first = __builtin_ctz(gm);
                    const float m2 = max8(((lane & 7) == first) ? -INFINITY : bs);
                    const float gs = m1 + m2; int grank = 0;
#pragma unroll
                    for (int j = 0; j < 8; ++j) { const float gj = rdlane(gs, 8 * j); grank += (gj > gs || (gj == gs && j < g)) ? 1 : 0; }
                    const bool keep = grank < 4; const float v = keep ? bs : -INFINITY; int rank = 0;
#pragma unroll
                    for (int j = 0; j < 64; ++j) { const float vj = rdlane(v, j); rank += (vj > v || (vj == v && j < lane)) ? 1 : 0; }
                    const bool sel = keep && rank < 8;
                    const float ssum = wave_sum(sel ? scv : 0.f);
                    if (sel) { ESEL[t * 8 + rank] = lane; GATE[t * 8 + rank] = scv / ssum * 2.5f * dsc; RANKL[t * 8 + rank] = mycnt; mycnt++; }
                }
                WCNT[(size_t)(w * 8 + F.wave) * 64 + lane] = mycnt;
                lcnt[F.wave * 64 + lane] = mycnt;
                __syncthreads();
                if (F.wave == 0) { int s = 0;
#pragma unroll
                    for (int v = 0; v < 8; ++v) s += lcnt[v * 64 + lane];
                    GTOT[w * 64 + lane] = s; }
                __syncthreads();
            }
            GRID_BAR();
        }
        if (IN(pb + 8)) {
            PHASE_REGS
            REPS(8) for (int w = vcu; w < 256; w += F.G) {
                int tot = 0, before = 0;
#pragma unroll 64
                for (int w2 = 0; w2 < 256; ++w2) { const int c = GTOT[w2 * 64 + lane]; tot += c; before += (w2 < w) ? c : 0; }
                for (int v2 = 0; v2 < F.wave; ++v2) before += WCNT[(size_t)(w * 8 + v2) * 64 + lane];
                const int pc = (tot + 255) & ~255; int incl = pc;
#pragma unroll
                for (int o = 1; o < 64; o <<= 1) { const int xv = __shfl_up(incl, o); if (lane >= o) incl += xv; }
                const int pstart = incl - pc, base = pstart + before; const int t0 = w * 128 + F.wave * 16;
#pragma unroll
                for (int it = 0; it < 2; ++it) { const int idx = it * 64 + lane, tt = t0 + (idx >> 3), k = idx & 7; const int e = ESEL[tt * 8 + k], r = RANKL[tt * 8 + k]; const float g = GATE[tt * 8 + k];
                    const int dest = __shfl(base, e) + r; TOKL[dest] = tt * 9 + k; GATL[dest] = g; }
                if (F.wave == 0 && w < 64) {
                    const int ps_ = __shfl(pstart, w), te = __shfl(tot, w), pe = __shfl(pc, w);
                    for (int i2 = te + lane; i2 < pe; i2 += 64) { TOKL[ps_ + i2] = YT_DUMP; GATL[ps_ + i2] = 0.f; } }
                if (F.wave == 1) {
                    const int nblk = __shfl(incl, 63) >> 8; const int rbk = 8 * w + (lane & 7); int cnt = 0;
                    for (int e = 0; e < 64; ++e) { const int pend = __shfl(incl, e); cnt += (pend <= rbk * 256) ? 1 : 0; }
                    if (lane < 8 && rbk < nblk) BLKE[rbk] = cnt < 63 ? cnt : 63;
                    if (w == 0 && lane == 0) BLKE[NBLK_MAX] = nblk; }
            }
            GRID_BAR();
        }
        if (IN(pb + 9)) {
            PHASE_REGS
            const int nblk = __builtin_amdgcn_readfirstlane(BLKE[NBLK_MAX]);
            { LAS int* bl = (LAS int*)(F.lds + LDS_BLKE); for (int i = tid; i < nblk; i += 512) bl[i] = BLKE[i]; __syncthreads(); }
            SchedMoeGU S{F.G, vcu, nblk, (const char*)(args.ws + W_XB8), (const char*)W_EGU_P(l), (const LAS int*)(F.lds + LDS_BLKE), TOKL};
            EpiMoeGU E{(unsigned char*)HB, WSC_P(l)};
            REPS(9) GEMM_PHASE_F8(512, S, E);
            { const int rounds = (2 * nblk + 255) >> 8, busy = 2 * nblk - 256 * (rounds - 1);
              const int n9 = min(PE_ALL - PE_A, (256 - busy) * 8 * P9_IPW);
              if (l + 1 < DEPTH && F.G == 256 && vcu >= busy) PREP_EXPERTS(l + 1, PE_A, PE_A + n9, (vcu - busy) * 8 + F.wave, (256 - busy) * 8); }
            GRID_BAR();
        }
        if (IN(pb + 10)) {
            PHASE_REGS
            const int nblk = __builtin_amdgcn_readfirstlane(BLKE[NBLK_MAX]);
            { LAS int* bl = (LAS int*)(F.lds + LDS_BLKE); for (int i = tid; i < nblk; i += 512) bl[i] = BLKE[i]; __syncthreads(); }
            { SchedShDown S{F.G, vcu, (const char*)HS, (const char*)(args.ws + W_SD_T)};
              EpiMoeDown<false> E{(unsigned char*)(args.ws + WS_R), (h16*)(args.ws + R_YS)};
              GEMM_PHASE(256, S, E); }
            __syncthreads();
            { SchedMoeDownR S{F.G, vcu, nblk, (const char*)HB, (const char*)W_ED_P(l), (const LAS int*)(F.lds + LDS_BLKE), TOKL};
              EpiMoeDown<true> E{(unsigned char*)(args.ws + WS_R), (h16*)(args.ws + R_YS)};
              REPS(10) GEMM_PHASE_F8(128, S, E); }
            GRID_BAR();
        }
        if (IN(pb + 11)) {
            PHASE_REGS
            { float* xo = (l == DEPTH - 1) ? X32 : nullptr;
            const unsigned char* YQ = (const unsigned char*)(args.ws + WS_R); const h16* YS = (const h16*)(args.ws + R_YS);
            const int c0 = 256 * (lane >> 4) + 32 * ((lane >> 2) & 3) + 8 * (lane & 3), c1 = c0 + 128;
            for (int m0_ = F.gw; m0_ < T; m0_ += 2 * F.NGW) { int m0 = m0_; asm volatile("" : "+s"(m0));
                u32x4 yq[2][9], xa[2], xb2[2]; unsigned short ys[2]; float gt[2];
#pragma unroll
                for (int q = 0; q < 2; ++q) { const int m = (m0 + q * F.NGW < T) ? m0 + q * F.NGW : m0;
                    xa[q] = *(const u32x4*)(XB + (size_t)m * D + c0); xb2[q] = *(const u32x4*)(XB + (size_t)m * D + c1); gt[q] = GATE[(size_t)m * 8 + (lane & 7)];
#pragma unroll
                    for (int k = 0; k < 9; ++k) yq[q][k] = __builtin_nontemporal_load((const u32x4*)(YQ + ((size_t)m * 9 + k) * 1024 + lane * 16));
                    ys[q] = __builtin_nontemporal_load((const unsigned short*)(YS + ((size_t)m * 9 + 8) * 64 + lane)); }
#pragma unroll
                for (int q = 0; q < 2; ++q) { const int m = m0 + q * F.NGW; if (m < T) {
                    f32x4 v[4]; unpack8(xa[q], v[0], v[1]); unpack8(xb2[q], v[2], v[3]);
#pragma unroll
                    for (int j = 0; j < 4; ++j) v[j] = v[j] * ALPHA;
#pragma unroll
                    for (int k = 0; k < 8; ++k) { const float gk = rdlane(gt[q], k);
#pragma unroll
                        for (int j = 0; j < 4; ++j) { const f32x2 lo = __builtin_amdgcn_cvt_pk_f32_fp8((int)yq[q][k][j], false), hi = __builtin_amdgcn_cvt_pk_f32_fp8((int)yq[q][k][j], true);
                            v[j][0] += lo.x * gk; v[j][1] += lo.y * gk; v[j][2] += hi.x * gk; v[j][3] += hi.y * gk; }
                        __builtin_amdgcn_sched_barrier(0); }
                    { const float sc = h2f(ys[q]); const float bias = -128.0f * sc;
#pragma unroll
                        for (int j = 0; j < 4; ++j) { const unsigned wd = yq[q][8][j] ^ 0x80808080u;
                            v[j][0] += (float)(wd & 0xffu) * sc + bias; v[j][1] += (float)((wd >> 8) & 0xffu) * sc + bias; v[j][2] += (float)((wd >> 16) & 0xffu) * sc + bias; v[j][3] += (float)(wd >> 24) * sc + bias; } }
                    ln_store8(v, L_LN2G, L_LN2B, xo ? xo + (size_t)m * D : nullptr, XB + (size_t)m * D, lane, c0, c1, XB8 + (size_t)m * D); } } } }
            if (l + 1 < DEPTH) { const int nblk_ = __builtin_amdgcn_readfirstlane(BLKE[NBLK_MAX]); const int rounds_ = (2 * nblk_ + 255) >> 8, busy_ = 2 * nblk_ - 256 * (rounds_ - 1);
                const int e_lo = (F.G != 256) ? 0 : PE_A + min(PE_ALL - PE_A, (256 - busy_) * 8 * P9_IPW);
                ++l; PREP_WEIGHTS(e_lo); --l; }
            if (pb + 11 != DEPTH * NPH - 1) GRID_BAR();
        }
    }
#undef IN
}

extern "C" void kernel_launch(void* const* d_in, const int* in_sizes, int n_in, void* d_out, int out_size, void* d_ws, size_t ws_size, hipStream_t stream) {
    static int grid = 0;
    if (grid == 0) {
        if (n_in != 23 || out_size != T * D || ws_size < WS_END2) { fprintf(stderr, "kernel_launch: unexpected shapes (n_in %d out %d ws %zu)\n", n_in, out_size, ws_size); grid = -1; return; }
        int dev = 0, cus = 0;
        if (hipGetDevice(&dev) != hipSuccess || hipDeviceGetAttribute(&cus, hipDeviceAttributeMultiprocessorCount, dev) != hipSuccess) { grid = -1; return; }
        if (hipFuncSetAttribute((const void*)fwd_kernel, hipFuncAttributeMaxDynamicSharedMemorySize, LDS_BYTES) != hipSuccess) { fprintf(stderr, "kernel_launch: hipFuncSetAttribute failed\n"); grid = -1; return; }
        int per_cu = 0;
        if (hipOccupancyMaxActiveBlocksPerMultiprocessor(&per_cu, (const void*)fwd_kernel, 512, LDS_BYTES) != hipSuccess || per_cu < 1) { fprintf(stderr, "kernel_launch: occupancy query says %d\n", per_cu); }
        (void)hipGetLastError();
        grid = cus;
    }
    if (grid < 0) return;
    (void)hipMemsetAsync((char*)d_ws + WS_CTL, 0, CTL_ZERO_BYTES, stream);
    Args a{};
    for (int i = 0; i < 23; ++i) a.in[i] = (const float*)d_in[i];
    a.out = (float*)d_out; a.ws = (unsigned char*)d_ws;
#if MK_ONE_LAUNCH
    a.ph_lo = 0; a.ph_hi = DEPTH * NPH;
    hipLaunchKernelGGL(fwd_kernel, dim3(grid), dim3(512), LDS_BYTES, stream, a);
#else
    for (int p = 0; p < DEPTH * NPH; ++p) { a.ph_lo = p; a.ph_hi = p + 1; hipLaunchKernelGGL(fwd_kernel, dim3(grid), dim3(512), LDS_BYTES, stream, a); }
#endif
}
```

```cpp
#include <hip/hip_runtime.h>
#include <stdint.h>
#include <stdio.h>

#ifndef MK_ONE_LAUNCH
#define MK_ONE_LAUNCH 1
#endif

#define GAS __attribute__((address_space(1)))
#define LAS __attribute__((address_space(3)))
typedef unsigned short h16;
typedef short h16x8 __attribute__((ext_vector_type(8)));
typedef float f32x4 __attribute__((ext_vector_type(4)));
typedef float f32x2 __attribute__((ext_vector_type(2)));
typedef unsigned u32x4 __attribute__((ext_vector_type(4)));
typedef unsigned u32x2 __attribute__((ext_vector_type(2)));

constexpr int NB = 16, SEQ = 2048, T = NB * SEQ, D = 1024, DIN = 3328, DEPTH = 4;
constexpr int C_U = 0, C_Q = 512, C_K = 1024, C_V = 1152, C_GP = 1280, C_GA = 2304;
constexpr int NE = 64, FF = 256, TOPK = 8;
constexpr int NASSIGN = T * TOPK;
constexpr int NBLK_MAX = NASSIGN / 256 + NE;
constexpr int A_PAD = NBLK_MAX * 256;
constexpr float ALPHA = 1.6817928305074290f;
constexpr float LN_EPS = 1e-5f;
constexpr int NPH = 12;

constexpr size_t MiB = 1u << 20;
constexpr size_t WS_CTL = 0, CTL_ZERO_BYTES = 1 * MiB;
constexpr size_t WS_W = 1 * MiB;
constexpr size_t W_IN_T = WS_W + 0 * MiB;
constexpr size_t W_PE_T = WS_W + 7 * MiB;
constexpr size_t W_BA_T = WS_W + 8 * MiB;
constexpr size_t W_OUT_T = WS_W + 9 * MiB;
constexpr size_t W_R_T = WS_W + 11 * MiB;
constexpr size_t W_SGU_T = WS_W + 12 * MiB;
constexpr size_t W_SD_T = WS_W + 13 * MiB;
constexpr size_t W_EGU_T = WS_W + 14 * MiB;
constexpr size_t W_ED_T = WS_W + 78 * MiB;
constexpr size_t W_XB8 = W_EGU_T + 32 * MiB;
constexpr size_t WS_XB = 111 * MiB;
constexpr size_t WS_HB = 175 * MiB;
constexpr size_t WS_HS = 311 * MiB;
constexpr size_t WS_MISC = 327 * MiB;
constexpr size_t MS_LOGIT = WS_MISC;
constexpr size_t MS_ESEL = WS_MISC + 8 * MiB;
constexpr size_t MS_GATE = WS_MISC + 9 * MiB;
constexpr size_t MS_RANK = WS_MISC + 10 * MiB;
constexpr size_t MS_SLOT = WS_MISC + 11 * MiB;
constexpr size_t MS_TOKL = WS_MISC + 12 * MiB;
constexpr size_t MS_GATL = WS_MISC + 13 * MiB + 256 * 1024;
constexpr size_t MS_WCNT = WS_MISC + 14 * MiB + 512 * 1024;
constexpr size_t MS_GTOT = WS_MISC + 15 * MiB;
constexpr size_t MS_BLKE = WS_MISC + 15 * MiB + 256 * 1024;
constexpr size_t MS_WSC = WS_MISC + 15 * MiB + 512 * 1024;
constexpr size_t WS_R = 343 * MiB;
constexpr size_t R_HH = WS_R;
constexpr size_t R_PD = WS_R + 208 * MiB;
constexpr size_t R_MG = WS_R + 240 * MiB;
constexpr size_t WS_END = WS_R + 577 * MiB;
constexpr size_t W_EGU_ALT = WS_END;
constexpr size_t W_ED_ALT = WS_END + 64 * MiB;
constexpr size_t WS_END2 = WS_END + 96 * MiB;
constexpr size_t R_YS = WS_R + 296 * MiB;
constexpr int YT_DUMP = T * 9;
static_assert((size_t)A_PAD * 4 <= 1 * MiB + 256 * 1024, "toklist");
static_assert((size_t)A_PAD * 256 * 2 <= 136 * MiB, "Hbuf");
static_assert(((size_t)T * 9 + 1) * 1024 * 2 <= 577 * MiB, "Yt");

constexpr int CW_BAR = 4096;

constexpr int RING_BYTES = 131072;
constexpr int LDSCTL_OFF = RING_BYTES, MISC_OFF = LDSCTL_OFF + 320;
constexpr int LDS_BYTES = 147456;
constexpr int LDS_BLKE = LDSCTL_OFF + 1024;
constexpr int LDS_IDX = LDS_BLKE + 4352;
constexpr int LDS_OID = LDS_IDX + 2048;
static_assert(LDS_OID + 3072 <= LDS_BYTES, "LDS map");

#define RLX_AGENT __ATOMIC_RELAXED, __HIP_MEMORY_SCOPE_AGENT
__device__ __forceinline__ int lane_id() { int l; asm volatile("v_mbcnt_lo_u32_b32 %0, -1, 0\n\tv_mbcnt_hi_u32_b32 %0, -1, %0" : "=v"(l)); return l; }
typedef _Float16 f16x2 __attribute__((ext_vector_type(2)));
typedef _Float16 f16x8 __attribute__((ext_vector_type(8)));
__device__ __forceinline__ float h2f(unsigned short h) { return (float)__builtin_bit_cast(_Float16, h); }
__device__ __forceinline__ unsigned short f2h(float f) { return __builtin_bit_cast(unsigned short, (_Float16)f); }
__device__ __forceinline__ unsigned cvt_pk_h16(float lo, float hi) { f32x2 v = {lo, hi}; return __builtin_bit_cast(unsigned, __builtin_convertvector(v, f16x2)); }
__device__ __forceinline__ float lo16(unsigned w) { return (float)__builtin_bit_cast(f16x2, w)[0]; }
__device__ __forceinline__ float hi16(unsigned w) { return (float)__builtin_bit_cast(f16x2, w)[1]; }
__device__ __forceinline__ float sigmoidf_(float x) { return __builtin_amdgcn_rcpf(1.0f + __builtin_amdgcn_exp2f(-1.4426950408889634f * x)); }
template <int CTRL> __device__ __forceinline__ float dppf(float x) { return __builtin_bit_cast(float, __builtin_amdgcn_update_dpp(0, __builtin_bit_cast(int, x), CTRL, 0xf, 0xf, true)); }
__device__ __forceinline__ float rdlane(float x, int l) { return __builtin_bit_cast(float, __builtin_amdgcn_readlane(__builtin_bit_cast(int, x), l)); }
__device__ __forceinline__ float wave_sum(float v) {
    v += dppf<0xB1>(v); v += dppf<0x4E>(v); v += dppf<0x141>(v); v += dppf<0x140>(v);
    return (rdlane(v, 0) + rdlane(v, 16)) + (rdlane(v, 32) + rdlane(v, 48));
}
__device__ __forceinline__ float wave_max(float v) {
    v = fmaxf(v, dppf<0xB1>(v)); v = fmaxf(v, dppf<0x4E>(v)); v = fmaxf(v, dppf<0x141>(v)); v = fmaxf(v, dppf<0x140>(v));
    return fmaxf(fmaxf(rdlane(v, 0), rdlane(v, 16)), fmaxf(rdlane(v, 32), rdlane(v, 48)));
}
__device__ __forceinline__ float dppf_swap32(float x) { return __shfl_xor(x, 32); }
__device__ __forceinline__ float max8(float v) {
    v = fmaxf(v, dppf<0xB1>(v)); v = fmaxf(v, dppf<0x4E>(v)); return fmaxf(v, dppf<0x141>(v));
}

#define XB_TMO      128
#define XB_XCNT(j)  (256  + 64 * (j))
#define XB_XSUB(j)  (1280 + 64 * (j))
#define XB_XGEN(j)  (2304 + 64 * (j))
#define XB_TOP      3328
#define XB_TOPGEN   3392
#define XCD_BAR_WORDS 3456
#define XB_SPIN_CAP (1u << 18)
__device__ __forceinline__ unsigned xb_ld(unsigned* p)              { return __hip_atomic_load(p, __ATOMIC_RELAXED, __HIP_MEMORY_SCOPE_AGENT); }
__device__ __forceinline__ unsigned xb_add(unsigned* p, unsigned v) { return __hip_atomic_fetch_add(p, v, __ATOMIC_RELAXED, __HIP_MEMORY_SCOPE_AGENT); }
__device__ __forceinline__ unsigned xb_xcc_id() { return (unsigned)__builtin_amdgcn_s_getreg((3 << 11) | 20) & 0xFu; }
#define XB_SPIN(cond, bar) do { unsigned _sp = 0; while (cond) { __builtin_amdgcn_s_sleep(1); \
    if ((++_sp & 255u) == 0u) { if (xb_ld(&(bar)[XB_TMO])) break; if (_sp > XB_SPIN_CAP) { atomicAdd(&(bar)[XB_TMO], 1u); break; } } } } while (0)
struct XcdBarrier { unsigned* bar; unsigned x; volatile LAS unsigned* st; };
__device__ __forceinline__ XcdBarrier xcd_barrier_post(unsigned* bar, volatile LAS unsigned* st) {
    XcdBarrier b; b.bar = bar; b.x = xb_xcc_id(); b.st = st;
    if (threadIdx.x == 0) (void)xb_add(&bar[XB_XCNT(b.x)], 1u);
    return b;
}
__device__ __forceinline__ void xcd_barrier_complete(unsigned* bar, unsigned x, unsigned& nloc, unsigned& nx) {
    const unsigned G = gridDim.x * gridDim.y * gridDim.z;
    unsigned sum, cnt, mine, sp = 0u;
    for (;;) {
        sum = 0u; cnt = 0u; mine = 0u;
#pragma unroll
        for (unsigned j = 0; j < 16; ++j) { const unsigned c = xb_ld(&bar[XB_XCNT(j)]); sum += c; cnt += (c > 0u) ? 1u : 0u; mine = (j == x) ? c : mine; }
        if (sum == G) break;
        __builtin_amdgcn_s_sleep(1);
        if ((++sp & 255u) == 0u) { if (xb_ld(&bar[XB_TMO])) break; if (sp > XB_SPIN_CAP) { atomicAdd(&bar[XB_TMO], 1u); break; } }
    }
    nloc = mine > 0u ? mine : 1u; nx = cnt > 0u ? cnt : 1u;
}
__device__ __forceinline__ void xcd_barrier(const XcdBarrier& b, const int wave) {
    asm volatile("s_waitcnt vmcnt(0)" ::: "memory");
    __syncthreads();
    if (wave == 0 && lane_id() == 0) {
        unsigned* bar = b.bar;
        __builtin_amdgcn_s_waitcnt(0);
        unsigned nloc = b.st[0], nx = b.st[1];
        if (nloc == 0u) { xcd_barrier_complete(bar, b.x, nloc, nx); b.st[0] = nloc; b.st[1] = nx; }
        const unsigned old = xb_add(&bar[XB_XSUB(b.x)], 1u);
        const unsigned gen = old / nloc;
        if (old + 1u == (gen + 1u) * nloc) {
            __builtin_amdgcn_fence(__ATOMIC_RELEASE, "agent");
            asm volatile("s_waitcnt vmcnt(0)" ::: "memory");
            const unsigned og = xb_add(&bar[XB_TOP], 1u);
            const unsigned tg = og / nx;
            if (og + 1u == (tg + 1u) * nx) xb_add(&bar[XB_TOPGEN], 1u);
            else XB_SPIN(xb_ld(&bar[XB_TOPGEN]) == tg, bar);
            __builtin_amdgcn_fence(__ATOMIC_ACQUIRE, "agent");
            xb_add(&bar[XB_XGEN(b.x)], 1u);
            asm volatile("s_waitcnt vmcnt(0)" ::: "memory");
        } else {
            XB_SPIN(xb_ld(&bar[XB_XGEN(b.x)]) == gen, bar);
            __builtin_amdgcn_fence(__ATOMIC_ACQUIRE, "agent");
            asm volatile("s_waitcnt vmcnt(0)" ::: "memory");
        }
    }
    __syncthreads();
}

struct Unit {
    const char* a;
    const char* b;
    const int* ridx;
    unsigned apitch, bpitch;
    int row0;
    int col0;
    int kind;
    const int* oidx;
    const LAS int* oidl;
    int nt;
    int keep;
};
__device__ __forceinline__ int id2tok(int id) { const int t = (int)(((unsigned long long)(unsigned)id * 954437177ull) >> 33); return t < T ? t : T - 1; }
#define ACC_T f32x4 (&acc)[2][2][4][2]

template <class Epi, class Sched>
__device__ __forceinline__ void gemm_phase_simple(const int wid, const int K, const Sched& S, const Epi& E) {
    const int lane = lane_id(), tid = wid * 64 + lane; (void)tid;
    const int  wr = wid >> 2, wc = wid & 3, fr = lane & 15, fq = lane >> 4;
    Unit u;
    for (int i = 0; S.next(i, u); ++i) {
        f32x4 acc[2][2][4][2];
#pragma unroll
        for (int a = 0; a < 2; ++a)
#pragma unroll
            for (int b = 0; b < 2; ++b)
#pragma unroll
                for (int m = 0; m < 4; ++m)
#pragma unroll
                    for (int n = 0; n < 2; ++n) acc[a][b][m][n] = (f32x4){0.f, 0.f, 0.f, 0.f};
        unsigned offA[2][4], offB[2][2];
#pragma unroll
        for (int ai = 0; ai < 2; ++ai)
#pragma unroll
            for (int m = 0; m < 4; ++m) { const int r = 128 * ai + 64 * wr + 16 * m + fr; const int row = u.ridx ? id2tok(u.ridx[r]) : u.row0 + r; offA[ai][m] = (unsigned)row * u.apitch + (unsigned)fq * 16u; }
#pragma unroll
        for (int bj = 0; bj < 2; ++bj)
#pragma unroll
            for (int n = 0; n < 2; ++n) { const int wrow = 128 * bj + 32 * wc + 8 * (fr >> 2) + 4 * n + (fr & 3); offB[bj][n] = (unsigned)wrow * u.bpitch + (unsigned)fq * 16u; }
#pragma unroll 1
        for (int k0 = 0; k0 < K; k0 += 32) {
            h16x8 b[2][2];
#pragma unroll
            for (int bj = 0; bj < 2; ++bj)
#pragma unroll
                for (int n = 0; n < 2; ++n) b[bj][n] = *(const h16x8*)(u.b + offB[bj][n] + (size_t)k0 * 2);
#pragma unroll
            for (int ai = 0; ai < 2; ++ai) {
                h16x8 a[4];
#pragma unroll
                for (int m = 0; m < 4; ++m) a[m] = *(const h16x8*)(u.a + offA[ai][m] + (size_t)k0 * 2);
#pragma unroll
                for (int bj = 0; bj < 2; ++bj)
#pragma unroll
                    for (int m = 0; m < 4; ++m)
#pragma unroll
                        for (int n = 0; n < 2; ++n) acc[ai][bj][m][n] = __builtin_amdgcn_mfma_f32_16x16x32_f16(__builtin_bit_cast(f16x8, b[bj][n]), __builtin_bit_cast(f16x8, a[m]), acc[ai][bj][m][n], 0, 0, 0);
                asm volatile("" ::: "memory");
            }
        }
        u.oidl = nullptr;
        E(acc, u, wr, wc, fr, fq);
    }
}


#ifndef FAST_GEMM
#define FAST_GEMM 1
#endif
constexpr int HTB = 128 * 64 * 2;
__device__ __forceinline__ int lds_byte(int r, int c) { const int st = (r >> 4) * 2 + (c >> 5), rr = r & 15, cc = c & 31, ob = rr * 64 + cc * 2; return st * 1024 + (ob ^ (((ob >> 9) & 1) << 5)); }
__device__ __forceinline__ void stage_rc(int b, int& R, int& C) { const int st = b / 1024, sb = b % 1024, swz = sb ^ (((sb >> 9) & 1) << 5); R = (st >> 1) * 16 + swz / 64; C = (st & 1) * 32 + (swz % 64) / 2; }
__device__ __forceinline__ int perm32(int rho) { const int n = rho >> 4, i = rho & 15; return 8 * (i >> 2) + 4 * n + (i & 3); }

__device__ __forceinline__ const char* uptr(const char* p) { const unsigned long long v = (unsigned long long)p; const unsigned lo = __builtin_amdgcn_readfirstlane((unsigned)v), hi = __builtin_amdgcn_readfirstlane((unsigned)(v >> 32)); return (const char*)(((unsigned long long)hi << 32) | lo); }
typedef int i32x8 __attribute__((ext_vector_type(8)));
__device__ __forceinline__ i32x8 cat8(const u32x4 a, const u32x4 b) { return (i32x8){(int)a.x, (int)a.y, (int)a.z, (int)a.w, (int)b.x, (int)b.y, (int)b.z, (int)b.w}; }
template <int H> __device__ __forceinline__ f16x8 half8(const i32x8 v) { typedef int i32x4_ __attribute__((ext_vector_type(4))); const i32x4_ q = __builtin_shufflevector(v, v, 4 * H, 4 * H + 1, 4 * H + 2, 4 * H + 3); return __builtin_bit_cast(f16x8, q); }
template <bool F8, class Epi, class Sched>
__device__ __forceinline__ void gemm_phase(LAS unsigned char* lds, const int wid, const int K, const Sched& S, const Epi& E) {
    const int lane = lane_id(), tid = wid * 64 + lane;
    const int  wr = wid >> 2, wc = wid & 3, fr = lane & 15, fq = lane >> 4;
    int nt = K / 64; asm volatile("" : "+s"(nt));
    const unsigned ldsw = (unsigned)wid * 1024u;
    const int aoff = lds_byte(wr * 64 + fr, fq * 8), boff = lds_byte(wc * 32 + fr, fq * 8);
#define G_SA(b, h) (((b) * 2 + (h)) * HTB)
#define G_SB(b, h) ((4 + (b) * 2 + (h)) * HTB)
#define G_STAGE(bufoff, gbase, o0, o1) do { \
        __builtin_amdgcn_global_load_lds((const unsigned*)((const char*)(gbase) + (o0)), (LAS unsigned*)(lds + (bufoff) + ldsw), 16, 0, 0); \
        __builtin_amdgcn_global_load_lds((const unsigned*)((const char*)(gbase) + (o1)), (LAS unsigned*)(lds + (bufoff) + ldsw + 8192), 16, 0, 0); } while (0)
#define G_LDA(dst, b, h) do { _Pragma("unroll") for (int m = 0; m < 4; ++m) dst[m] = cat8(*(const LAS u32x4*)(lds + G_SA(b, h) + aoff + m * 2048), *(const LAS u32x4*)(lds + G_SA(b, h) + aoff + m * 2048 + 1024)); } while (0)
#define G_LDB(dst, b, h) do { _Pragma("unroll") for (int n = 0; n < 2; ++n) dst[n] = cat8(*(const LAS u32x4*)(lds + G_SB(b, h) + boff + n * 2048), *(const LAS u32x4*)(lds + G_SB(b, h) + boff + n * 2048 + 1024)); } while (0)
#define G_MMA(ai, bj, At, Bt) do { __builtin_amdgcn_s_setprio(1); _Pragma("unroll") for (int m = 0; m < 4; ++m) _Pragma("unroll") for (int n = 0; n < 2; ++n) { \
        if constexpr (F8) { acc[ai][bj][m][n] = __builtin_amdgcn_mfma_scale_f32_16x16x128_f8f6f4(Bt[n], At[m], acc[ai][bj][m][n], 0, 0, 0, 0, 0, 0); } \
        else { acc[ai][bj][m][n] = __builtin_amdgcn_mfma_f32_16x16x32_f16(half8<0>(Bt[n]), half8<0>(At[m]), acc[ai][bj][m][n], 0, 0, 0); \
               acc[ai][bj][m][n] = __builtin_amdgcn_mfma_f32_16x16x32_f16(half8<1>(Bt[n]), half8<1>(At[m]), acc[ai][bj][m][n], 0, 0, 0); } } \
        __builtin_amdgcn_s_setprio(0); } while (0)
#define G_WAIT_V(n) asm volatile("s_waitcnt vmcnt(" #n ")" ::: "memory")
#define G_WAIT_L(n) asm volatile("s_waitcnt lgkmcnt(" #n ")" ::: "memory")
#define G_BAR __builtin_amdgcn_s_barrier()
#define G_SCHED __builtin_amdgcn_sched_barrier(0)
#define G_OFFS(u, OA, OB, IDXB) do { int tl_ = wid * 64 + lane_id(); _Pragma("unroll") for (int i = 0; i < 2; ++i) { int R_, C_; stage_rc(tl_ * 16 + i * 8192, R_, C_); const int Rb_ = (R_ & ~31) + perm32(R_ & 31); \
        _Pragma("unroll") for (int h = 0; h < 2; ++h) { const int r_ = h * 128 + R_; const int row_ = (u).ridx ? id2tok(((const LAS int*)(lds + LDS_IDX + (IDXB) * 1024))[r_]) : (u).row0 + r_; \
        OA[h][i] = (unsigned)row_ * (u).apitch + (unsigned)C_ * 2u; OB[h][i] = (unsigned)(h * 128 + Rb_) * (u).bpitch + (unsigned)C_ * 2u; } } } while (0)
#define G_IDX_DMA(u, IDXB, OIDB) do { if ((u).ridx && wid < 4) __builtin_amdgcn_global_load_lds((const unsigned*)((u).ridx + wid * 64 + lane_id()), (LAS unsigned*)(lds + LDS_IDX + (IDXB) * 1024 + wid * 256), 4, 0, 0); \
        if ((u).oidx && wid < 4) __builtin_amdgcn_global_load_lds((const unsigned*)((u).oidx + wid * 64 + lane_id()), (LAS unsigned*)(lds + LDS_OID + (OIDB) * 1024 + wid * 256), 4, 0, 0); } while (0)
    Unit cur, nxt; int ui = 0;
    if (!S.next(0, cur)) return;
    if constexpr (Sched::DYN) nt = cur.nt;
    unsigned cOA[2][2], cOB[2][2];
    G_IDX_DMA(cur, 0, 0); asm volatile("s_waitcnt vmcnt(0)" ::: "memory"); __builtin_amdgcn_s_barrier(); asm volatile("" ::: "memory");
    G_OFFS(cur, cOA, cOB, 0);
    f32x4 acc[2][2][4][2];
#pragma unroll
    for (int a = 0; a < 2; ++a)
#pragma unroll
        for (int b = 0; b < 2; ++b)
#pragma unroll
            for (int m = 0; m < 4; ++m)
#pragma unroll
                for (int n = 0; n < 2; ++n) acc[a][b][m][n] = (f32x4){0.f, 0.f, 0.f, 0.f};
    i32x8 At[4], B0[2], B1[2];
    const char* cA = uptr(cur.a); const char* cB = uptr(cur.b);
    G_STAGE(G_SB(0, 0), cB, cOB[0][0], cOB[0][1]); G_STAGE(G_SB(0, 1), cB, cOB[1][0], cOB[1][1]); G_STAGE(G_SA(0, 0), cA, cOA[0][0], cOA[0][1]); G_STAGE(G_SA(0, 1), cA, cOA[1][0], cOA[1][1]);
    if (wr == 1) G_BAR;
    G_WAIT_V(2); G_BAR;
    { const char* cA1 = uptr(cA + 128); const char* cB1 = uptr(cB + 128);
      G_STAGE(G_SB(1, 0), cB1, cOB[0][0], cOB[0][1]); G_STAGE(G_SA(1, 0), cA1, cOA[0][0], cOA[0][1]); G_STAGE(G_SB(1, 1), cB1, cOB[1][0], cOB[1][1]); }
    G_WAIT_V(6); G_BAR;
    for (;;) {
        const bool has_next = S.next(ui + 1, nxt); const char* nA = cA; const char* nB = cB;
        if (has_next) G_IDX_DMA(nxt, (ui + 1) & 1, (ui + 1) % 3);
#pragma unroll 1
        for (int t = 0; t < nt; t += 2) {
            const bool last = (t == nt - 2);
            const char* a1 = uptr(cA + (size_t)(t + 1) * 128);
            G_LDB(B0, 0, 0); G_LDB(B1, 0, 1); G_SCHED; G_LDA(At, 0, 0); G_STAGE(G_SA(1, 1), a1, cOA[1][0], cOA[1][1]);
            G_WAIT_V(8); G_WAIT_L(0); G_BAR; G_MMA(0, 0, At, B0); G_MMA(0, 1, At, B1); G_BAR; G_SCHED;
            if (last && has_next) { nA = uptr(nxt.a); nB = uptr(nxt.b); G_OFFS(nxt, cOA, cOB, (ui + 1) & 1); }
            const char* a2 = uptr(last ? nA : cA + (size_t)(t + 2) * 128); const char* b2 = uptr(last ? nB : cB + (size_t)(t + 2) * 128);
            const char* a3 = uptr(a2 + 128); const char* b3 = uptr(b2 + 128);
            G_LDA(At, 0, 1); G_STAGE(G_SB(0, 0), b2, cOB[0][0], cOB[0][1]); G_STAGE(G_SB(0, 1), b2, cOB[1][0], cOB[1][1]); G_STAGE(G_SA(0, 0), a2, cOA[0][0], cOA[0][1]);
            G_WAIT_V(8); G_WAIT_L(0); G_BAR; G_MMA(1, 0, At, B0); G_MMA(1, 1, At, B1); G_BAR; G_SCHED;
            G_LDB(B0, 1, 0); G_LDB(B1, 1, 1); G_SCHED; G_LDA(At, 1, 0); G_STAGE(G_SA(0, 1), a2, cOA[1][0], cOA[1][1]);
            G_WAIT_V(8); G_WAIT_L(0); G_BAR; G_MMA(0, 0, At, B0); G_MMA(0, 1, At, B1); G_BAR; G_SCHED;
            G_LDA(At, 1, 1); G_STAGE(G_SB(1, 0), b3, cOB[0][0], cOB[0][1]); G_STAGE(G_SB(1, 1), b3, cOB[1][0], cOB[1][1]); G_STAGE(G_SA(1, 0), a3, cOA[0][0], cOA[0][1]);
            G_WAIT_V(8); G_WAIT_L(0); G_BAR; G_MMA(1, 0, At, B0); G_MMA(1, 1, At, B1); G_BAR; G_SCHED;
        }
        if (wr == 0) G_BAR;
        cur.oidl = (const LAS int*)(lds + LDS_OID + (ui % 3) * 1024);
        { const int le = lane_id(); E(acc, cur, wr, wc, le & 15, le >> 4); }
        if (!has_next) break;
        if (!nxt.keep) {
#pragma unroll
        for (int a = 0; a < 2; ++a)
#pragma unroll
            for (int b = 0; b < 2; ++b)
#pragma unroll
                for (int m = 0; m < 4; ++m)
#pragma unroll
                    for (int n = 0; n < 2; ++n) acc[a][b][m][n] = (f32x4){0.f, 0.f, 0.f, 0.f};
        }
        cur = nxt; cA = nA; cB = nB; ++ui;
        if constexpr (Sched::DYN) nt = cur.nt;
        if (wr == 1) G_BAR;
    }
    G_WAIT_V(0);
    G_BAR;
#undef G_SA
#undef G_SB
#undef G_STAGE
#undef G_LDA
#undef G_LDB
#undef G_MMA
#undef G_WAIT_V
#undef G_WAIT_L
#undef G_BAR
#undef G_SCHED
#undef G_OFFS
#undef G_IDX_DMA
}
#if FAST_GEMM
#define GEMM_PHASE(K, S, E) gemm_phase<false>(F.lds, F.wave, K, S, E)
#define GEMM_PHASE_F8(K, S, E) gemm_phase<true>(F.lds, F.wave, K, S, E)
#else
#define GEMM_PHASE(K, S, E) gemm_phase_simple(F.wave, K, S, E)
#endif

constexpr int NXCD = 8, WGM = 8;
struct TileOrder {
    int nM, nN, nwg, G, c;
    __device__ void init(int M, int N, int G_, int c_) { nM = M / 256; nN = N / 256; nwg = nM * nN; G = G_; c = c_; }
    __device__ bool tile(int i, int& pm, int& pn) const {
        const long L = (long)i * G + c; if (L >= nwg) return false;
        int wgid = (int)L; { const int q = nwg / NXCD, r = nwg % NXCD, xcd = wgid % NXCD, off = wgid / NXCD; wgid = (xcd < r ? xcd * (q + 1) : r * (q + 1) + (xcd - r) * q) + off; }
        const int nig = WGM * nN, gid = wgid / nig, fm = gid * WGM, gsz = (nM - fm) < WGM ? (nM - fm) : WGM;
        pm = fm + ((wgid % nig) % gsz); pn = (wgid % nig) / gsz; return true;
    }
};
struct SchedDense { static constexpr bool DYN = false;
    TileOrder o; const char* a; const char* b; unsigned apitch, bpitch;
    __device__ bool next(int i, Unit& u) const {
        int pm, pn; if (!o.tile(i, pm, pn)) return false;
        u.a = a; u.b = b + (size_t)pn * 256 * bpitch; u.ridx = nullptr; u.apitch = apitch; u.bpitch = bpitch; u.row0 = pm * 256; u.col0 = pn * 256; u.kind = 0; u.oidx = nullptr; u.keep = 0; return true;
    }
};
struct SchedMerged { static constexpr bool DYN = false;
    TileOrder o; const char* pd; const char* oo; const char* wpe; const char* wba;
    __device__ bool next(int i, Unit& u) const {
        int pm, pn; if (!o.tile(i >> 1, pm, pn)) return false;
        const int part = i & 1;
        u.a = part ? oo : pd; u.apitch = part ? DIN * 2 : 512 * 2; u.b = (part ? wba : wpe) + (size_t)pn * 256 * 1024; u.bpitch = 1024; u.ridx = nullptr; u.row0 = pm * 256; u.col0 = pn * 256; u.kind = part; u.oidx = nullptr; u.keep = part; return true;
    }
};
struct SchedSharedRouter { static constexpr bool DYN = true;
    int G, c; const char* xb; const char* wsgu; const char* wr;
    __device__ bool next(int i, Unit& u) const {
        const int L = i * G + c; if (L >= 512) return false;
        u.apitch = 2048; u.bpitch = 2048; u.ridx = nullptr; u.oidx = nullptr; u.keep = 0;
        if (L < 256) { const int pm = L >> 1, pn = L & 1; u.a = xb; u.b = wsgu + (size_t)pn * 256 * 2048; u.row0 = pm * 256; u.col0 = pn * 128; u.kind = 0; u.nt = 16; }
        else { const int pm = (L - 256) >> 1, kh = L & 1; u.a = xb + kh * 1024; u.b = wr + kh * 1024; u.row0 = pm * 256; u.col0 = kh; u.kind = 1; u.nt = 8; }
        return true;
    }
};
struct SchedMoeGU { static constexpr bool DYN = false;
    int G, c, nblk; const char* xb; const char* wegu; const LAS int* blke; const int* tokl;
    __device__ bool next(int i, Unit& u) const {
        const int L = i * G + c; if (L >= 2 * nblk) return false;
        const int rb = L >> 1, pn = L & 1, e = __builtin_amdgcn_readfirstlane(blke[rb]);
        u.a = xb; u.apitch = 1024; u.bpitch = 1024; u.b = wegu + ((size_t)e * 512 + pn * 256) * 1024; u.ridx = tokl + rb * 256; u.row0 = rb * 256; u.col0 = pn * 128; u.kind = e; u.oidx = nullptr; u.keep = 0; return true;
    }
};
struct SchedMoeDownR { static constexpr bool DYN = false;
    int G, c, nblk; const char* hb; const char* wed; const LAS int* blke; const int* tokl;
    __device__ bool next(int i, Unit& u) const {
        const int L = i * G + c; if (L >= 4 * nblk) return false;
        const int rb = L >> 2, pn = L & 3, e = __builtin_amdgcn_readfirstlane(blke[rb]);
        u.apitch = 256; u.bpitch = 256; u.ridx = nullptr; u.a = hb; u.b = wed + ((size_t)e * 1024 + pn * 256) * 256; u.row0 = rb * 256; u.col0 = pn * 256; u.kind = e; u.oidx = tokl + rb * 256; u.keep = 0; return true;
    }
};
struct SchedShDown { static constexpr bool DYN = false;
    int G, c; const char* hs; const char* wsd;
    __device__ bool next(int i, Unit& u) const {
        const int L = i * G + c; if (L >= 512) return false;
        const int pm = L >> 2, pn = L & 3; u.apitch = 512; u.bpitch = 512; u.ridx = nullptr; u.a = hs; u.b = wsd + (size_t)pn * 256 * 512; u.row0 = pm * 256; u.col0 = pn * 256; u.kind = 64; u.oidx = nullptr; u.keep = 0; return true;
    }
};

__device__ __forceinline__ u32x4 pack8(const f32x4& v0, const f32x4& v1) { u32x4 w; w.x = cvt_pk_h16(v0[0], v0[1]); w.y = cvt_pk_h16(v0[2], v0[3]); w.z = cvt_pk_h16(v1[0], v1[1]); w.w = cvt_pk_h16(v1[2], v1[3]); return w; }
__device__ __forceinline__ void unpack8(const u32x4& w, f32x4& v0, f32x4& v1) { v0 = (f32x4){lo16(w.x), hi16(w.x), lo16(w.y), hi16(w.y)}; v1 = (f32x4){lo16(w.z), hi16(w.z), lo16(w.w), hi16(w.w)}; }
__device__ __forceinline__ f32x4 sig4(const f32x4& v) { return (f32x4){sigmoidf_(v[0]), sigmoidf_(v[1]), sigmoidf_(v[2]), sigmoidf_(v[3])}; }
__device__ __forceinline__ f32x4 swiglu4(const f32x4& g, const f32x4& u) { return (f32x4){g[0] * sigmoidf_(g[0]) * u[0], g[1] * sigmoidf_(g[1]) * u[1], g[2] * sigmoidf_(g[2]) * u[2], g[3] * sigmoidf_(g[3]) * u[3]}; }

__device__ __forceinline__ unsigned q8x4(float a, float b, float c, float d, float inv) {
    const unsigned ua = __float_as_uint(a * inv + 12582912.0f), ub = __float_as_uint(b * inv + 12582912.0f), uc = __float_as_uint(c * inv + 12582912.0f), ud = __float_as_uint(d * inv + 12582912.0f);
    const unsigned lo = __builtin_amdgcn_perm(ub, ua, 0x0c0c0400u), hi = __builtin_amdgcn_perm(ud, uc, 0x0c0c0400u);
    return __builtin_amdgcn_perm(hi, lo, 0x05040100u);
}
__device__ __forceinline__ unsigned f8x4(const f32x4 v) {
    int w = __builtin_amdgcn_cvt_pk_fp8_f32(__builtin_amdgcn_fmed3f(v.x, -448.f, 448.f), __builtin_amdgcn_fmed3f(v.y, -448.f, 448.f), 0, false);
    w = __builtin_amdgcn_cvt_pk_fp8_f32(__builtin_amdgcn_fmed3f(v.z, -448.f, 448.f), __builtin_amdgcn_fmed3f(v.w, -448.f, 448.f), w, true); return (unsigned)w; }
struct EpiInProj {
    h16* H; const float* bias; float isc;
    __device__ __forceinline__ void operator()(const ACC_T, const Unit& u, int wr, int wc, int fr, int fq) const {
        const int pn = u.col0 >> 8; const float sc = (pn == 2 || pn == 3) ? 0.125f : 1.f; const bool sg = pn >= 5;
        f32x4 bv[2][2];
#pragma unroll
        for (int bj = 0; bj < 2; ++bj)
#pragma unroll
            for (int n = 0; n < 2; ++n) bv[bj][n] = *(const f32x4*)(bias + u.col0 + 128 * bj + 32 * wc + 8 * fq + 4 * n);
#pragma unroll
        for (int ai = 0; ai < 2; ++ai)
#pragma unroll
            for (int m = 0; m < 4; ++m) { const int row = u.row0 + 128 * ai + 64 * wr + 16 * m + fr; h16* rowp = H + (size_t)row * DIN + u.col0 + 32 * wc + 8 * fq;
#pragma unroll
                for (int bj = 0; bj < 2; ++bj) { f32x4 v0 = (acc[ai][bj][m][0] * isc + bv[bj][0]) * sc, v1 = (acc[ai][bj][m][1] * isc + bv[bj][1]) * sc;
                    if (sg) { v0 = sig4(v0); v1 = sig4(v1);
                        u32x2 w; w.x = q8x4(v0[0], v0[1], v0[2], v0[3], 255.0f); w.y = q8x4(v1[0], v1[1], v1[2], v1[3], 255.0f);
                        *(u32x2*)((unsigned char*)(H + (size_t)row * DIN + C_GP) + (u.col0 - C_GP) + 128 * bj + 32 * wc + 8 * fq) = w; }
                    else *(u32x4*)(rowp + 128 * bj) = pack8(v0, v1); } }
    }
};
__device__ __forceinline__ void ungate8(const u32x2& w, f32x4& v0, f32x4& v1) {
    const float k = 1.0f / 255.0f;
    v0 = (f32x4){(float)(w.x & 0xffu) * k, (float)((w.x >> 8) & 0xffu) * k, (float)((w.x >> 16) & 0xffu) * k, (float)(w.x >> 24) * k};
    v1 = (f32x4){(float)(w.y & 0xffu) * k, (float)((w.y >> 8) & 0xffu) * k, (float)((w.y >> 16) & 0xffu) * k, (float)(w.y >> 24) * k};
}
struct EpiMerged {
    unsigned char* MG; const h16* H;
    __device__ __forceinline__ void operator()(f32x4 (&acc)[2][2][4][2], const Unit& u, int wr, int wc, int fr, int fq) const {
        const int col = u.col0 + 32 * wc + 8 * fq;
#pragma unroll
        for (int ai = 0; ai < 2; ++ai) {
            u32x2 ga[4][2], gp[4][2];
#pragma unroll
            for (int m = 0; m < 4; ++m) { const int row = u.row0 + 128 * ai + 64 * wr + 16 * m + fr;
#pragma unroll
                for (int bj = 0; bj < 2; ++bj) { const unsigned char* gb = (const unsigned char*)(H + (size_t)row * DIN + C_GP) + col + 128 * bj; ga[m][bj] = *(const u32x2*)(gb + 1024); if (u.kind == 0) gp[m][bj] = *(const u32x2*)gb; } }
#pragma unroll
            for (int m = 0; m < 4; ++m) { const int row = u.row0 + 128 * ai + 64 * wr + 16 * m + fr;
#pragma unroll
                for (int bj = 0; bj < 2; ++bj) { f32x4 a0, a1; ungate8(ga[m][bj], a0, a1);
                    if (u.kind == 0) { f32x4 p0, p1; ungate8(gp[m][bj], p0, p1);
#pragma unroll
                        for (int j = 0; j < 4; ++j) { acc[ai][bj][m][0][j] *= p0[j] * __builtin_amdgcn_rcpf(fmaxf(a0[j], 6.2e-5f)); acc[ai][bj][m][1][j] *= p1[j] * __builtin_amdgcn_rcpf(fmaxf(a1[j], 6.2e-5f)); } }
                    else { u32x2 w; w.x = f8x4(acc[ai][bj][m][0] * a0 * 16.0f); w.y = f8x4(acc[ai][bj][m][1] * a1 * 16.0f); *(u32x2*)(MG + (size_t)row * D + col + 128 * bj) = w; } } }
        }
    }
};
struct EpiResid {
    h16* S; const h16* XBp; float isc;
    __device__ __forceinline__ void operator()(const ACC_T, const Unit& u, int wr, int wc, int fr, int fq) const {
#pragma unroll
        for (int ai = 0; ai < 2; ++ai) {
            u32x4 xw[4][2];
#pragma unroll
            for (int m = 0; m < 4; ++m) { const int row = u.row0 + 128 * ai + 64 * wr + 16 * m + fr; const size_t off = (size_t)row * D + u.col0 + 32 * wc + 8 * fq;
#pragma unroll
                for (int bj = 0; bj < 2; ++bj) xw[m][bj] = *(const u32x4*)(XBp + off + 128 * bj); }
#pragma unroll
            for (int m = 0; m < 4; ++m) { const int row = u.row0 + 128 * ai + 64 * wr + 16 * m + fr; const size_t off = (size_t)row * D + u.col0 + 32 * wc + 8 * fq;
#pragma unroll
                for (int bj = 0; bj < 2; ++bj) { f32x4 x0, x1; unpack8(xw[m][bj], x0, x1);
                    *(u32x4*)(S + off + 128 * bj) = pack8(x0 * ALPHA + acc[ai][bj][m][0] * isc, x1 * ALPHA + acc[ai][bj][m][1] * isc); } }
        }
    }
};
struct EpiSharedRouter {
    h16* HS; float* LG;
    __device__ __forceinline__ void operator()(const ACC_T, const Unit& u, int wr, int wc, int fr, int fq) const {
#pragma unroll
        for (int ai = 0; ai < 2; ++ai)
#pragma unroll
            for (int m = 0; m < 4; ++m) { const int row = u.row0 + 128 * ai + 64 * wr + 16 * m + fr;
                if (u.kind == 0) { *(u32x4*)(HS + (size_t)row * FF + u.col0 + 32 * wc + 8 * fq) = pack8(swiglu4(acc[ai][0][m][0], acc[ai][1][m][0]), swiglu4(acc[ai][0][m][1], acc[ai][1][m][1])); }
                else if (wc < 2) {
#pragma unroll
                    for (int n = 0; n < 2; ++n) *(f32x4*)(LG + (size_t)u.col0 * T * NE + (size_t)row * NE + 32 * wc + 8 * fq + 4 * n) = acc[ai][0][m][n] + acc[ai][1][m][n]; } }
    }
};
struct EpiMoeGU {
    unsigned char* HB; const float* wsc;
    __device__ __forceinline__ void operator()(const ACC_T, const Unit& u, int wr, int wc, int fr, int fq) const {
        const float isg = wsc[4 * u.kind], isu = wsc[4 * u.kind + 1], hsc = 1.52587890625e-05f / (isg * isu);
#pragma unroll
        for (int ai = 0; ai < 2; ++ai)
#pragma unroll
            for (int m = 0; m < 4; ++m) { const int row = u.row0 + 128 * ai + 64 * wr + 16 * m + fr;
                u32x2 w; w.x = f8x4(swiglu4(acc[ai][0][m][0] * isg, acc[ai][1][m][0] * isu) * hsc); w.y = f8x4(swiglu4(acc[ai][0][m][1] * isg, acc[ai][1][m][1] * isu) * hsc);
                *(u32x2*)(HB + (size_t)row * FF + u.col0 + 32 * wc + 8 * fq) = w; }
    }
};
template <bool ROUTED> struct EpiMoeDown {
    unsigned char* YQ; h16* YS;
    __device__ __forceinline__ void operator()(const ACC_T, const Unit& u, int wr, int wc, int fr, int fq) const {
        const int grp = (u.col0 >> 8) * 16 + 4 * wc + fq;
#pragma unroll
        for (int ai = 0; ai < 2; ++ai)
#pragma unroll
            for (int m = 0; m < 4; ++m) {
                const int r = 128 * ai + 64 * wr + 16 * m + fr; int id; if constexpr (ROUTED) id = u.oidl[r]; else id = (u.row0 + r) * 9 + 8;
                const f32x4 v0 = acc[ai][0][m][0], v1 = acc[ai][0][m][1], v2 = acc[ai][1][m][0], v3 = acc[ai][1][m][1];
                if constexpr (ROUTED) { u32x4 w; w.x = f8x4(v0 * 0.015625f); w.y = f8x4(v1 * 0.015625f); w.z = f8x4(v2 * 0.015625f); w.w = f8x4(v3 * 0.015625f);
                    *(u32x4*)(YQ + (size_t)id * 1024 + grp * 16) = w; }
                else {
                float mx = fmaxf(fmaxf(fabsf(v0[0]), fabsf(v0[1])), fmaxf(fabsf(v0[2]), fabsf(v0[3])));
                mx = fmaxf(mx, fmaxf(fmaxf(fabsf(v1[0]), fabsf(v1[1])), fmaxf(fabsf(v1[2]), fabsf(v1[3]))));
                mx = fmaxf(mx, fmaxf(fmaxf(fabsf(v2[0]), fabsf(v2[1])), fmaxf(fabsf(v2[2]), fabsf(v2[3]))));
                mx = fmaxf(mx, fmaxf(fmaxf(fabsf(v3[0]), fabsf(v3[1])), fmaxf(fabsf(v3[2]), fabsf(v3[3]))));
                const unsigned short sh = f2h(mx * (1.0f / 127.0f) * 1.0005f);
                const float scr = h2f(sh); const float inv = scr > 0.f ? __builtin_amdgcn_rcpf(scr) : 0.f;
                u32x4 w; w.x = q8x4(v0[0], v0[1], v0[2], v0[3], inv); w.y = q8x4(v1[0], v1[1], v1[2], v1[3], inv); w.z = q8x4(v2[0], v2[1], v2[2], v2[3], inv); w.w = q8x4(v3[0], v3[1], v3[2], v3[3], inv);
                *(u32x4*)(YQ + (size_t)id * 1024 + grp * 16) = w;
                *(unsigned short*)(YS + (size_t)id * 64 + grp) = sh; } }
    }
};

struct Args { const float* in[23]; float* out; unsigned char* ws; int ph_lo, ph_hi; };
struct Frame {
    LAS unsigned char* lds; int wave, vcu, G, gw, NGW;
};

__device__ __forceinline__ void ln_store(f32x4 (&v)[4], const float* gam, const float* bet, float* o32, h16* o16, int lane) {
    float s = 0.f;
#pragma unroll
    for (int j = 0; j < 4; ++j) s += (v[j].x + v[j].y) + (v[j].z + v[j].w);
    const float mean = wave_sum(s) * (1.f / D); float s2 = 0.f;
#pragma unroll
    for (int j = 0; j < 4; ++j) { v[j] = v[j] - mean; s2 += (v[j].x * v[j].x + v[j].y * v[j].y) + (v[j].z * v[j].z + v[j].w * v[j].w); }
    const float rstd = 1.f / sqrtf(wave_sum(s2) * (1.f / D) + LN_EPS);
#pragma unroll
    for (int j = 0; j < 4; ++j) { const f32x4 g = *(const f32x4*)(gam + 4 * lane + 256 * j), b = *(const f32x4*)(bet + 4 * lane + 256 * j); const f32x4 y = v[j] * rstd * g + b;
        *(f32x4*)(o32 + 4 * lane + 256 * j) = y; u32x2 w; w.x = cvt_pk_h16(y[0], y[1]); w.y = cvt_pk_h16(y[2], y[3]); *(u32x2*)(o16 + 4 * lane + 256 * j) = w; }
}


__device__ __forceinline__ void ln_store8(f32x4 (&v)[4], const float* gam, const float* bet, float* o32, h16* o16, int lane, int c0 = -1, int c1 = -1, unsigned char* o8 = nullptr) {
    if (c0 < 0) { c0 = 8 * lane; c1 = 512 + 8 * lane; }
    float s = 0.f;
#pragma unroll
    for (int j = 0; j < 4; ++j) s += (v[j].x + v[j].y) + (v[j].z + v[j].w);
    const float mean = wave_sum(s) * (1.f / D); float s2 = 0.f;
#pragma unroll
    for (int j = 0; j < 4; ++j) { v[j] = v[j] - mean; s2 += (v[j].x * v[j].x + v[j].y * v[j].y) + (v[j].z * v[j].z + v[j].w * v[j].w); }
    const float rstd = 1.f / sqrtf(wave_sum(s2) * (1.f / D) + LN_EPS);
    f32x4 y[4];
#pragma unroll
    for (int j = 0; j < 4; ++j) { const int c = ((j >> 1) ? c1 : c0) + 4 * (j & 1); const f32x4 g = *(const f32x4*)(gam + c), b = *(const f32x4*)(bet + c); y[j] = v[j] * rstd * g + b; if (o32) *(f32x4*)(o32 + c) = y[j]; }
    *(u32x4*)(o16 + c0) = pack8(y[0], y[1]); *(u32x4*)(o16 + c1) = pack8(y[2], y[3]);
    if (o8) { u32x2 w; w.x = f8x4(y[0]); w.y = f8x4(y[1]); *(u32x2*)(o8 + c0) = w; w.x = f8x4(y[2]); w.y = f8x4(y[3]); *(u32x2*)(o8 + c1) = w; }
}
__device__ __forceinline__ void tr_item(const float* W, int N, h16* WT, int ldt, int k0, int n0, int drow0, LAS float* scr, int lane) {
    float tv[32];
#pragma unroll
    for (int i = 0; i < 32; ++i) { const int kk = 2 * i + (lane >> 5); tv[i] = __builtin_nontemporal_load(W + (size_t)(k0 + kk) * N + n0 + (lane & 31)); }
#pragma unroll
    for (int i = 0; i < 32; ++i) { const int kk = 2 * i + (lane >> 5); scr[kk * 33 + (lane & 31)] = tv[i]; }
    asm volatile("s_waitcnt lgkmcnt(0)" ::: "memory");
    const int c = lane & 7;
#pragma unroll
    for (int j = 0; j < 4; ++j) { const int n = (lane >> 3) + 8 * j; const LAS float* s = scr + (8 * c) * 33 + n;
        u32x4 o; o.x = cvt_pk_h16(s[0 * 33], s[1 * 33]); o.y = cvt_pk_h16(s[2 * 33], s[3 * 33]); o.z = cvt_pk_h16(s[4 * 33], s[5 * 33]); o.w = cvt_pk_h16(s[6 * 33], s[7 * 33]);
        *(u32x4*)(WT + (size_t)(drow0 + n) * ldt + k0 + 8 * c) = o; }
    asm volatile("s_waitcnt lgkmcnt(0)" ::: "memory");
}
__device__ __forceinline__ void tr_item_f8(const float* W, int N, unsigned char* WT, int ldt, int k0, int n0, int drow0, LAS float* scr, int lane, float scale) {
    float tv[32];
#pragma unroll
    for (int i = 0; i < 32; ++i) { const int kk = 2 * i + (lane >> 5); tv[i] = __builtin_nontemporal_load(W + (size_t)(k0 + kk) * N + n0 + (lane & 31)); }
#pragma unroll
    for (int i = 0; i < 32; ++i) { const int kk = 2 * i + (lane >> 5); scr[kk * 33 + (lane & 31)] = tv[i]; }
    asm volatile("s_waitcnt lgkmcnt(0)" ::: "memory");
    const int c = lane & 7;
#pragma unroll
    for (int j = 0; j < 4; ++j) { const int n = (lane >> 3) + 8 * j; const LAS float* s = scr + (8 * c) * 33 + n;
        u32x2 o; o.x = f8x4((f32x4){s[0 * 33], s[1 * 33], s[2 * 33], s[3 * 33]} * scale); o.y = f8x4((f32x4){s[4 * 33], s[5 * 33], s[6 * 33], s[7 * 33]} * scale);
        *(u32x2*)(WT + (size_t)(drow0 + n) * ldt + k0 + 8 * c) = o; }
    asm volatile("s_waitcnt lgkmcnt(0)" ::: "memory");
}
__device__ __forceinline__ float f8_scale_of(const float* W, int lane) {
    const f32x4 q = *(const f32x4*)(W + 4 * lane); const float ma = wave_sum((fabsf(q.x) + fabsf(q.y)) + (fabsf(q.z) + fabsf(q.w))) * (1.2533f / 256.f);
    float t = 32.f / fmaxf(ma, 1e-30f); t = fminf(fmaxf(t, 1.0e-18f), 1.0e18f);
    return __uint_as_float(__builtin_amdgcn_readfirstlane(__float_as_uint(t)) & 0x7f800000u);
}
__device__ __forceinline__ void tr_item_hilo(const float* W, int N, h16* WT, int ldt, int k0, int n0, LAS float* scr, int lane) {
    float tv[32];
#pragma unroll
    for (int i = 0; i < 32; ++i) { const int kk = 2 * i + (lane >> 5); tv[i] = __builtin_nontemporal_load(W + (size_t)(k0 + kk) * N + n0 + (lane & 31)); }
#pragma unroll
    for (int i = 0; i < 32; ++i) { const int kk = 2 * i + (lane >> 5); scr[kk * 33 + (lane & 31)] = tv[i]; }
    asm volatile("s_waitcnt lgkmcnt(0)" ::: "memory");
    const int c = lane & 7;
#pragma unroll
    for (int j = 0; j < 4; ++j) { const int n = (lane >> 3) + 8 * j; const LAS float* s = scr + (8 * c) * 33 + n;
        float v[8], r[8];
#pragma unroll
        for (int q = 0; q < 8; ++q) { v[q] = s[q * 33]; r[q] = v[q] - h2f(f2h(v[q])); }
        u32x4 o; o.x = cvt_pk_h16(v[0], v[1]); o.y = cvt_pk_h16(v[2], v[3]); o.z = cvt_pk_h16(v[4], v[5]); o.w = cvt_pk_h16(v[6], v[7]);
        *(u32x4*)(WT + (size_t)(n0 + n) * ldt + k0 + 8 * c) = o;
        o.x = cvt_pk_h16(r[0], r[1]); o.y = cvt_pk_h16(r[2], r[3]); o.z = cvt_pk_h16(r[4], r[5]); o.w = cvt_pk_h16(r[6], r[7]);
        *(u32x4*)(WT + (size_t)(128 + n0 + n) * ldt + k0 + 8 * c) = o; }
    asm volatile("s_waitcnt lgkmcnt(0)" ::: "memory");
}


typedef float f32x16 __attribute__((ext_vector_type(16)));
constexpr int AT_KP = 144, AT_VP = 528, AT_VOFF = 256 * AT_KP;
__device__ __forceinline__ int crow(int r, int hi) { return (r & 3) + 8 * (r >> 2) + 4 * hi; }
struct KVRegs { u32x4 k[4], v[4]; };
__device__ __forceinline__ void attn_load_kv(const h16* HHp, const int b, const int n, const int hk, const int tid, KVRegs& r) {
    const int tb = b * SEQ + n * 128;
#pragma unroll
    for (int i = 0; i < 4; ++i) { const int idx = tid + 512 * i, key = idx >> 3, ch = idx & 7; const int tok = (n > 0) ? tb - 128 + key : tb + (key & 127);
        const h16* kp = HHp + (size_t)tok * DIN + C_K + hk * 64 + ch * 8; r.k[i] = *(const u32x4*)kp; r.v[i] = *(const u32x4*)(kp + 128); }
}
__device__ __forceinline__ void attn_unit(LAS unsigned char* lds, h16* HHp, h16* OUTp, const int opitch, const float* sinks, const int b, const int n, const int hk, const int tid,
                                          const int unused_ = 0) {
    const int lane = tid & 63, wid = __builtin_amdgcn_readfirstlane(tid >> 6), q32 = lane & 31, hi = lane >> 5;
    const int g = wid >> 1, qh = wid & 1, hq = hk * 4 + g;
    const int tb = b * SEQ + n * 128;
    LAS unsigned char* Ks = lds; LAS unsigned char* Vs = lds + AT_VOFF;
    KVRegs cur; attn_load_kv(HHp, b, n, hk, tid, cur);
    f16x8 qs[4];
    { const h16* qp = HHp + (size_t)(tb + 64 * qh + q32) * DIN + C_Q + hq * 64;
#pragma unroll
      for (int ks = 0; ks < 4; ++ks) qs[ks] = *(const f16x8*)(qp + 16 * ks + 8 * hi); }
#pragma unroll
    for (int i = 0; i < 4; ++i) { const int idx = tid + 512 * i, key = idx >> 3, ch = idx & 7; const u32x4 kw = cur.k[i], vw = cur.v[i];
        *(LAS u32x4*)(Ks + key * AT_KP + ch * 16) = kw;
        LAS unsigned short* vd = (LAS unsigned short*)(Vs + (ch * 8) * AT_VP + key * 2);
        vd[0 * (AT_VP / 2)] = (unsigned short)(vw.x & 0xffffu); vd[1 * (AT_VP / 2)] = (unsigned short)(vw.x >> 16); vd[2 * (AT_VP / 2)] = (unsigned short)(vw.y & 0xffffu); vd[3 * (AT_VP / 2)] = (unsigned short)(vw.y >> 16);
        vd[4 * (AT_VP / 2)] = (unsigned short)(vw.z & 0xffffu); vd[5 * (AT_VP / 2)] = (unsigned short)(vw.z >> 16); vd[6 * (AT_VP / 2)] = (unsigned short)(vw.w & 0xffffu); vd[7 * (AT_VP / 2)] = (unsigned short)(vw.w >> 16); }
    __syncthreads();
    const float slope = exp2f(-(float)(hq + 1)), sink = sinks[hq];
    float ab[16];
#pragma unroll
    for (int r = 0; r < 16; ++r) ab[r] = slope * (float)(crow(r, hi) - 128 - q32);
#pragma unroll 1
    for (int sub = 0; sub < 2; ++sub) {
        const int q0 = 64 * qh + 32 * sub, qi = q0 + q32;
        f32x16 sv[5]; float mx = -INFINITY;
#pragma unroll
        for (int j = 0; j < 5; ++j) { const int key0 = q0 + 32 * j; f32x16 c; float sl = slope; asm volatile("" : "+v"(sl)); const float aj = sl * (float)(32 * j);
#pragma unroll
            for (int r = 0; r < 16; ++r) c[r] = ab[r] + aj;
#pragma unroll
            for (int ks = 0; ks < 4; ++ks) { const f16x8 kf = *(const LAS f16x8*)(Ks + (key0 + q32) * AT_KP + (16 * ks + 8 * hi) * 2); c = __builtin_amdgcn_mfma_f32_32x32x16_f16(kf, qs[ks], c, 0, 0, 0); }
            const bool dead = (n == 0) && (key0 < 128);
            int hil = hi; asm volatile("" : "+v"(hil));
#pragma unroll
            for (int r = 0; r < 16; ++r) { float v = c[r];
                if (j == 0) v = (crow(r, hil) > q32) ? v : -INFINITY;
                if (j == 4) v = (crow(r, hil) <= q32) ? v : -INFINITY;
                if (dead) v = -INFINITY;
                c[r] = v; mx = fmaxf(mx, v); }
            sv[j] = c; __builtin_amdgcn_sched_barrier(0); }
        if (sub == 0) { const h16* qp = HHp + (size_t)(tb + 64 * qh + 32 + q32) * DIN + C_Q + hq * 64;
#pragma unroll
            for (int ks = 0; ks < 4; ++ks) qs[ks] = *(const f16x8*)(qp + 16 * ks + 8 * hi); }
        mx = fmaxf(mx, dppf_swap32(mx)); mx = fmaxf(mx, sink);
        float lsum = 0.f; f32x16 o0, o1;
#pragma unroll
        for (int r = 0; r < 16; ++r) { o0[r] = 0.f; o1[r] = 0.f; }
#pragma unroll
        for (int j = 0; j < 5; ++j) { const int key0 = q0 + 32 * j;
#pragma unroll
            for (int r = 0; r < 16; ++r) { const float pv = __expf(sv[j][r] - mx); sv[j][r] = pv; lsum += pv; }
#pragma unroll
            for (int cc = 0; cc < 2; ++cc) {
                u32x4 pw; pw.x = cvt_pk_h16(sv[j][8 * cc + 0], sv[j][8 * cc + 1]); pw.y = cvt_pk_h16(sv[j][8 * cc + 2], sv[j][8 * cc + 3]); pw.z = cvt_pk_h16(sv[j][8 * cc + 4], sv[j][8 * cc + 5]); pw.w = cvt_pk_h16(sv[j][8 * cc + 6], sv[j][8 * cc + 7]);
                const f16x8 pb = __builtin_bit_cast(f16x8, pw);
                const LAS unsigned char* vp = Vs + q32 * AT_VP + (key0 + 16 * cc + 4 * hi) * 2;
                { const u32x2 a0 = *(const LAS u32x2*)vp, a1 = *(const LAS u32x2*)(vp + 16); const u32x4 vw = {a0.x, a0.y, a1.x, a1.y}; o0 = __builtin_amdgcn_mfma_f32_32x32x16_f16(__builtin_bit_cast(f16x8, vw), pb, o0, 0, 0, 0); }
                { const u32x2 a0 = *(const LAS u32x2*)(vp + 32 * AT_VP), a1 = *(const LAS u32x2*)(vp + 32 * AT_VP + 16); const u32x4 vw = {a0.x, a0.y, a1.x, a1.y}; o1 = __builtin_amdgcn_mfma_f32_32x32x16_f16(__builtin_bit_cast(f16x8, vw), pb, o1, 0, 0, 0); }
                __builtin_amdgcn_sched_barrier(0);
            } }
        lsum += dppf_swap32(lsum); lsum += __expf(sink - mx);
        const float rl = 1.0f / lsum;
#pragma unroll
        for (int rg = 0; rg < 4; ++rg) { u32x2 w0, w1;
            w0.x = cvt_pk_h16(o0[4 * rg] * rl, o0[4 * rg + 1] * rl); w0.y = cvt_pk_h16(o0[4 * rg + 2] * rl, o0[4 * rg + 3] * rl);
            w1.x = cvt_pk_h16(o1[4 * rg] * rl, o1[4 * rg + 1] * rl); w1.y = cvt_pk_h16(o1[4 * rg + 2] * rl, o1[4 * rg + 3] * rl);
            h16* op = OUTp + (size_t)(tb + qi) * opitch + hq * 64; *(u32x2*)(op + 8 * rg + 4 * hi) = w0; *(u32x2*)(op + 32 + 8 * rg + 4 * hi) = w1; }
    }
    __syncthreads();
}
template <int W> __device__ __forceinline__ void pool_pair(const h16* HHp, h16* PDp, const int c8, const int tA, const int tB) {
    u32x4 q[2][W];
#pragma unroll
    for (int p = 0; p < 2; ++p) { const int t = p ? tB : tA; const int s = t & (SEQ - 1); const h16* up = HHp + (size_t)t * DIN + C_U + c8 * 8;
#pragma unroll
        for (int i = 0; i < W; ++i) { const int ii = (i <= s) ? i : 0; q[p][i] = *(const u32x4*)(up - (size_t)ii * DIN); } }
#pragma unroll
    for (int p = 0; p < 2; ++p) { const int t = p ? tB : tA; const int s = t & (SEQ - 1); f32x4 a0 = {0.f, 0.f, 0.f, 0.f}, a1 = {0.f, 0.f, 0.f, 0.f}, u0, u1;
#pragma unroll
        for (int i = 0; i < W; ++i) { f32x4 v0, v1; unpack8(q[p][i], v0, v1); if (i == 0) { u0 = v0; u1 = v1; } if (i <= s) { a0 += v0; a1 += v1; } }
        const float rn = 1.0f / (float)((s + 1 < W) ? s + 1 : W);
        *(u32x4*)(PDp + (size_t)t * 512 + c8 * 8) = pack8(a0 * rn - u0, a1 * rn - u1); }
}


__device__ __forceinline__ void prep_expert_items(const float* w_eg, const float* w_eu, const float* w_ed, unsigned char* egu_t, unsigned char* ed_t, float* wsc, int e_lo, int e_hi, int wrk, int nwrk, LAS float* scr, int lane) {
    for (int it = e_lo + wrk; it < e_hi; it += nwrk) {
        if (it < 2 * 8192) { const int up = it >> 13, q = it & 8191, e = q >> 7, q2 = q & 127, kb = q2 >> 3, nb = q2 & 7, n0 = 32 * nb;
            const float* Wm = (up ? w_eu : w_eg) + (size_t)e * D * FF; const float sc = f8_scale_of(Wm, lane); if (q2 == 0 && lane == 0) wsc[4 * e + up] = 1.0f / sc;
            tr_item_f8(Wm, FF, egu_t + (size_t)e * 512 * 1024, 1024, 64 * kb, n0, 256 * (n0 >> 7) + (n0 & 127) + 128 * up, scr, lane, sc); }
        else { const int r = it - 2 * 8192, e = r >> 7, q2 = r & 127, kb = q2 >> 5, nb = q2 & 31; const float* Wm = w_ed + (size_t)e * FF * D; const float sc = f8_scale_of(Wm, lane); if (q2 == 0 && lane == 0) wsc[4 * e + 2] = 1.0f / sc;
            tr_item_f8(Wm, D, ed_t + (size_t)e * 1024 * 256, 256, 64 * kb, 32 * nb, 32 * nb, scr, lane, sc); }
    }
}
#define W_EGU_P(lt) ((unsigned char*)(args.ws + (((lt) & 1) ? W_EGU_ALT : W_EGU_T)))
#define WSC_P(lt) ((float*)(args.ws + MS_WSC) + ((lt) & 1) * 256)
#define W_ED_P(lt)  ((unsigned char*)(args.ws + (((lt) & 1) ? W_ED_ALT : W_ED_T)))
#define PREP_EXPERTS(lt, e_lo, e_hi, wrk, nwrk) prep_expert_items(args.in[15] + (size_t)(lt) * NE * D * FF, args.in[16] + (size_t)(lt) * NE * D * FF, args.in[17] + (size_t)(lt) * NE * FF * D, W_EGU_P(lt), W_ED_P(lt), WSC_P(lt), e_lo, e_hi, wrk, nwrk, (LAS float*)(F.lds + F.wave * 16384), lane_id())
#ifndef P9_IPW
#define P9_IPW 5
#endif
constexpr int PE_A = 9830, PE_B = PE_A + 8602, PE_ALL = 3 * 8192;
#define PREP_WEIGHTS(E_LO) do { \
            LAS float* scr = (LAS float*)(F.lds + F.wave * 16384); \
            const float* w_in = L_W_IN; const float* w_br_attn = L_W_BRA; const float* w_out = L_W_OUT; const float* w_sg = L_W_SG; const float* w_su = L_W_SU; const float* w_sd = L_W_SD; \
            const float* w_eg = L_W_EG; const float* w_eu = L_W_EU; const float* w_ed = L_W_ED; const float* w_router = L_W_R; \
            constexpr int I_IN = 16 * 104, I_BA = 8 * 32, I_OUT = 16 * 32, I_SG = 16 * 8, I_SD = 4 * 32, I_EG = 64 * 128, I_ED = 64 * 128, I_R = 16 * 2; \
            constexpr int NITEMS = I_IN + I_BA + I_OUT + 2 * I_SG + I_SD + I_R; \
            for (int it = F.gw; it < NITEMS; it += F.NGW) { \
                int r = it; \
                if (r < I_IN) { const int kb = r / 104, nb = r % 104; const float sc = f8_scale_of(w_in, lane); if (r == 0 && lane == 0) *WSC_IN = 1.0f / sc; tr_item_f8(w_in, DIN, (unsigned char*)(args.ws + W_IN_T), 1024, 64 * kb, 32 * nb, 32 * nb, scr, lane, sc); continue; } r -= I_IN; \
                if (r < I_BA) { const int kb = r / 32, nb = r % 32; tr_item(w_br_attn, D, (h16*)(args.ws + W_BA_T), 512, 64 * kb, 32 * nb, 32 * nb, scr, lane); continue; } r -= I_BA; \
                if (r < I_OUT) { const int kb = r / 32, nb = r % 32; const float sc = f8_scale_of(w_out, lane); if (r == 0 && lane == 0) WSC_IN[1] = 1.0f / sc; tr_item_f8(w_out, D, (unsigned char*)(args.ws + W_OUT_T), 1024, 64 * kb, 32 * nb, 32 * nb, scr, lane, sc); continue; } r -= I_OUT; \
                if (r < 2 * I_SG) { const int up = r / I_SG, q = r % I_SG, kb = q / 8, nb = q % 8, n0 = 32 * nb; tr_item(up ? w_su : w_sg, FF, (h16*)(args.ws + W_SGU_T), 1024, 64 * kb, n0, 256 * (n0 >> 7) + (n0 & 127) + 128 * up, scr, lane); continue; } r -= 2 * I_SG; \
                if (r < I_SD) { const int kb = r / 32, nb = r % 32; tr_item(w_sd, D, (h16*)(args.ws + W_SD_T), 256, 64 * kb, 32 * nb, 32 * nb, scr, lane); continue; } r -= I_SD; \
                { const int kb = r / 2, nb = r % 2; tr_item_hilo(w_router, NE, (h16*)(args.ws + W_R_T), 1024, 64 * kb, 32 * nb, scr, lane); } \
            } \
            PREP_EXPERTS(l, (E_LO), PE_ALL, F.gw, F.NGW); \
            { h16* wpe = (h16*)(args.ws + W_PE_T); const float* w_pool = L_W_POOL; const float* pool_scale = L_PSCALE; const float* w_br_pool = L_W_BRP; \
              for (int idx = F.gw; idx < 512 * 16; idx += F.NGW) { const int cg = idx >> 4, n = ((idx & 15) << 6) + lane, g = cg >> 7; float s = 0.f; \
                  const float* wp = w_pool + (size_t)cg * 128; const float* ps = pool_scale + 128 * g; const float* wb = w_br_pool + (size_t)(128 * g) * D + n; \
                  float wv[128]; \
            _Pragma("unroll") \
                  for (int d = 0; d < 128; ++d) wv[d] = wb[(size_t)d * D]; \
            _Pragma("unroll") \
                  for (int d = 0; d < 128; ++d) s += wp[d] * ps[d] * wv[d]; \
                  wpe[(size_t)n * 512 + cg] = (h16)f2h(s); } } \
} while (0)
#define X32   (args.out)
#define XB    ((h16*)(args.ws + WS_XB))
#define XB8   ((unsigned char*)(args.ws + W_XB8))
#define WSC_IN ((float*)(args.ws + MS_WSC) + 512)
#define HH    ((h16*)(args.ws + R_HH))
#define PD    ((h16*)(args.ws + R_PD))
#define MG    ((h16*)(args.ws + R_MG))
#define HB    ((h16*)(args.ws + WS_HB))
#define HS    ((h16*)(args.ws + WS_HS))
#define YD    ((h16*)(args.ws + WS_R))
#define LOGIT ((float*)(args.ws + WS_HB))
#define ESEL  ((int*)(args.ws + MS_ESEL))
#define GATE  ((float*)(args.ws + MS_GATE))
#define RANKL ((int*)(args.ws + MS_RANK))
#define SLOT  ((int*)(args.ws + MS_SLOT))
#define TOKL  ((int*)(args.ws + MS_TOKL))
#define GATL  ((float*)(args.ws + MS_GATL))
#define WCNT  ((int*)(args.ws + MS_WCNT))
#define GTOT  ((int*)(args.ws + MS_GTOT))
#define BLKE  ((int*)(args.ws + MS_BLKE))
#define L_W_IN   (args.in[3] + (size_t)l * D * DIN)
#define L_B_IN   (args.in[4] + (size_t)l * DIN)
#define L_W_POOL (args.in[5] + (size_t)l * 4 * 128 * 128)
#define L_PSCALE (args.in[6] + (size_t)l * 512)
#define L_SINKS  (args.in[7] + (size_t)l * 8)
#define L_W_BRP  (args.in[8] + (size_t)l * 512 * D)
#define L_W_BRA  (args.in[9] + (size_t)l * 512 * D)
#define L_W_OUT  (args.in[10] + (size_t)l * D * D)
#define L_LN1G   (args.in[11] + (size_t)l * D)
#define L_LN1B   (args.in[12] + (size_t)l * D)
#define L_W_R    (args.in[13] + (size_t)l * D * NE)
#define L_RBIAS  (args.in[14] + (size_t)l * NE)
#define L_W_EG   (args.in[15] + (size_t)l * NE * D * FF)
#define L_W_EU   (args.in[16] + (size_t)l * NE * D * FF)
#define L_W_ED   (args.in[17] + (size_t)l * NE * FF * D)
#define L_W_SG   (args.in[18] + (size_t)l * D * FF)
#define L_W_SU   (args.in[19] + (size_t)l * D * FF)
#define L_W_SD   (args.in[20] + (size_t)l * FF * D)
#define L_LN2G   (args.in[21] + (size_t)l * D)
#define L_LN2B   (args.in[22] + (size_t)l * D)
__global__ void __launch_bounds__(512, 2) fwd_kernel(Args args) {
    extern __shared__ __attribute__((aligned(16))) unsigned char lds_raw[];
    Frame F;
    F.lds = (LAS unsigned char*)lds_raw;
    F.wave = __builtin_amdgcn_readfirstlane((int)threadIdx.x >> 6);
    F.G = gridDim.x; { const int bx = blockIdx.x; F.vcu = (F.G % 8 == 0) ? (bx % 8) * (F.G / 8) + bx / 8 : bx; }
    F.gw = F.vcu * 8 + F.wave; F.NGW = F.G * 8;
    unsigned* ctl = (unsigned*)(args.ws + WS_CTL);
    volatile LAS unsigned* MISC = (volatile LAS unsigned*)(F.lds + MISC_OFF);
    for (int u = threadIdx.x; u < (LDS_BYTES - LDSCTL_OFF) / 4; u += 512) ((LAS unsigned*)(F.lds + LDSCTL_OFF))[u] = 0u;
    __syncthreads();
#if MK_ONE_LAUNCH
    XcdBarrier bar = xcd_barrier_post(ctl + CW_BAR, MISC + 8);
#define GRID_BAR() xcd_barrier(bar, F.wave)
#else
#define GRID_BAR() do {} while (0)
#endif
    const int lo = args.ph_lo, hi = args.ph_hi;
#ifndef PHASE_MASK
#define PHASE_MASK 0xfff
#endif
#ifndef REPEAT_MASK
#define REPEAT_MASK 0
#endif
#define REPS(p) for (int rep_ = 0; rep_ < 1 + ((REPEAT_MASK >> (p)) & 1); ++rep_)
#define IN(p) (((PHASE_MASK >> ((p) - pb)) & 1) && lo <= (p) && (p) < hi)
#define PHASE_REGS const int lane = lane_id(); const int tid = F.wave * 64 + lane; int vcu = F.vcu, bx = (int)blockIdx.x; asm volatile("" : "+s"(vcu), "+s"(bx)); (void)lane; (void)tid; (void)vcu; (void)bx;

    for (int l = 0; l < DEPTH; ++l) {
        const int pb = l * NPH;
        if (IN(pb + 0) && l == 0) {
            PHASE_REGS
            PREP_WEIGHTS(0);
            for (int m = F.gw; m < T; m += F.NGW) { f32x4 v[4];
#pragma unroll
                for (int j = 0; j < 4; ++j) v[j] = *(const f32x4*)(args.in[0] + (size_t)m * D + 8 * lane + 4 * (j & 1) + 512 * (j >> 1));
                ln_store8(v, args.in[1], args.in[2], nullptr, XB + (size_t)m * D, lane, -1, -1, XB8 + (size_t)m * D); }
            GRID_BAR();
        }
        if (IN(pb + 1)) {
            PHASE_REGS
            SchedDense S; S.o.init(T, DIN, F.G, bx); S.a = (const char*)XB8; S.b = (const char*)(args.ws + W_IN_T); S.apitch = 1024; S.bpitch = 1024;
            EpiInProj E{HH, L_B_IN, *WSC_IN};
            REPS(1) GEMM_PHASE_F8(512, S, E);
            if (l + 1 < DEPTH && F.G == 256 && bx >= 128) PREP_EXPERTS(l + 1, 0, PE_A, (bx - 128) * 8 + F.wave, 128 * 8);
            GRID_BAR();
        }
        if (IN(pb + 2)) {
            PHASE_REGS
            { const int g = F.gw & 3, c8 = 16 * g + (lane & 15);
              for (int it = F.gw; it < T; it += 2 * F.NGW) { const int tA = (it >> 2) * 4 + (lane >> 4); const int it2 = (it + F.NGW < T) ? it + F.NGW : it; const int tB = (it2 >> 2) * 4 + (lane >> 4);
                  if (g == 0) pool_pair<2>(HH, PD, c8, tA, tB); else if (g == 1) pool_pair<4>(HH, PD, c8, tA, tB); else if (g == 2) pool_pair<8>(HH, PD, c8, tA, tB); else pool_pair<16>(HH, PD, c8, tA, tB); } }
            for (int U = vcu; U < NB * 16 * 2; U += F.G) attn_unit(F.lds, HH, HH + C_Q, DIN, L_SINKS, U >> 5, (U >> 1) & 15, U & 1, tid);
            GRID_BAR();
        }
        if (IN(pb + 3)) {
            PHASE_REGS
            SchedMerged S; S.o.init(T, D, F.G, bx); S.pd = (const char*)PD; S.oo = (const char*)(HH + C_Q); S.wpe = (const char*)(args.ws + W_PE_T); S.wba = (const char*)(args.ws + W_BA_T);
            EpiMerged E{(unsigned char*)MG, HH};
            REPS(3) GEMM_PHASE(512, S, E);
            GRID_BAR();
        }
        if (IN(pb + 4)) {
            PHASE_REGS
            SchedDense S; S.o.init(T, D, F.G, bx); S.a = (const char*)MG; S.b = (const char*)(args.ws + W_OUT_T); S.apitch = 1024; S.bpitch = 1024;
            EpiResid E{(h16*)X32, XB, WSC_IN[1] * 0.0625f};
            REPS(4) GEMM_PHASE_F8(512, S, E);
            GRID_BAR();
        }
        if (IN(pb + 5)) {
            PHASE_REGS
            for (int m0 = F.gw; m0 < T; m0 += 4 * F.NGW) { u32x4 ra[4], rb4[4];
#pragma unroll
                for (int q = 0; q < 4; ++q) { const int m = (m0 + q * F.NGW < T) ? m0 + q * F.NGW : m0; const h16* sp = (const h16*)X32 + (size_t)m * D + 8 * lane;
                    ra[q] = __builtin_nontemporal_load((const u32x4*)sp); rb4[q] = __builtin_nontemporal_load((const u32x4*)(sp + 512)); }
#pragma unroll
                for (int q = 0; q < 4; ++q) { const int m = m0 + q * F.NGW; if (m < T) { f32x4 v[4]; unpack8(ra[q], v[0], v[1]); unpack8(rb4[q], v[2], v[3]); ln_store8(v, L_LN1G, L_LN1B, nullptr, XB + (size_t)m * D, lane, -1, -1, XB8 + (size_t)m * D); } } }
            GRID_BAR();
        }
        if (IN(pb + 6)) {
            PHASE_REGS
            SchedSharedRouter S{F.G, vcu, (const char*)XB, (const char*)(args.ws + W_SGU_T), (const char*)(args.ws + W_R_T)};
            EpiSharedRouter E{HS, LOGIT};
            REPS(6) GEMM_PHASE(1024, S, E);
            GRID_BAR();
        }
        if (IN(pb + 7)) {
            PHASE_REGS
            LAS int* lcnt = (LAS int*)(F.lds);
            const float rb = L_RBIAS[lane];
            const float dsc = WSC_P(l)[4 * lane] * WSC_P(l)[4 * lane + 1] * WSC_P(l)[4 * lane + 2] * 4194304.0f;
            REPS(7) for (int w = vcu; w < 256; w += F.G) {
                int mycnt = 0; const int t0 = w * 128 + F.wave * 16;
                float lgs[16];
#pragma unroll
                for (int tt = 0; tt < 16; ++tt) lgs[tt] = LOGIT[(size_t)(t0 + tt) * NE + lane] + LOGIT[(size_t)T * NE + (size_t)(t0 + tt) * NE + lane];
#pragma unroll
                for (int tt = 0; tt < 16; ++tt) { const int t = t0 + tt;
                    const float lg = lgs[tt]; const float scv = 1.0f / (1.0f + __expf(-lg)); const float bs = scv + rb;
                    const float m1 = max8(bs);
                    const unsigned long long eq = __ballot(bs == m1); const int g = lane >> 3; const unsigned gm = (unsigned)(eq >> (8 * g)) & 0xffu; const int first = __builtin_ctz(gm);
                    const float m2 = max8(((lane & 7) == first) ? -INFINITY : bs);
                    const float gs = m1 + m2; int grank = 0;
#pragma unroll
                    for (int j = 0; j < 8; ++j) { const float gj = rdlane(gs, 8 * j); grank += (gj > gs || (gj == gs && j < g)) ? 1 : 0; }
                    const bool keep = grank < 4; const float v = keep ? bs : -INFINITY; int rank = 0;
#pragma unroll
                    for (int j = 0; j < 64; ++j) { const float vj = rdlane(v, j); rank += (vj > v || (vj == v && j < lane)) ? 1 : 0; }
                    const bool sel = keep && rank < 8;
                    const float ssum = wave_sum(sel ? scv : 0.f);
                    if (sel) { ESEL[t * 8 + rank] = lane; GATE[t * 8 + rank] = scv / ssum * 2.5f * dsc; RANKL[t * 8 + rank] = mycnt; mycnt++; }
                }
                WCNT[(size_t)(w * 8 + F.wave) * 64 + lane] = mycnt;
                lcnt[F.wave * 64 + lane] = mycnt;
                __syncthreads();
                if (F.wave == 0) { int s = 0;
#pragma unroll
                    for (int v = 0; v < 8; ++v) s += lcnt[v * 64 + lane];
                    GTOT[w * 64 + lane] = s; }
                __syncthreads();
            }
            GRID_BAR();
        }
        if (IN(pb + 8)) {
            PHASE_REGS
            REPS(8) for (int w = vcu; w < 256; w += F.G) {
                int tot = 0, before = 0;
#pragma unroll 64
                for (int w2 = 0; w2 < 256; ++w2) { const int c = GTOT[w2 * 64 + lane]; tot += c; before += (w2 < w) ? c : 0; }
                for (int v2 = 0; v2 < F.wave; ++v2) before += WCNT[(size_t)(w * 8 + v2) * 64 + lane];
                const int pc = (tot + 255) & ~255; int incl = pc;
#pragma unroll
                for (int o = 1; o < 64; o <<= 1) { const int xv = __shfl_up(incl, o); if (lane >= o) incl += xv; }
                const int pstart = incl - pc, base = pstart + before; const int t0 = w * 128 + F.wave * 16;
#pragma unroll
                for (int it = 0; it < 2; ++it) { const int idx = it * 64 + lane, tt = t0 + (idx >> 3), k = idx & 7; const int e = ESEL[tt * 8 + k], r = RANKL[tt * 8 + k]; const float g = GATE[tt * 8 + k];
                    const int dest = __shfl(base, e) + r; TOKL[dest] = tt * 9 + k; GATL[dest] = g; }
                if (F.wave == 0 && w < 64) {
                    const int ps_ = __shfl(pstart, w), te = __shfl(tot, w), pe = __shfl(pc, w);
                    for (int i2 = te + lane; i2 < pe; i2 += 64) { TOKL[ps_ + i2] = YT_DUMP; GATL[ps_ + i2] = 0.f; } }
                if (F.wave == 1) {
                    const int nblk = __shfl(incl, 63) >> 8; const int rbk = 8 * w + (lane & 7); int cnt = 0;
                    for (int e = 0; e < 64; ++e) { const int pend = __shfl(incl, e); cnt += (pend <= rbk * 256) ? 1 : 0; }
                    if (lane < 8 && rbk < nblk) BLKE[rbk] = cnt < 63 ? cnt : 63;
                    if (w == 0 && lane == 0) BLKE[NBLK_MAX] = nblk; }
            }
            GRID_BAR();
        }
        if (IN(pb + 9)) {
            PHASE_REGS
            const int nblk = __builtin_amdgcn_readfirstlane(BLKE[NBLK_MAX]);
            { LAS int* bl = (LAS int*)(F.lds + LDS_BLKE); for (int i = tid; i < nblk; i += 512) bl[i] = BLKE[i]; __syncthreads(); }
            SchedMoeGU S{F.G, vcu, nblk, (const char*)(args.ws + W_XB8), (const char*)W_EGU_P(l), (const LAS int*)(F.lds + LDS_BLKE), TOKL};
            EpiMoeGU E{(unsigned char*)HB, WSC_P(l)};
            REPS(9) GEMM_PHASE_F8(512, S, E);
            { const int rounds = (2 * nblk + 255) >> 8, busy = 2 * nblk - 256 * (rounds - 1);
              const int n9 = min(PE_ALL - PE_A, (256 - busy) * 8 * P9_IPW);
              if (l + 1 < DEPTH && F.G == 256 && vcu >= busy) PREP_EXPERTS(l + 1, PE_A, PE_A + n9, (vcu - busy) * 8 + F.wave, (256 - busy) * 8); }
            GRID_BAR();
        }
        if (IN(pb + 10)) {
            PHASE_REGS
            const int nblk = __builtin_amdgcn_readfirstlane(BLKE[NBLK_MAX]);
            { LAS int* bl = (LAS int*)(F.lds + LDS_BLKE); for (int i = tid; i < nblk; i += 512) bl[i] = BLKE[i]; __syncthreads(); }
            { SchedShDown S{F.G, vcu, (const char*)HS, (const char*)(args.ws + W_SD_T)};
              EpiMoeDown<false> E{(unsigned char*)(args.ws + WS_R), (h16*)(args.ws + R_YS)};
              GEMM_PHASE(256, S, E); }
            __syncthreads();
            { SchedMoeDownR S{F.G, vcu, nblk, (const char*)HB, (const char*)W_ED_P(l), (const LAS int*)(F.lds + LDS_BLKE), TOKL};
              EpiMoeDown<true> E{(unsigned char*)(args.ws + WS_R), (h16*)(args.ws + R_YS)};
              REPS(10) GEMM_PHASE_F8(128, S, E); }
            GRID_BAR();
        }
        if (IN(pb + 11)) {
            PHASE_REGS
            { float* xo = (l == DEPTH - 1) ? X32 : nullptr;
            const unsigned char* YQ = (const unsigned char*)(args.ws + WS_R); const h16* YS = (const h16*)(args.ws + R_YS);
            const int c0 = 256 * (lane >> 4) + 32 * ((lane >> 2) & 3) + 8 * (lane & 3), c1 = c0 + 128;
            for (int m0_ = F.gw; m0_ < T; m0_ += 2 * F.NGW) { int m0 = m0_; asm volatile("" : "+s"(m0));
                u32x4 yq[2][9], xa[2], xb2[2]; unsigned short ys[2]; float gt[2];
#pragma unroll
                for (int q = 0; q < 2; ++q) { const int m = (m0 + q * F.NGW < T) ? m0 + q * F.NGW : m0;
                    xa[q] = *(const u32x4*)(XB + (size_t)m * D + c0); xb2[q] = *(const u32x4*)(XB + (size_t)m * D + c1); gt[q] = GATE[(size_t)m * 8 + (lane & 7)];
#pragma unroll
                    for (int k = 0; k < 9; ++k) yq[q][k] = __builtin_nontemporal_load((const u32x4*)(YQ + ((size_t)m * 9 + k) * 1024 + lane * 16));
                    ys[q] = __builtin_nontemporal_load((const unsigned short*)(YS + ((size_t)m * 9 + 8) * 64 + lane)); }
#pragma unroll
                for (int q = 0; q < 2; ++q) { const int m = m0 + q * F.NGW; if (m < T) {
                    f32x4 v[4]; unpack8(xa[q], v[0], v[1]); unpack8(xb2[q], v[2], v[3]);
#pragma unroll
                    for (int j = 0; j < 4; ++j) v[j] = v[j] * ALPHA;
#pragma unroll
                    for (int k = 0; k < 8; ++k) { const float gk = rdlane(gt[q], k);
#pragma unroll
                        for (int j = 0; j < 4; ++j) { const f32x2 lo = __builtin_amdgcn_cvt_pk_f32_fp8((int)yq[q][k][j], false), hi = __builtin_amdgcn_cvt_pk_f32_fp8((int)yq[q][k][j], true);
                            v[j][0] += lo.x * gk; v[j][1] += lo.y * gk; v[j][2] += hi.x * gk; v[j][3] += hi.y * gk; }
                        __builtin_amdgcn_sched_barrier(0); }
                    { const float sc = h2f(ys[q]); const float bias = -128.0f * sc;
#pragma unroll
                        for (int j = 0; j < 4; ++j) { const unsigned wd = yq[q][8][j] ^ 0x80808080u;
                            v[j][0] += (float)(wd & 0xffu) * sc + bias; v[j][1] += (float)((wd >> 8) & 0xffu) * sc + bias; v[j][2] += (float)((wd >> 16) & 0xffu) * sc + bias; v[j][3] += (float)(wd >> 24) * sc + bias; } }
                    ln_store8(v, L_LN2G, L_LN2B, xo ? xo + (size_t)m * D : nullptr, XB + (size_t)m * D, lane, c0, c1, XB8 + (size_t)m * D); } } } }
            if (l + 1 < DEPTH) { const int nblk_ = __builtin_amdgcn_readfirstlane(BLKE[NBLK_MAX]); const int rounds_ = (2 * nblk_ + 255) >> 8, busy_ = 2 * nblk_ - 256 * (rounds_ - 1);
                const int e_lo = (F.G != 256) ? 0 : PE_A + min(PE_ALL - PE_A, (256 - busy_) * 8 * P9_IPW);
                ++l; PREP_WEIGHTS(e_lo); --l; }
            if (pb + 11 != DEPTH * NPH - 1) GRID_BAR();
        }
    }
#undef IN
}

extern "C" void kernel_launch(void* const* d_in, const int* in_sizes, int n_in, void* d_out, int out_size, void* d_ws, size_t ws_size, hipStream_t stream) {
    static int grid = 0;
    if (grid == 0) {
        if (n_in != 23 || out_size != T * D || ws_size < WS_END2) { fprintf(stderr, "kernel_launch: unexpected shapes (n_in %d out %d ws %zu)\n", n_in, out_size, ws_size); grid = -1; return; }
        int dev = 0, cus = 0;
        if (hipGetDevice(&dev) != hipSuccess || hipDeviceGetAttribute(&cus, hipDeviceAttributeMultiprocessorCount, dev) != hipSuccess) { grid = -1; return; }
        if (hipFuncSetAttribute((const void*)fwd_kernel, hipFuncAttributeMaxDynamicSharedMemorySize, LDS_BYTES) != hipSuccess) { fprintf(stderr, "kernel_launch: hipFuncSetAttribute failed\n"); grid = -1; return; }
        int per_cu = 0;
        if (hipOccupancyMaxActiveBlocksPerMultiprocessor(&per_cu, (const void*)fwd_kernel, 512, LDS_BYTES) != hipSuccess || per_cu < 1) { fprintf(stderr, "kernel_launch: occupancy query says %d\n", per_cu); }
        (void)hipGetLastError();
        grid = cus;
    }
    if (grid < 0) return;
    (void)hipMemsetAsync((char*)d_ws + WS_CTL, 0, CTL_ZERO_BYTES, stream);
    Args a{};
    for (int i = 0; i < 23; ++i) a.in[i] = (const float*)d_in[i];
    a.out = (float*)d_out; a.ws = (unsigned char*)d_ws;
#if MK_ONE_LAUNCH
    a.ph_lo = 0; a.ph_hi = DEPTH * NPH;
    hipLaunchKernelGGL(fwd_kernel, dim3(grid), dim3(512), LDS_BYTES, stream, a);
#else
    for (int p = 0; p < DEPTH * NPH; ++p) { a.ph_lo = p; a.ph_hi = p + 1; hipLaunchKernelGGL(fwd_kernel, dim3(grid), dim3(512), LDS_BYTES, stream, a); }
#endif
}
```

```cpp
#include <hip/hip_runtime.h>
#include <stdint.h>
#include <stdio.h>

#ifndef MK_ONE_LAUNCH
#define MK_ONE_LAUNCH 1
#endif

#define GAS __attribute__((address_space(1)))
#define LAS __attribute__((address_space(3)))
typedef unsigned short h16;
typedef short h16x8 __attribute__((ext_vector_type(8)));
typedef float f32x4 __attribute__((ext_vector_type(4)));
typedef float f32x2 __attribute__((ext_vector_type(2)));
typedef unsigned u32x4 __attribute__((ext_vector_type(4)));
typedef unsigned u32x2 __attribute__((ext_vector_type(2)));

constexpr int NB = 16, SEQ = 2048, T = NB * SEQ, D = 1024, DIN = 3328, DEPTH = 4;
constexpr int C_U = 0, C_Q = 512, C_K = 1024, C_V = 1152, C_GP = 1280, C_GA = 2304;
constexpr int NE = 64, FF = 256, TOPK = 8;
constexpr int NASSIGN = T * TOPK;
constexpr int NBLK_MAX = NASSIGN / 256 + NE;
constexpr int A_PAD = NBLK_MAX * 256;
constexpr float ALPHA = 1.6817928305074290f;
constexpr float LN_EPS = 1e-5f;
constexpr int NPH = 12;

constexpr size_t MiB = 1u << 20;
constexpr size_t WS_CTL = 0, CTL_ZERO_BYTES = 1 * MiB;
constexpr size_t WS_W = 1 * MiB;
constexpr size_t W_IN_T = WS_W + 0 * MiB;
constexpr size_t W_PE_T = WS_W + 7 * MiB;
constexpr size_t W_BA_T = WS_W + 8 * MiB;
constexpr size_t W_OUT_T = WS_W + 9 * MiB;
constexpr size_t W_R_T = WS_W + 11 * MiB;
constexpr size_t W_SGU_T = WS_W + 12 * MiB;
constexpr size_t W_SD_T = WS_W + 13 * MiB;
constexpr size_t W_EGU_T = WS_W + 14 * MiB;
constexpr size_t W_ED_T = WS_W + 78 * MiB;
constexpr size_t W_XB8 = W_EGU_T + 32 * MiB;
constexpr size_t WS_XB = 111 * MiB;
constexpr size_t WS_HB = 175 * MiB;
constexpr size_t WS_HS = 311 * MiB;
constexpr size_t WS_MISC = 327 * MiB;
constexpr size_t MS_LOGIT = WS_MISC;
constexpr size_t MS_ESEL = WS_MISC + 8 * MiB;
constexpr size_t MS_GATE = WS_MISC + 9 * MiB;
constexpr size_t MS_RANK = WS_MISC + 10 * MiB;
constexpr size_t MS_SLOT = WS_MISC + 11 * MiB;
constexpr size_t MS_TOKL = WS_MISC + 12 * MiB;
constexpr size_t MS_GATL = WS_MISC + 13 * MiB + 256 * 1024;
constexpr size_t MS_WCNT = WS_MISC + 14 * MiB + 512 * 1024;
constexpr size_t MS_GTOT = WS_MISC + 15 * MiB;
constexpr size_t MS_BLKE = WS_MISC + 15 * MiB + 256 * 1024;
constexpr size_t MS_WSC = WS_MISC + 15 * MiB + 512 * 1024;
constexpr size_t WS_R = 343 * MiB;
constexpr size_t R_HH = WS_R;
constexpr size_t R_PD = WS_R + 208 * MiB;
constexpr size_t R_MG = WS_R + 240 * MiB;
constexpr size_t WS_END = WS_R + 577 * MiB;
constexpr size_t W_EGU_ALT = WS_END;
constexpr size_t W_ED_ALT = WS_END + 64 * MiB;
constexpr size_t WS_END2 = WS_END + 96 * MiB;
constexpr size_t R_YS = WS_R + 296 * MiB;
constexpr int YT_DUMP = T * 9;
static_assert((size_t)A_PAD * 4 <= 1 * MiB + 256 * 1024, "toklist");
static_assert((size_t)A_PAD * 256 * 2 <= 136 * MiB, "Hbuf");
static_assert(((size_t)T * 9 + 1) * 1024 * 2 <= 577 * MiB, "Yt");

constexpr int CW_BAR = 4096;

constexpr int RING_BYTES = 131072;
constexpr int LDSCTL_OFF = RING_BYTES, MISC_OFF = LDSCTL_OFF + 320;
constexpr int LDS_BYTES = 147456;
constexpr int LDS_BLKE = LDSCTL_OFF + 1024;
constexpr int LDS_IDX = LDS_BLKE + 4352;
constexpr int LDS_OID = LDS_IDX + 2048;
static_assert(LDS_OID + 3072 <= LDS_BYTES, "LDS map");

#define RLX_AGENT __ATOMIC_RELAXED, __HIP_MEMORY_SCOPE_AGENT
__device__ __forceinline__ int lane_id() { int l; asm volatile("v_mbcnt_lo_u32_b32 %0, -1, 0\n\tv_mbcnt_hi_u32_b32 %0, -1, %0" : "=v"(l)); return l; }
typedef _Float16 f16x2 __attribute__((ext_vector_type(2)));
typedef _Float16 f16x8 __attribute__((ext_vector_type(8)));
__device__ __forceinline__ float h2f(unsigned short h) { return (float)__builtin_bit_cast(_Float16, h); }
__device__ __forceinline__ unsigned short f2h(float f) { return __builtin_bit_cast(unsigned short, (_Float16)f); }
__device__ __forceinline__ unsigned cvt_pk_h16(float lo, float hi) { f32x2 v = {lo, hi}; return __builtin_bit_cast(unsigned, __builtin_convertvector(v, f16x2)); }
__device__ __forceinline__ float lo16(unsigned w) { return (float)__builtin_bit_cast(f16x2, w)[0]; }
__device__ __forceinline__ float hi16(unsigned w) { return (float)__builtin_bit_cast(f16x2, w)[1]; }
__device__ __forceinline__ float sigmoidf_(float x) { return __builtin_amdgcn_rcpf(1.0f + __builtin_amdgcn_exp2f(-1.4426950408889634f * x)); }
template <int CTRL> __device__ __forceinline__ float dppf(float x) { return __builtin_bit_cast(float, __builtin_amdgcn_update_dpp(0, __builtin_bit_cast(int, x), CTRL, 0xf, 0xf, true)); }
__device__ __forceinline__ float rdlane(float x, int l) { return __builtin_bit_cast(float, __builtin_amdgcn_readlane(__builtin_bit_cast(int, x), l)); }
__device__ __forceinline__ float wave_sum(float v) {
    v += dppf<0xB1>(v); v += dppf<0x4E>(v); v += dppf<0x141>(v); v += dppf<0x140>(v);
    return (rdlane(v, 0) + rdlane(v, 16)) + (rdlane(v, 32) + rdlane(v, 48));
}
__device__ __forceinline__ float wave_max(float v) {
    v = fmaxf(v, dppf<0xB1>(v)); v = fmaxf(v, dppf<0x4E>(v)); v = fmaxf(v, dppf<0x141>(v)); v = fmaxf(v, dppf<0x140>(v));
    return fmaxf(fmaxf(rdlane(v, 0), rdlane(v, 16)), fmaxf(rdlane(v, 32), rdlane(v, 48)));
}
__device__ __forceinline__ float dppf_swap32(float x) { return __shfl_xor(x, 32); }
__device__ __forceinline__ float max8(float v) {
    v = fmaxf(v, dppf<0xB1>(v)); v = fmaxf(v, dppf<0x4E>(v)); return fmaxf(v, dppf<0x141>(v));
}

#define XB_TMO      128
#define XB_XCNT(j)  (256  + 64 * (j))
#define XB_XSUB(j)  (1280 + 64 * (j))
#define XB_XGEN(j)  (2304 + 64 * (j))
#define XB_TOP      3328
#define XB_TOPGEN   3392
#define XCD_BAR_WORDS 3456
#define XB_SPIN_CAP (1u << 18)
__device__ __forceinline__ unsigned xb_ld(unsigned* p)              { return __hip_atomic_load(p, __ATOMIC_RELAXED, __HIP_MEMORY_SCOPE_AGENT); }
__device__ __forceinline__ unsigned xb_add(unsigned* p, unsigned v) { return __hip_atomic_fetch_add(p, v, __ATOMIC_RELAXED, __HIP_MEMORY_SCOPE_AGENT); }
__device__ __forceinline__ unsigned xb_xcc_id() { return (unsigned)__builtin_amdgcn_s_getreg((3 << 11) | 20) & 0xFu; }
#define XB_SPIN(cond, bar) do { unsigned _sp = 0; while (cond) { __builtin_amdgcn_s_sleep(1); \
    if ((++_sp & 255u) == 0u) { if (xb_ld(&(bar)[XB_TMO])) break; if (_sp > XB_SPIN_CAP) { atomicAdd(&(bar)[XB_TMO], 1u); break; } } } } while (0)
struct XcdBarrier { unsigned* bar; unsigned x; volatile LAS unsigned* st; };
__device__ __forceinline__ XcdBarrier xcd_barrier_post(unsigned* bar, volatile LAS unsigned* st) {
    XcdBarrier b; b.bar = bar; b.x = xb_xcc_id(); b.st = st;
    if (threadIdx.x == 0) (void)xb_add(&bar[XB_XCNT(b.x)], 1u);
    return b;
}
__device__ __forceinline__ void xcd_barrier_complete(unsigned* bar, unsigned x, unsigned& nloc, unsigned& nx) {
    const unsigned G = gridDim.x * gridDim.y * gridDim.z;
    unsigned sum, cnt, mine, sp = 0u;
    for (;;) {
        sum = 0u; cnt = 0u; mine = 0u;
#pragma unroll
        for (unsigned j = 0; j < 16; ++j) { const unsigned c = xb_ld(&bar[XB_XCNT(j)]); sum += c; cnt += (c > 0u) ? 1u : 0u; mine = (j == x) ? c : mine; }
        if (sum == G) break;
        __builtin_amdgcn_s_sleep(1);
        if ((++sp & 255u) == 0u) { if (xb_ld(&bar[XB_TMO])) break; if (sp > XB_SPIN_CAP) { atomicAdd(&bar[XB_TMO], 1u); break; } }
    }
    nloc = mine > 0u ? mine : 1u; nx = cnt > 0u ? cnt : 1u;
}
__device__ __forceinline__ void xcd_barrier(const XcdBarrier& b, const int wave) {
    asm volatile("s_waitcnt vmcnt(0)" ::: "memory");
    __syncthreads();
    if (wave == 0 && lane_id() == 0) {
        unsigned* bar = b.bar;
        __builtin_amdgcn_s_waitcnt(0);
        unsigned nloc = b.st[0], nx = b.st[1];
        if (nloc == 0u) { xcd_barrier_complete(bar, b.x, nloc, nx); b.st[0] = nloc; b.st[1] = nx; }
        const unsigned old = xb_add(&bar[XB_XSUB(b.x)], 1u);
        const unsigned gen = old / nloc;
        if (old + 1u == (gen + 1u) * nloc) {
            __builtin_amdgcn_fence(__ATOMIC_RELEASE, "agent");
            asm volatile("s_waitcnt vmcnt(0)" ::: "memory");
            const unsigned og = xb_add(&bar[XB_TOP], 1u);
            const unsigned tg = og / nx;
            if (og + 1u == (tg + 1u) * nx) xb_add(&bar[XB_TOPGEN], 1u);
            else XB_SPIN(xb_ld(&bar[XB_TOPGEN]) == tg, bar);
            __builtin_amdgcn_fence(__ATOMIC_ACQUIRE, "agent");
            xb_add(&bar[XB_XGEN(b.x)], 1u);
            asm volatile("s_waitcnt vmcnt(0)" ::: "memory");
        } else {
            XB_SPIN(xb_ld(&bar[XB_XGEN(b.x)]) == gen, bar);
            __builtin_amdgcn_fence(__ATOMIC_ACQUIRE, "agent");
            asm volatile("s_waitcnt vmcnt(0)" ::: "memory");
        }
    }
    __syncthreads();
}

struct Unit {
    const char* a;
    const char* b;
    const int* ridx;
    unsigned apitch, bpitch;
    int row0;
    int col0;
    int kind;
    const int* oidx;
    const LAS int* oidl;
    int nt;
    int keep;
};
__device__ __forceinline__ int id2tok(int id) { const int t = (int)(((unsigned long long)(unsigned)id * 954437177ull) >> 33); return t < T ? t : T - 1; }
#define ACC_T f32x4 (&acc)[2][2][4][2]

template <class Epi, class Sched>
__device__ __forceinline__ void gemm_phase_simple(const int wid, const int K, const Sched& S, const Epi& E) {
    const int lane = lane_id(), tid = wid * 64 + lane; (void)tid;
    const int  wr = wid >> 2, wc = wid & 3, fr = lane & 15, fq = lane >> 4;
    Unit u;
    for (int i = 0; S.next(i, u); ++i) {
        f32x4 acc[2][2][4][2];
#pragma unroll
        for (int a = 0; a < 2; ++a)
#pragma unroll
            for (int b = 0; b < 2; ++b)
#pragma unroll
                for (int m = 0; m < 4; ++m)
#pragma unroll
                    for (int n = 0; n < 2; ++n) acc[a][b][m][n] = (f32x4){0.f, 0.f, 0.f, 0.f};
        unsigned offA[2][4], offB[2][2];
#pragma unroll
        for (int ai = 0; ai < 2; ++ai)
#pragma unroll
            for (int m = 0; m < 4; ++m) { const int r = 128 * ai + 64 * wr + 16 * m + fr; const int row = u.ridx ? id2tok(u.ridx[r]) : u.row0 + r; offA[ai][m] = (unsigned)row * u.apitch + (unsigned)fq * 16u; }
#pragma unroll
        for (int bj = 0; bj < 2; ++bj)
#pragma unroll
            for (int n = 0; n < 2; ++n) { const int wrow = 128 * bj + 32 * wc + 8 * (fr >> 2) + 4 * n + (fr & 3); offB[bj][n] = (unsigned)wrow * u.bpitch + (unsigned)fq * 16u; }
#pragma unroll 1
        for (int k0 = 0; k0 < K; k0 += 32) {
            h16x8 b[2][2];
#pragma unroll
            for (int bj = 0; bj < 2; ++bj)
#pragma unroll
                for (int n = 0; n < 2; ++n) b[bj][n] = *(const h16x8*)(u.b + offB[bj][n] + (size_t)k0 * 2);
#pragma unroll
            for (int ai = 0; ai < 2; ++ai) {
                h16x8 a[4];
#pragma unroll
                for (int m = 0; m < 4; ++m) a[m] = *(const h16x8*)(u.a + offA[ai][m] + (size_t)k0 * 2);
#pragma unroll
                for (int bj = 0; bj < 2; ++bj)
#pragma unroll
                    for (int m = 0; m < 4; ++m)
#pragma unroll
                        for (int n = 0; n < 2; ++n) acc[ai][bj][m][n] = __builtin_amdgcn_mfma_f32_16x16x32_f16(__builtin_bit_cast(f16x8, b[bj][n]), __builtin_bit_cast(f16x8, a[m]), acc[ai][bj][m][n], 0, 0, 0);
                asm volatile("" ::: "memory");
            }
        }
        u.oidl = nullptr;
        E(acc, u, wr, wc, fr, fq);
    }
}


#ifndef FAST_GEMM
#define FAST_GEMM 1
#endif
constexpr int HTB = 128 * 64 * 2;
__device__ __forceinline__ int lds_byte(int r, int c) { const int st = (r >> 4) * 2 + (c >> 5), rr = r & 15, cc = c & 31, ob = rr * 64 + cc * 2; return st * 1024 + (ob ^ (((ob >> 9) & 1) << 5)); }
__device__ __forceinline__ void stage_rc(int b, int& R, int& C) { const int st = b / 1024, sb = b % 1024, swz = sb ^ (((sb >> 9) & 1) << 5); R = (st >> 1) * 16 + swz / 64; C = (st & 1) * 32 + (swz % 64) / 2; }
__device__ __forceinline__ int perm32(int rho) { const int n = rho >> 4, i = rho & 15; return 8 * (i >> 2) + 4 * n + (i & 3); }

__device__ __forceinline__ const char* uptr(const char* p) { const unsigned long long v = (unsigned long long)p; const unsigned lo = __builtin_amdgcn_readfirstlane((unsigned)v), hi = __builtin_amdgcn_readfirstlane((unsigned)(v >> 32)); return (const char*)(((unsigned long long)hi << 32) | lo); }
typedef int i32x8 __attribute__((ext_vector_type(8)));
__device__ __forceinline__ i32x8 cat8(const u32x4 a, const u32x4 b) { return (i32x8){(int)a.x, (int)a.y, (int)a.z, (int)a.w, (int)b.x, (int)b.y, (int)b.z, (int)b.w}; }
template <int H> __device__ __forceinline__ f16x8 half8(const i32x8 v) { typedef int i32x4_ __attribute__((ext_vector_type(4))); const i32x4_ q = __builtin_shufflevector(v, v, 4 * H, 4 * H + 1, 4 * H + 2, 4 * H + 3); return __builtin_bit_cast(f16x8, q); }
template <bool F8, class Epi, class Sched>
__device__ __forceinline__ void gemm_phase(LAS unsigned char* lds, const int wid, const int K, const Sched& S, const Epi& E) {
    const int lane = lane_id(), tid = wid * 64 + lane;
    const int  wr = wid >> 2, wc = wid & 3, fr = lane & 15, fq = lane >> 4;
    int nt = K / 64; asm volatile("" : "+s"(nt));
    const unsigned ldsw = (unsigned)wid * 1024u;
    const int aoff = lds_byte(wr * 64 + fr, fq * 8), boff = lds_byte(wc * 32 + fr, fq * 8);
#define G_SA(b, h) (((b) * 2 + (h)) * HTB)
#define G_SB(b, h) ((4 + (b) * 2 + (h)) * HTB)
#define G_STAGE(bufoff, gbase, o0, o1) do { \
        __builtin_amdgcn_global_load_lds((const unsigned*)((const char*)(gbase) + (o0)), (LAS unsigned*)(lds + (bufoff) + ldsw), 16, 0, 0); \
        __builtin_amdgcn_global_load_lds((const unsigned*)((const char*)(gbase) + (o1)), (LAS unsigned*)(lds + (bufoff) + ldsw + 8192), 16, 0, 0); } while (0)
#define G_LDA(dst, b, h) do { _Pragma("unroll") for (int m = 0; m < 4; ++m) dst[m] = cat8(*(const LAS u32x4*)(lds + G_SA(b, h) + aoff + m * 2048), *(const LAS u32x4*)(lds + G_SA(b, h) + aoff + m * 2048 + 1024)); } while (0)
#define G_LDB(dst, b, h) do { _Pragma("unroll") for (int n = 0; n < 2; ++n) dst[n] = cat8(*(const LAS u32x4*)(lds + G_SB(b, h) + boff + n * 2048), *(const LAS u32x4*)(lds + G_SB(b, h) + boff + n * 2048 + 1024)); } while (0)
#define G_MMA(ai, bj, At, Bt) do { __builtin_amdgcn_s_setprio(1); _Pragma("unroll") for (int m = 0; m < 4; ++m) _Pragma("unroll") for (int n = 0; n < 2; ++n) { \
        if constexpr (F8) { acc[ai][bj][m][n] = __builtin_amdgcn_mfma_scale_f32_16x16x128_f8f6f4(Bt[n], At[m], acc[ai][bj][m][n], 0, 0, 0, 0, 0, 0); } \
        else { acc[ai][bj][m][n] = __builtin_amdgcn_mfma_f32_16x16x32_f16(half8<0>(Bt[n]), half8<0>(At[m]), acc[ai][bj][m][n], 0, 0, 0); \
               acc[ai][bj][m][n] = __builtin_amdgcn_mfma_f32_16x16x32_f16(half8<1>(Bt[n]), half8<1>(At[m]), acc[ai][bj][m][n], 0, 0, 0); } } \
        __builtin_amdgcn_s_setprio(0); } while (0)
#define G_WAIT_V(n) asm volatile("s_waitcnt vmcnt(" #n ")" ::: "memory")
#define G_WAIT_L(n) asm volatile("s_waitcnt lgkmcnt(" #n ")" ::: "memory")
#define G_BAR __builtin_amdgcn_s_barrier()
#define G_SCHED __builtin_amdgcn_sched_barrier(0)
#define G_OFFS(u, OA, OB, IDXB) do { int tl_ = wid * 64 + lane_id(); _Pragma("unroll") for (int i = 0; i < 2; ++i) { int R_, C_; stage_rc(tl_ * 16 + i * 8192, R_, C_); const int Rb_ = (R_ & ~31) + perm32(R_ & 31); \
        _Pragma("unroll") for (int h = 0; h < 2; ++h) { const int r_ = h * 128 + R_; const int row_ = (u).ridx ? id2tok(((const LAS int*)(lds + LDS_IDX + (IDXB) * 1024))[r_]) : (u).row0 + r_; \
        OA[h][i] = (unsigned)row_ * (u).apitch + (unsigned)C_ * 2u; OB[h][i] = (unsigned)(h * 128 + Rb_) * (u).bpitch + (unsigned)C_ * 2u; } } } while (0)
#define G_IDX_DMA(u, IDXB, OIDB) do { if ((u).ridx && wid < 4) __builtin_amdgcn_global_load_lds((const unsigned*)((u).ridx + wid * 64 + lane_id()), (LAS unsigned*)(lds + LDS_IDX + (IDXB) * 1024 + wid * 256), 4, 0, 0); \
        if ((u).oidx && wid < 4) __builtin_amdgcn_global_load_lds((const unsigned*)((u).oidx + wid * 64 + lane_id()), (LAS unsigned*)(lds + LDS_OID + (OIDB) * 1024 + wid * 256), 4, 0, 0); } while (0)
    Unit cur, nxt; int ui = 0;
    if (!S.next(0, cur)) return;
    if constexpr (Sched::DYN) nt = cur.nt;
    unsigned cOA[2][2], cOB[2][2];
    G_IDX_DMA(cur, 0, 0); asm volatile("s_waitcnt vmcnt(0)" ::: "memory"); __builtin_amdgcn_s_barrier(); asm volatile("" ::: "memory");
    G_OFFS(cur, cOA, cOB, 0);
    f32x4 acc[2][2][4][2];
#pragma unroll
    for (int a = 0; a < 2; ++a)
#pragma unroll
        for (int b = 0; b < 2; ++b)
#pragma unroll
            for (int m = 0; m < 4; ++m)
#pragma unroll
                for (int n = 0; n < 2; ++n) acc[a][b][m][n] = (f32x4){0.f, 0.f, 0.f, 0.f};
    i32x8 At[4], B0[2], B1[2];
    const char* cA = uptr(cur.a); const char* cB = uptr(cur.b);
    G_STAGE(G_SB(0, 0), cB, cOB[0][0], cOB[0][1]); G_STAGE(G_SB(0, 1), cB, cOB[1][0], cOB[1][1]); G_STAGE(G_SA(0, 0), cA, cOA[0][0], cOA[0][1]); G_STAGE(G_SA(0, 1), cA, cOA[1][0], cOA[1][1]);
    if (wr == 1) G_BAR;
    G_WAIT_V(2); G_BAR;
    { const char* cA1 = uptr(cA + 128); const char* cB1 = uptr(cB + 128);
      G_STAGE(G_SB(1, 0), cB1, cOB[0][0], cOB[0][1]); G_STAGE(G_SA(1, 0), cA1, cOA[0][0], cOA[0][1]); G_STAGE(G_SB(1, 1), cB1, cOB[1][0], cOB[1][1]); }
    G_WAIT_V(6); G_BAR;
    for (;;) {
        const bool has_next = S.next(ui + 1, nxt); const char* nA = cA; const char* nB = cB;
        if (has_next) G_IDX_DMA(nxt, (ui + 1) & 1, (ui + 1) % 3);
#pragma unroll 1
        for (int t = 0; t < nt; t += 2) {
            const bool last = (t == nt - 2);
            const char* a1 = uptr(cA + (size_t)(t + 1) * 128);
            G_LDB(B0, 0, 0); G_LDB(B1, 0, 1); G_SCHED; G_LDA(At, 0, 0); G_STAGE(G_SA(1, 1), a1, cOA[1][0], cOA[1][1]);
            G_WAIT_V(8); G_WAIT_L(0); G_BAR; G_MMA(0, 0, At, B0); G_MMA(0, 1, At, B1); G_BAR; G_SCHED;
            if (last && has_next) { nA = uptr(nxt.a); nB = uptr(nxt.b); G_OFFS(nxt, cOA, cOB, (ui + 1) & 1); }
            const char* a2 = uptr(last ? nA : cA + (size_t)(t + 2) * 128); const char* b2 = uptr(last ? nB : cB + (size_t)(t + 2) * 128);
            const char* a3 = uptr(a2 + 128); const char* b3 = uptr(b2 + 128);
            G_LDA(At, 0, 1); G_STAGE(G_SB(0, 0), b2, cOB[0][0], cOB[0][1]); G_STAGE(G_SB(0, 1), b2, cOB[1][0], cOB[1][1]); G_STAGE(G_SA(0, 0), a2, cOA[0][0], cOA[0][1]);
            G_WAIT_V(8); G_WAIT_L(0); G_BAR; G_MMA(1, 0, At, B0); G_MMA(1, 1, At, B1); G_BAR; G_SCHED;
            G_LDB(B0, 1, 0); G_LDB(B1, 1, 1); G_SCHED; G_LDA(At, 1, 0); G_STAGE(G_SA(0, 1), a2, cOA[1][0], cOA[1][1]);
            G_WAIT_V(8); G_WAIT_L(0); G_BAR; G_MMA(0, 0, At, B0); G_MMA(0, 1, At, B1); G_BAR; G_SCHED;
            G_LDA(At, 1, 1); G_STAGE(G_SB(1, 0), b3, cOB[0][0], cOB[0][1]); G_STAGE(G_SB(1, 1), b3, cOB[1][0], cOB[1][1]); G_STAGE(G_SA(1, 0), a3, cOA[0][0], cOA[0][1]);
            G_WAIT_V(8); G_WAIT_L(0); G_BAR; G_MMA(1, 0, At, B0); G_MMA(1, 1, At, B1); G_BAR; G_SCHED;
        }
        if (wr == 0) G_BAR;
        cur.oidl = (const LAS int*)(lds + LDS_OID + (ui % 3) * 1024);
        { const int le = lane_id(); E(acc, cur, wr, wc, le & 15, le >> 4); }
        if (!has_next) break;
        if (!nxt.keep) {
#pragma unroll
        for (int a = 0; a < 2; ++a)
#pragma unroll
            for (int b = 0; b < 2; ++b)
#pragma unroll
                for (int m = 0; m < 4; ++m)
#pragma unroll
                    for (int n = 0; n < 2; ++n) acc[a][b][m][n] = (f32x4){0.f, 0.f, 0.f, 0.f};
        }
        cur = nxt; cA = nA; cB = nB; ++ui;
        if constexpr (Sched::DYN) nt = cur.nt;
        if (wr == 1) G_BAR;
    }
    G_WAIT_V(0);
    G_BAR;
#undef G_SA
#undef G_SB
#undef G_STAGE
#undef G_LDA
#undef G_LDB
#undef G_MMA
#undef G_WAIT_V
#undef G_WAIT_L
#undef G_BAR
#undef G_SCHED
#undef G_OFFS
#undef G_IDX_DMA
}
#if FAST_GEMM
#define GEMM_PHASE(K, S, E) gemm_phase<false>(F.lds, F.wave, K, S, E)
#define GEMM_PHASE_F8(K, S, E) gemm_phase<true>(F.lds, F.wave, K, S, E)
#else
#define GEMM_PHASE(K, S, E) gemm_phase_simple(F.wave, K, S, E)
#endif

constexpr int NXCD = 8, WGM = 8;
struct TileOrder {
    int nM, nN, nwg, G, c;
    __device__ void init(int M, int N, int G_, int c_) { nM = M / 256; nN = N / 256; nwg = nM * nN; G = G_; c = c_; }
    __device__ bool tile(int i, int& pm, int& pn) const {
        const long L = (long)i * G + c; if (L >= nwg) return false;
        int wgid = (int)L; { const int q = nwg / NXCD, r = nwg % NXCD, xcd = wgid % NXCD, off = wgid / NXCD; wgid = (xcd < r ? xcd * (q + 1) : r * (q + 1) + (xcd - r) * q) + off; }
        const int nig = WGM * nN, gid = wgid / nig, fm = gid * WGM, gsz = (nM - fm) < WGM ? (nM - fm) : WGM;
        pm = fm + ((wgid % nig) % gsz); pn = (wgid % nig) / gsz; return true;
    }
};
struct SchedDense { static constexpr bool DYN = false;
    TileOrder o; const char* a; const char* b; unsigned apitch, bpitch;
    __device__ bool next(int i, Unit& u) const {
        int pm, pn; if (!o.tile(i, pm, pn)) return false;
        u.a = a; u.b = b + (size_t)pn * 256 * bpitch; u.ridx = nullptr; u.apitch = apitch; u.bpitch = bpitch; u.row0 = pm * 256; u.col0 = pn * 256; u.kind = 0; u.oidx = nullptr; u.keep = 0; return true;
    }
};
struct SchedMerged { static constexpr bool DYN = false;
    TileOrder o; const char* pd; const char* oo; const char* wpe; const char* wba;
    __device__ bool next(int i, Unit& u) const {
        int pm, pn; if (!o.tile(i >> 1, pm, pn)) return false;
        const int part = i & 1;
        u.a = part ? oo : pd; u.apitch = 512; u.b = (part ? wba : wpe) + (size_t)pn * 256 * 512; u.bpitch = 512; u.ridx = nullptr; u.row0 = pm * 256; u.col0 = pn * 256; u.kind = part; u.oidx = nullptr; u.keep = part; return true;
    }
};
struct SchedSharedRouter { static constexpr bool DYN = true;
    int G, c; const char* xb; const char* wsgu; const char* wr;
    __device__ bool next(int i, Unit& u) const {
        const int L = i * G + c; if (L >= 512) return false;
        u.apitch = 2048; u.bpitch = 2048; u.ridx = nullptr; u.oidx = nullptr; u.keep = 0;
        if (L < 256) { const int pm = L >> 1, pn = L & 1; u.a = xb; u.b = wsgu + (size_t)pn * 256 * 2048; u.row0 = pm * 256; u.col0 = pn * 128; u.kind = 0; u.nt = 16; }
        else { const int pm = (L - 256) >> 1, kh = L & 1; u.a = xb + kh * 1024; u.b = wr + kh * 1024; u.row0 = pm * 256; u.col0 = kh; u.kind = 1; u.nt = 8; }
        return true;
    }
};
struct SchedMoeGU { static constexpr bool DYN = false;
    int G, c, nblk; const char* xb; const char* wegu; const LAS int* blke; const int* tokl;
    __device__ bool next(int i, Unit& u) const {
        const int L = i * G + c; if (L >= 2 * nblk) return false;
        const int rb = L >> 1, pn = L & 1, e = __builtin_amdgcn_readfirstlane(blke[rb]);
        u.a = xb; u.apitch = 1024; u.bpitch = 1024; u.b = wegu + ((size_t)e * 512 + pn * 256) * 1024; u.ridx = tokl + rb * 256; u.row0 = rb * 256; u.col0 = pn * 128; u.kind = e; u.oidx = nullptr; u.keep = 0; return true;
    }
};
struct SchedMoeDownR { static constexpr bool DYN = false;
    int G, c, nblk; const char* hb; const char* wed; const LAS int* blke; const int* tokl;
    __device__ bool next(int i, Unit& u) const {
        const int L = i * G + c; if (L >= 4 * nblk) return false;
        const int rb = L >> 2, pn = L & 3, e = __builtin_amdgcn_readfirstlane(blke[rb]);
        u.apitch = 256; u.bpitch = 256; u.ridx = nullptr; u.a = hb; u.b = wed + ((size_t)e * 1024 + pn * 256) * 256; u.row0 = rb * 256; u.col0 = pn * 256; u.kind = e; u.oidx = tokl + rb * 256; u.keep = 0; return true;
    }
};
struct SchedShDown { static constexpr bool DYN = false;
    int G, c; const char* hs; const char* wsd;
    __device__ bool next(int i, Unit& u) const {
        const int L = i * G + c; if (L >= 512) return false;
        const int pm = L >> 2, pn = L & 3; u.apitch = 512; u.bpitch = 512; u.ridx = nullptr; u.a = hs; u.b = wsd + (size_t)pn * 256 * 512; u.row0 = pm * 256; u.col0 = pn * 256; u.kind = 64; u.oidx = nullptr; u.keep = 0; return true;
    }
};

__device__ __forceinline__ u32x4 pack8(const f32x4& v0, const f32x4& v1) { u32x4 w; w.x = cvt_pk_h16(v0[0], v0[1]); w.y = cvt_pk_h16(v0[2], v0[3]); w.z = cvt_pk_h16(v1[0], v1[1]); w.w = cvt_pk_h16(v1[2], v1[3]); return w; }
__device__ __forceinline__ void unpack8(const u32x4& w, f32x4& v0, f32x4& v1) { v0 = (f32x4){lo16(w.x), hi16(w.x), lo16(w.y), hi16(w.y)}; v1 = (f32x4){lo16(w.z), hi16(w.z), lo16(w.w), hi16(w.w)}; }
__device__ __forceinline__ f32x4 sig4(const f32x4& v) { return (f32x4){sigmoidf_(v[0]), sigmoidf_(v[1]), sigmoidf_(v[2]), sigmoidf_(v[3])}; }
__device__ __forceinline__ f32x4 swiglu4(const f32x4& g, const f32x4& u) { return (f32x4){g[0] * sigmoidf_(g[0]) * u[0], g[1] * sigmoidf_(g[1]) * u[1], g[2] * sigmoidf_(g[2]) * u[2], g[3] * sigmoidf_(g[3]) * u[3]}; }

__device__ __forceinline__ unsigned q8x4(float a, float b, float c, float d, float inv) {
    const unsigned ua = __float_as_uint(a * inv + 12582912.0f), ub = __float_as_uint(b * inv + 12582912.0f), uc = __float_as_uint(c * inv + 12582912.0f), ud = __float_as_uint(d * inv + 12582912.0f);
    const unsigned lo = __builtin_amdgcn_perm(ub, ua, 0x0c0c0400u), hi = __builtin_amdgcn_perm(ud, uc, 0x0c0c0400u);
    return __builtin_amdgcn_perm(hi, lo, 0x05040100u);
}
__device__ __forceinline__ unsigned f8x4(const f32x4 v) {
    int w = __builtin_amdgcn_cvt_pk_fp8_f32(__builtin_amdgcn_fmed3f(v.x, -448.f, 448.f), __builtin_amdgcn_fmed3f(v.y, -448.f, 448.f), 0, false);
    w = __builtin_amdgcn_cvt_pk_fp8_f32(__builtin_amdgcn_fmed3f(v.z, -448.f, 448.f), __builtin_amdgcn_fmed3f(v.w, -448.f, 448.f), w, true); return (unsigned)w; }
struct EpiInProj {
    h16* H; const float* bias; float isc;
    __device__ __forceinline__ void operator()(const ACC_T, const Unit& u, int wr, int wc, int fr, int fq) const {
        const int pn = u.col0 >> 8; const float sc = (pn == 2 || pn == 3) ? 0.125f : 1.f; const bool sg = pn >= 5;
        f32x4 bv[2][2];
#pragma unroll
        for (int bj = 0; bj < 2; ++bj)
#pragma unroll
            for (int n = 0; n < 2; ++n) bv[bj][n] = *(const f32x4*)(bias + u.col0 + 128 * bj + 32 * wc + 8 * fq + 4 * n);
#pragma unroll
        for (int ai = 0; ai < 2; ++ai)
#pragma unroll
            for (int m = 0; m < 4; ++m) { const int row = u.row0 + 128 * ai + 64 * wr + 16 * m + fr; h16* rowp = H + (size_t)row * DIN + u.col0 + 32 * wc + 8 * fq;
#pragma unroll
                for (int bj = 0; bj < 2; ++bj) { f32x4 v0 = (acc[ai][bj][m][0] * isc + bv[bj][0]) * sc, v1 = (acc[ai][bj][m][1] * isc + bv[bj][1]) * sc;
                    if (sg) { v0 = sig4(v0); v1 = sig4(v1);
                        u32x2 w; w.x = q8x4(v0[0], v0[1], v0[2], v0[3], 255.0f); w.y = q8x4(v1[0], v1[1], v1[2], v1[3], 255.0f);
                        *(u32x2*)((unsigned char*)(H + (size_t)row * DIN + C_GP) + (u.col0 - C_GP) + 128 * bj + 32 * wc + 8 * fq) = w; }
                    else *(u32x4*)(rowp + 128 * bj) = pack8(v0, v1); } }
    }
};
__device__ __forceinline__ void ungate8(const u32x2& w, f32x4& v0, f32x4& v1) {
    const float k = 1.0f / 255.0f;
    v0 = (f32x4){(float)(w.x & 0xffu) * k, (float)((w.x >> 8) & 0xffu) * k, (float)((w.x >> 16) & 0xffu) * k, (float)(w.x >> 24) * k};
    v1 = (f32x4){(float)(w.y & 0xffu) * k, (float)((w.y >> 8) & 0xffu) * k, (float)((w.y >> 16) & 0xffu) * k, (float)(w.y >> 24) * k};
}
struct EpiMerged {
    unsigned char* MG; const h16* H; float r01, i1;
    __device__ __forceinline__ void operator()(f32x4 (&acc)[2][2][4][2], const Unit& u, int wr, int wc, int fr, int fq) const {
        const int col = u.col0 + 32 * wc + 8 * fq;
#pragma unroll
        for (int ai = 0; ai < 2; ++ai) {
            u32x2 ga[4][2], gp[4][2];
#pragma unroll
            for (int m = 0; m < 4; ++m) { const int row = u.row0 + 128 * ai + 64 * wr + 16 * m + fr;
#pragma unroll
                for (int bj = 0; bj < 2; ++bj) { const unsigned char* gb = (const unsigned char*)(H + (size_t)row * DIN + C_GP) + col + 128 * bj; ga[m][bj] = *(const u32x2*)(gb + 1024); if (u.kind == 0) gp[m][bj] = *(const u32x2*)gb; } }
#pragma unroll
            for (int m = 0; m < 4; ++m) { const int row = u.row0 + 128 * ai + 64 * wr + 16 * m + fr;
#pragma unroll
                for (int bj = 0; bj < 2; ++bj) { f32x4 a0, a1; ungate8(ga[m][bj], a0, a1);
                    if (u.kind == 0) { f32x4 p0, p1; ungate8(gp[m][bj], p0, p1);
#pragma unroll
                        for (int j = 0; j < 4; ++j) { acc[ai][bj][m][0][j] *= p0[j] * r01 * __builtin_amdgcn_rcpf(fmaxf(a0[j], 6.2e-5f)); acc[ai][bj][m][1][j] *= p1[j] * r01 * __builtin_amdgcn_rcpf(fmaxf(a1[j], 6.2e-5f)); } }
                    else { u32x2 w; w.x = f8x4(acc[ai][bj][m][0] * a0 * i1); w.y = f8x4(acc[ai][bj][m][1] * a1 * i1); *(u32x2*)(MG + (size_t)row * D + col + 128 * bj) = w; } } }
        }
    }
};
struct EpiResid {
    h16* S; const h16* XBp; float isc;
    __device__ __forceinline__ void operator()(const ACC_T, const Unit& u, int wr, int wc, int fr, int fq) const {
#pragma unroll
        for (int ai = 0; ai < 2; ++ai) {
            u32x4 xw[4][2];
#pragma unroll
            for (int m = 0; m < 4; ++m) { const int row = u.row0 + 128 * ai + 64 * wr + 16 * m + fr; const size_t off = (size_t)row * D + u.col0 + 32 * wc + 8 * fq;
#pragma unroll
                for (int bj = 0; bj < 2; ++bj) xw[m][bj] = *(const u32x4*)(XBp + off + 128 * bj); }
#pragma unroll
            for (int m = 0; m < 4; ++m) { const int row = u.row0 + 128 * ai + 64 * wr + 16 * m + fr; const size_t off = (size_t)row * D + u.col0 + 32 * wc + 8 * fq;
#pragma unroll
                for (int bj = 0; bj < 2; ++bj) { f32x4 x0, x1; unpack8(xw[m][bj], x0, x1);
                    *(u32x4*)(S + off + 128 * bj) = pack8(x0 * ALPHA + acc[ai][bj][m][0] * isc, x1 * ALPHA + acc[ai][bj][m][1] * isc); } }
        }
    }
};
struct EpiSharedRouter {
    h16* HS; float* LG;
    __device__ __forceinline__ void operator()(const ACC_T, const Unit& u, int wr, int wc, int fr, int fq) const {
#pragma unroll
        for (int ai = 0; ai < 2; ++ai)
#pragma unroll
            for (int m = 0; m < 4; ++m) { const int row = u.row0 + 128 * ai + 64 * wr + 16 * m + fr;
                if (u.kind == 0) { *(u32x4*)(HS + (size_t)row * FF + u.col0 + 32 * wc + 8 * fq) = pack8(swiglu4(acc[ai][0][m][0], acc[ai][1][m][0]), swiglu4(acc[ai][0][m][1], acc[ai][1][m][1])); }
                else if (wc < 2) {
#pragma unroll
                    for (int n = 0; n < 2; ++n) *(f32x4*)(LG + (size_t)u.col0 * T * NE + (size_t)row * NE + 32 * wc + 8 * fq + 4 * n) = acc[ai][0][m][n] + acc[ai][1][m][n]; } }
    }
};
struct EpiMoeGU {
    unsigned char* HB; const float* wsc;
    __device__ __forceinline__ void operator()(const ACC_T, const Unit& u, int wr, int wc, int fr, int fq) const {
        const float isg = wsc[4 * u.kind], isu = wsc[4 * u.kind + 1], hsc = 1.52587890625e-05f / (isg * isu);
#pragma unroll
        for (int ai = 0; ai < 2; ++ai)
#pragma unroll
            for (int m = 0; m < 4; ++m) { const int row = u.row0 + 128 * ai + 64 * wr + 16 * m + fr;
                u32x2 w; w.x = f8x4(swiglu4(acc[ai][0][m][0] * isg, acc[ai][1][m][0] * isu) * hsc); w.y = f8x4(swiglu4(acc[ai][0][m][1] * isg, acc[ai][1][m][1] * isu) * hsc);
                *(u32x2*)(HB + (size_t)row * FF + u.col0 + 32 * wc + 8 * fq) = w; }
    }
};
template <bool ROUTED> struct EpiMoeDown {
    unsigned char* YQ; h16* YS;
    __device__ __forceinline__ void operator()(const ACC_T, const Unit& u, int wr, int wc, int fr, int fq) const {
        const int grp = (u.col0 >> 8) * 16 + 4 * wc + fq;
#pragma unroll
        for (int ai = 0; ai < 2; ++ai)
#pragma unroll
            for (int m = 0; m < 4; ++m) {
                const int r = 128 * ai + 64 * wr + 16 * m + fr; int id; if constexpr (ROUTED) id = u.oidl[r]; else id = (u.row0 + r) * 9 + 8;
                const f32x4 v0 = acc[ai][0][m][0], v1 = acc[ai][0][m][1], v2 = acc[ai][1][m][0], v3 = acc[ai][1][m][1];
                if constexpr (ROUTED) { u32x4 w; w.x = f8x4(v0 * 0.015625f); w.y = f8x4(v1 * 0.015625f); w.z = f8x4(v2 * 0.015625f); w.w = f8x4(v3 * 0.015625f);
                    *(u32x4*)(YQ + (size_t)id * 1024 + grp * 16) = w; }
                else {
                float mx = fmaxf(fmaxf(fabsf(v0[0]), fabsf(v0[1])), fmaxf(fabsf(v0[2]), fabsf(v0[3])));
                mx = fmaxf(mx, fmaxf(fmaxf(fabsf(v1[0]), fabsf(v1[1])), fmaxf(fabsf(v1[2]), fabsf(v1[3]))));
                mx = fmaxf(mx, fmaxf(fmaxf(fabsf(v2[0]), fabsf(v2[1])), fmaxf(fabsf(v2[2]), fabsf(v2[3]))));
                mx = fmaxf(mx, fmaxf(fmaxf(fabsf(v3[0]), fabsf(v3[1])), fmaxf(fabsf(v3[2]), fabsf(v3[3]))));
                const unsigned short sh = f2h(mx * (1.0f / 127.0f) * 1.0005f);
                const float scr = h2f(sh); const float inv = scr > 0.f ? __builtin_amdgcn_rcpf(scr) : 0.f;
                u32x4 w; w.x = q8x4(v0[0], v0[1], v0[2], v0[3], inv); w.y = q8x4(v1[0], v1[1], v1[2], v1[3], inv); w.z = q8x4(v2[0], v2[1], v2[2], v2[3], inv); w.w = q8x4(v3[0], v3[1], v3[2], v3[3], inv);
                *(u32x4*)(YQ + (size_t)id * 1024 + grp * 16) = w;
                *(unsigned short*)(YS + (size_t)id * 64 + grp) = sh; } }
    }
};

struct Args { const float* in[23]; float* out; unsigned char* ws; int ph_lo, ph_hi; };
struct Frame {
    LAS unsigned char* lds; int wave, vcu, G, gw, NGW;
};

__device__ __forceinline__ void ln_store(f32x4 (&v)[4], const float* gam, const float* bet, float* o32, h16* o16, int lane) {
    float s = 0.f;
#pragma unroll
    for (int j = 0; j < 4; ++j) s += (v[j].x + v[j].y) + (v[j].z + v[j].w);
    const float mean = wave_sum(s) * (1.f / D); float s2 = 0.f;
#pragma unroll
    for (int j = 0; j < 4; ++j) { v[j] = v[j] - mean; s2 += (v[j].x * v[j].x + v[j].y * v[j].y) + (v[j].z * v[j].z + v[j].w * v[j].w); }
    const float rstd = 1.f / sqrtf(wave_sum(s2) * (1.f / D) + LN_EPS);
#pragma unroll
    for (int j = 0; j < 4; ++j) { const f32x4 g = *(const f32x4*)(gam + 4 * lane + 256 * j), b = *(const f32x4*)(bet + 4 * lane + 256 * j); const f32x4 y = v[j] * rstd * g + b;
        *(f32x4*)(o32 + 4 * lane + 256 * j) = y; u32x2 w; w.x = cvt_pk_h16(y[0], y[1]); w.y = cvt_pk_h16(y[2], y[3]); *(u32x2*)(o16 + 4 * lane + 256 * j) = w; }
}


__device__ __forceinline__ void ln_store8(f32x4 (&v)[4], const float* gam, const float* bet, float* o32, h16* o16, int lane, int c0 = -1, int c1 = -1, unsigned char* o8 = nullptr) {
    if (c0 < 0) { c0 = 8 * lane; c1 = 512 + 8 * lane; }
    float s = 0.f;
#pragma unroll
    for (int j = 0; j < 4; ++j) s += (v[j].x + v[j].y) + (v[j].z + v[j].w);
    const float mean = wave_sum(s) * (1.f / D); float s2 = 0.f;
#pragma unroll
    for (int j = 0; j < 4; ++j) { v[j] = v[j] - mean; s2 += (v[j].x * v[j].x + v[j].y * v[j].y) + (v[j].z * v[j].z + v[j].w * v[j].w); }
    const float rstd = 1.f / sqrtf(wave_sum(s2) * (1.f / D) + LN_EPS);
    f32x4 y[4];
#pragma unroll
    for (int j = 0; j < 4; ++j) { const int c = ((j >> 1) ? c1 : c0) + 4 * (j & 1); const f32x4 g = *(const f32x4*)(gam + c), b = *(const f32x4*)(bet + c); y[j] = v[j] * rstd * g + b; if (o32) *(f32x4*)(o32 + c) = y[j]; }
    *(u32x4*)(o16 + c0) = pack8(y[0], y[1]); *(u32x4*)(o16 + c1) = pack8(y[2], y[3]);
    if (o8) { u32x2 w; w.x = f8x4(y[0]); w.y = f8x4(y[1]); *(u32x2*)(o8 + c0) = w; w.x = f8x4(y[2]); w.y = f8x4(y[3]); *(u32x2*)(o8 + c1) = w; }
}
__device__ __forceinline__ void tr_item(const float* W, int N, h16* WT, int ldt, int k0, int n0, int drow0, LAS float* scr, int lane) {
    float tv[32];
#pragma unroll
    for (int i = 0; i < 32; ++i) { const int kk = 2 * i + (lane >> 5); tv[i] = __builtin_nontemporal_load(W + (size_t)(k0 + kk) * N + n0 + (lane & 31)); }
#pragma unroll
    for (int i = 0; i < 32; ++i) { const int kk = 2 * i + (lane >> 5); scr[kk * 33 + (lane & 31)] = tv[i]; }
    asm volatile("s_waitcnt lgkmcnt(0)" ::: "memory");
    const int c = lane & 7;
#pragma unroll
    for (int j = 0; j < 4; ++j) { const int n = (lane >> 3) + 8 * j; const LAS float* s = scr + (8 * c) * 33 + n;
        u32x4 o; o.x = cvt_pk_h16(s[0 * 33], s[1 * 33]); o.y = cvt_pk_h16(s[2 * 33], s[3 * 33]); o.z = cvt_pk_h16(s[4 * 33], s[5 * 33]); o.w = cvt_pk_h16(s[6 * 33], s[7 * 33]);
        *(u32x4*)(WT + (size_t)(drow0 + n) * ldt + k0 + 8 * c) = o; }
    asm volatile("s_waitcnt lgkmcnt(0)" ::: "memory");
}
__device__ __forceinline__ void tr_item_f8(const float* W, int N, unsigned char* WT, int ldt, int k0, int n0, int drow0, LAS float* scr, int lane, float scale) {
    float tv[32];
#pragma unroll
    for (int i = 0; i < 32; ++i) { const int kk = 2 * i + (lane >> 5); tv[i] = __builtin_nontemporal_load(W + (size_t)(k0 + kk) * N + n0 + (lane & 31)); }
#pragma unroll
    for (int i = 0; i < 32; ++i) { const int kk = 2 * i + (lane >> 5); scr[kk * 33 + (lane & 31)] = tv[i]; }
    asm volatile("s_waitcnt lgkmcnt(0)" ::: "memory");
    const int c = lane & 7;
#pragma unroll
    for (int j = 0; j < 4; ++j) { const int n = (lane >> 3) + 8 * j; const LAS float* s = scr + (8 * c) * 33 + n;
        u32x2 o; o.x = f8x4((f32x4){s[0 * 33], s[1 * 33], s[2 * 33], s[3 * 33]} * scale); o.y = f8x4((f32x4){s[4 * 33], s[5 * 33], s[6 * 33], s[7 * 33]} * scale);
        *(u32x2*)(WT + (size_t)(drow0 + n) * ldt + k0 + 8 * c) = o; }
    asm volatile("s_waitcnt lgkmcnt(0)" ::: "memory");
}
__device__ __forceinline__ float f8_scale_of(const float* W, int lane) {
    const f32x4 q = *(const f32x4*)(W + 4 * lane); const float ma = wave_sum((fabsf(q.x) + fabsf(q.y)) + (fabsf(q.z) + fabsf(q.w))) * (1.2533f / 256.f);
    float t = 32.f / fmaxf(ma, 1e-30f); t = fminf(fmaxf(t, 1.0e-18f), 1.0e18f);
    return __uint_as_float(__builtin_amdgcn_readfirstlane(__float_as_uint(t)) & 0x7f800000u);
}
__device__ __forceinline__ void tr_item_hilo(const float* W, int N, h16* WT, int ldt, int k0, int n0, LAS float* scr, int lane) {
    float tv[32];
#pragma unroll
    for (int i = 0; i < 32; ++i) { const int kk = 2 * i + (lane >> 5); tv[i] = __builtin_nontemporal_load(W + (size_t)(k0 + kk) * N + n0 + (lane & 31)); }
#pragma unroll
    for (int i = 0; i < 32; ++i) { const int kk = 2 * i + (lane >> 5); scr[kk * 33 + (lane & 31)] = tv[i]; }
    asm volatile("s_waitcnt lgkmcnt(0)" ::: "memory");
    const int c = lane & 7;
#pragma unroll
    for (int j = 0; j < 4; ++j) { const int n = (lane >> 3) + 8 * j; const LAS float* s = scr + (8 * c) * 33 + n;
        float v[8], r[8];
#pragma unroll
        for (int q = 0; q < 8; ++q) { v[q] = s[q * 33]; r[q] = v[q] - h2f(f2h(v[q])); }
        u32x4 o; o.x = cvt_pk_h16(v[0], v[1]); o.y = cvt_pk_h16(v[2], v[3]); o.z = cvt_pk_h16(v[4], v[5]); o.w = cvt_pk_h16(v[6], v[7]);
        *(u32x4*)(WT + (size_t)(n0 + n) * ldt + k0 + 8 * c) = o;
        o.x = cvt_pk_h16(r[0], r[1]); o.y = cvt_pk_h16(r[2], r[3]); o.z = cvt_pk_h16(r[4], r[5]); o.w = cvt_pk_h16(r[6], r[7]);
        *(u32x4*)(WT + (size_t)(128 + n0 + n) * ldt + k0 + 8 * c) = o; }
    asm volatile("s_waitcnt lgkmcnt(0)" ::: "memory");
}


typedef float f32x16 __attribute__((ext_vector_type(16)));
constexpr int AT_KP = 144, AT_VP = 528, AT_VOFF = 256 * AT_KP;
__device__ __forceinline__ int crow(int r, int hi) { return (r & 3) + 8 * (r >> 2) + 4 * hi; }
struct KVRegs { u32x4 k[4], v[4]; };
__device__ __forceinline__ void attn_load_kv(const h16* HHp, const int b, const int n, const int hk, const int tid, KVRegs& r) {
    const int tb = b * SEQ + n * 128;
#pragma unroll
    for (int i = 0; i < 4; ++i) { const int idx = tid + 512 * i, key = idx >> 3, ch = idx & 7; const int tok = (n > 0) ? tb - 128 + key : tb + (key & 127);
        const h16* kp = HHp + (size_t)tok * DIN + C_K + hk * 64 + ch * 8; r.k[i] = *(const u32x4*)kp; r.v[i] = *(const u32x4*)(kp + 128); }
}
__device__ __forceinline__ void attn_unit(LAS unsigned char* lds, h16* HHp, unsigned char* OUTp, const float osc, const float* sinks, const int b, const int n, const int hk, const int tid,
                                          const int unused_ = 0) {
    const int lane = tid & 63, wid = __builtin_amdgcn_readfirstlane(tid >> 6), q32 = lane & 31, hi = lane >> 5;
    const int g = wid >> 1, qh = wid & 1, hq = hk * 4 + g;
    const int tb = b * SEQ + n * 128;
    LAS unsigned char* Ks = lds; LAS unsigned char* Vs = lds + AT_VOFF;
    KVRegs cur; attn_load_kv(HHp, b, n, hk, tid, cur);
    f16x8 qs[4];
    { const h16* qp = HHp + (size_t)(tb + 64 * qh + q32) * DIN + C_Q + hq * 64;
#pragma unroll
      for (int ks = 0; ks < 4; ++ks) qs[ks] = *(const f16x8*)(qp + 16 * ks + 8 * hi); }
#pragma unroll
    for (int i = 0; i < 4; ++i) { const int idx = tid + 512 * i, key = idx >> 3, ch = idx & 7; const u32x4 kw = cur.k[i], vw = cur.v[i];
        *(LAS u32x4*)(Ks + key * AT_KP + ch * 16) = kw;
        LAS unsigned short* vd = (LAS unsigned short*)(Vs + (ch * 8) * AT_VP + key * 2);
        vd[0 * (AT_VP / 2)] = (unsigned short)(vw.x & 0xffffu); vd[1 * (AT_VP / 2)] = (unsigned short)(vw.x >> 16); vd[2 * (AT_VP / 2)] = (unsigned short)(vw.y & 0xffffu); vd[3 * (AT_VP / 2)] = (unsigned short)(vw.y >> 16);
        vd[4 * (AT_VP / 2)] = (unsigned short)(vw.z & 0xffffu); vd[5 * (AT_VP / 2)] = (unsigned short)(vw.z >> 16); vd[6 * (AT_VP / 2)] = (unsigned short)(vw.w & 0xffffu); vd[7 * (AT_VP / 2)] = (unsigned short)(vw.w >> 16); }
    __syncthreads();
    const float slope = exp2f(-(float)(hq + 1)), sink = sinks[hq];
    float ab[16];
#pragma unroll
    for (int r = 0; r < 16; ++r) ab[r] = slope * (float)(crow(r, hi) - 128 - q32);
#pragma unroll 1
    for (int sub = 0; sub < 2; ++sub) {
        const int q0 = 64 * qh + 32 * sub, qi = q0 + q32;
        f32x16 sv[5]; float mx = -INFINITY;
#pragma unroll
        for (int j = 0; j < 5; ++j) { const int key0 = q0 + 32 * j; f32x16 c; float sl = slope; asm volatile("" : "+v"(sl)); const float aj = sl * (float)(32 * j);
#pragma unroll
            for (int r = 0; r < 16; ++r) c[r] = ab[r] + aj;
#pragma unroll
            for (int ks = 0; ks < 4; ++ks) { const f16x8 kf = *(const LAS f16x8*)(Ks + (key0 + q32) * AT_KP + (16 * ks + 8 * hi) * 2); c = __builtin_amdgcn_mfma_f32_32x32x16_f16(kf, qs[ks], c, 0, 0, 0); }
            const bool dead = (n == 0) && (key0 < 128);
            int hil = hi; asm volatile("" : "+v"(hil));
#pragma unroll
            for (int r = 0; r < 16; ++r) { float v = c[r];
                if (j == 0) v = (crow(r, hil) > q32) ? v : -INFINITY;
                if (j == 4) v = (crow(r, hil) <= q32) ? v : -INFINITY;
                if (dead) v = -INFINITY;
                c[r] = v; mx = fmaxf(mx, v); }
            sv[j] = c; __builtin_amdgcn_sched_barrier(0); }
        if (sub == 0) { const h16* qp = HHp + (size_t)(tb + 64 * qh + 32 + q32) * DIN + C_Q + hq * 64;
#pragma unroll
            for (int ks = 0; ks < 4; ++ks) qs[ks] = *(const f16x8*)(qp + 16 * ks + 8 * hi); }
        mx = fmaxf(mx, dppf_swap32(mx)); mx = fmaxf(mx, sink);
        float lsum = 0.f; f32x16 o0, o1;
#pragma unroll
        for (int r = 0; r < 16; ++r) { o0[r] = 0.f; o1[r] = 0.f; }
#pragma unroll
        for (int j = 0; j < 5; ++j) { const int key0 = q0 + 32 * j;
#pragma unroll
            for (int r = 0; r < 16; ++r) { const float pv = __expf(sv[j][r] - mx); sv[j][r] = pv; lsum += pv; }
#pragma unroll
            for (int cc = 0; cc < 2; ++cc) {
                u32x4 pw; pw.x = cvt_pk_h16(sv[j][8 * cc + 0], sv[j][8 * cc + 1]); pw.y = cvt_pk_h16(sv[j][8 * cc + 2], sv[j][8 * cc + 3]); pw.z = cvt_pk_h16(sv[j][8 * cc + 4], sv[j][8 * cc + 5]); pw.w = cvt_pk_h16(sv[j][8 * cc + 6], sv[j][8 * cc + 7]);
                const f16x8 pb = __builtin_bit_cast(f16x8, pw);
                const LAS unsigned char* vp = Vs + q32 * AT_VP + (key0 + 16 * cc + 4 * hi) * 2;
                { const u32x2 a0 = *(const LAS u32x2*)vp, a1 = *(const LAS u32x2*)(vp + 16); const u32x4 vw = {a0.x, a0.y, a1.x, a1.y}; o0 = __builtin_amdgcn_mfma_f32_32x32x16_f16(__builtin_bit_cast(f16x8, vw), pb, o0, 0, 0, 0); }
                { const u32x2 a0 = *(const LAS u32x2*)(vp + 32 * AT_VP), a1 = *(const LAS u32x2*)(vp + 32 * AT_VP + 16); const u32x4 vw = {a0.x, a0.y, a1.x, a1.y}; o1 = __builtin_amdgcn_mfma_f32_32x32x16_f16(__builtin_bit_cast(f16x8, vw), pb, o1, 0, 0, 0); }
                __builtin_amdgcn_sched_barrier(0);
            } }
        lsum += dppf_swap32(lsum); lsum += __expf(sink - mx);
        const float rl = 1.0f / lsum;
#pragma unroll
        for (int rg = 0; rg < 4; ++rg) {
            const float ro = rl * osc;
            unsigned char* op = OUTp + (size_t)(tb + qi) * 512 + hq * 64;
            *(unsigned*)(op + 8 * rg + 4 * hi) = f8x4((f32x4){o0[4 * rg], o0[4 * rg + 1], o0[4 * rg + 2], o0[4 * rg + 3]} * ro);
            *(unsigned*)(op + 32 + 8 * rg + 4 * hi) = f8x4((f32x4){o1[4 * rg], o1[4 * rg + 1], o1[4 * rg + 2], o1[4 * rg + 3]} * ro); }
    }
    __syncthreads();
}
template <int W> __device__ __forceinline__ void pool_pair(const h16* HHp, unsigned char* PDp, const float psc, const int c8, const int tA, const int tB) {
    u32x4 q[2][W];
#pragma unroll
    for (int p = 0; p < 2; ++p) { const int t = p ? tB : tA; const int s = t & (SEQ - 1); const h16* up = HHp + (size_t)t * DIN + C_U + c8 * 8;
#pragma unroll
        for (int i = 0; i < W; ++i) { const int ii = (i <= s) ? i : 0; q[p][i] = *(const u32x4*)(up - (size_t)ii * DIN); } }
#pragma unroll
    for (int p = 0; p < 2; ++p) { const int t = p ? tB : tA; const int s = t & (SEQ - 1); f32x4 a0 = {0.f, 0.f, 0.f, 0.f}, a1 = {0.f, 0.f, 0.f, 0.f}, u0, u1;
#pragma unroll
        for (int i = 0; i < W; ++i) { f32x4 v0, v1; unpack8(q[p][i], v0, v1); if (i == 0) { u0 = v0; u1 = v1; } if (i <= s) { a0 += v0; a1 += v1; } }
        const float rn = 1.0f / (float)((s + 1 < W) ? s + 1 : W);
        u32x2 w; w.x = f8x4((a0 * rn - u0) * psc); w.y = f8x4((a1 * rn - u1) * psc); *(u32x2*)(PDp + (size_t)t * 512 + c8 * 8) = w; }
}


__device__ __forceinline__ void prep_expert_items(const float* w_eg, const float* w_eu, const float* w_ed, unsigned char* egu_t, unsigned char* ed_t, float* wsc, int e_lo, int e_hi, int wrk, int nwrk, LAS float* scr, int lane) {
    for (int it = e_lo + wrk; it < e_hi; it += nwrk) {
        if (it < 2 * 8192) { const int up = it >> 13, q = it & 8191, e = q >> 7, q2 = q & 127, kb = q2 >> 3, nb = q2 & 7, n0 = 32 * nb;
            const float* Wm = (up ? w_eu : w_eg) + (size_t)e * D * FF; const float sc = f8_scale_of(Wm, lane); if (q2 == 0 && lane == 0) wsc[4 * e + up] = 1.0f / sc;
            tr_item_f8(Wm, FF, egu_t + (size_t)e * 512 * 1024, 1024, 64 * kb, n0, 256 * (n0 >> 7) + (n0 & 127) + 128 * up, scr, lane, sc); }
        else { const int r = it - 2 * 8192, e = r >> 7, q2 = r & 127, kb = q2 >> 5, nb = q2 & 31; const float* Wm = w_ed + (size_t)e * FF * D; const float sc = f8_scale_of(Wm, lane); if (q2 == 0 && lane == 0) wsc[4 * e + 2] = 1.0f / sc;
            tr_item_f8(Wm, D, ed_t + (size_t)e * 1024 * 256, 256, 64 * kb, 32 * nb, 32 * nb, scr, lane, sc); }
    }
}
#define W_EGU_P(lt) ((unsigned char*)(args.ws + (((lt) & 1) ? W_EGU_ALT : W_EGU_T)))
#define WSC_P(lt) ((float*)(args.ws + MS_WSC) + ((lt) & 1) * 256)
#define W_ED_P(lt)  ((unsigned char*)(args.ws + (((lt) & 1) ? W_ED_ALT : W_ED_T)))
#define PREP_EXPERTS(lt, e_lo, e_hi, wrk, nwrk) prep_expert_items(args.in[15] + (size_t)(lt) * NE * D * FF, args.in[16] + (size_t)(lt) * NE * D * FF, args.in[17] + (size_t)(lt) * NE * FF * D, W_EGU_P(lt), W_ED_P(lt), WSC_P(lt), e_lo, e_hi, wrk, nwrk, (LAS float*)(F.lds + F.wave * 16384), lane_id())
#ifndef P9_IPW
#define P9_IPW 5
#endif
constexpr int PE_A = 9830, PE_B = PE_A + 8602, PE_ALL = 3 * 8192;
#define PREP_WEIGHTS(E_LO) do { \
            LAS float* scr = (LAS float*)(F.lds + F.wave * 16384); \
            const float* w_in = L_W_IN; const float* w_br_attn = L_W_BRA; const float* w_out = L_W_OUT; const float* w_sg = L_W_SG; const float* w_su = L_W_SU; const float* w_sd = L_W_SD; \
            const float* w_eg = L_W_EG; const float* w_eu = L_W_EU; const float* w_ed = L_W_ED; const float* w_router = L_W_R; \
            constexpr int I_IN = 16 * 104, I_BA = 8 * 32, I_OUT = 16 * 32, I_SG = 16 * 8, I_SD = 4 * 32, I_EG = 64 * 128, I_ED = 64 * 128, I_R = 16 * 2; \
            constexpr int NITEMS = I_IN + I_BA + I_OUT + 2 * I_SG + I_SD + I_R; \
            for (int it = F.gw; it < NITEMS; it += F.NGW) { \
                int r = it; \
                if (r < I_IN) { const int kb = r / 104, nb = r % 104; const float sc = f8_scale_of(w_in, lane); if (r == 0 && lane == 0) *WSC_IN = 1.0f / sc; tr_item_f8(w_in, DIN, (unsigned char*)(args.ws + W_IN_T), 1024, 64 * kb, 32 * nb, 32 * nb, scr, lane, sc); continue; } r -= I_IN; \
                if (r < I_BA) { const int kb = r / 32, nb = r % 32; tr_item_f8(w_br_attn, D, (unsigned char*)(args.ws + W_BA_T), 512, 64 * kb, 32 * nb, 32 * nb, scr, lane, f8_scale_of(w_br_attn, lane)); continue; } r -= I_BA; \
                if (r < I_OUT) { const int kb = r / 32, nb = r % 32; const float sc = f8_scale_of(w_out, lane); if (r == 0 && lane == 0) WSC_IN[1] = 1.0f / sc; tr_item_f8(w_out, D, (unsigned char*)(args.ws + W_OUT_T), 1024, 64 * kb, 32 * nb, 32 * nb, scr, lane, sc); continue; } r -= I_OUT; \
                if (r < 2 * I_SG) { const int up = r / I_SG, q = r % I_SG, kb = q / 8, nb = q % 8, n0 = 32 * nb; tr_item(up ? w_su : w_sg, FF, (h16*)(args.ws + W_SGU_T), 1024, 64 * kb, n0, 256 * (n0 >> 7) + (n0 & 127) + 128 * up, scr, lane); continue; } r -= 2 * I_SG; \
                if (r < I_SD) { const int kb = r / 32, nb = r % 32; tr_item(w_sd, D, (h16*)(args.ws + W_SD_T), 256, 64 * kb, 32 * nb, 32 * nb, scr, lane); continue; } r -= I_SD; \
                { const int kb = r / 2, nb = r % 2; tr_item_hilo(w_router, NE, (h16*)(args.ws + W_R_T), 1024, 64 * kb, 32 * nb, scr, lane); } \
            } \
            PREP_EXPERTS(l, (E_LO), PE_ALL, F.gw, F.NGW); \
            { unsigned char* wpe = (unsigned char*)(args.ws + W_PE_T); const float* w_pool = L_W_POOL; const float* pool_scale = L_PSCALE; const float* w_br_pool = L_W_BRP; \
                \
              const float sc_pe = f8_scale_of(w_pool, lane) * f8_scale_of(w_br_pool, lane) * (1.0f / 512.0f), sc_ba = f8_scale_of(w_br_attn, lane), sc_i = f8_scale_of(w_in, lane); \
              if (F.gw == 0 && lane == 0) { float psc = sc_i * (1.0f / 256.0f); asm volatile("" : "+v"(psc)); const float osc = psc * 4.0f; WSC_IN[2] = psc; WSC_IN[3] = osc; WSC_IN[4] = (osc * sc_ba) / (psc * sc_pe); WSC_IN[5] = 16.0f / (osc * sc_ba); } \
              for (int idx = F.gw; idx < 512 * 16; idx += F.NGW) { const int cg = idx >> 4, n = ((idx & 15) << 6) + lane, g = cg >> 7; float s = 0.f; \
                  const float* wp = w_pool + (size_t)cg * 128; const float* ps = pool_scale + 128 * g; const float* wb = w_br_pool + (size_t)(128 * g) * D + n; \
                  float wv[128]; \
            _Pragma("unroll") \
                  for (int d = 0; d < 128; ++d) wv[d] = wb[(size_t)d * D]; \
            _Pragma("unroll") \
                  for (int d = 0; d < 128; ++d) s += wp[d] * ps[d] * wv[d]; \
                  wpe[(size_t)n * 512 + cg] = (unsigned char)(f8x4((f32x4){s, s, s, s} * sc_pe) & 0xffu); } } \
} while (0)
#define X32   (args.out)
#define XB    ((h16*)(args.ws + WS_XB))
#define XB8   ((unsigned char*)(args.ws + W_XB8))
#define WSC_IN ((float*)(args.ws + MS_WSC) + 512)
#define HH    ((h16*)(args.ws + R_HH))
#define PD8   ((unsigned char*)(args.ws + R_PD))
#define O8    ((unsigned char*)(args.ws + R_PD + 16 * MiB))
#define MG    ((h16*)(args.ws + R_MG))
#define HB    ((h16*)(args.ws + WS_HB))
#define HS    ((h16*)(args.ws + WS_HS))
#define YD    ((h16*)(args.ws + WS_R))
#define LOGIT ((float*)(args.ws + WS_HB))
#define ESEL  ((int*)(args.ws + MS_ESEL))
#define GATE  ((float*)(args.ws + MS_GATE))
#define RANKL ((int*)(args.ws + MS_RANK))
#define SLOT  ((int*)(args.ws + MS_SLOT))
#define TOKL  ((int*)(args.ws + MS_TOKL))
#define GATL  ((float*)(args.ws + MS_GATL))
#define WCNT  ((int*)(args.ws + MS_WCNT))
#define GTOT  ((int*)(args.ws + MS_GTOT))
#define BLKE  ((int*)(args.ws + MS_BLKE))
#define L_W_IN   (args.in[3] + (size_t)l * D * DIN)
#define L_B_IN   (args.in[4] + (size_t)l * DIN)
#define L_W_POOL (args.in[5] + (size_t)l * 4 * 128 * 128)
#define L_PSCALE (args.in[6] + (size_t)l * 512)
#define L_SINKS  (args.in[7] + (size_t)l * 8)
#define L_W_BRP  (args.in[8] + (size_t)l * 512 * D)
#define L_W_BRA  (args.in[9] + (size_t)l * 512 * D)
#define L_W_OUT  (args.in[10] + (size_t)l * D * D)
#define L_LN1G   (args.in[11] + (size_t)l * D)
#define L_LN1B   (args.in[12] + (size_t)l * D)
#define L_W_R    (args.in[13] + (size_t)l * D * NE)
#define L_RBIAS  (args.in[14] + (size_t)l * NE)
#define L_W_EG   (args.in[15] + (size_t)l * NE * D * FF)
#define L_W_EU   (args.in[16] + (size_t)l * NE * D * FF)
#define L_W_ED   (args.in[17] + (size_t)l * NE * FF * D)
#define L_W_SG   (args.in[18] + (size_t)l * D * FF)
#define L_W_SU   (args.in[19] + (size_t)l * D * FF)
#define L_W_SD   (args.in[20] + (size_t)l * FF * D)
#define L_LN2G   (args.in[21] + (size_t)l * D)
#define L_LN2B   (args.in[22] + (size_t)l * D)
__global__ void __launch_bounds__(512, 2) fwd_kernel(Args args) {
    extern __shared__ __attribute__((aligned(16))) unsigned char lds_raw[];
    Frame F;
    F.lds = (LAS unsigned char*)lds_raw;
    F.wave = __builtin_amdgcn_readfirstlane((int)threadIdx.x >> 6);
    F.G = gridDim.x; { const int bx = blockIdx.x; F.vcu = (F.G % 8 == 0) ? (bx % 8) * (F.G / 8) + bx / 8 : bx; }
    F.gw = F.vcu * 8 + F.wave; F.NGW = F.G * 8;
    unsigned* ctl = (unsigned*)(args.ws + WS_CTL);
    volatile LAS unsigned* MISC = (volatile LAS unsigned*)(F.lds + MISC_OFF);
    for (int u = threadIdx.x; u < (LDS_BYTES - LDSCTL_OFF) / 4; u += 512) ((LAS unsigned*)(F.lds + LDSCTL_OFF))[u] = 0u;
    __syncthreads();
#if MK_ONE_LAUNCH
    XcdBarrier bar = xcd_barrier_post(ctl + CW_BAR, MISC + 8);
#define GRID_BAR() xcd_barrier(bar, F.wave)
#else
#define GRID_BAR() do {} while (0)
#endif
    const int lo = args.ph_lo, hi = args.ph_hi;
#ifndef PHASE_MASK
#define PHASE_MASK 0xfff
#endif
#ifndef REPEAT_MASK
#define REPEAT_MASK 0
#endif
#define REPS(p) for (int rep_ = 0; rep_ < 1 + ((REPEAT_MASK >> (p)) & 1); ++rep_)
#define IN(p) (((PHASE_MASK >> ((p) - pb)) & 1) && lo <= (p) && (p) < hi)
#define PHASE_REGS const int lane = lane_id(); const int tid = F.wave * 64 + lane; int vcu = F.vcu, bx = (int)blockIdx.x; asm volatile("" : "+s"(vcu), "+s"(bx)); (void)lane; (void)tid; (void)vcu; (void)bx;

    for (int l = 0; l < DEPTH; ++l) {
        const int pb = l * NPH;
        if (IN(pb + 0) && l == 0) {
            PHASE_REGS
            PREP_WEIGHTS(0);
            for (int m = F.gw; m < T; m += F.NGW) { f32x4 v[4];
#pragma unroll
                for (int j = 0; j < 4; ++j) v[j] = *(const f32x4*)(args.in[0] + (size_t)m * D + 8 * lane + 4 * (j & 1) + 512 * (j >> 1));
                ln_store8(v, args.in[1], args.in[2], nullptr, XB + (size_t)m * D, lane, -1, -1, XB8 + (size_t)m * D); }
            GRID_BAR();
        }
        if (IN(pb + 1)) {
            PHASE_REGS
            SchedDense S; S.o.init(T, DIN, F.G, bx); S.a = (const char*)XB8; S.b = (const char*)(args.ws + W_IN_T); S.apitch = 1024; S.bpitch = 1024;
            EpiInProj E{HH, L_B_IN, *WSC_IN};
            REPS(1) GEMM_PHASE_F8(512, S, E);
            if (l + 1 < DEPTH && F.G == 256 && bx >= 128) PREP_EXPERTS(l + 1, 0, PE_A, (bx - 128) * 8 + F.wave, 128 * 8);
            GRID_BAR();
        }
        if (IN(pb + 2)) {
            PHASE_REGS
            { const int g = F.gw & 3, c8 = 16 * g + (lane & 15); const float psc = WSC_IN[2];
              for (int it = F.gw; it < T; it += 2 * F.NGW) { const int tA = (it >> 2) * 4 + (lane >> 4); const int it2 = (it + F.NGW < T) ? it + F.NGW : it; const int tB = (it2 >> 2) * 4 + (lane >> 4);
                  if (g == 0) pool_pair<2>(HH, PD8, psc, c8, tA, tB); else if (g == 1) pool_pair<4>(HH, PD8, psc, c8, tA, tB); else if (g == 2) pool_pair<8>(HH, PD8, psc, c8, tA, tB); else pool_pair<16>(HH, PD8, psc, c8, tA, tB); } }
            for (int U = vcu; U < NB * 16 * 2; U += F.G) attn_unit(F.lds, HH, O8, WSC_IN[3], L_SINKS, U >> 5, (U >> 1) & 15, U & 1, tid);
            GRID_BAR();
        }
        if (IN(pb + 3)) {
            PHASE_REGS
            SchedMerged S; S.o.init(T, D, F.G, bx); S.pd = (const char*)PD8; S.oo = (const char*)O8; S.wpe = (const char*)(args.ws + W_PE_T); S.wba = (const char*)(args.ws + W_BA_T);
            EpiMerged E{(unsigned char*)MG, HH, WSC_IN[4], WSC_IN[5]};
            REPS(3) GEMM_PHASE_F8(256, S, E);
            GRID_BAR();
        }
        if (IN(pb + 4)) {
            PHASE_REGS
            SchedDense S; S.o.init(T, D, F.G, bx); S.a = (const char*)MG; S.b = (const char*)(args.ws + W_OUT_T); S.apitch = 1024; S.bpitch = 1024;
            EpiResid E{(h16*)X32, XB, WSC_IN[1] * 0.0625f};
            REPS(4) GEMM_PHASE_F8(512, S, E);
            GRID_BAR();
        }
        if (IN(pb + 5)) {
            PHASE_REGS
            for (int m0 = F.gw; m0 < T; m0 += 4 * F.NGW) { u32x4 ra[4], rb4[4];
#pragma unroll
                for (int q = 0; q < 4; ++q) { const int m = (m0 + q * F.NGW < T) ? m0 + q * F.NGW : m0; const h16* sp = (const h16*)X32 + (size_t)m * D + 8 * lane;
                    ra[q] = __builtin_nontemporal_load((const u32x4*)sp); rb4[q] = __builtin_nontemporal_load((const u32x4*)(sp + 512)); }
#pragma unroll
                for (int q = 0; q < 4; ++q) { const int m = m0 + q * F.NGW; if (m < T) { f32x4 v[4]; unpack8(ra[q], v[0], v[1]); unpack8(rb4[q], v[2], v[3]); ln_store8(v, L_LN1G, L_LN1B, nullptr, XB + (size_t)m * D, lane, -1, -1, XB8 + (size_t)m * D); } } }
            GRID_BAR();
        }
        if (IN(pb + 6)) {
            PHASE_REGS
            SchedSharedRouter S{F.G, vcu, (const char*)XB, (const char*)(args.ws + W_SGU_T), (const char*)(args.ws + W_R_T)};
            EpiSharedRouter E{HS, LOGIT};
            REPS(6) GEMM_PHASE(1024, S, E);
            GRID_BAR();
        }
        if (IN(pb + 7)) {
            PHASE_REGS
            LAS int* lcnt = (LAS int*)(F.lds);
            const float rb = L_RBIAS[lane];
            const float dsc = WSC_P(l)[4 * lane] * WSC_P(l)[4 * lane + 1] * WSC_P(l)[4 * lane + 2] * 4194304.0f;
            REPS(7) for (int w = vcu; w < 256; w += F.G) {
                int mycnt = 0; const int t0 = w * 128 + F.wave * 16;
                float lgs[16];
#pragma unroll
                for (int tt = 0; tt < 16; ++tt) lgs[tt] = LOGIT[(size_t)(t0 + tt) * NE + lane] + LOGIT[(size_t)T * NE + (size_t)(t0 + tt) * NE + lane];
#pragma unroll
                for (int tt = 0; tt < 16; ++tt) { const int t = t0 + tt;
                    const float lg = lgs[tt]; const float scv = 1.0f / (1.0f + __expf(-lg)); const float bs = scv + rb;
                    const float m1 = max8(bs);
                    const unsigned long long eq = __ballot(bs == m1); const int g = lane >> 3; const unsigned gm = (unsigned)(eq >> (8 * g)) & 0xffu; const int first = __builtin_ctz(gm);
                    const float m2 = max8(((lane & 7) == first) ? -INFINITY : bs);
                    const float gs = m1 + m2; int grank = 0;
#pragma unroll
                    for (int j = 0; j < 8; ++j) { const float gj = rdlane(gs, 8 * j); grank += (gj > gs || (gj == gs && j < g)) ? 1 : 0; }
                    const bool keep = grank < 4; const float v = keep ? bs : -INFINITY; int rank = 0;
#pragma unroll
                    for (int j = 0; j < 64; ++j) { const float vj = rdlane(v, j); rank += (vj > v || (vj == v && j < lane)) ? 1 : 0; }
                    const bool sel = keep && rank < 8;
                    const float ssum = wave_sum(sel ? scv : 0.f);
                    if (sel) { ESEL[t * 8 + rank] = lane; GATE[t * 8 + rank] = scv / ssum * 2.5f * dsc; RANKL[t * 8 + rank] = mycnt; mycnt++; }
                }
                WCNT[(size_t)(w * 8 + F.wave) * 64 + lane] = mycnt;
                lcnt[F.wave * 64 + lane] = mycnt;
                __syncthreads();
                if (F.wave == 0) { int s = 0;
#pragma unroll
                    for (int v = 0; v < 8; ++v) s += lcnt[v * 64 + lane];
                    GTOT[w * 64 + lane] = s; }
                __syncthreads();
            }
            GRID_BAR();
        }
        if (IN(pb + 8)) {
            PHASE_REGS
            REPS(8) for (int w = vcu; w < 256; w += F.G) {
                int tot = 0, before = 0;
#pragma unroll 64
                for (int w2 = 0; w2 < 256; ++w2) { const int c = GTOT[w2 * 64 + lane]; tot += c; before += (w2 < w) ? c : 0; }
                for (int v2 = 0; v2 < F.wave; ++v2) before += WCNT[(size_t)(w * 8 + v2) * 64 + lane];
                const int pc = (tot + 255) & ~255; int incl = pc;
#pragma unroll
                for (int o = 1; o < 64; o <<= 1) { const int xv = __shfl_up(incl, o); if (lane >= o) incl += xv; }
                const int pstart = incl - pc, base = pstart + before; const int t0 = w * 128 + F.wave * 16;
#pragma unroll
                for (int it = 0; it < 2; ++it) { const int idx = it * 64 + lane, tt = t0 + (idx >> 3), k = idx & 7; const int e = ESEL[tt * 8 + k], r = RANKL[tt * 8 + k]; const float g = GATE[tt * 8 + k];
                    const int dest = __shfl(base, e) + r; TOKL[dest] = tt * 9 + k; GATL[dest] = g; }
                if (F.wave == 0 && w < 64) {
                    const int ps_ = __shfl(pstart, w), te = __shfl(tot, w), pe = __shfl(pc, w);
                    for (int i2 = te + lane; i2 < pe; i2 += 64) { TOKL[ps_ + i2] = YT_DUMP; GATL[ps_ + i2] = 0.f; } }
                if (F.wave == 1) {
                    const int nblk = __shfl(incl, 63) >> 8; const int rbk = 8 * w + (lane & 7); int cnt = 0;
                    for (int e = 0; e < 64; ++e) { const int pend = __shfl(incl, e); cnt += (pend <= rbk * 256) ? 1 : 0; }
                    if (lane < 8 && rbk < nblk) BLKE[rbk] = cnt < 63 ? cnt : 63;
                    if (w == 0 && lane == 0) BLKE[NBLK_MAX] = nblk; }
            }
            GRID_BAR();
        }
        if (IN(pb + 9)) {
            PHASE_REGS
            const int nblk = __builtin_amdgcn_readfirstlane(BLKE[NBLK_MAX]);
            { LAS int* bl = (LAS int*)(F.lds + LDS_BLKE); for (int i = tid; i < nblk; i += 512) bl[i] = BLKE[i]; __syncthreads(); }
            SchedMoeGU S{F.G, vcu, nblk, (const char*)(args.ws + W_XB8), (const char*)W_EGU_P(l), (const LAS int*)(F.lds + LDS_BLKE), TOKL};
            EpiMoeGU E{(unsigned char*)HB, WSC_P(l)};
            REPS(9) GEMM_PHASE_F8(512, S, E);
            { const int rounds = (2 * nblk + 255) >> 8, busy = 2 * nblk - 256 * (rounds - 1);
              const int n9 = min(PE_ALL - PE_A, (256 - busy) * 8 * P9_IPW);
              if (l + 1 < DEPTH && F.G == 256 && vcu >= busy) PREP_EXPERTS(l + 1, PE_A, PE_A + n9, (vcu - busy) * 8 + F.wave, (256 - busy) * 8); }
            GRID_BAR();
        }
        if (IN(pb + 10)) {
            PHASE_REGS
            const int nblk = __builtin_amdgcn_readfirstlane(BLKE[NBLK_MAX]);
            { LAS int* bl = (LAS int*)(F.lds + LDS_BLKE); for (int i = tid; i < nblk; i += 512) bl[i] = BLKE[i]; __syncthreads(); }
            { SchedShDown S{F.G, vcu, (const char*)HS, (const char*)(args.ws + W_SD_T)};
              EpiMoeDown<false> E{(unsigned char*)(args.ws + WS_R), (h16*)(args.ws + R_YS)};
              GEMM_PHASE(256, S, E); }
            __syncthreads();
            { SchedMoeDownR S{F.G, vcu, nblk, (const char*)HB, (const char*)W_ED_P(l), (const LAS int*)(F.lds + LDS_BLKE), TOKL};
              EpiMoeDown<true> E{(unsigned char*)(args.ws + WS_R), (h16*)(args.ws + R_YS)};
              REPS(10) GEMM_PHASE_F8(128, S, E); }
            GRID_BAR();
        }
        if (IN(pb + 11)) {
            PHASE_REGS
            { float* xo = (l == DEPTH - 1) ? X32 : nullptr;
            const unsigned char* YQ = (const unsigned char*)(args.ws + WS_R); const h16* YS = (const h16*)(args.ws + R_YS);
            const int c0 = 256 * (lane >> 4) + 32 * ((lane >> 2) & 3) + 8 * (lane & 3), c1 = c0 + 128;
            for (int m0_ = F.gw; m0_ < T; m0_ += 2 * F.NGW) { int m0 = m0_; asm volatile("" : "+s"(m0));
                u32x4 yq[2][9], xa[2], xb2[2]; unsigned short ys[2]; float gt[2];
#pragma unroll
                for (int q = 0; q < 2; ++q) { const int m = (m0 + q * F.NGW < T) ? m0 + q * F.NGW : m0;
                    xa[q] = *(const u32x4*)(XB + (size_t)m * D + c0); xb2[q] = *(const u32x4*)(XB + (size_t)m * D + c1); gt[q] = GATE[(size_t)m * 8 + (lane & 7)];
#pragma unroll
                    for (int k = 0; k < 9; ++k) yq[q][k] = __builtin_nontemporal_load((const u32x4*)(YQ + ((size_t)m * 9 + k) * 1024 + lane * 16));
                    ys[q] = __builtin_nontemporal_load((const unsigned short*)(YS + ((size_t)m * 9 + 8) * 64 + lane)); }
#pragma unroll
                for (int q = 0; q < 2; ++q) { const int m = m0 + q * F.NGW; if (m < T) {
                    f32x4 v[4]; unpack8(xa[q], v[0], v[1]); unpack8(xb2[q], v[2], v[3]);
#pragma unroll
                    for (int j = 0; j < 4; ++j) v[j] = v[j] * ALPHA;
#pragma unroll
                    for (int k = 0; k < 8; ++k) { const float gk = rdlane(gt[q], k);
#pragma unroll
                        for (int j = 0; j < 4; ++j) { const f32x2 lo = __builtin_amdgcn_cvt_pk_f32_fp8((int)yq[q][k][j], false), hi = __builtin_amdgcn_cvt_pk_f32_fp8((int)yq[q][k][j], true);
                            v[j][0] += lo.x * gk; v[j][1] += lo.y * gk; v[j][2] += hi.x * gk; v[j][3] += hi.y * gk; }
                        __builtin_amdgcn_sched_barrier(0); }
                    { const float sc = h2f(ys[q]); const float bias = -128.0f * sc;
#pragma unroll
                        for (int j = 0; j < 4; ++j) { const unsigned wd = yq[q][8][j] ^ 0x80808080u;
                            v[j][0] += (float)(wd & 0xffu) * sc + bias; v[j][1] += (float)((wd >> 8) & 0xffu) * sc + bias; v[j][2] += (float)((wd >> 16) & 0xffu) * sc + bias; v[j][3] += (float)(wd >> 24) * sc + bias; } }
                    ln_store8(v, L_LN2G, L_LN2B, xo ? xo + (size_t)m * D : nullptr, XB + (size_t)m * D, lane, c0, c1, XB8 + (size_t)m * D); } } } }
            if (l + 1 < DEPTH) { const int nblk_ = __builtin_amdgcn_readfirstlane(BLKE[NBLK_MAX]); const int rounds_ = (2 * nblk_ + 255) >> 8, busy_ = 2 * nblk_ - 256 * (rounds_ - 1);
                const int e_lo = (F.G != 256) ? 0 : PE_A + min(PE_ALL - PE_A, (256 - busy_) * 8 * P9_IPW);
                ++l; PREP_WEIGHTS(e_lo); --l; }
            if (pb + 11 != DEPTH * NPH - 1) GRID_BAR();
        }
    }
#undef IN
}

extern "C" void kernel_launch(void* const* d_in, const int* in_sizes, int n_in, void* d_out, int out_size, void* d_ws, size_t ws_size, hipStream_t stream) {
    static int grid = 0;
    if (grid == 0) {
        if (n_in != 23 || out_size != T * D || ws_size < WS_END2) { fprintf(stderr, "kernel_launch: unexpected shapes (n_in %d out %d ws %zu)\n", n_in, out_size, ws_size); grid = -1; return; }
        int dev = 0, cus = 0;
        if (hipGetDevice(&dev) != hipSuccess || hipDeviceGetAttribute(&cus, hipDeviceAttributeMultiprocessorCount, dev) != hipSuccess) { grid = -1; return; }
        if (hipFuncSetAttribute((const void*)fwd_kernel, hipFuncAttributeMaxDynamicSharedMemorySize, LDS_BYTES) != hipSuccess) { fprintf(stderr, "kernel_launch: hipFuncSetAttribute failed\n"); grid = -1; return; }
        int per_cu = 0;
        if (hipOccupancyMaxActiveBlocksPerMultiprocessor(&per_cu, (const void*)fwd_kernel, 512, LDS_BYTES) != hipSuccess || per_cu < 1) { fprintf(stderr, "kernel_launch: occupancy query says %d\n", per_cu); }
        (void)hipGetLastError();
        grid = cus;
    }
    if (grid < 0) return;
    (void)hipMemsetAsync((char*)d_ws + WS_CTL, 0, CTL_ZERO_BYTES, stream);
    Args a{};
    for (int i = 0; i < 23; ++i) a.in[i] = (const float*)d_in[i];
    a.out = (float*)d_out; a.ws = (unsigned char*)d_ws;
#if MK_ONE_LAUNCH
    a.ph_lo = 0; a.ph_hi = DEPTH * NPH;
    hipLaunchKernelGGL(fwd_kernel, dim3(grid), dim3(512), LDS_BYTES, stream, a);
#else
    for (int p = 0; p < DEPTH * NPH; ++p) { a.ph_lo = p; a.ph_hi = p + 1; hipLaunchKernelGGL(fwd_kernel, dim3(grid), dim3(512), LDS_BYTES, stream, a); }
#endif
}
```

```cpp
#include <hip/hip_runtime.h>
#include <stdint.h>
#include <stdio.h>

#ifndef MK_ONE_LAUNCH
#define MK_ONE_LAUNCH 1
#endif

#define GAS __attribute__((address_space(1)))
#define LAS __attribute__((address_space(3)))
typedef unsigned short h16;
typedef short h16x8 __attribute__((ext_vector_type(8)));
typedef float f32x4 __attribute__((ext_vector_type(4)));
typedef float f32x2 __attribute__((ext_vector_type(2)));
typedef unsigned u32x4 __attribute__((ext_vector_type(4)));
typedef unsigned u32x2 __attribute__((ext_vector_type(2)));

constexpr int NB = 16, SEQ = 2048, T = NB * SEQ, D = 1024, DIN = 3328, DEPTH = 4;
constexpr int C_U = 0, C_Q = 512, C_K = 1024, C_V = 1152, C_GP = 1280, C_GA = 2304;
constexpr int NE = 64, FF = 256, TOPK = 8;
constexpr int NASSIGN = T * TOPK;
constexpr int NBLK_MAX = NASSIGN / 256 + NE;
constexpr int A_PAD = NBLK_MAX * 256;
constexpr float ALPHA = 1.6817928305074290f;
constexpr float LN_EPS = 1e-5f;
constexpr int NPH = 12;

constexpr size_t MiB = 1u << 20;
constexpr size_t WS_CTL = 0, CTL_ZERO_BYTES = 1 * MiB;
constexpr size_t WS_W = 1 * MiB;
constexpr size_t W_IN_T = WS_W + 0 * MiB;
constexpr size_t W_PE_T = WS_W + 7 * MiB;
constexpr size_t W_BA_T = WS_W + 8 * MiB;
constexpr size_t W_OUT_T = WS_W + 9 * MiB;
constexpr size_t W_R_T = WS_W + 11 * MiB;
constexpr size_t W_SGU_T = WS_W + 12 * MiB;
constexpr size_t W_SD_T = WS_W + 13 * MiB;
constexpr size_t W_EGU_T = WS_W + 14 * MiB;
constexpr size_t W_ED_T = WS_W + 78 * MiB;
constexpr size_t W_XB8 = W_EGU_T + 32 * MiB;
constexpr size_t WS_XB = 111 * MiB;
constexpr size_t WS_HB = 175 * MiB;
constexpr size_t WS_HS = 311 * MiB;
constexpr size_t WS_MISC = 327 * MiB;
constexpr size_t MS_LOGIT = WS_MISC;
constexpr size_t MS_ESEL = WS_MISC + 8 * MiB;
constexpr size_t MS_GATE = WS_MISC + 9 * MiB;
constexpr size_t MS_RANK = WS_MISC + 10 * MiB;
constexpr size_t MS_SLOT = WS_MISC + 11 * MiB;
constexpr size_t MS_TOKL = WS_MISC + 12 * MiB;
constexpr size_t MS_GATL = WS_MISC + 13 * MiB + 256 * 1024;
constexpr size_t MS_WCNT = WS_MISC + 14 * MiB + 512 * 1024;
constexpr size_t MS_GTOT = WS_MISC + 15 * MiB;
constexpr size_t MS_BLKE = WS_MISC + 15 * MiB + 256 * 1024;
constexpr size_t MS_WSC = WS_MISC + 15 * MiB + 512 * 1024;
constexpr size_t WS_R = 343 * MiB;
constexpr size_t R_HH = WS_R;
constexpr size_t R_PD = WS_R + 208 * MiB;
constexpr size_t R_MG = WS_R + 240 * MiB;
constexpr size_t WS_END = WS_R + 577 * MiB;
constexpr size_t W_EGU_ALT = WS_END;
constexpr size_t W_ED_ALT = WS_END + 64 * MiB;
constexpr size_t WS_END2 = WS_END + 96 * MiB;
constexpr size_t R_YS = WS_R + 296 * MiB;
constexpr int YT_DUMP = T * 9;
static_assert((size_t)A_PAD * 4 <= 1 * MiB + 256 * 1024, "toklist");
static_assert((size_t)A_PAD * 256 * 2 <= 136 * MiB, "Hbuf");
static_assert(((size_t)T * 9 + 1) * 1024 * 2 <= 577 * MiB, "Yt");

constexpr int CW_BAR = 4096;

constexpr int RING_BYTES = 131072;
constexpr int LDSCTL_OFF = RING_BYTES, MISC_OFF = LDSCTL_OFF + 320;
constexpr int LDS_BYTES = 147456;
constexpr int LDS_BLKE = LDSCTL_OFF + 1024;
constexpr int LDS_IDX = LDS_BLKE + 4352;
constexpr int LDS_OID = LDS_IDX + 2048;
static_assert(LDS_OID + 3072 <= LDS_BYTES, "LDS map");

#define RLX_AGENT __ATOMIC_RELAXED, __HIP_MEMORY_SCOPE_AGENT
__device__ __forceinline__ int lane_id() { int l; asm volatile("v_mbcnt_lo_u32_b32 %0, -1, 0\n\tv_mbcnt_hi_u32_b32 %0, -1, %0" : "=v"(l)); return l; }
typedef _Float16 f16x2 __attribute__((ext_vector_type(2)));
typedef _Float16 f16x8 __attribute__((ext_vector_type(8)));
__device__ __forceinline__ float h2f(unsigned short h) { return (float)__builtin_bit_cast(_Float16, h); }
__device__ __forceinline__ unsigned short f2h(float f) { return __builtin_bit_cast(unsigned short, (_Float16)f); }
__device__ __forceinline__ unsigned cvt_pk_h16(float lo, float hi) { f32x2 v = {lo, hi}; return __builtin_bit_cast(unsigned, __builtin_convertvector(v, f16x2)); }
__device__ __forceinline__ float lo16(unsigned w) { return (float)__builtin_bit_cast(f16x2, w)[0]; }
__device__ __forceinline__ float hi16(unsigned w) { return (float)__builtin_bit_cast(f16x2, w)[1]; }
__device__ __forceinline__ float sigmoidf_(float x) { return __builtin_amdgcn_rcpf(1.0f + __builtin_amdgcn_exp2f(-1.4426950408889634f * x)); }
template <int CTRL> __device__ __forceinline__ float dppf(float x) { return __builtin_bit_cast(float, __builtin_amdgcn_update_dpp(0, __builtin_bit_cast(int, x), CTRL, 0xf, 0xf, true)); }
__device__ __forceinline__ float rdlane(float x, int l) { return __builtin_bit_cast(float, __builtin_amdgcn_readlane(__builtin_bit_cast(int, x), l)); }
__device__ __forceinline__ float wave_sum(float v) {
    v += dppf<0xB1>(v); v += dppf<0x4E>(v); v += dppf<0x141>(v); v += dppf<0x140>(v);
    return (rdlane(v, 0) + rdlane(v, 16)) + (rdlane(v, 32) + rdlane(v, 48));
}
__device__ __forceinline__ float wave_max(float v) {
    v = fmaxf(v, dppf<0xB1>(v)); v = fmaxf(v, dppf<0x4E>(v)); v = fmaxf(v, dppf<0x141>(v)); v = fmaxf(v, dppf<0x140>(v));
    return fmaxf(fmaxf(rdlane(v, 0), rdlane(v, 16)), fmaxf(rdlane(v, 32), rdlane(v, 48)));
}
__device__ __forceinline__ float dppf_swap32(float x) { return __shfl_xor(x, 32); }
__device__ __forceinline__ float max8(float v) {
    v = fmaxf(v, dppf<0xB1>(v)); v = fmaxf(v, dppf<0x4E>(v)); return fmaxf(v, dppf<0x141>(v));
}

#define XB_TMO      128
#define XB_XCNT(j)  (256  + 64 * (j))
#define XB_XSUB(j)  (1280 + 64 * (j))
#define XB_XGEN(j)  (2304 + 64 * (j))
#define XB_TOP      3328
#define XB_TOPGEN   3392
#define XCD_BAR_WORDS 3456
#define XB_SPIN_CAP (1u << 18)
__device__ __forceinline__ unsigned xb_ld(unsigned* p)              { return __hip_atomic_load(p, __ATOMIC_RELAXED, __HIP_MEMORY_SCOPE_AGENT); }
__device__ __forceinline__ unsigned xb_add(unsigned* p, unsigned v) { return __hip_atomic_fetch_add(p, v, __ATOMIC_RELAXED, __HIP_MEMORY_SCOPE_AGENT); }
__device__ __forceinline__ unsigned xb_xcc_id() { return (unsigned)__builtin_amdgcn_s_getreg((3 << 11) | 20) & 0xFu; }
#define XB_SPIN(cond, bar) do { unsigned _sp = 0; while (cond) { __builtin_amdgcn_s_sleep(1); \
    if ((++_sp & 255u) == 0u) { if (xb_ld(&(bar)[XB_TMO])) break; if (_sp > XB_SPIN_CAP) { atomicAdd(&(bar)[XB_TMO], 1u); break; } } } } while (0)
struct XcdBarrier { unsigned* bar; unsigned x; volatile LAS unsigned* st; };
__device__ __forceinline__ XcdBarrier xcd_barrier_post(unsigned* bar, volatile LAS unsigned* st) {
    XcdBarrier b; b.bar = bar; b.x = xb_xcc_id(); b.st = st;
    if (threadIdx.x == 0) (void)xb_add(&bar[XB_XCNT(b.x)], 1u);
    return b;
}
__device__ __forceinline__ void xcd_barrier_complete(unsigned* bar, unsigned x, unsigned& nloc, unsigned& nx) {
    const unsigned G = gridDim.x * gridDim.y * gridDim.z;
    unsigned sum, cnt, mine, sp = 0u;
    for (;;) {
        sum = 0u; cnt = 0u; mine = 0u;
#pragma unroll
        for (unsigned j = 0; j < 16; ++j) { const unsigned c = xb_ld(&bar[XB_XCNT(j)]); sum += c; cnt += (c > 0u) ? 1u : 0u; mine = (j == x) ? c : mine; }
        if (sum == G) break;
        __builtin_amdgcn_s_sleep(1);
        if ((++sp & 255u) == 0u) { if (xb_ld(&bar[XB_TMO])) break; if (sp > XB_SPIN_CAP) { atomicAdd(&bar[XB_TMO], 1u); break; } }
    }
    nloc = mine > 0u ? mine : 1u; nx = cnt > 0u ? cnt : 1u;
}
__device__ __forceinline__ void xcd_barrier(const XcdBarrier& b, const int wave) {
    asm volatile("s_waitcnt vmcnt(0)" ::: "memory");
    __syncthreads();
    if (wave == 0 && lane_id() == 0) {
        unsigned* bar = b.bar;
        __builtin_amdgcn_s_waitcnt(0);
        unsigned nloc = b.st[0], nx = b.st[1];
        if (nloc == 0u) { xcd_barrier_complete(bar, b.x, nloc, nx); b.st[0] = nloc; b.st[1] = nx; }
        const unsigned old = xb_add(&bar[XB_XSUB(b.x)], 1u);
        const unsigned gen = old / nloc;
        if (old + 1u == (gen + 1u) * nloc) {
            __builtin_amdgcn_fence(__ATOMIC_RELEASE, "agent");
            asm volatile("s_waitcnt vmcnt(0)" ::: "memory");
            const unsigned og = xb_add(&bar[XB_TOP], 1u);
            const unsigned tg = og / nx;
            if (og + 1u == (tg + 1u) * nx) xb_add(&bar[XB_TOPGEN], 1u);
            else XB_SPIN(xb_ld(&bar[XB_TOPGEN]) == tg, bar);
            __builtin_amdgcn_fence(__ATOMIC_ACQUIRE, "agent");
            xb_add(&bar[XB_XGEN(b.x)], 1u);
            asm volatile("s_waitcnt vmcnt(0)" ::: "memory");
        } else {
            XB_SPIN(xb_ld(&bar[XB_XGEN(b.x)]) == gen, bar);
            __builtin_amdgcn_fence(__ATOMIC_ACQUIRE, "agent");
            asm volatile("s_waitcnt vmcnt(0)" ::: "memory");
        }
    }
    __syncthreads();
}

struct Unit {
    const char* a;
    const char* b;
    const int* ridx;
    unsigned apitch, bpitch;
    int row0;
    int col0;
    int kind;
    const int* oidx;
    const LAS int* oidl;
    int nt;
    int keep;
};
__device__ __forceinline__ int id2tok(int id) { const int t = (int)(((unsigned long long)(unsigned)id * 954437177ull) >> 33); return t < T ? t : T - 1; }
#define ACC_T f32x4 (&acc)[2][2][4][2]

template <class Epi, class Sched>
__device__ __forceinline__ void gemm_phase_simple(const int wid, const int K, const Sched& S, const Epi& E) {
    const int lane = lane_id(), tid = wid * 64 + lane; (void)tid;
    const int  wr = wid >> 2, wc = wid & 3, fr = lane & 15, fq = lane >> 4;
    Unit u;
    for (int i = 0; S.next(i, u); ++i) {
        f32x4 acc[2][2][4][2];
#pragma unroll
        for (int a = 0; a < 2; ++a)
#pragma unroll
            for (int b = 0; b < 2; ++b)
#pragma unroll
                for (int m = 0; m < 4; ++m)
#pragma unroll
                    for (int n = 0; n < 2; ++n) acc[a][b][m][n] = (f32x4){0.f, 0.f, 0.f, 0.f};
        unsigned offA[2][4], offB[2][2];
#pragma unroll
        for (int ai = 0; ai < 2; ++ai)
#pragma unroll
            for (int m = 0; m < 4; ++m) { const int r = 128 * ai + 64 * wr + 16 * m + fr; const int row = u.ridx ? id2tok(u.ridx[r]) : u.row0 + r; offA[ai][m] = (unsigned)row * u.apitch + (unsigned)fq * 16u; }
#pragma unroll
        for (int bj = 0; bj < 2; ++bj)
#pragma unroll
            for (int n = 0; n < 2; ++n) { const int wrow = 128 * bj + 32 * wc + 8 * (fr >> 2) + 4 * n + (fr & 3); offB[bj][n] = (unsigned)wrow * u.bpitch + (unsigned)fq * 16u; }
#pragma unroll 1
        for (int k0 = 0; k0 < K; k0 += 32) {
            h16x8 b[2][2];
#pragma unroll
            for (int bj = 0; bj < 2; ++bj)
#pragma unroll
                for (int n = 0; n < 2; ++n) b[bj][n] = *(const h16x8*)(u.b + offB[bj][n] + (size_t)k0 * 2);
#pragma unroll
            for (int ai = 0; ai < 2; ++ai) {
                h16x8 a[4];
#pragma unroll
                for (int m = 0; m < 4; ++m) a[m] = *(const h16x8*)(u.a + offA[ai][m] + (size_t)k0 * 2);
#pragma unroll
                for (int bj = 0; bj < 2; ++bj)
#pragma unroll
                    for (int m = 0; m < 4; ++m)
#pragma unroll
                        for (int n = 0; n < 2; ++n) acc[ai][bj][m][n] = __builtin_amdgcn_mfma_f32_16x16x32_f16(__builtin_bit_cast(f16x8, b[bj][n]), __builtin_bit_cast(f16x8, a[m]), acc[ai][bj][m][n], 0, 0, 0);
                asm volatile("" ::: "memory");
            }
        }
        u.oidl = nullptr;
        E(acc, u, wr, wc, fr, fq);
    }
}


#ifndef FAST_GEMM
#define FAST_GEMM 1
#endif
constexpr int HTB = 128 * 64 * 2;
__device__ __forceinline__ int lds_byte(int r, int c) { const int st = (r >> 4) * 2 + (c >> 5), rr = r & 15, cc = c & 31, ob = rr * 64 + cc * 2; return st * 1024 + (ob ^ (((ob >> 9) & 1) << 5)); }
__device__ __forceinline__ void stage_rc(int b, int& R, int& C) { const int st = b / 1024, sb = b % 1024, swz = sb ^ (((sb >> 9) & 1) << 5); R = (st >> 1) * 16 + swz / 64; C = (st & 1) * 32 + (swz % 64) / 2; }
__device__ __forceinline__ int perm32(int rho) { const int n = rho >> 4, i = rho & 15; return 8 * (i >> 2) + 4 * n + (i & 3); }

__device__ __forceinline__ const char* uptr(const char* p) { const unsigned long long v = (unsigned long long)p; const unsigned lo = __builtin_amdgcn_readfirstlane((unsigned)v), hi = __builtin_amdgcn_readfirstlane((unsigned)(v >> 32)); return (const char*)(((unsigned long long)hi << 32) | lo); }
typedef int i32x8 __attribute__((ext_vector_type(8)));
__device__ __forceinline__ i32x8 cat8(const u32x4 a, const u32x4 b) { return (i32x8){(int)a.x, (int)a.y, (int)a.z, (int)a.w, (int)b.x, (int)b.y, (int)b.z, (int)b.w}; }
template <int H> __device__ __forceinline__ f16x8 half8(const i32x8 v) { typedef int i32x4_ __attribute__((ext_vector_type(4))); const i32x4_ q = __builtin_shufflevector(v, v, 4 * H, 4 * H + 1, 4 * H + 2, 4 * H + 3); return __builtin_bit_cast(f16x8, q); }
template <bool F8, class Epi, class Sched>
__device__ __forceinline__ void gemm_phase(LAS unsigned char* lds, const int wid, const int K, const Sched& S, const Epi& E) {
    const int lane = lane_id(), tid = wid * 64 + lane;
    const int  wr = wid >> 2, wc = wid & 3, fr = lane & 15, fq = lane >> 4;
    int nt = K / 64; asm volatile("" : "+s"(nt));
    const unsigned ldsw = (unsigned)wid * 1024u;
    const int aoff = lds_byte(wr * 64 + fr, fq * 8), boff = lds_byte(wc * 32 + fr, fq * 8);
#define G_SA(b, h) (((b) * 2 + (h)) * HTB)
#define G_SB(b, h) ((4 + (b) * 2 + (h)) * HTB)
#define G_STAGE(bufoff, gbase, o0, o1) do { \
        __builtin_amdgcn_global_load_lds((const unsigned*)((const char*)(gbase) + (o0)), (LAS unsigned*)(lds + (bufoff) + ldsw), 16, 0, 0); \
        __builtin_amdgcn_global_load_lds((const unsigned*)((const char*)(gbase) + (o1)), (LAS unsigned*)(lds + (bufoff) + ldsw + 8192), 16, 0, 0); } while (0)
#define G_LDA(dst, b, h) do { _Pragma("unroll") for (int m = 0; m < 4; ++m) dst[m] = cat8(*(const LAS u32x4*)(lds + G_SA(b, h) + aoff + m * 2048), *(const LAS u32x4*)(lds + G_SA(b, h) + aoff + m * 2048 + 1024)); } while (0)
#define G_LDB(dst, b, h) do { _Pragma("unroll") for (int n = 0; n < 2; ++n) dst[n] = cat8(*(const LAS u32x4*)(lds + G_SB(b, h) + boff + n * 2048), *(const LAS u32x4*)(lds + G_SB(b, h) + boff + n * 2048 + 1024)); } while (0)
#define G_MMA(ai, bj, At, Bt) do { __builtin_amdgcn_s_setprio(1); _Pragma("unroll") for (int m = 0; m < 4; ++m) _Pragma("unroll") for (int n = 0; n < 2; ++n) { \
        if constexpr (F8) { acc[ai][bj][m][n] = __builtin_amdgcn_mfma_scale_f32_16x16x128_f8f6f4(Bt[n], At[m], acc[ai][bj][m][n], 0, 0, 0, 0, 0, 0); } \
        else { acc[ai][bj][m][n] = __builtin_amdgcn_mfma_f32_16x16x32_f16(half8<0>(Bt[n]), half8<0>(At[m]), acc[ai][bj][m][n], 0, 0, 0); \
               acc[ai][bj][m][n] = __builtin_amdgcn_mfma_f32_16x16x32_f16(half8<1>(Bt[n]), half8<1>(At[m]), acc[ai][bj][m][n], 0, 0, 0); } } \
        __builtin_amdgcn_s_setprio(0); } while (0)
#define G_WAIT_V(n) asm volatile("s_waitcnt vmcnt(" #n ")" ::: "memory")
#define G_WAIT_L(n) asm volatile("s_waitcnt lgkmcnt(" #n ")" ::: "memory")
#define G_BAR __builtin_amdgcn_s_barrier()
#define G_SCHED __builtin_amdgcn_sched_barrier(0)
#define G_OFFS(u, OA, OB, IDXB) do { int tl_ = wid * 64 + lane_id(); _Pragma("unroll") for (int i = 0; i < 2; ++i) { int R_, C_; stage_rc(tl_ * 16 + i * 8192, R_, C_); const int Rb_ = (R_ & ~31) + perm32(R_ & 31); \
        _Pragma("unroll") for (int h = 0; h < 2; ++h) { const int r_ = h * 128 + R_; const int row_ = (u).ridx ? id2tok(((const LAS int*)(lds + LDS_IDX + (IDXB) * 1024))[r_]) : (u).row0 + r_; \
        OA[h][i] = (unsigned)row_ * (u).apitch + (unsigned)C_ * 2u; OB[h][i] = (unsigned)(h * 128 + Rb_) * (u).bpitch + (unsigned)C_ * 2u; } } } while (0)
#define G_IDX_DMA(u, IDXB, OIDB) do { if ((u).ridx && wid < 4) __builtin_amdgcn_global_load_lds((const unsigned*)((u).ridx + wid * 64 + lane_id()), (LAS unsigned*)(lds + LDS_IDX + (IDXB) * 1024 + wid * 256), 4, 0, 0); \
        if ((u).oidx && wid < 4) __builtin_amdgcn_global_load_lds((const unsigned*)((u).oidx + wid * 64 + lane_id()), (LAS unsigned*)(lds + LDS_OID + (OIDB) * 1024 + wid * 256), 4, 0, 0); } while (0)
    Unit cur, nxt; int ui = 0;
    if (!S.next(0, cur)) return;
    if constexpr (Sched::DYN) nt = cur.nt;
    unsigned cOA[2][2], cOB[2][2];
    G_IDX_DMA(cur, 0, 0); asm volatile("s_waitcnt vmcnt(0)" ::: "memory"); __builtin_amdgcn_s_barrier(); asm volatile("" ::: "memory");
    G_OFFS(cur, cOA, cOB, 0);
    f32x4 acc[2][2][4][2];
#pragma unroll
    for (int a = 0; a < 2; ++a)
#pragma unroll
        for (int b = 0; b < 2; ++b)
#pragma unroll
            for (int m = 0; m < 4; ++m)
#pragma unroll
                for (int n = 0; n < 2; ++n) acc[a][b][m][n] = (f32x4){0.f, 0.f, 0.f, 0.f};
    i32x8 At[4], B0[2], B1[2];
    const char* cA = uptr(cur.a); const char* cB = uptr(cur.b);
    G_STAGE(G_SB(0, 0), cB, cOB[0][0], cOB[0][1]); G_STAGE(G_SB(0, 1), cB, cOB[1][0], cOB[1][1]); G_STAGE(G_SA(0, 0), cA, cOA[0][0], cOA[0][1]); G_STAGE(G_SA(0, 1), cA, cOA[1][0], cOA[1][1]);
    if (wr == 1) G_BAR;
    G_WAIT_V(2); G_BAR;
    { const char* cA1 = uptr(cA + 128); const char* cB1 = uptr(cB + 128);
      G_STAGE(G_SB(1, 0), cB1, cOB[0][0], cOB[0][1]); G_STAGE(G_SA(1, 0), cA1, cOA[0][0], cOA[0][1]); G_STAGE(G_SB(1, 1), cB1, cOB[1][0], cOB[1][1]); }
    G_WAIT_V(6); G_BAR;
    for (;;) {
        const bool has_next = S.next(ui + 1, nxt); const char* nA = cA; const char* nB = cB;
        if (has_next) G_IDX_DMA(nxt, (ui + 1) & 1, (ui + 1) % 3);
#pragma unroll 1
        for (int t = 0; t < nt; t += 2) {
            const bool last = (t == nt - 2);
            const char* a1 = uptr(cA + (size_t)(t + 1) * 128);
            G_LDB(B0, 0, 0); G_LDB(B1, 0, 1); G_SCHED; G_LDA(At, 0, 0); G_STAGE(G_SA(1, 1), a1, cOA[1][0], cOA[1][1]);
            G_WAIT_V(8); G_WAIT_L(0); G_BAR; G_MMA(0, 0, At, B0); G_MMA(0, 1, At, B1); G_BAR; G_SCHED;
            if (last && has_next) { nA = uptr(nxt.a); nB = uptr(nxt.b); G_OFFS(nxt, cOA, cOB, (ui + 1) & 1); }
            const char* a2 = uptr(last ? nA : cA + (size_t)(t + 2) * 128); const char* b2 = uptr(last ? nB : cB + (size_t)(t + 2) * 128);
            const char* a3 = uptr(a2 + 128); const char* b3 = uptr(b2 + 128);
            G_LDA(At, 0, 1); G_STAGE(G_SB(0, 0), b2, cOB[0][0], cOB[0][1]); G_STAGE(G_SB(0, 1), b2, cOB[1][0], cOB[1][1]); G_STAGE(G_SA(0, 0), a2, cOA[0][0], cOA[0][1]);
            G_WAIT_V(8); G_WAIT_L(0); G_BAR; G_MMA(1, 0, At, B0); G_MMA(1, 1, At, B1); G_BAR; G_SCHED;
            G_LDB(B0, 1, 0); G_LDB(B1, 1, 1); G_SCHED; G_LDA(At, 1, 0); G_STAGE(G_SA(0, 1), a2, cOA[1][0], cOA[1][1]);
            G_WAIT_V(8); G_WAIT_L(0); G_BAR; G_MMA(0, 0, At, B0); G_MMA(0, 1, At, B1); G_BAR; G_SCHED;
            G_LDA(At, 1, 1); G_STAGE(G_SB(1, 0), b3, cOB[0][0], cOB[0][1]); G_STAGE(G_SB(1, 1), b3, cOB[1][0], cOB[1][1]); G_STAGE(G_SA(1, 0), a3, cOA[0][0], cOA[0][1]);
            G_WAIT_V(8); G_WAIT_L(0); G_BAR; G_MMA(1, 0, At, B0); G_MMA(1, 1, At, B1); G_BAR; G_SCHED;
        }
        if (wr == 0) G_BAR;
        cur.oidl = (const LAS int*)(lds + LDS_OID + (ui % 3) * 1024);
        { const int le = lane_id(); E(acc, cur, wr, wc, le & 15, le >> 4); }
        if (!has_next) break;
        if (!nxt.keep) {
#pragma unroll
        for (int a = 0; a < 2; ++a)
#pragma unroll
            for (int b = 0; b < 2; ++b)
#pragma unroll
                for (int m = 0; m < 4; ++m)
#pragma unroll
                    for (int n = 0; n < 2; ++n) acc[a][b][m][n] = (f32x4){0.f, 0.f, 0.f, 0.f};
        }
        cur = nxt; cA = nA; cB = nB; ++ui;
        if constexpr (Sched::DYN) nt = cur.nt;
        if (wr == 1) G_BAR;
    }
    G_WAIT_V(0);
    G_BAR;
#undef G_SA
#undef G_SB
#undef G_STAGE
#undef G_LDA
#undef G_LDB
#undef G_MMA
#undef G_WAIT_V
#undef G_WAIT_L
#undef G_BAR
#undef G_SCHED
#undef G_OFFS
#undef G_IDX_DMA
}
#if FAST_GEMM
#define GEMM_PHASE(K, S, E) gemm_phase<false>(F.lds, F.wave, K, S, E)
#define GEMM_PHASE_F8(K, S, E) gemm_phase<true>(F.lds, F.wave, K, S, E)
#else
#define GEMM_PHASE(K, S, E) gemm_phase_simple(F.wave, K, S, E)
#endif

constexpr int NXCD = 8, WGM = 8;
struct TileOrder {
    int nM, nN, nwg, G, c;
    __device__ void init(int M, int N, int G_, int c_) { nM = M / 256; nN = N / 256; nwg = nM * nN; G = G_; c = c_; }
    __device__ bool tile(int i, int& pm, int& pn) const {
        const long L = (long)i * G + c; if (L >= nwg) return false;
        int wgid = (int)L; { const int q = nwg / NXCD, r = nwg % NXCD, xcd = wgid % NXCD, off = wgid / NXCD; wgid = (xcd < r ? xcd * (q + 1) : r * (q + 1) + (xcd - r) * q) + off; }
        const int nig = WGM * nN, gid = wgid / nig, fm = gid * WGM, gsz = (nM - fm) < WGM ? (nM - fm) : WGM;
        pm = fm + ((wgid % nig) % gsz); pn = (wgid % nig) / gsz; return true;
    }
};
struct SchedDense { static constexpr bool DYN = false;
    TileOrder o; const char* a; const char* b; unsigned apitch, bpitch;
    __device__ bool next(int i, Unit& u) const {
        int pm, pn; if (!o.tile(i, pm, pn)) return false;
        u.a = a; u.b = b + (size_t)pn * 256 * bpitch; u.ridx = nullptr; u.apitch = apitch; u.bpitch = bpitch; u.row0 = pm * 256; u.col0 = pn * 256; u.kind = 0; u.oidx = nullptr; u.keep = 0; return true;
    }
};
struct SchedMerged { static constexpr bool DYN = false;
    TileOrder o; const char* pd; const char* oo; const char* wpe; const char* wba;
    __device__ bool next(int i, Unit& u) const {
        int pm, pn; if (!o.tile(i >> 1, pm, pn)) return false;
        const int part = i & 1;
        u.a = part ? oo : pd; u.apitch = 512; u.b = (part ? wba : wpe) + (size_t)pn * 256 * 512; u.bpitch = 512; u.ridx = nullptr; u.row0 = pm * 256; u.col0 = pn * 256; u.kind = part; u.oidx = nullptr; u.keep = part; return true;
    }
};
struct SchedSharedRouter { static constexpr bool DYN = true;
    int G, c; const char* xb; const char* wsgu; const char* wr;
    __device__ bool next(int i, Unit& u) const {
        const int L = i * G + c; if (L >= 512) return false;
        u.apitch = 2048; u.bpitch = 2048; u.ridx = nullptr; u.oidx = nullptr; u.keep = 0;
        if (L < 256) { const int pm = L >> 1, pn = L & 1; u.a = xb; u.b = wsgu + (size_t)pn * 256 * 2048; u.row0 = pm * 256; u.col0 = pn * 128; u.kind = 0; u.nt = 16; }
        else { const int pm = (L - 256) >> 1, kh = L & 1; u.a = xb + kh * 1024; u.b = wr + kh * 1024; u.row0 = pm * 256; u.col0 = kh; u.kind = 1; u.nt = 8; }
        return true;
    }
};
struct SchedMoeGU { static constexpr bool DYN = false;
    int G, c, nblk; const char* xb; const char* wegu; const LAS int* blke; const int* tokl;
    __device__ bool next(int i, Unit& u) const {
        const int L = i * G + c; if (L >= 2 * nblk) return false;
        const int rb = L >> 1, pn = L & 1, e = __builtin_amdgcn_readfirstlane(blke[rb]);
        u.a = xb; u.apitch = 1024; u.bpitch = 1024; u.b = wegu + ((size_t)e * 512 + pn * 256) * 1024; u.ridx = tokl + rb * 256; u.row0 = rb * 256; u.col0 = pn * 128; u.kind = e; u.oidx = nullptr; u.keep = 0; return true;
    }
};
struct SchedMoeDownR { static constexpr bool DYN = false;
    int G, c, nblk; const char* hb; const char* wed; const LAS int* blke; const int* tokl;
    __device__ bool next(int i, Unit& u) const {
        const int L = i * G + c; if (L >= 4 * nblk) return false;
        const int rb = L >> 2, pn = L & 3, e = __builtin_amdgcn_readfirstlane(blke[rb]);
        u.apitch = 256; u.bpitch = 256; u.ridx = nullptr; u.a = hb; u.b = wed + ((size_t)e * 1024 + pn * 256) * 256; u.row0 = rb * 256; u.col0 = pn * 256; u.kind = e; u.oidx = tokl + rb * 256; u.keep = 0; return true;
    }
};
struct SchedShDown { static constexpr bool DYN = false;
    int G, c; const char* hs; const char* wsd;
    __device__ bool next(int i, Unit& u) const {
        const int L = i * G + c; if (L >= 512) return false;
        const int pm = L >> 2, pn = L & 3; u.apitch = 512; u.bpitch = 512; u.ridx = nullptr; u.a = hs; u.b = wsd + (size_t)pn * 256 * 512; u.row0 = pm * 256; u.col0 = pn * 256; u.kind = 64; u.oidx = nullptr; u.keep = 0; return true;
    }
};

__device__ __forceinline__ u32x4 pack8(const f32x4& v0, const f32x4& v1) { u32x4 w; w.x = cvt_pk_h16(v0[0], v0[1]); w.y = cvt_pk_h16(v0[2], v0[3]); w.z = cvt_pk_h16(v1[0], v1[1]); w.w = cvt_pk_h16(v1[2], v1[3]); return w; }
__device__ __forceinline__ void unpack8(const u32x4& w, f32x4& v0, f32x4& v1) { v0 = (f32x4){lo16(w.x), hi16(w.x), lo16(w.y), hi16(w.y)}; v1 = (f32x4){lo16(w.z), hi16(w.z), lo16(w.w), hi16(w.w)}; }
__device__ __forceinline__ f32x4 sig4(const f32x4& v) { return (f32x4){sigmoidf_(v[0]), sigmoidf_(v[1]), sigmoidf_(v[2]), sigmoidf_(v[3])}; }
__device__ __forceinline__ f32x4 swiglu4(const f32x4& g, const f32x4& u) { return (f32x4){g[0] * sigmoidf_(g[0]) * u[0], g[1] * sigmoidf_(g[1]) * u[1], g[2] * sigmoidf_(g[2]) * u[2], g[3] * sigmoidf_(g[3]) * u[3]}; }

__device__ __forceinline__ unsigned q8x4(float a, float b, float c, float d, float inv) {
    const unsigned ua = __float_as_uint(a * inv + 12582912.0f), ub = __float_as_uint(b * inv + 12582912.0f), uc = __float_as_uint(c * inv + 12582912.0f), ud = __float_as_uint(d * inv + 12582912.0f);
    const unsigned lo = __builtin_amdgcn_perm(ub, ua, 0x0c0c0400u), hi = __builtin_amdgcn_perm(ud, uc, 0x0c0c0400u);
    return __builtin_amdgcn_perm(hi, lo, 0x05040100u);
}
__device__ __forceinline__ unsigned f8x4(const f32x4 v) {
    int w = __builtin_amdgcn_cvt_pk_fp8_f32(__builtin_amdgcn_fmed3f(v.x, -448.f, 448.f), __builtin_amdgcn_fmed3f(v.y, -448.f, 448.f), 0, false);
    w = __builtin_amdgcn_cvt_pk_fp8_f32(__builtin_amdgcn_fmed3f(v.z, -448.f, 448.f), __builtin_amdgcn_fmed3f(v.w, -448.f, 448.f), w, true); return (unsigned)w; }
struct EpiInProj {
    h16* H; const float* bias; float isc;
    __device__ __forceinline__ void operator()(const ACC_T, const Unit& u, int wr, int wc, int fr, int fq) const {
        const int pn = u.col0 >> 8; const float sc = (pn == 2 || pn == 3) ? 0.125f : 1.f; const bool sg = pn >= 5;
        f32x4 bv[2][2];
#pragma unroll
        for (int bj = 0; bj < 2; ++bj)
#pragma unroll
            for (int n = 0; n < 2; ++n) bv[bj][n] = *(const f32x4*)(bias + u.col0 + 128 * bj + 32 * wc + 8 * fq + 4 * n);
        if (sg) {
            unsigned char* gb = (unsigned char*)H + 336 * MiB + ((size_t)((u.row0 >> 8) * 8 + (pn - 5)) << 16) + (size_t)((wr * 4 + wc) * 8) * 1024 + (size_t)(fq * 16 + fr) * 16;
#pragma unroll
            for (int ai = 0; ai < 2; ++ai)
#pragma unroll
                for (int m = 0; m < 4; ++m) { u32x4 w;
                    { const f32x4 v0 = sig4(acc[ai][0][m][0] * isc + bv[0][0]), v1 = sig4(acc[ai][0][m][1] * isc + bv[0][1]); w.x = q8x4(v0[0], v0[1], v0[2], v0[3], 255.0f); w.y = q8x4(v1[0], v1[1], v1[2], v1[3], 255.0f); }
                    { const f32x4 v0 = sig4(acc[ai][1][m][0] * isc + bv[1][0]), v1 = sig4(acc[ai][1][m][1] * isc + bv[1][1]); w.z = q8x4(v0[0], v0[1], v0[2], v0[3], 255.0f); w.w = q8x4(v1[0], v1[1], v1[2], v1[3], 255.0f); }
                    *(u32x4*)(gb + (ai * 4 + m) * 1024) = w; }
            return;
        }
#pragma unroll
        for (int ai = 0; ai < 2; ++ai)
#pragma unroll
            for (int m = 0; m < 4; ++m) { const int row = u.row0 + 128 * ai + 64 * wr + 16 * m + fr; h16* rowp = H + (size_t)row * DIN + u.col0 + 32 * wc + 8 * fq;
#pragma unroll
                for (int bj = 0; bj < 2; ++bj) { const f32x4 v0 = (acc[ai][bj][m][0] * isc + bv[bj][0]) * sc, v1 = (acc[ai][bj][m][1] * isc + bv[bj][1]) * sc;
                    *(u32x4*)(rowp + 128 * bj) = pack8(v0, v1); } }
    }
};
__device__ __forceinline__ void ungate8(const u32x2& w, f32x4& v0, f32x4& v1) {
    const float k = 1.0f / 255.0f;
    v0 = (f32x4){(float)(w.x & 0xffu) * k, (float)((w.x >> 8) & 0xffu) * k, (float)((w.x >> 16) & 0xffu) * k, (float)(w.x >> 24) * k};
    v1 = (f32x4){(float)(w.y & 0xffu) * k, (float)((w.y >> 8) & 0xffu) * k, (float)((w.y >> 16) & 0xffu) * k, (float)(w.y >> 24) * k};
}
struct EpiMerged {
    unsigned char* MG; const unsigned char* G8; float r01, i1;
    __device__ __forceinline__ void operator()(f32x4 (&acc)[2][2][4][2], const Unit& u, int wr, int wc, int fr, int fq) const {
        const int col = u.col0 + 32 * wc + 8 * fq;
        const unsigned char* gpb = G8 + ((size_t)((u.row0 >> 8) * 8 + (u.col0 >> 8)) << 16) + (size_t)((wr * 4 + wc) * 8) * 1024 + (size_t)(fq * 16 + fr) * 16;
        const unsigned char* gab = gpb + 4 * 65536;
#pragma unroll
        for (int ai = 0; ai < 2; ++ai) {
            u32x4 ga[2][4], gp[2][4];
#pragma unroll
            for (int m = 0; m < 4; ++m) { ga[ai][m] = *(const u32x4*)(gab + (ai * 4 + m) * 1024); if (u.kind == 0) gp[ai][m] = *(const u32x4*)(gpb + (ai * 4 + m) * 1024); }
#pragma unroll
            for (int m = 0; m < 4; ++m) { const int row = u.row0 + 128 * ai + 64 * wr + 16 * m + fr;
#pragma unroll
                for (int bj = 0; bj < 2; ++bj) { f32x4 a0, a1; { u32x2 t; t.x = bj ? ga[ai][m].z : ga[ai][m].x; t.y = bj ? ga[ai][m].w : ga[ai][m].y; ungate8(t, a0, a1); }
                    if (u.kind == 0) { f32x4 p0, p1; { u32x2 t; t.x = bj ? gp[ai][m].z : gp[ai][m].x; t.y = bj ? gp[ai][m].w : gp[ai][m].y; ungate8(t, p0, p1); }
#pragma unroll
                        for (int j = 0; j < 4; ++j) { acc[ai][bj][m][0][j] *= p0[j] * r01 * __builtin_amdgcn_rcpf(fmaxf(a0[j], 6.2e-5f)); acc[ai][bj][m][1][j] *= p1[j] * r01 * __builtin_amdgcn_rcpf(fmaxf(a1[j], 6.2e-5f)); } }
                    else { u32x2 w; w.x = f8x4(acc[ai][bj][m][0] * a0 * i1); w.y = f8x4(acc[ai][bj][m][1] * a1 * i1); *(u32x2*)(MG + (size_t)row * D + col + 128 * bj) = w; } } }
        }
    }
};
struct EpiResid {
    h16* S; const h16* XBp; float isc;
    __device__ __forceinline__ void operator()(const ACC_T, const Unit& u, int wr, int wc, int fr, int fq) const {
#pragma unroll
        for (int ai = 0; ai < 2; ++ai) {
            u32x4 xw[4][2];
#pragma unroll
            for (int m = 0; m < 4; ++m) { const int row = u.row0 + 128 * ai + 64 * wr + 16 * m + fr; const size_t off = (size_t)row * D + u.col0 + 32 * wc + 8 * fq;
#pragma unroll
                for (int bj = 0; bj < 2; ++bj) xw[m][bj] = *(const u32x4*)(XBp + off + 128 * bj); }
#pragma unroll
            for (int m = 0; m < 4; ++m) { const int row = u.row0 + 128 * ai + 64 * wr + 16 * m + fr; const size_t off = (size_t)row * D + u.col0 + 32 * wc + 8 * fq;
#pragma unroll
                for (int bj = 0; bj < 2; ++bj) { f32x4 x0, x1; unpack8(xw[m][bj], x0, x1);
                    *(u32x4*)(S + off + 128 * bj) = pack8(x0 * ALPHA + acc[ai][bj][m][0] * isc, x1 * ALPHA + acc[ai][bj][m][1] * isc); } }
        }
    }
};
struct EpiSharedRouter {
    h16* HS; float* LG;
    __device__ __forceinline__ void operator()(const ACC_T, const Unit& u, int wr, int wc, int fr, int fq) const {
#pragma unroll
        for (int ai = 0; ai < 2; ++ai)
#pragma unroll
            for (int m = 0; m < 4; ++m) { const int row = u.row0 + 128 * ai + 64 * wr + 16 * m + fr;
                if (u.kind == 0) { *(u32x4*)(HS + (size_t)row * FF + u.col0 + 32 * wc + 8 * fq) = pack8(swiglu4(acc[ai][0][m][0], acc[ai][1][m][0]), swiglu4(acc[ai][0][m][1], acc[ai][1][m][1])); }
                else if (wc < 2) {
#pragma unroll
                    for (int n = 0; n < 2; ++n) *(f32x4*)(LG + (size_t)u.col0 * T * NE + (size_t)row * NE + 32 * wc + 8 * fq + 4 * n) = acc[ai][0][m][n] + acc[ai][1][m][n]; } }
    }
};
struct EpiMoeGU {
    unsigned char* HB; const float* wsc;
    __device__ __forceinline__ void operator()(const ACC_T, const Unit& u, int wr, int wc, int fr, int fq) const {
        const float isg = wsc[4 * u.kind], isu = wsc[4 * u.kind + 1], hsc = 1.52587890625e-05f / (isg * isu);
#pragma unroll
        for (int ai = 0; ai < 2; ++ai)
#pragma unroll
            for (int m = 0; m < 4; ++m) { const int row = u.row0 + 128 * ai + 64 * wr + 16 * m + fr;
                u32x2 w; w.x = f8x4(swiglu4(acc[ai][0][m][0] * isg, acc[ai][1][m][0] * isu) * hsc); w.y = f8x4(swiglu4(acc[ai][0][m][1] * isg, acc[ai][1][m][1] * isu) * hsc);
                *(u32x2*)(HB + (size_t)row * FF + u.col0 + 32 * wc + 8 * fq) = w; }
    }
};
template <bool ROUTED> struct EpiMoeDown {
    unsigned char* YQ; h16* YS;
    __device__ __forceinline__ void operator()(const ACC_T, const Unit& u, int wr, int wc, int fr, int fq) const {
        const int grp = (u.col0 >> 8) * 16 + 4 * wc + fq;
#pragma unroll
        for (int ai = 0; ai < 2; ++ai)
#pragma unroll
            for (int m = 0; m < 4; ++m) {
                const int r = 128 * ai + 64 * wr + 16 * m + fr; int id; if constexpr (ROUTED) id = u.oidl[r]; else id = (u.row0 + r) * 9 + 8;
                const f32x4 v0 = acc[ai][0][m][0], v1 = acc[ai][0][m][1], v2 = acc[ai][1][m][0], v3 = acc[ai][1][m][1];
                if constexpr (ROUTED) { u32x4 w; w.x = f8x4(v0 * 0.015625f); w.y = f8x4(v1 * 0.015625f); w.z = f8x4(v2 * 0.015625f); w.w = f8x4(v3 * 0.015625f);
                    *(u32x4*)(YQ + (size_t)id * 1024 + grp * 16) = w; }
                else {
                float mx = fmaxf(fmaxf(fabsf(v0[0]), fabsf(v0[1])), fmaxf(fabsf(v0[2]), fabsf(v0[3])));
                mx = fmaxf(mx, fmaxf(fmaxf(fabsf(v1[0]), fabsf(v1[1])), fmaxf(fabsf(v1[2]), fabsf(v1[3]))));
                mx = fmaxf(mx, fmaxf(fmaxf(fabsf(v2[0]), fabsf(v2[1])), fmaxf(fabsf(v2[2]), fabsf(v2[3]))));
                mx = fmaxf(mx, fmaxf(fmaxf(fabsf(v3[0]), fabsf(v3[1])), fmaxf(fabsf(v3[2]), fabsf(v3[3]))));
                const unsigned short sh = f2h(mx * (1.0f / 127.0f) * 1.0005f);
                const float scr = h2f(sh); const float inv = scr > 0.f ? __builtin_amdgcn_rcpf(scr) : 0.f;
                u32x4 w; w.x = q8x4(v0[0], v0[1], v0[2], v0[3], inv); w.y = q8x4(v1[0], v1[1], v1[2], v1[3], inv); w.z = q8x4(v2[0], v2[1], v2[2], v2[3], inv); w.w = q8x4(v3[0], v3[1], v3[2], v3[3], inv);
                *(u32x4*)(YQ + (size_t)id * 1024 + grp * 16) = w;
                *(unsigned short*)(YS + (size_t)id * 64 + grp) = sh; } }
    }
};

struct Args { const float* in[23]; float* out; unsigned char* ws; int ph_lo, ph_hi; };
struct Frame {
    LAS unsigned char* lds; int wave, vcu, G, gw, NGW;
};

__device__ __forceinline__ void ln_store(f32x4 (&v)[4], const float* gam, const float* bet, float* o32, h16* o16, int lane) {
    float s = 0.f;
#pragma unroll
    for (int j = 0; j < 4; ++j) s += (v[j].x + v[j].y) + (v[j].z + v[j].w);
    const float mean = wave_sum(s) * (1.f / D); float s2 = 0.f;
#pragma unroll
    for (int j = 0; j < 4; ++j) { v[j] = v[j] - mean; s2 += (v[j].x * v[j].x + v[j].y * v[j].y) + (v[j].z * v[j].z + v[j].w * v[j].w); }
    const float rstd = 1.f / sqrtf(wave_sum(s2) * (1.f / D) + LN_EPS);
#pragma unroll
    for (int j = 0; j < 4; ++j) { const f32x4 g = *(const f32x4*)(gam + 4 * lane + 256 * j), b = *(const f32x4*)(bet + 4 * lane + 256 * j); const f32x4 y = v[j] * rstd * g + b;
        *(f32x4*)(o32 + 4 * lane + 256 * j) = y; u32x2 w; w.x = cvt_pk_h16(y[0], y[1]); w.y = cvt_pk_h16(y[2], y[3]); *(u32x2*)(o16 + 4 * lane + 256 * j) = w; }
}


__device__ __forceinline__ void ln_store8(f32x4 (&v)[4], const float* gam, const float* bet, float* o32, h16* o16, int lane, int c0 = -1, int c1 = -1, unsigned char* o8 = nullptr) {
    if (c0 < 0) { c0 = 8 * lane; c1 = 512 + 8 * lane; }
    float s = 0.f;
#pragma unroll
    for (int j = 0; j < 4; ++j) s += (v[j].x + v[j].y) + (v[j].z + v[j].w);
    const float mean = wave_sum(s) * (1.f / D); float s2 = 0.f;
#pragma unroll
    for (int j = 0; j < 4; ++j) { v[j] = v[j] - mean; s2 += (v[j].x * v[j].x + v[j].y * v[j].y) + (v[j].z * v[j].z + v[j].w * v[j].w); }
    const float rstd = 1.f / sqrtf(wave_sum(s2) * (1.f / D) + LN_EPS);
    f32x4 y[4];
#pragma unroll
    for (int j = 0; j < 4; ++j) { const int c = ((j >> 1) ? c1 : c0) + 4 * (j & 1); const f32x4 g = *(const f32x4*)(gam + c), b = *(const f32x4*)(bet + c); y[j] = v[j] * rstd * g + b; if (o32) *(f32x4*)(o32 + c) = y[j]; }
    *(u32x4*)(o16 + c0) = pack8(y[0], y[1]); *(u32x4*)(o16 + c1) = pack8(y[2], y[3]);
    if (o8) { u32x2 w; w.x = f8x4(y[0]); w.y = f8x4(y[1]); *(u32x2*)(o8 + c0) = w; w.x = f8x4(y[2]); w.y = f8x4(y[3]); *(u32x2*)(o8 + c1) = w; }
}
__device__ __forceinline__ void tr_item(const float* W, int N, h16* WT, int ldt, int k0, int n0, int drow0, LAS float* scr, int lane) {
    float tv[32];
#pragma unroll
    for (int i = 0; i < 32; ++i) { const int kk = 2 * i + (lane >> 5); tv[i] = __builtin_nontemporal_load(W + (size_t)(k0 + kk) * N + n0 + (lane & 31)); }
#pragma unroll
    for (int i = 0; i < 32; ++i) { const int kk = 2 * i + (lane >> 5); scr[kk * 33 + (lane & 31)] = tv[i]; }
    asm volatile("s_waitcnt lgkmcnt(0)" ::: "memory");
    const int c = lane & 7;
#pragma unroll
    for (int j = 0; j < 4; ++j) { const int n = (lane >> 3) + 8 * j; const LAS float* s = scr + (8 * c) * 33 + n;
        u32x4 o; o.x = cvt_pk_h16(s[0 * 33], s[1 * 33]); o.y = cvt_pk_h16(s[2 * 33], s[3 * 33]); o.z = cvt_pk_h16(s[4 * 33], s[5 * 33]); o.w = cvt_pk_h16(s[6 * 33], s[7 * 33]);
        *(u32x4*)(WT + (size_t)(drow0 + n) * ldt + k0 + 8 * c) = o; }
    asm volatile("s_waitcnt lgkmcnt(0)" ::: "memory");
}
__device__ __forceinline__ void tr_item_f8(const float* W, int N, unsigned char* WT, int ldt, int k0, int n0, int drow0, LAS float* scr, int lane, float scale) {
    float tv[32];
#pragma unroll
    for (int i = 0; i < 32; ++i) { const int kk = 2 * i + (lane >> 5); tv[i] = __builtin_nontemporal_load(W + (size_t)(k0 + kk) * N + n0 + (lane & 31)); }
#pragma unroll
    for (int i = 0; i < 32; ++i) { const int kk = 2 * i + (lane >> 5); scr[kk * 33 + (lane & 31)] = tv[i]; }
    asm volatile("s_waitcnt lgkmcnt(0)" ::: "memory");
    const int c = lane & 7;
#pragma unroll
    for (int j = 0; j < 4; ++j) { const int n = (lane >> 3) + 8 * j; const LAS float* s = scr + (8 * c) * 33 + n;
        u32x2 o; o.x = f8x4((f32x4){s[0 * 33], s[1 * 33], s[2 * 33], s[3 * 33]} * scale); o.y = f8x4((f32x4){s[4 * 33], s[5 * 33], s[6 * 33], s[7 * 33]} * scale);
        *(u32x2*)(WT + (size_t)(drow0 + n) * ldt + k0 + 8 * c) = o; }
    asm volatile("s_waitcnt lgkmcnt(0)" ::: "memory");
}
__device__ __forceinline__ float f8_scale_of(const float* W, int lane) {
    const f32x4 q = *(const f32x4*)(W + 4 * lane); const float ma = wave_sum((fabsf(q.x) + fabsf(q.y)) + (fabsf(q.z) + fabsf(q.w))) * (1.2533f / 256.f);
    float t = 32.f / fmaxf(ma, 1e-30f); t = fminf(fmaxf(t, 1.0e-18f), 1.0e18f);
    return __uint_as_float(__builtin_amdgcn_readfirstlane(__float_as_uint(t)) & 0x7f800000u);
}
__device__ __forceinline__ void tr_item_hilo(const float* W, int N, h16* WT, int ldt, int k0, int n0, LAS float* scr, int lane) {
    float tv[32];
#pragma unroll
    for (int i = 0; i < 32; ++i) { const int kk = 2 * i + (lane >> 5); tv[i] = __builtin_nontemporal_load(W + (size_t)(k0 + kk) * N + n0 + (lane & 31)); }
#pragma unroll
    for (int i = 0; i < 32; ++i) { const int kk = 2 * i + (lane >> 5); scr[kk * 33 + (lane & 31)] = tv[i]; }
    asm volatile("s_waitcnt lgkmcnt(0)" ::: "memory");
    const int c = lane & 7;
#pragma unroll
    for (int j = 0; j < 4; ++j) { const int n = (lane >> 3) + 8 * j; const LAS float* s = scr + (8 * c) * 33 + n;
        float v[8], r[8];
#pragma unroll
        for (int q = 0; q < 8; ++q) { v[q] = s[q * 33]; r[q] = v[q] - h2f(f2h(v[q])); }
        u32x4 o; o.x = cvt_pk_h16(v[0], v[1]); o.y = cvt_pk_h16(v[2], v[3]); o.z = cvt_pk_h16(v[4], v[5]); o.w = cvt_pk_h16(v[6], v[7]);
        *(u32x4*)(WT + (size_t)(n0 + n) * ldt + k0 + 8 * c) = o;
        o.x = cvt_pk_h16(r[0], r[1]); o.y = cvt_pk_h16(r[2], r[3]); o.z = cvt_pk_h16(r[4], r[5]); o.w = cvt_pk_h16(r[6], r[7]);
        *(u32x4*)(WT + (size_t)(128 + n0 + n) * ldt + k0 + 8 * c) = o; }
    asm volatile("s_waitcnt lgkmcnt(0)" ::: "memory");
}


typedef float f32x16 __attribute__((ext_vector_type(16)));
constexpr int AT_KP = 144, AT_VP = 528, AT_VOFF = 256 * AT_KP;
__device__ __forceinline__ int crow(int r, int hi) { return (r & 3) + 8 * (r >> 2) + 4 * hi; }
struct KVRegs { u32x4 k[4], v[4]; };
__device__ __forceinline__ void attn_load_kv(const h16* HHp, const int b, const int n, const int hk, const int tid, KVRegs& r) {
    const int tb = b * SEQ + n * 128;
#pragma unroll
    for (int i = 0; i < 4; ++i) { const int idx = tid + 512 * i, key = idx >> 3, ch = idx & 7; const int tok = (n > 0) ? tb - 128 + key : tb + (key & 127);
        const h16* kp = HHp + (size_t)tok * DIN + C_K + hk * 64 + ch * 8; r.k[i] = *(const u32x4*)kp; r.v[i] = *(const u32x4*)(kp + 128); }
}
__device__ __forceinline__ void attn_unit(LAS unsigned char* lds, h16* HHp, unsigned char* OUTp, const float osc, const float* sinks, const int b, const int n, const int hk, const int tid,
                                          const int unused_ = 0) {
    const int lane = tid & 63, wid = __builtin_amdgcn_readfirstlane(tid >> 6), q32 = lane & 31, hi = lane >> 5;
    const int g = wid >> 1, qh = wid & 1, hq = hk * 4 + g;
    const int tb = b * SEQ + n * 128;
    LAS unsigned char* Ks = lds; LAS unsigned char* Vs = lds + AT_VOFF;
    KVRegs cur; attn_load_kv(HHp, b, n, hk, tid, cur);
    f16x8 qs[4];
    { const h16* qp = HHp + (size_t)(tb + 64 * qh + q32) * DIN + C_Q + hq * 64;
#pragma unroll
      for (int ks = 0; ks < 4; ++ks) qs[ks] = *(const f16x8*)(qp + 16 * ks + 8 * hi); }
#pragma unroll
    for (int i = 0; i < 4; ++i) { const int idx = tid + 512 * i, key = idx >> 3, ch = idx & 7; const u32x4 kw = cur.k[i], vw = cur.v[i];
        *(LAS u32x4*)(Ks + key * AT_KP + ch * 16) = kw;
        LAS unsigned short* vd = (LAS unsigned short*)(Vs + (ch * 8) * AT_VP + key * 2);
        vd[0 * (AT_VP / 2)] = (unsigned short)(vw.x & 0xffffu); vd[1 * (AT_VP / 2)] = (unsigned short)(vw.x >> 16); vd[2 * (AT_VP / 2)] = (unsigned short)(vw.y & 0xffffu); vd[3 * (AT_VP / 2)] = (unsigned short)(vw.y >> 16);
        vd[4 * (AT_VP / 2)] = (unsigned short)(vw.z & 0xffffu); vd[5 * (AT_VP / 2)] = (unsigned short)(vw.z >> 16); vd[6 * (AT_VP / 2)] = (unsigned short)(vw.w & 0xffffu); vd[7 * (AT_VP / 2)] = (unsigned short)(vw.w >> 16); }
    __syncthreads();
    const float slope = exp2f(-(float)(hq + 1)), sink = sinks[hq];
    float ab[16];
#pragma unroll
    for (int r = 0; r < 16; ++r) ab[r] = slope * (float)(crow(r, hi) - 128 - q32);
#pragma unroll 1
    for (int sub = 0; sub < 2; ++sub) {
        const int q0 = 64 * qh + 32 * sub, qi = q0 + q32;
        f32x16 sv[5]; float mx = -INFINITY;
#pragma unroll
        for (int j = 0; j < 5; ++j) { const int key0 = q0 + 32 * j; f32x16 c; float sl = slope; asm volatile("" : "+v"(sl)); const float aj = sl * (float)(32 * j);
#pragma unroll
            for (int r = 0; r < 16; ++r) c[r] = ab[r] + aj;
#pragma unroll
            for (int ks = 0; ks < 4; ++ks) { const f16x8 kf = *(const LAS f16x8*)(Ks + (key0 + q32) * AT_KP + (16 * ks + 8 * hi) * 2); c = __builtin_amdgcn_mfma_f32_32x32x16_f16(kf, qs[ks], c, 0, 0, 0); }
            const bool dead = (n == 0) && (key0 < 128);
            int hil = hi; asm volatile("" : "+v"(hil));
#pragma unroll
            for (int r = 0; r < 16; ++r) { float v = c[r];
                if (j == 0) v = (crow(r, hil) > q32) ? v : -INFINITY;
                if (j == 4) v = (crow(r, hil) <= q32) ? v : -INFINITY;
                if (dead) v = -INFINITY;
                c[r] = v; mx = fmaxf(mx, v); }
            sv[j] = c; __builtin_amdgcn_sched_barrier(0); }
        if (sub == 0) { const h16* qp = HHp + (size_t)(tb + 64 * qh + 32 + q32) * DIN + C_Q + hq * 64;
#pragma unroll
            for (int ks = 0; ks < 4; ++ks) qs[ks] = *(const f16x8*)(qp + 16 * ks + 8 * hi); }
        mx = fmaxf(mx, dppf_swap32(mx)); mx = fmaxf(mx, sink);
        float lsum = 0.f; f32x16 o0, o1;
#pragma unroll
        for (int r = 0; r < 16; ++r) { o0[r] = 0.f; o1[r] = 0.f; }
#pragma unroll
        for (int j = 0; j < 5; ++j) { const int key0 = q0 + 32 * j;
#pragma unroll
            for (int r = 0; r < 16; ++r) { const float pv = __expf(sv[j][r] - mx); sv[j][r] = pv; lsum += pv; }
#pragma unroll
            for (int cc = 0; cc < 2; ++cc) {
                u32x4 pw; pw.x = cvt_pk_h16(sv[j][8 * cc + 0], sv[j][8 * cc + 1]); pw.y = cvt_pk_h16(sv[j][8 * cc + 2], sv[j][8 * cc + 3]); pw.z = cvt_pk_h16(sv[j][8 * cc + 4], sv[j][8 * cc + 5]); pw.w = cvt_pk_h16(sv[j][8 * cc + 6], sv[j][8 * cc + 7]);
                const f16x8 pb = __builtin_bit_cast(f16x8, pw);
                const LAS unsigned char* vp = Vs + q32 * AT_VP + (key0 + 16 * cc + 4 * hi) * 2;
                { const u32x2 a0 = *(const LAS u32x2*)vp, a1 = *(const LAS u32x2*)(vp + 16); const u32x4 vw = {a0.x, a0.y, a1.x, a1.y}; o0 = __builtin_amdgcn_mfma_f32_32x32x16_f16(__builtin_bit_cast(f16x8, vw), pb, o0, 0, 0, 0); }
                { const u32x2 a0 = *(const LAS u32x2*)(vp + 32 * AT_VP), a1 = *(const LAS u32x2*)(vp + 32 * AT_VP + 16); const u32x4 vw = {a0.x, a0.y, a1.x, a1.y}; o1 = __builtin_amdgcn_mfma_f32_32x32x16_f16(__builtin_bit_cast(f16x8, vw), pb, o1, 0, 0, 0); }
                __builtin_amdgcn_sched_barrier(0);
            } }
        lsum += dppf_swap32(lsum); lsum += __expf(sink - mx);
        const float rl = 1.0f / lsum;
#pragma unroll
        for (int rg = 0; rg < 4; ++rg) {
            const float ro = rl * osc;
            unsigned char* op = OUTp + (size_t)(tb + qi) * 512 + hq * 64;
            *(unsigned*)(op + 8 * rg + 4 * hi) = f8x4((f32x4){o0[4 * rg], o0[4 * rg + 1], o0[4 * rg + 2], o0[4 * rg + 3]} * ro);
            *(unsigned*)(op + 32 + 8 * rg + 4 * hi) = f8x4((f32x4){o1[4 * rg], o1[4 * rg + 1], o1[4 * rg + 2], o1[4 * rg + 3]} * ro); }
    }
    __syncthreads();
}
template <int W> __device__ __forceinline__ void pool_pair(const h16* HHp, unsigned char* PDp, const float psc, const int c8, const int tA, const int tB) {
    u32x4 q[2][W];
#pragma unroll
    for (int p = 0; p < 2; ++p) { const int t = p ? tB : tA; const int s = t & (SEQ - 1); const h16* up = HHp + (size_t)t * DIN + C_U + c8 * 8;
#pragma unroll
        for (int i = 0; i < W; ++i) { const int ii = (i <= s) ? i : 0; q[p][i] = *(const u32x4*)(up - (size_t)ii * DIN); } }
#pragma unroll
    for (int p = 0; p < 2; ++p) { const int t = p ? tB : tA; const int s = t & (SEQ - 1); f32x4 a0 = {0.f, 0.f, 0.f, 0.f}, a1 = {0.f, 0.f, 0.f, 0.f}, u0, u1;
#pragma unroll
        for (int i = 0; i < W; ++i) { f32x4 v0, v1; unpack8(q[p][i], v0, v1); if (i == 0) { u0 = v0; u1 = v1; } if (i <= s) { a0 += v0; a1 += v1; } }
        const float rn = 1.0f / (float)((s + 1 < W) ? s + 1 : W);
        u32x2 w; w.x = f8x4((a0 * rn - u0) * psc); w.y = f8x4((a1 * rn - u1) * psc); *(u32x2*)(PDp + (size_t)t * 512 + c8 * 8) = w; }
}


__device__ __forceinline__ void prep_expert_items(const float* w_eg, const float* w_eu, const float* w_ed, unsigned char* egu_t, unsigned char* ed_t, float* wsc, int e_lo, int e_hi, int wrk, int nwrk, LAS float* scr, int lane) {
    for (int it = e_lo + wrk; it < e_hi; it += nwrk) {
        if (it < 2 * 8192) { const int up = it >> 13, q = it & 8191, e = q >> 7, q2 = q & 127, kb = q2 >> 3, nb = q2 & 7, n0 = 32 * nb;
            const float* Wm = (up ? w_eu : w_eg) + (size_t)e * D * FF; const float sc = f8_scale_of(Wm, lane); if (q2 == 0 && lane == 0) wsc[4 * e + up] = 1.0f / sc;
            tr_item_f8(Wm, FF, egu_t + (size_t)e * 512 * 1024, 1024, 64 * kb, n0, 256 * (n0 >> 7) + (n0 & 127) + 128 * up, scr, lane, sc); }
        else { const int r = it - 2 * 8192, e = r >> 7, q2 = r & 127, kb = q2 >> 5, nb = q2 & 31; const float* Wm = w_ed + (size_t)e * FF * D; const float sc = f8_scale_of(Wm, lane); if (q2 == 0 && lane == 0) wsc[4 * e + 2] = 1.0f / sc;
            tr_item_f8(Wm, D, ed_t + (size_t)e * 1024 * 256, 256, 64 * kb, 32 * nb, 32 * nb, scr, lane, sc); }
    }
}
#define W_EGU_P(lt) ((unsigned char*)(args.ws + (((lt) & 1) ? W_EGU_ALT : W_EGU_T)))
#define WSC_P(lt) ((float*)(args.ws + MS_WSC) + ((lt) & 1) * 256)
#define W_ED_P(lt)  ((unsigned char*)(args.ws + (((lt) & 1) ? W_ED_ALT : W_ED_T)))
#define PREP_EXPERTS(lt, e_lo, e_hi, wrk, nwrk) prep_expert_items(args.in[15] + (size_t)(lt) * NE * D * FF, args.in[16] + (size_t)(lt) * NE * D * FF, args.in[17] + (size_t)(lt) * NE * FF * D, W_EGU_P(lt), W_ED_P(lt), WSC_P(lt), e_lo, e_hi, wrk, nwrk, (LAS float*)(F.lds + F.wave * 16384), lane_id())
#ifndef P9_IPW
#define P9_IPW 5
#endif
constexpr int PE_A = 9830, PE_B = PE_A + 8602, PE_ALL = 3 * 8192;
#define PREP_WEIGHTS(E_LO) do { \
            LAS float* scr = (LAS float*)(F.lds + F.wave * 16384); \
            const float* w_in = L_W_IN; const float* w_br_attn = L_W_BRA; const float* w_out = L_W_OUT; const float* w_sg = L_W_SG; const float* w_su = L_W_SU; const float* w_sd = L_W_SD; \
            const float* w_eg = L_W_EG; const float* w_eu = L_W_EU; const float* w_ed = L_W_ED; const float* w_router = L_W_R; \
            constexpr int I_IN = 16 * 104, I_BA = 8 * 32, I_OUT = 16 * 32, I_SG = 16 * 8, I_SD = 4 * 32, I_EG = 64 * 128, I_ED = 64 * 128, I_R = 16 * 2; \
            constexpr int NITEMS = I_IN + I_BA + I_OUT + 2 * I_SG + I_SD + I_R; \
            for (int it = F.gw; it < NITEMS; it += F.NGW) { \
                int r = it; \
                if (r < I_IN) { const int kb = r / 104, nb = r % 104; const float sc = f8_scale_of(w_in, lane); if (r == 0 && lane == 0) *WSC_IN = 1.0f / sc; tr_item_f8(w_in, DIN, (unsigned char*)(args.ws + W_IN_T), 1024, 64 * kb, 32 * nb, 32 * nb, scr, lane, sc); continue; } r -= I_IN; \
                if (r < I_BA) { const int kb = r / 32, nb = r % 32; tr_item_f8(w_br_attn, D, (unsigned char*)(args.ws + W_BA_T), 512, 64 * kb, 32 * nb, 32 * nb, scr, lane, f8_scale_of(w_br_attn, lane)); continue; } r -= I_BA; \
                if (r < I_OUT) { const int kb = r / 32, nb = r % 32; const float sc = f8_scale_of(w_out, lane); if (r == 0 && lane == 0) WSC_IN[1] = 1.0f / sc; tr_item_f8(w_out, D, (unsigned char*)(args.ws + W_OUT_T), 1024, 64 * kb, 32 * nb, 32 * nb, scr, lane, sc); continue; } r -= I_OUT; \
                if (r < 2 * I_SG) { const int up = r / I_SG, q = r % I_SG, kb = q / 8, nb = q % 8, n0 = 32 * nb; tr_item(up ? w_su : w_sg, FF, (h16*)(args.ws + W_SGU_T), 1024, 64 * kb, n0, 256 * (n0 >> 7) + (n0 & 127) + 128 * up, scr, lane); continue; } r -= 2 * I_SG; \
                if (r < I_SD) { const int kb = r / 32, nb = r % 32; tr_item(w_sd, D, (h16*)(args.ws + W_SD_T), 256, 64 * kb, 32 * nb, 32 * nb, scr, lane); continue; } r -= I_SD; \
                { const int kb = r / 2, nb = r % 2; tr_item_hilo(w_router, NE, (h16*)(args.ws + W_R_T), 1024, 64 * kb, 32 * nb, scr, lane); } \
            } \
            PREP_EXPERTS(l, (E_LO), PE_ALL, F.gw, F.NGW); \
            { unsigned char* wpe = (unsigned char*)(args.ws + W_PE_T); const float* w_pool = L_W_POOL; const float* pool_scale = L_PSCALE; const float* w_br_pool = L_W_BRP; \
                \
              const float sc_pe = f8_scale_of(w_pool, lane) * f8_scale_of(w_br_pool, lane) * (1.0f / 512.0f), sc_ba = f8_scale_of(w_br_attn, lane), sc_i = f8_scale_of(w_in, lane); \
              if (F.gw == 0 && lane == 0) { float psc = sc_i * (1.0f / 256.0f); asm volatile("" : "+v"(psc)); const float osc = psc * 4.0f; WSC_IN[2] = psc; WSC_IN[3] = osc; WSC_IN[4] = (osc * sc_ba) / (psc * sc_pe); WSC_IN[5] = 16.0f / (osc * sc_ba); } \
              for (int idx = F.gw; idx < 512 * 16; idx += F.NGW) { const int cg = idx >> 4, n = ((idx & 15) << 6) + lane, g = cg >> 7; float s = 0.f; \
                  const float* wp = w_pool + (size_t)cg * 128; const float* ps = pool_scale + 128 * g; const float* wb = w_br_pool + (size_t)(128 * g) * D + n; \
                  float wv[128]; \
            _Pragma("unroll") \
                  for (int d = 0; d < 128; ++d) wv[d] = wb[(size_t)d * D]; \
            _Pragma("unroll") \
                  for (int d = 0; d < 128; ++d) s += wp[d] * ps[d] * wv[d]; \
                  wpe[(size_t)n * 512 + cg] = (unsigned char)(f8x4((f32x4){s, s, s, s} * sc_pe) & 0xffu); } } \
} while (0)
#define X32   (args.out)
#define XB    ((h16*)(args.ws + WS_XB))
#define XB8   ((unsigned char*)(args.ws + W_XB8))
#define WSC_IN ((float*)(args.ws + MS_WSC) + 512)
#define HH    ((h16*)(args.ws + R_HH))
#define PD8   ((unsigned char*)(args.ws + R_PD))
#define O8    ((unsigned char*)(args.ws + R_PD + 16 * MiB))
#define MG    ((h16*)(args.ws + R_MG))
#define G8B   ((unsigned char*)(args.ws + WS_R + 336 * MiB))
#define HB    ((h16*)(args.ws + WS_HB))
#define HS    ((h16*)(args.ws + WS_HS))
#define YD    ((h16*)(args.ws + WS_R))
#define LOGIT ((float*)(args.ws + WS_HB))
#define ESEL  ((int*)(args.ws + MS_ESEL))
#define GATE  ((float*)(args.ws + MS_GATE))
#define RANKL ((int*)(args.ws + MS_RANK))
#define SLOT  ((int*)(args.ws + MS_SLOT))
#define TOKL  ((int*)(args.ws + MS_TOKL))
#define GATL  ((float*)(args.ws + MS_GATL))
#define WCNT  ((int*)(args.ws + MS_WCNT))
#define GTOT  ((int*)(args.ws + MS_GTOT))
#define BLKE  ((int*)(args.ws + MS_BLKE))
#define L_W_IN   (args.in[3] + (size_t)l * D * DIN)
#define L_B_IN   (args.in[4] + (size_t)l * DIN)
#define L_W_POOL (args.in[5] + (size_t)l * 4 * 128 * 128)
#define L_PSCALE (args.in[6] + (size_t)l * 512)
#define L_SINKS  (args.in[7] + (size_t)l * 8)
#define L_W_BRP  (args.in[8] + (size_t)l * 512 * D)
#define L_W_BRA  (args.in[9] + (size_t)l * 512 * D)
#define L_W_OUT  (args.in[10] + (size_t)l * D * D)
#define L_LN1G   (args.in[11] + (size_t)l * D)
#define L_LN1B   (args.in[12] + (size_t)l * D)
#define L_W_R    (args.in[13] + (size_t)l * D * NE)
#define L_RBIAS  (args.in[14] + (size_t)l * NE)
#define L_W_EG   (args.in[15] + (size_t)l * NE * D * FF)
#define L_W_EU   (args.in[16] + (size_t)l * NE * D * FF)
#define L_W_ED   (args.in[17] + (size_t)l * NE * FF * D)
#define L_W_SG   (args.in[18] + (size_t)l * D * FF)
#define L_W_SU   (args.in[19] + (size_t)l * D * FF)
#define L_W_SD   (args.in[20] + (size_t)l * FF * D)
#define L_LN2G   (args.in[21] + (size_t)l * D)
#define L_LN2B   (args.in[22] + (size_t)l * D)
__global__ void __launch_bounds__(512, 2) fwd_kernel(Args args) {
    extern __shared__ __attribute__((aligned(16))) unsigned char lds_raw[];
    Frame F;
    F.lds = (LAS unsigned char*)lds_raw;
    F.wave = __builtin_amdgcn_readfirstlane((int)threadIdx.x >> 6);
    F.G = gridDim.x; { const int bx = blockIdx.x; F.vcu = (F.G % 8 == 0) ? (bx % 8) * (F.G / 8) + bx / 8 : bx; }
    F.gw = F.vcu * 8 + F.wave; F.NGW = F.G * 8;
    unsigned* ctl = (unsigned*)(args.ws + WS_CTL);
    volatile LAS unsigned* MISC = (volatile LAS unsigned*)(F.lds + MISC_OFF);
    for (int u = threadIdx.x; u < (LDS_BYTES - LDSCTL_OFF) / 4; u += 512) ((LAS unsigned*)(F.lds + LDSCTL_OFF))[u] = 0u;
    __syncthreads();
#if MK_ONE_LAUNCH
    XcdBarrier bar = xcd_barrier_post(ctl + CW_BAR, MISC + 8);
#define GRID_BAR() xcd_barrier(bar, F.wave)
#else
#define GRID_BAR() do {} while (0)
#endif
    const int lo = args.ph_lo, hi = args.ph_hi;
#ifndef PHASE_MASK
#define PHASE_MASK 0xfff
#endif
#ifndef REPEAT_MASK
#define REPEAT_MASK 0
#endif
#define REPS(p) for (int rep_ = 0; rep_ < 1 + ((REPEAT_MASK >> (p)) & 1); ++rep_)
#define IN(p) (((PHASE_MASK >> ((p) - pb)) & 1) && lo <= (p) && (p) < hi)
#define PHASE_REGS const int lane = lane_id(); const int tid = F.wave * 64 + lane; int vcu = F.vcu, bx = (int)blockIdx.x; asm volatile("" : "+s"(vcu), "+s"(bx)); (void)lane; (void)tid; (void)vcu; (void)bx;

    for (int l = 0; l < DEPTH; ++l) {
        const int pb = l * NPH;
        if (IN(pb + 0) && l == 0) {
            PHASE_REGS
            PREP_WEIGHTS(0);
            for (int m = F.gw; m < T; m += F.NGW) { f32x4 v[4];
#pragma unroll
                for (int j = 0; j < 4; ++j) v[j] = *(const f32x4*)(args.in[0] + (size_t)m * D + 8 * lane + 4 * (j & 1) + 512 * (j >> 1));
                ln_store8(v, args.in[1], args.in[2], nullptr, XB + (size_t)m * D, lane, -1, -1, XB8 + (size_t)m * D); }
            GRID_BAR();
        }
        if (IN(pb + 1)) {
            PHASE_REGS
            SchedDense S; S.o.init(T, DIN, F.G, bx); S.a = (const char*)XB8; S.b = (const char*)(args.ws + W_IN_T); S.apitch = 1024; S.bpitch = 1024;
            EpiInProj E{HH, L_B_IN, *WSC_IN};
            REPS(1) GEMM_PHASE_F8(512, S, E);
            if (l + 1 < DEPTH && F.G == 256 && bx >= 128) PREP_EXPERTS(l + 1, 0, PE_A, (bx - 128) * 8 + F.wave, 128 * 8);
            GRID_BAR();
        }
        if (IN(pb + 2)) {
            PHASE_REGS
            { const int g = F.gw & 3, c8 = 16 * g + (lane & 15); const float psc = WSC_IN[2];
              for (int it = F.gw; it < T; it += 2 * F.NGW) { const int tA = (it >> 2) * 4 + (lane >> 4); const int it2 = (it + F.NGW < T) ? it + F.NGW : it; const int tB = (it2 >> 2) * 4 + (lane >> 4);
                  if (g == 0) pool_pair<2>(HH, PD8, psc, c8, tA, tB); else if (g == 1) pool_pair<4>(HH, PD8, psc, c8, tA, tB); else if (g == 2) pool_pair<8>(HH, PD8, psc, c8, tA, tB); else pool_pair<16>(HH, PD8, psc, c8, tA, tB); } }
            for (int U = vcu; U < NB * 16 * 2; U += F.G) attn_unit(F.lds, HH, O8, WSC_IN[3], L_SINKS, U >> 5, (U >> 1) & 15, U & 1, tid);
            GRID_BAR();
        }
        if (IN(pb + 3)) {
            PHASE_REGS
            SchedMerged S; S.o.init(T, D, F.G, bx); S.pd = (const char*)PD8; S.oo = (const char*)O8; S.wpe = (const char*)(args.ws + W_PE_T); S.wba = (const char*)(args.ws + W_BA_T);
            EpiMerged E{(unsigned char*)MG, G8B, WSC_IN[4], WSC_IN[5]};
            REPS(3) GEMM_PHASE_F8(256, S, E);
            GRID_BAR();
        }
        if (IN(pb + 4)) {
            PHASE_REGS
            SchedDense S; S.o.init(T, D, F.G, bx); S.a = (const char*)MG; S.b = (const char*)(args.ws + W_OUT_T); S.apitch = 1024; S.bpitch = 1024;
            EpiResid E{(h16*)X32, XB, WSC_IN[1] * 0.0625f};
            REPS(4) GEMM_PHASE_F8(512, S, E);
            GRID_BAR();
        }
        if (IN(pb + 5)) {
            PHASE_REGS
            for (int m0 = F.gw; m0 < T; m0 += 4 * F.NGW) { u32x4 ra[4], rb4[4];
#pragma unroll
                for (int q = 0; q < 4; ++q) { const int m = (m0 + q * F.NGW < T) ? m0 + q * F.NGW : m0; const h16* sp = (const h16*)X32 + (size_t)m * D + 8 * lane;
                    ra[q] = __builtin_nontemporal_load((const u32x4*)sp); rb4[q] = __builtin_nontemporal_load((const u32x4*)(sp + 512)); }
#pragma unroll
                for (int q = 0; q < 4; ++q) { const int m = m0 + q * F.NGW; if (m < T) { f32x4 v[4]; unpack8(ra[q], v[0], v[1]); unpack8(rb4[q], v[2], v[3]); ln_store8(v, L_LN1G, L_LN1B, nullptr, XB + (size_t)m * D, lane, -1, -1, XB8 + (size_t)m * D); } } }
            GRID_BAR();
        }
        if (IN(pb + 6)) {
            PHASE_REGS
            SchedSharedRouter S{F.G, vcu, (const char*)XB, (const char*)(args.ws + W_SGU_T), (const char*)(args.ws + W_R_T)};
            EpiSharedRouter E{HS, LOGIT};
            REPS(6) GEMM_PHASE(1024, S, E);
            GRID_BAR();
        }
        if (IN(pb + 7)) {
            PHASE_REGS
            LAS int* lcnt = (LAS int*)(F.lds);
            const float rb = L_RBIAS[lane];
            const float dsc = WSC_P(l)[4 * lane] * WSC_P(l)[4 * lane + 1] * WSC_P(l)[4 * lane + 2] * 4194304.0f;
            REPS(7) for (int w = vcu; w < 256; w += F.G) {
                int mycnt = 0; const int t0 = w * 128 + F.wave * 16;
                float lgs[16];
#pragma unroll
                for (int tt = 0; tt < 16; ++tt) lgs[tt] = LOGIT[(size_t)(t0 + tt) * NE + lane] + LOGIT[(size_t)T * NE + (size_t)(t0 + tt) * NE + lane];
#pragma unroll
                for (int tt = 0; tt < 16; ++tt) { const int t = t0 + tt;
                    const float lg = lgs[tt]; const float scv = 1.0f / (1.0f + __expf(-lg)); const float bs = scv + rb;
                    const float m1 = max8(bs);
                    const unsigned long long eq = __ballot(bs == m1); const int g = lane >> 3; const unsigned gm = (unsigned)(eq >> (8 * g)) & 0xffu; const int first = __builtin_ctz(gm);
                    const float m2 = max8(((lane & 7) == first) ? -INFINITY : bs);
                    const float gs = m1 + m2; int grank = 0;
#pragma unroll
                    for (int j = 0; j < 8; ++j) { const float gj = rdlane(gs, 8 * j); grank += (gj > gs || (gj == gs && j < g)) ? 1 : 0; }
                    const bool keep = grank < 4; const float v = keep ? bs : -INFINITY; int rank = 0;
#pragma unroll
                    for (int j = 0; j < 64; ++j) { const float vj = rdlane(v, j); rank += (vj > v || (vj == v && j < lane)) ? 1 : 0; }
                    const bool sel = keep && rank < 8;
                    const float ssum = wave_sum(sel ? scv : 0.f);
                    if (sel) { ESEL[t * 8 + rank] = lane; GATE[t * 8 + rank] = scv / ssum * 2.5f * dsc; RANKL[t * 8 + rank] = mycnt; mycnt++; }
                }
                WCNT[(size_t)(w * 8 + F.wave) * 64 + lane] = mycnt;
                lcnt[F.wave * 64 + lane] = mycnt;
                __syncthreads();
                if (F.wave == 0) { int s = 0;
#pragma unroll
                    for (int v = 0; v < 8; ++v) s += lcnt[v * 64 + lane];
                    GTOT[w * 64 + lane] = s; }
                __syncthreads();
            }
            GRID_BAR();
        }
        if (IN(pb + 8)) {
            PHASE_REGS
            REPS(8) for (int w = vcu; w < 256; w += F.G) {
                int tot = 0, before = 0;
#pragma unroll 64
                for (int w2 = 0; w2 < 256; ++w2) { const int c = GTOT[w2 * 64 + lane]; tot += c; before += (w2 < w) ? c : 0; }
                for (int v2 = 0; v2 < F.wave; ++v2) before += WCNT[(size_t)(w * 8 + v2) * 64 + lane];
                const int pc = (tot + 255) & ~255; int incl = pc;
#pragma unroll
                for (int o = 1; o < 64; o <<= 1) { const int xv = __shfl_up(incl, o); if (lane >= o) incl += xv; }
                const int pstart = incl - pc, base = pstart + before; const int t0 = w * 128 + F.wave * 16;
#pragma unroll
                for (int it = 0; it < 2; ++it) { const int idx = it * 64 + lane, tt = t0 + (idx >> 3), k = idx & 7; const int e = ESEL[tt * 8 + k], r = RANKL[tt * 8 + k]; const float g = GATE[tt * 8 + k];
                    const int dest = __shfl(base, e) + r; TOKL[dest] = tt * 9 + k; GATL[dest] = g; }
                if (F.wave == 0 && w < 64) {
                    const int ps_ = __shfl(pstart, w), te = __shfl(tot, w), pe = __shfl(pc, w);
                    for (int i2 = te + lane; i2 < pe; i2 += 64) { TOKL[ps_ + i2] = YT_DUMP; GATL[ps_ + i2] = 0.f; } }
                if (F.wave == 1) {
                    const int nblk = __shfl(incl, 63) >> 8; const int rbk = 8 * w + (lane & 7); int cnt = 0;
                    for (int e = 0; e < 64; ++e) { const int pend = __shfl(incl, e); cnt += (pend <= rbk * 256) ? 1 : 0; }
                    if (lane < 8 && rbk < nblk) BLKE[rbk] = cnt < 63 ? cnt : 63;
                    if (w == 0 && lane == 0) BLKE[NBLK_MAX] = nblk; }
            }
            GRID_BAR();
        }
        if (IN(pb + 9)) {
            PHASE_REGS
            const int nblk = __builtin_amdgcn_readfirstlane(BLKE[NBLK_MAX]);
            { LAS int* bl = (LAS int*)(F.lds + LDS_BLKE); for (int i = tid; i < nblk; i += 512) bl[i] = BLKE[i]; __syncthreads(); }
            SchedMoeGU S{F.G, vcu, nblk, (const char*)(args.ws + W_XB8), (const char*)W_EGU_P(l), (const LAS int*)(F.lds + LDS_BLKE), TOKL};
            EpiMoeGU E{(unsigned char*)HB, WSC_P(l)};
            REPS(9) GEMM_PHASE_F8(512, S, E);
            { const int rounds = (2 * nblk + 255) >> 8, busy = 2 * nblk - 256 * (rounds - 1);
              const int n9 = min(PE_ALL - PE_A, (256 - busy) * 8 * P9_IPW);
              if (l + 1 < DEPTH && F.G == 256 && vcu >= busy) PREP_EXPERTS(l + 1, PE_A, PE_A + n9, (vcu - busy) * 8 + F.wave, (256 - busy) * 8); }
            GRID_BAR();
        }
        if (IN(pb + 10)) {
            PHASE_REGS
            const int nblk = __builtin_amdgcn_readfirstlane(BLKE[NBLK_MAX]);
            { LAS int* bl = (LAS int*)(F.lds + LDS_BLKE); for (int i = tid; i < nblk; i += 512) bl[i] = BLKE[i]; __syncthreads(); }
            { SchedShDown S{F.G, vcu, (const char*)HS, (const char*)(args.ws + W_SD_T)};
              EpiMoeDown<false> E{(unsigned char*)(args.ws + WS_R), (h16*)(args.ws + R_YS)};
              GEMM_PHASE(256, S, E); }
            __syncthreads();
            { SchedMoeDownR S{F.G, vcu, nblk, (const char*)HB, (const char*)W_ED_P(l), (const LAS int*)(F.lds + LDS_BLKE), TOKL};
              EpiMoeDown<true> E{(unsigned char*)(args.ws + WS_R), (h16*)(args.ws + R_YS)};
              REPS(10) GEMM_PHASE_F8(128, S, E); }
            GRID_BAR();
        }
        if (IN(pb + 11)) {
            PHASE_REGS
            { float* xo = (l == DEPTH - 1) ? X32 : nullptr;
            const unsigned char* YQ = (const unsigned char*)(args.ws + WS_R); const h16* YS = (const h16*)(args.ws + R_YS);
            const int c0 = 256 * (lane >> 4) + 32 * ((lane >> 2) & 3) + 8 * (lane & 3), c1 = c0 + 128;
            for (int m0_ = F.gw; m0_ < T; m0_ += 2 * F.NGW) { int m0 = m0_; asm volatile("" : "+s"(m0));
                u32x4 yq[2][9], xa[2], xb2[2]; unsigned short ys[2]; float gt[2];
#pragma unroll
                for (int q = 0; q < 2; ++q) { const int m = (m0 + q * F.NGW < T) ? m0 + q * F.NGW : m0;
                    xa[q] = *(const u32x4*)(XB + (size_t)m * D + c0); xb2[q] = *(const u32x4*)(XB + (size_t)m * D + c1); gt[q] = GATE[(size_t)m * 8 + (lane & 7)];
#pragma unroll
                    for (int k = 0; k < 9; ++k) yq[q][k] = __builtin_nontemporal_load((const u32x4*)(YQ + ((size_t)m * 9 + k) * 1024 + lane * 16));
                    ys[q] = __builtin_nontemporal_load((const unsigned short*)(YS + ((size_t)m * 9 + 8) * 64 + lane)); }
#pragma unroll
                for (int q = 0; q < 2; ++q) { const int m = m0 + q * F.NGW; if (m < T) {
                    f32x4 v[4]; unpack8(xa[q], v[0], v[1]); unpack8(xb2[q], v[2], v[3]);
#pragma unroll
                    for (int j = 0; j < 4; ++j) v[j] = v[j] * ALPHA;
#pragma unroll
                    for (int k = 0; k < 8; ++k) { const float gk = rdlane(gt[q], k);
#pragma unroll
                        for (int j = 0; j < 4; ++j) { const f32x2 lo = __builtin_amdgcn_cvt_pk_f32_fp8((int)yq[q][k][j], false), hi = __builtin_amdgcn_cvt_pk_f32_fp8((int)yq[q][k][j], true);
                            v[j][0] += lo.x * gk; v[j][1] += lo.y * gk; v[j][2] += hi.x * gk; v[j][3] += hi.y * gk; }
                        __builtin_amdgcn_sched_barrier(0); }
                    { const float sc = h2f(ys[q]); const float bias = -128.0f * sc;
#pragma unroll
                        for (int j = 0; j < 4; ++j) { const unsigned wd = yq[q][8][j] ^ 0x80808080u;
                            v[j][0] += (float)(wd & 0xffu) * sc + bias; v[j][1] += (float)((wd >> 8) & 0xffu) * sc + bias; v[j][2] += (float)((wd >> 16) & 0xffu) * sc + bias; v[j][3] += (float)(wd >> 24) * sc + bias; } }
                    ln_store8(v, L_LN2G, L_LN2B, xo ? xo + (size_t)m * D : nullptr, XB + (size_t)m * D, lane, c0, c1, XB8 + (size_t)m * D); } } } }
            if (l + 1 < DEPTH) { const int nblk_ = __builtin_amdgcn_readfirstlane(BLKE[NBLK_MAX]); const int rounds_ = (2 * nblk_ + 255) >> 8, busy_ = 2 * nblk_ - 256 * (rounds_ - 1);
                const int e_lo = (F.G != 256) ? 0 : PE_A + min(PE_ALL - PE_A, (256 - busy_) * 8 * P9_IPW);
                ++l; PREP_WEIGHTS(e_lo); --l; }
            if (pb + 11 != DEPTH * NPH - 1) GRID_BAR();
        }
    }
#undef IN
}

extern "C" void kernel_launch(void* const* d_in, const int* in_sizes, int n_in, void* d_out, int out_size, void* d_ws, size_t ws_size, hipStream_t stream) {
    static int grid = 0;
    if (grid == 0) {
        if (n_in != 23 || out_size != T * D || ws_size < WS_END2) { fprintf(stderr, "kernel_launch: unexpected shapes (n_in %d out %d ws %zu)\n", n_in, out_size, ws_size); grid = -1; return; }
        int dev = 0, cus = 0;
        if (hipGetDevice(&dev) != hipSuccess || hipDeviceGetAttribute(&cus, hipDeviceAttributeMultiprocessorCount, dev) != hipSuccess) { grid = -1; return; }
        if (hipFuncSetAttribute((const void*)fwd_kernel, hipFuncAttributeMaxDynamicSharedMemorySize, LDS_BYTES) != hipSuccess) { fprintf(stderr, "kernel_launch: hipFuncSetAttribute failed\n"); grid = -1; return; }
        int per_cu = 0;
        if (hipOccupancyMaxActiveBlocksPerMultiprocessor(&per_cu, (const void*)fwd_kernel, 512, LDS_BYTES) != hipSuccess || per_cu < 1) { fprintf(stderr, "kernel_launch: occupancy query says %d\n", per_cu); }
        (void)hipGetLastError();
        grid = cus;
    }
    if (grid < 0) return;
    (void)hipMemsetAsync((char*)d_ws + WS_CTL, 0, CTL_ZERO_BYTES, stream);
    Args a{};
    for (int i = 0; i < 23; ++i) a.in[i] = (const float*)d_in[i];
    a.out = (float*)d_out; a.ws = (unsigned char*)d_ws;
#if MK_ONE_LAUNCH
    a.ph_lo = 0; a.ph_hi = DEPTH * NPH;
    hipLaunchKernelGGL(fwd_kernel, dim3(grid), dim3(512), LDS_BYTES, stream, a);
#else
    for (int p = 0; p < DEPTH * NPH; ++p) { a.ph_lo = p; a.ph_hi = p + 1; hipLaunchKernelGGL(fwd_kernel, dim3(grid), dim3(512), LDS_BYTES, stream, a); }
#endif
}
```

```cpp
#include <hip/hip_runtime.h>
#include <stdint.h>
#include <stdio.h>

#ifndef MK_ONE_LAUNCH
#define MK_ONE_LAUNCH 1
#endif

#define GAS __attribute__((address_space(1)))
#define LAS __attribute__((address_space(3)))
typedef unsigned short h16;
typedef short h16x8 __attribute__((ext_vector_type(8)));
typedef float f32x4 __attribute__((ext_vector_type(4)));
typedef float f32x2 __attribute__((ext_vector_type(2)));
typedef unsigned u32x4 __attribute__((ext_vector_type(4)));
typedef unsigned u32x2 __attribute__((ext_vector_type(2)));

constexpr int NB = 16, SEQ = 2048, T = NB * SEQ, D = 1024, DIN = 3328, DEPTH = 4;
constexpr int C_U = 0, C_Q = 512, C_K = 1024, C_V = 1152, C_GP = 1280, C_GA = 2304;
constexpr int NE = 64, FF = 256, TOPK = 8;
constexpr int NASSIGN = T * TOPK;
constexpr int NBLK_MAX = NASSIGN / 256 + NE;
constexpr int A_PAD = NBLK_MAX * 256;
constexpr float ALPHA = 1.6817928305074290f;
constexpr float LN_EPS = 1e-5f;
constexpr int NPH = 12;

constexpr size_t MiB = 1u << 20;
constexpr size_t WS_CTL = 0, CTL_ZERO_BYTES = 1 * MiB;
constexpr size_t WS_W = 1 * MiB;
constexpr size_t W_IN_T = WS_W + 0 * MiB;
constexpr size_t W_PE_T = WS_W + 7 * MiB;
constexpr size_t W_BA_T = WS_W + 8 * MiB;
constexpr size_t W_OUT_T = WS_W + 9 * MiB;
constexpr size_t W_R_T = WS_W + 11 * MiB;
constexpr size_t W_SGU_T = WS_W + 12 * MiB;
constexpr size_t W_SD_T = WS_W + 13 * MiB;
constexpr size_t W_EGU_T = WS_W + 14 * MiB;
constexpr size_t W_ED_T = WS_W + 78 * MiB;
constexpr size_t W_XB8 = W_EGU_T + 32 * MiB;
constexpr size_t WS_XB = 111 * MiB;
constexpr size_t WS_HB = 175 * MiB;
constexpr size_t WS_HS = 311 * MiB;
constexpr size_t WS_MISC = 327 * MiB;
constexpr size_t MS_LOGIT = WS_MISC;
constexpr size_t MS_ESEL = WS_MISC + 8 * MiB;
constexpr size_t MS_GATE = WS_MISC + 9 * MiB;
constexpr size_t MS_RANK = WS_MISC + 10 * MiB;
constexpr size_t MS_SLOT = WS_MISC + 11 * MiB;
constexpr size_t MS_TOKL = WS_MISC + 12 * MiB;
constexpr size_t MS_GATL = WS_MISC + 13 * MiB + 256 * 1024;
constexpr size_t MS_WCNT = WS_MISC + 14 * MiB + 512 * 1024;
constexpr size_t MS_GTOT = WS_MISC + 15 * MiB;
constexpr size_t MS_BLKE = WS_MISC + 15 * MiB + 256 * 1024;
constexpr size_t MS_WSC = WS_MISC + 15 * MiB + 512 * 1024;
constexpr size_t WS_R = 343 * MiB;
constexpr size_t R_HH = WS_R;
constexpr size_t R_PD = WS_R + 208 * MiB;
constexpr size_t R_MG = WS_R + 240 * MiB;
constexpr size_t WS_END = WS_R + 577 * MiB;
constexpr size_t W_EGU_ALT = WS_END;
constexpr size_t W_ED_ALT = WS_END + 64 * MiB;
constexpr size_t WS_END2 = WS_END + 96 * MiB;
constexpr size_t R_YS = WS_R + 296 * MiB;
constexpr int YT_DUMP = T * 9;
static_assert((size_t)A_PAD * 4 <= 1 * MiB + 256 * 1024, "toklist");
static_assert((size_t)A_PAD * 256 * 2 <= 136 * MiB, "Hbuf");
static_assert(((size_t)T * 9 + 1) * 1024 * 2 <= 577 * MiB, "Yt");

constexpr int CW_BAR = 4096;

constexpr int RING_BYTES = 131072;
constexpr int LDSCTL_OFF = RING_BYTES, MISC_OFF = LDSCTL_OFF + 320;
constexpr int LDS_BYTES = 147456;
constexpr int LDS_BLKE = LDSCTL_OFF + 1024;
constexpr int LDS_IDX = LDS_BLKE + 4352;
constexpr int LDS_OID = LDS_IDX + 2048;
static_assert(LDS_OID + 3072 <= LDS_BYTES, "LDS map");

#define RLX_AGENT __ATOMIC_RELAXED, __HIP_MEMORY_SCOPE_AGENT
__device__ __forceinline__ int lane_id() { int l; asm volatile("v_mbcnt_lo_u32_b32 %0, -1, 0\n\tv_mbcnt_hi_u32_b32 %0, -1, %0" : "=v"(l)); return l; }
typedef _Float16 f16x2 __attribute__((ext_vector_type(2)));
typedef _Float16 f16x8 __attribute__((ext_vector_type(8)));
__device__ __forceinline__ float h2f(unsigned short h) { return (float)__builtin_bit_cast(_Float16, h); }
__device__ __forceinline__ unsigned short f2h(float f) { return __builtin_bit_cast(unsigned short, (_Float16)f); }
__device__ __forceinline__ unsigned cvt_pk_h16(float lo, float hi) { f32x2 v = {lo, hi}; return __builtin_bit_cast(unsigned, __builtin_convertvector(v, f16x2)); }
__device__ __forceinline__ float lo16(unsigned w) { return (float)__builtin_bit_cast(f16x2, w)[0]; }
__device__ __forceinline__ float hi16(unsigned w) { return (float)__builtin_bit_cast(f16x2, w)[1]; }
__device__ __forceinline__ float sigmoidf_(float x) { return __builtin_amdgcn_rcpf(1.0f + __builtin_amdgcn_exp2f(-1.4426950408889634f * x)); }
template <int CTRL> __device__ __forceinline__ float dppf(float x) { return __builtin_bit_cast(float, __builtin_amdgcn_update_dpp(0, __builtin_bit_cast(int, x), CTRL, 0xf, 0xf, true)); }
__device__ __forceinline__ float rdlane(float x, int l) { return __builtin_bit_cast(float, __builtin_amdgcn_readlane(__builtin_bit_cast(int, x), l)); }
__device__ __forceinline__ float wave_sum(float v) {
    v += dppf<0xB1>(v); v += dppf<0x4E>(v); v += dppf<0x141>(v); v += dppf<0x140>(v);
    return (rdlane(v, 0) + rdlane(v, 16)) + (rdlane(v, 32) + rdlane(v, 48));
}
__device__ __forceinline__ float wave_max(float v) {
    v = fmaxf(v, dppf<0xB1>(v)); v = fmaxf(v, dppf<0x4E>(v)); v = fmaxf(v, dppf<0x141>(v)); v = fmaxf(v, dppf<0x140>(v));
    return fmaxf(fmaxf(rdlane(v, 0), rdlane(v, 16)), fmaxf(rdlane(v, 32), rdlane(v, 48)));
}
__device__ __forceinline__ float dppf_swap32(float x) { return __shfl_xor(x, 32); }
__device__ __forceinline__ float max8(float v) {
    v = fmaxf(v, dppf<0xB1>(v)); v = fmaxf(v, dppf<0x4E>(v)); return fmaxf(v, dppf<0x141>(v));
}

#define XB_TMO      128
#define XB_XCNT(j)  (256  + 64 * (j))
#define XB_XSUB(j)  (1280 + 64 * (j))
#define XB_XGEN(j)  (2304 + 64 * (j))
#define XB_TOP      3328
#define XB_TOPGEN   3392
#define XCD_BAR_WORDS 3456
#define XB_SPIN_CAP (1u << 18)
__device__ __forceinline__ unsigned xb_ld(unsigned* p)              { return __hip_atomic_load(p, __ATOMIC_RELAXED, __HIP_MEMORY_SCOPE_AGENT); }
__device__ __forceinline__ unsigned xb_add(unsigned* p, unsigned v) { return __hip_atomic_fetch_add(p, v, __ATOMIC_RELAXED, __HIP_MEMORY_SCOPE_AGENT); }
__device__ __forceinline__ unsigned xb_xcc_id() { return (unsigned)__builtin_amdgcn_s_getreg((3 << 11) | 20) & 0xFu; }
#define XB_SPIN(cond, bar) do { unsigned _sp = 0; while (cond) { __builtin_amdgcn_s_sleep(1); \
    if ((++_sp & 255u) == 0u) { if (xb_ld(&(bar)[XB_TMO])) break; if (_sp > XB_SPIN_CAP) { atomicAdd(&(bar)[XB_TMO], 1u); break; } } } } while (0)
struct XcdBarrier { unsigned* bar; unsigned x; volatile LAS unsigned* st; };
__device__ __forceinline__ XcdBarrier xcd_barrier_post(unsigned* bar, volatile LAS unsigned* st) {
    XcdBarrier b; b.bar = bar; b.x = xb_xcc_id(); b.st = st;
    if (threadIdx.x == 0) (void)xb_add(&bar[XB_XCNT(b.x)], 1u);
    return b;
}
__device__ __forceinline__ void xcd_barrier_complete(unsigned* bar, unsigned x, unsigned& nloc, unsigned& nx) {
    const unsigned G = gridDim.x * gridDim.y * gridDim.z;
    unsigned sum, cnt, mine, sp = 0u;
    for (;;) {
        sum = 0u; cnt = 0u; mine = 0u;
#pragma unroll
        for (unsigned j = 0; j < 16; ++j) { const unsigned c = xb_ld(&bar[XB_XCNT(j)]); sum += c; cnt += (c > 0u) ? 1u : 0u; mine = (j == x) ? c : mine; }
        if (sum == G) break;
        __builtin_amdgcn_s_sleep(1);
        if ((++sp & 255u) == 0u) { if (xb_ld(&bar[XB_TMO])) break; if (sp > XB_SPIN_CAP) { atomicAdd(&bar[XB_TMO], 1u); break; } }
    }
    nloc = mine > 0u ? mine : 1u; nx = cnt > 0u ? cnt : 1u;
}
__device__ __forceinline__ void xcd_barrier(const XcdBarrier& b, const int wave) {
    asm volatile("s_waitcnt vmcnt(0)" ::: "memory");
    __syncthreads();
    if (wave == 0 && lane_id() == 0) {
        unsigned* bar = b.bar;
        __builtin_amdgcn_s_waitcnt(0);
        unsigned nloc = b.st[0], nx = b.st[1];
        if (nloc == 0u) { xcd_barrier_complete(bar, b.x, nloc, nx); b.st[0] = nloc; b.st[1] = nx; }
        const unsigned old = xb_add(&bar[XB_XSUB(b.x)], 1u);
        const unsigned gen = old / nloc;
        if (old + 1u == (gen + 1u) * nloc) {
            __builtin_amdgcn_fence(__ATOMIC_RELEASE, "agent");
            asm volatile("s_waitcnt vmcnt(0)" ::: "memory");
            const unsigned og = xb_add(&bar[XB_TOP], 1u);
            const unsigned tg = og / nx;
            if (og + 1u == (tg + 1u) * nx) xb_add(&bar[XB_TOPGEN], 1u);
            else XB_SPIN(xb_ld(&bar[XB_TOPGEN]) == tg, bar);
            __builtin_amdgcn_fence(__ATOMIC_ACQUIRE, "agent");
            xb_add(&bar[XB_XGEN(b.x)], 1u);
            asm volatile("s_waitcnt vmcnt(0)" ::: "memory");
        } else {
            XB_SPIN(xb_ld(&bar[XB_XGEN(b.x)]) == gen, bar);
            __builtin_amdgcn_fence(__ATOMIC_ACQUIRE, "agent");
            asm volatile("s_waitcnt vmcnt(0)" ::: "memory");
        }
    }
    __syncthreads();
}

struct Unit {
    const char* a;
    const char* b;
    const int* ridx;
    unsigned apitch, bpitch;
    int row0;
    int col0;
    int kind;
    const int* oidx;
    const LAS int* oidl;
    int nt;
    int keep;
};
__device__ __forceinline__ int id2tok(int id) { const int t = (int)(((unsigned long long)(unsigned)id * 954437177ull) >> 33); return t < T ? t : T - 1; }
#define ACC_T f32x4 (&acc)[2][2][4][2]

template <class Epi, class Sched>
__device__ __forceinline__ void gemm_phase_simple(const int wid, const int K, const Sched& S, const Epi& E) {
    const int lane = lane_id(), tid = wid * 64 + lane; (void)tid;
    const int  wr = wid >> 2, wc = wid & 3, fr = lane & 15, fq = lane >> 4;
    Unit u;
    for (int i = 0; S.next(i, u); ++i) {
        f32x4 acc[2][2][4][2];
#pragma unroll
        for (int a = 0; a < 2; ++a)
#pragma unroll
            for (int b = 0; b < 2; ++b)
#pragma unroll
                for (int m = 0; m < 4; ++m)
#pragma unroll
                    for (int n = 0; n < 2; ++n) acc[a][b][m][n] = (f32x4){0.f, 0.f, 0.f, 0.f};
        unsigned offA[2][4], offB[2][2];
#pragma unroll
        for (int ai = 0; ai < 2; ++ai)
#pragma unroll
            for (int m = 0; m < 4; ++m) { const int r = 128 * ai + 64 * wr + 16 * m + fr; const int row = u.ridx ? id2tok(u.ridx[r]) : u.row0 + r; offA[ai][m] = (unsigned)row * u.apitch + (unsigned)fq * 16u; }
#pragma unroll
        for (int bj = 0; bj < 2; ++bj)
#pragma unroll
            for (int n = 0; n < 2; ++n) { const int wrow = 128 * bj + 32 * wc + 8 * (fr >> 2) + 4 * n + (fr & 3); offB[bj][n] = (unsigned)wrow * u.bpitch + (unsigned)fq * 16u; }
#pragma unroll 1
        for (int k0 = 0; k0 < K; k0 += 32) {
            h16x8 b[2][2];
#pragma unroll
            for (int bj = 0; bj < 2; ++bj)
#pragma unroll
                for (int n = 0; n < 2; ++n) b[bj][n] = *(const h16x8*)(u.b + offB[bj][n] + (size_t)k0 * 2);
#pragma unroll
            for (int ai = 0; ai < 2; ++ai) {
                h16x8 a[4];
#pragma unroll
                for (int m = 0; m < 4; ++m) a[m] = *(const h16x8*)(u.a + offA[ai][m] + (size_t)k0 * 2);
#pragma unroll
                for (int bj = 0; bj < 2; ++bj)
#pragma unroll
                    for (int m = 0; m < 4; ++m)
#pragma unroll
                        for (int n = 0; n < 2; ++n) acc[ai][bj][m][n] = __builtin_amdgcn_mfma_f32_16x16x32_f16(__builtin_bit_cast(f16x8, b[bj][n]), __builtin_bit_cast(f16x8, a[m]), acc[ai][bj][m][n], 0, 0, 0);
                asm volatile("" ::: "memory");
            }
        }
        u.oidl = nullptr;
        E(acc, u, wr, wc, fr, fq);
    }
}


#ifndef FAST_GEMM
#define FAST_GEMM 1
#endif
constexpr int HTB = 128 * 64 * 2;
__device__ __forceinline__ int lds_byte(int r, int c) { const int st = (r >> 4) * 2 + (c >> 5), rr = r & 15, cc = c & 31, ob = rr * 64 + cc * 2; return st * 1024 + (ob ^ (((ob >> 9) & 1) << 5)); }
__device__ __forceinline__ void stage_rc(int b, int& R, int& C) { const int st = b / 1024, sb = b % 1024, swz = sb ^ (((sb >> 9) & 1) << 5); R = (st >> 1) * 16 + swz / 64; C = (st & 1) * 32 + (swz % 64) / 2; }
__device__ __forceinline__ int perm32(int rho) { const int n = rho >> 4, i = rho & 15; return 8 * (i >> 2) + 4 * n + (i & 3); }

__device__ __forceinline__ const char* uptr(const char* p) { const unsigned long long v = (unsigned long long)p; const unsigned lo = __builtin_amdgcn_readfirstlane((unsigned)v), hi = __builtin_amdgcn_readfirstlane((unsigned)(v >> 32)); return (const char*)(((unsigned long long)hi << 32) | lo); }
typedef int i32x8 __attribute__((ext_vector_type(8)));
__device__ __forceinline__ i32x8 cat8(const u32x4 a, const u32x4 b) { return (i32x8){(int)a.x, (int)a.y, (int)a.z, (int)a.w, (int)b.x, (int)b.y, (int)b.z, (int)b.w}; }
template <int H> __device__ __forceinline__ f16x8 half8(const i32x8 v) { typedef int i32x4_ __attribute__((ext_vector_type(4))); const i32x4_ q = __builtin_shufflevector(v, v, 4 * H, 4 * H + 1, 4 * H + 2, 4 * H + 3); return __builtin_bit_cast(f16x8, q); }
template <bool F8, class Epi, class Sched>
__device__ __forceinline__ void gemm_phase(LAS unsigned char* lds, const int wid, const int K, const Sched& S, const Epi& E) {
    const int lane = lane_id(), tid = wid * 64 + lane;
    const int  wr = wid >> 2, wc = wid & 3, fr = lane & 15, fq = lane >> 4;
    int nt = K / 64; asm volatile("" : "+s"(nt));
    const unsigned ldsw = (unsigned)wid * 1024u;
    const int aoff = lds_byte(wr * 64 + fr, fq * 8), boff = lds_byte(wc * 32 + fr, fq * 8);
#define G_SA(b, h) (((b) * 2 + (h)) * HTB)
#define G_SB(b, h) ((4 + (b) * 2 + (h)) * HTB)
#define G_STAGE(bufoff, gbase, o0, o1) do { \
        __builtin_amdgcn_global_load_lds((const unsigned*)((const char*)(gbase) + (o0)), (LAS unsigned*)(lds + (bufoff) + ldsw), 16, 0, 0); \
        __builtin_amdgcn_global_load_lds((const unsigned*)((const char*)(gbase) + (o1)), (LAS unsigned*)(lds + (bufoff) + ldsw + 8192), 16, 0, 0); } while (0)
#define G_LDA(dst, b, h) do { _Pragma("unroll") for (int m = 0; m < 4; ++m) dst[m] = cat8(*(const LAS u32x4*)(lds + G_SA(b, h) + aoff + m * 2048), *(const LAS u32x4*)(lds + G_SA(b, h) + aoff + m * 2048 + 1024)); } while (0)
#define G_LDB(dst, b, h) do { _Pragma("unroll") for (int n = 0; n < 2; ++n) dst[n] = cat8(*(const LAS u32x4*)(lds + G_SB(b, h) + boff + n * 2048), *(const LAS u32x4*)(lds + G_SB(b, h) + boff + n * 2048 + 1024)); } while (0)
#define G_MMA(ai, bj, At, Bt) do { __builtin_amdgcn_s_setprio(1); _Pragma("unroll") for (int m = 0; m < 4; ++m) _Pragma("unroll") for (int n = 0; n < 2; ++n) { \
        if constexpr (F8) { acc[ai][bj][m][n] = __builtin_amdgcn_mfma_scale_f32_16x16x128_f8f6f4(Bt[n], At[m], acc[ai][bj][m][n], 0, 0, 0, 0, 0, 0); } \
        else { acc[ai][bj][m][n] = __builtin_amdgcn_mfma_f32_16x16x32_f16(half8<0>(Bt[n]), half8<0>(At[m]), acc[ai][bj][m][n], 0, 0, 0); \
               acc[ai][bj][m][n] = __builtin_amdgcn_mfma_f32_16x16x32_f16(half8<1>(Bt[n]), half8<1>(At[m]), acc[ai][bj][m][n], 0, 0, 0); } } \
        __builtin_amdgcn_s_setprio(0); } while (0)
#define G_WAIT_V(n) asm volatile("s_waitcnt vmcnt(" #n ")" ::: "memory")
#define G_WAIT_L(n) asm volatile("s_waitcnt lgkmcnt(" #n ")" ::: "memory")
#define G_BAR __builtin_amdgcn_s_barrier()
#define G_SCHED __builtin_amdgcn_sched_barrier(0)
#define G_OFFS(u, OA, OB, IDXB) do { int tl_ = wid * 64 + lane_id(); _Pragma("unroll") for (int i = 0; i < 2; ++i) { int R_, C_; stage_rc(tl_ * 16 + i * 8192, R_, C_); const int Rb_ = (R_ & ~31) + perm32(R_ & 31); \
        _Pragma("unroll") for (int h = 0; h < 2; ++h) { const int r_ = h * 128 + R_; const int row_ = (u).ridx ? id2tok(((const LAS int*)(lds + LDS_IDX + (IDXB) * 1024))[r_]) : (u).row0 + r_; \
        OA[h][i] = (unsigned)row_ * (u).apitch + (unsigned)C_ * 2u; OB[h][i] = (unsigned)(h * 128 + Rb_) * (u).bpitch + (unsigned)C_ * 2u; } } } while (0)
#define G_IDX_DMA(u, IDXB, OIDB) do { if ((u).ridx && wid < 4) __builtin_amdgcn_global_load_lds((const unsigned*)((u).ridx + wid * 64 + lane_id()), (LAS unsigned*)(lds + LDS_IDX + (IDXB) * 1024 + wid * 256), 4, 0, 0); \
        if ((u).oidx && wid < 4) __builtin_amdgcn_global_load_lds((const unsigned*)((u).oidx + wid * 64 + lane_id()), (LAS unsigned*)(lds + LDS_OID + (OIDB) * 1024 + wid * 256), 4, 0, 0); } while (0)
    Unit cur, nxt; int ui = 0;
    if (!S.next(0, cur)) return;
    if constexpr (Sched::DYN) nt = cur.nt;
    unsigned cOA[2][2], cOB[2][2];
    G_IDX_DMA(cur, 0, 0); asm volatile("s_waitcnt vmcnt(0)" ::: "memory"); __builtin_amdgcn_s_barrier(); asm volatile("" ::: "memory");
    G_OFFS(cur, cOA, cOB, 0);
    f32x4 acc[2][2][4][2];
#pragma unroll
    for (int a = 0; a < 2; ++a)
#pragma unroll
        for (int b = 0; b < 2; ++b)
#pragma unroll
            for (int m = 0; m < 4; ++m)
#pragma unroll
                for (int n = 0; n < 2; ++n) acc[a][b][m][n] = (f32x4){0.f, 0.f, 0.f, 0.f};
    i32x8 At[4], B0[2], B1[2];
    const char* cA = uptr(cur.a); const char* cB = uptr(cur.b);
    G_STAGE(G_SB(0, 0), cB, cOB[0][0], cOB[0][1]); G_STAGE(G_SB(0, 1), cB, cOB[1][0], cOB[1][1]); G_STAGE(G_SA(0, 0), cA, cOA[0][0], cOA[0][1]); G_STAGE(G_SA(0, 1), cA, cOA[1][0], cOA[1][1]);
    if (wr == 1) G_BAR;
    G_WAIT_V(2); G_BAR;
    { const char* cA1 = uptr(cA + 128); const char* cB1 = uptr(cB + 128);
      G_STAGE(G_SB(1, 0), cB1, cOB[0][0], cOB[0][1]); G_STAGE(G_SA(1, 0), cA1, cOA[0][0], cOA[0][1]); G_STAGE(G_SB(1, 1), cB1, cOB[1][0], cOB[1][1]); }
    G_WAIT_V(6); G_BAR;
    for (;;) {
        const bool has_next = S.next(ui + 1, nxt); const char* nA = cA; const char* nB = cB;
        if (has_next) G_IDX_DMA(nxt, (ui + 1) & 1, (ui + 1) % 3);
#pragma unroll 1
        for (int t = 0; t < nt; t += 2) {
            const bool last = (t == nt - 2);
            const char* a1 = uptr(cA + (size_t)(t + 1) * 128);
            G_LDB(B0, 0, 0); G_LDB(B1, 0, 1); G_SCHED; G_LDA(At, 0, 0); G_STAGE(G_SA(1, 1), a1, cOA[1][0], cOA[1][1]);
            G_WAIT_V(8); G_WAIT_L(0); G_BAR; G_MMA(0, 0, At, B0); G_MMA(0, 1, At, B1); G_BAR; G_SCHED;
            if (last && has_next) { nA = uptr(nxt.a); nB = uptr(nxt.b); G_OFFS(nxt, cOA, cOB, (ui + 1) & 1); }
            const char* a2 = uptr(last ? nA : cA + (size_t)(t + 2) * 128); const char* b2 = uptr(last ? nB : cB + (size_t)(t + 2) * 128);
            const char* a3 = uptr(a2 + 128); const char* b3 = uptr(b2 + 128);
            G_LDA(At, 0, 1); G_STAGE(G_SB(0, 0), b2, cOB[0][0], cOB[0][1]); G_STAGE(G_SB(0, 1), b2, cOB[1][0], cOB[1][1]); G_STAGE(G_SA(0, 0), a2, cOA[0][0], cOA[0][1]);
            G_WAIT_V(8); G_WAIT_L(0); G_BAR; G_MMA(1, 0, At, B0); G_MMA(1, 1, At, B1); G_BAR; G_SCHED;
            G_LDB(B0, 1, 0); G_LDB(B1, 1, 1); G_SCHED; G_LDA(At, 1, 0); G_STAGE(G_SA(0, 1), a2, cOA[1][0], cOA[1][1]);
            G_WAIT_V(8); G_WAIT_L(0); G_BAR; G_MMA(0, 0, At, B0); G_MMA(0, 1, At, B1); G_BAR; G_SCHED;
            G_LDA(At, 1, 1); G_STAGE(G_SB(1, 0), b3, cOB[0][0], cOB[0][1]); G_STAGE(G_SB(1, 1), b3, cOB[1][0], cOB[1][1]); G_STAGE(G_SA(1, 0), a3, cOA[0][0], cOA[0][1]);
            G_WAIT_V(8); G_WAIT_L(0); G_BAR; G_MMA(1, 0, At, B0); G_MMA(1, 1, At, B1); G_BAR; G_SCHED;
        }
        if (wr == 0) G_BAR;
        cur.oidl = (const LAS int*)(lds + LDS_OID + (ui % 3) * 1024);
        { const int le = lane_id(); E(acc, cur, wr, wc, le & 15, le >> 4); }
        if (!has_next) break;
        if (!nxt.keep) {
#pragma unroll
        for (int a = 0; a < 2; ++a)
#pragma unroll
            for (int b = 0; b < 2; ++b)
#pragma unroll
                for (int m = 0; m < 4; ++m)
#pragma unroll
                    for (int n = 0; n < 2; ++n) acc[a][b][m][n] = (f32x4){0.f, 0.f, 0.f, 0.f};
        }
        cur = nxt; cA = nA; cB = nB; ++ui;
        if constexpr (Sched::DYN) nt = cur.nt;
        if (wr == 1) G_BAR;
    }
    G_WAIT_V(0);
    G_BAR;
#undef G_SA
#undef G_SB
#undef G_STAGE
#undef G_LDA
#undef G_LDB
#undef G_MMA
#undef G_WAIT_V
#undef G_WAIT_L
#undef G_BAR
#undef G_SCHED
#undef G_OFFS
#undef G_IDX_DMA
}
#if FAST_GEMM
#define GEMM_PHASE(K, S, E) gemm_phase<false>(F.lds, F.wave, K, S, E)
#define GEMM_PHASE_F8(K, S, E) gemm_phase<true>(F.lds, F.wave, K, S, E)
#else
#define GEMM_PHASE(K, S, E) gemm_phase_simple(F.wave, K, S, E)
#endif

constexpr int NXCD = 8, WGM = 8;
struct TileOrder {
    int nM, nN, nwg, G, c;
    __device__ void init(int M, int N, int G_, int c_) { nM = M / 256; nN = N / 256; nwg = nM * nN; G = G_; c = c_; }
    __device__ bool tile(int i, int& pm, int& pn) const {
        const long L = (long)i * G + c; if (L >= nwg) return false;
        int wgid = (int)L; { const int q = nwg / NXCD, r = nwg % NXCD, xcd = wgid % NXCD, off = wgid / NXCD; wgid = (xcd < r ? xcd * (q + 1) : r * (q + 1) + (xcd - r) * q) + off; }
        const int nig = WGM * nN, gid = wgid / nig, fm = gid * WGM, gsz = (nM - fm) < WGM ? (nM - fm) : WGM;
        pm = fm + ((wgid % nig) % gsz); pn = (wgid % nig) / gsz; return true;
    }
};
struct SchedDense { static constexpr bool DYN = false;
    TileOrder o; const char* a; const char* b; unsigned apitch, bpitch;
    __device__ bool next(int i, Unit& u) const {
        int pm, pn; if (!o.tile(i, pm, pn)) return false;
        u.a = a; u.b = b + (size_t)pn * 256 * bpitch; u.ridx = nullptr; u.apitch = apitch; u.bpitch = bpitch; u.row0 = pm * 256; u.col0 = pn * 256; u.kind = 0; u.oidx = nullptr; u.keep = 0; return true;
    }
};
struct SchedMerged { static constexpr bool DYN = false;
    TileOrder o; const char* pd; const char* oo; const char* wpe; const char* wba;
    __device__ bool next(int i, Unit& u) const {
        int pm, pn; if (!o.tile(i >> 1, pm, pn)) return false;
        const int part = i & 1;
        u.a = part ? oo : pd; u.apitch = 512; u.b = (part ? wba : wpe) + (size_t)pn * 256 * 512; u.bpitch = 512; u.ridx = nullptr; u.row0 = pm * 256; u.col0 = pn * 256; u.kind = part; u.oidx = nullptr; u.keep = part; return true;
    }
};
struct SchedSharedRouter { static constexpr bool DYN = true;
    int G, c; const char* xb; const char* wsgu; const char* wr;
    __device__ bool next(int i, Unit& u) const {
        const int L = i * G + c; if (L >= 512) return false;
        u.apitch = 2048; u.bpitch = 2048; u.ridx = nullptr; u.oidx = nullptr; u.keep = 0;
        if (L < 256) { const int pm = L >> 1, pn = L & 1; u.a = xb; u.b = wsgu + (size_t)pn * 256 * 2048; u.row0 = pm * 256; u.col0 = pn * 128; u.kind = 0; u.nt = 16; }
        else { const int pm = (L - 256) >> 1, kh = L & 1; u.a = xb + kh * 1024; u.b = wr + kh * 1024; u.row0 = pm * 256; u.col0 = kh; u.kind = 1; u.nt = 8; }
        return true;
    }
};
struct SchedMoeGU { static constexpr bool DYN = false;
    int G, c, nblk; const char* xb; const char* wegu; const LAS int* blke; const int* tokl;
    __device__ bool next(int i, Unit& u) const {
        const int L = i * G + c; if (L >= 2 * nblk) return false;
        const int rb = L >> 1, pn = L & 1, e = __builtin_amdgcn_readfirstlane(blke[rb]);
        u.a = xb; u.apitch = 1024; u.bpitch = 1024; u.b = wegu + ((size_t)e * 512 + pn * 256) * 1024; u.ridx = tokl + rb * 256; u.row0 = rb * 256; u.col0 = pn * 128; u.kind = e; u.oidx = nullptr; u.keep = 0; return true;
    }
};
struct SchedMoeDownR { static constexpr bool DYN = false;
    int G, c, nblk; const char* hb; const char* wed; const LAS int* blke; const int* tokl;
    __device__ bool next(int i, Unit& u) const {
        const int L = i * G + c; if (L >= 4 * nblk) return false;
        const int rb = L >> 2, pn = L & 3, e = __builtin_amdgcn_readfirstlane(blke[rb]);
        u.apitch = 256; u.bpitch = 256; u.ridx = nullptr; u.a = hb; u.b = wed + ((size_t)e * 1024 + pn * 256) * 256; u.row0 = rb * 256; u.col0 = pn * 256; u.kind = e; u.oidx = tokl + rb * 256; u.keep = 0; return true;
    }
};
struct SchedShDown { static constexpr bool DYN = false;
    int G, c; const char* hs; const char* wsd;
    __device__ bool next(int i, Unit& u) const {
        const int L = i * G + c; if (L >= 512) return false;
        const int pm = L >> 2, pn = L & 3; u.apitch = 512; u.bpitch = 512; u.ridx = nullptr; u.a = hs; u.b = wsd + (size_t)pn * 256 * 512; u.row0 = pm * 256; u.col0 = pn * 256; u.kind = 64; u.oidx = nullptr; u.keep = 0; return true;
    }
};

__device__ __forceinline__ u32x4 pack8(const f32x4& v0, const f32x4& v1) { u32x4 w; w.x = cvt_pk_h16(v0[0], v0[1]); w.y = cvt_pk_h16(v0[2], v0[3]); w.z = cvt_pk_h16(v1[0], v1[1]); w.w = cvt_pk_h16(v1[2], v1[3]); return w; }
__device__ __forceinline__ void unpack8(const u32x4& w, f32x4& v0, f32x4& v1) { v0 = (f32x4){lo16(w.x), hi16(w.x), lo16(w.y), hi16(w.y)}; v1 = (f32x4){lo16(w.z), hi16(w.z), lo16(w.w), hi16(w.w)}; }
__device__ __forceinline__ f32x4 sig4(const f32x4& v) { return (f32x4){sigmoidf_(v[0]), sigmoidf_(v[1]), sigmoidf_(v[2]), sigmoidf_(v[3])}; }
__device__ __forceinline__ f32x4 swiglu4(const f32x4& g, const f32x4& u) { return (f32x4){g[0] * sigmoidf_(g[0]) * u[0], g[1] * sigmoidf_(g[1]) * u[1], g[2] * sigmoidf_(g[2]) * u[2], g[3] * sigmoidf_(g[3]) * u[3]}; }

__device__ __forceinline__ unsigned q8x4(float a, float b, float c, float d, float inv) {
    const unsigned ua = __float_as_uint(a * inv + 12582912.0f), ub = __float_as_uint(b * inv + 12582912.0f), uc = __float_as_uint(c * inv + 12582912.0f), ud = __float_as_uint(d * inv + 12582912.0f);
    const unsigned lo = __builtin_amdgcn_perm(ub, ua, 0x0c0c0400u), hi = __builtin_amdgcn_perm(ud, uc, 0x0c0c0400u);
    return __builtin_amdgcn_perm(hi, lo, 0x05040100u);
}
__device__ __forceinline__ unsigned f8x4(const f32x4 v) {
    int w = __builtin_amdgcn_cvt_pk_fp8_f32(__builtin_amdgcn_fmed3f(v.x, -448.f, 448.f), __builtin_amdgcn_fmed3f(v.y, -448.f, 448.f), 0, false);
    w = __builtin_amdgcn_cvt_pk_fp8_f32(__builtin_amdgcn_fmed3f(v.z, -448.f, 448.f), __builtin_amdgcn_fmed3f(v.w, -448.f, 448.f), w, true); return (unsigned)w; }
struct EpiInProj {
    h16* H; const float* bias; float isc;
    __device__ __forceinline__ void operator()(const ACC_T, const Unit& u, int wr, int wc, int fr, int fq) const {
        const int pn = u.col0 >> 8; const float sc = (pn == 2 || pn == 3) ? 0.125f : 1.f; const bool sg = pn >= 5;
        f32x4 bv[2][2];
#pragma unroll
        for (int bj = 0; bj < 2; ++bj)
#pragma unroll
            for (int n = 0; n < 2; ++n) bv[bj][n] = *(const f32x4*)(bias + u.col0 + 128 * bj + 32 * wc + 8 * fq + 4 * n);
        if (sg) {
            unsigned char* gb = (unsigned char*)H + 336 * MiB + ((size_t)((u.row0 >> 8) * 8 + (pn - 5)) << 16) + (size_t)((wr * 4 + wc) * 8) * 1024 + (size_t)(fq * 16 + fr) * 16;
#pragma unroll
            for (int ai = 0; ai < 2; ++ai)
#pragma unroll
                for (int m = 0; m < 4; ++m) { u32x4 w;
                    { const f32x4 v0 = sig4(acc[ai][0][m][0] * isc + bv[0][0]), v1 = sig4(acc[ai][0][m][1] * isc + bv[0][1]); w.x = q8x4(v0[0], v0[1], v0[2], v0[3], 255.0f); w.y = q8x4(v1[0], v1[1], v1[2], v1[3], 255.0f); }
                    { const f32x4 v0 = sig4(acc[ai][1][m][0] * isc + bv[1][0]), v1 = sig4(acc[ai][1][m][1] * isc + bv[1][1]); w.z = q8x4(v0[0], v0[1], v0[2], v0[3], 255.0f); w.w = q8x4(v1[0], v1[1], v1[2], v1[3], 255.0f); }
                    *(u32x4*)(gb + (ai * 4 + m) * 1024) = w; }
            return;
        }
#pragma unroll
        for (int ai = 0; ai < 2; ++ai)
#pragma unroll
            for (int m = 0; m < 4; ++m) { const int row = u.row0 + 128 * ai + 64 * wr + 16 * m + fr; h16* rowp = H + (size_t)row * DIN + u.col0 + 32 * wc + 8 * fq;
#pragma unroll
                for (int bj = 0; bj < 2; ++bj) { const f32x4 v0 = (acc[ai][bj][m][0] * isc + bv[bj][0]) * sc, v1 = (acc[ai][bj][m][1] * isc + bv[bj][1]) * sc;
                    *(u32x4*)(rowp + 128 * bj) = pack8(v0, v1); } }
    }
};
__device__ __forceinline__ void ungate8(const u32x2& w, f32x4& v0, f32x4& v1) {
    const float k = 1.0f / 255.0f;
    v0 = (f32x4){(float)(w.x & 0xffu) * k, (float)((w.x >> 8) & 0xffu) * k, (float)((w.x >> 16) & 0xffu) * k, (float)(w.x >> 24) * k};
    v1 = (f32x4){(float)(w.y & 0xffu) * k, (float)((w.y >> 8) & 0xffu) * k, (float)((w.y >> 16) & 0xffu) * k, (float)(w.y >> 24) * k};
}
struct EpiMerged {
    unsigned char* MG; const unsigned char* G8; float r01, i1;
    __device__ __forceinline__ void operator()(f32x4 (&acc)[2][2][4][2], const Unit& u, int wr, int wc, int fr, int fq) const {
        const int col = u.col0 + 32 * wc + 8 * fq;
        const unsigned char* gpb = G8 + ((size_t)((u.row0 >> 8) * 8 + (u.col0 >> 8)) << 16) + (size_t)((wr * 4 + wc) * 8) * 1024 + (size_t)(fq * 16 + fr) * 16;
        const unsigned char* gab = gpb + 4 * 65536;
#pragma unroll
        for (int ai = 0; ai < 2; ++ai) {
            u32x4 ga[2][4], gp[2][4];
#pragma unroll
            for (int m = 0; m < 4; ++m) { ga[ai][m] = *(const u32x4*)(gab + (ai * 4 + m) * 1024); if (u.kind == 0) gp[ai][m] = *(const u32x4*)(gpb + (ai * 4 + m) * 1024); }
#pragma unroll
            for (int m = 0; m < 4; ++m) { const int row = u.row0 + 128 * ai + 64 * wr + 16 * m + fr;
#pragma unroll
                for (int bj = 0; bj < 2; ++bj) { f32x4 a0, a1; { u32x2 t; t.x = bj ? ga[ai][m].z : ga[ai][m].x; t.y = bj ? ga[ai][m].w : ga[ai][m].y; ungate8(t, a0, a1); }
                    if (u.kind == 0) { f32x4 p0, p1; { u32x2 t; t.x = bj ? gp[ai][m].z : gp[ai][m].x; t.y = bj ? gp[ai][m].w : gp[ai][m].y; ungate8(t, p0, p1); }
#pragma unroll
                        for (int j = 0; j < 4; ++j) { acc[ai][bj][m][0][j] *= p0[j] * r01 * __builtin_amdgcn_rcpf(fmaxf(a0[j], 6.2e-5f)); acc[ai][bj][m][1][j] *= p1[j] * r01 * __builtin_amdgcn_rcpf(fmaxf(a1[j], 6.2e-5f)); } }
                    else { u32x2 w; w.x = f8x4(acc[ai][bj][m][0] * a0 * i1); w.y = f8x4(acc[ai][bj][m][1] * a1 * i1); *(u32x2*)(MG + (size_t)row * D + col + 128 * bj) = w; } } }
        }
    }
};
struct EpiResid {
    h16* S; const h16* XBp; float isc;
    __device__ __forceinline__ void operator()(const ACC_T, const Unit& u, int wr, int wc, int fr, int fq) const {
#pragma unroll
        for (int ai = 0; ai < 2; ++ai) {
            u32x4 xw[4][2];
#pragma unroll
            for (int m = 0; m < 4; ++m) { const int row = u.row0 + 128 * ai + 64 * wr + 16 * m + fr; const size_t off = (size_t)row * D + u.col0 + 32 * wc + 8 * fq;
#pragma unroll
                for (int bj = 0; bj < 2; ++bj) xw[m][bj] = *(const u32x4*)(XBp + off + 128 * bj); }
#pragma unroll
            for (int m = 0; m < 4; ++m) { const int row = u.row0 + 128 * ai + 64 * wr + 16 * m + fr; const size_t off = (size_t)row * D + u.col0 + 32 * wc + 8 * fq;
#pragma unroll
                for (int bj = 0; bj < 2; ++bj) { f32x4 x0, x1; unpack8(xw[m][bj], x0, x1);
                    *(u32x4*)(S + off + 128 * bj) = pack8(x0 * ALPHA + acc[ai][bj][m][0] * isc, x1 * ALPHA + acc[ai][bj][m][1] * isc); } }
        }
    }
};
struct EpiSharedRouter {
    h16* HS; float* LG;
    __device__ __forceinline__ void operator()(const ACC_T, const Unit& u, int wr, int wc, int fr, int fq) const {
#pragma unroll
        for (int ai = 0; ai < 2; ++ai)
#pragma unroll
            for (int m = 0; m < 4; ++m) { const int row = u.row0 + 128 * ai + 64 * wr + 16 * m + fr;
                if (u.kind == 0) { *(u32x4*)(HS + (size_t)row * FF + u.col0 + 32 * wc + 8 * fq) = pack8(swiglu4(acc[ai][0][m][0], acc[ai][1][m][0]), swiglu4(acc[ai][0][m][1], acc[ai][1][m][1])); }
                else if (wc < 2) {
#pragma unroll
                    for (int n = 0; n < 2; ++n) *(f32x4*)(LG + (size_t)u.col0 * T * NE + (size_t)row * NE + 32 * wc + 8 * fq + 4 * n) = acc[ai][0][m][n] + acc[ai][1][m][n]; } }
    }
};
struct EpiMoeGU {
    unsigned char* HB; const float* wsc;
    __device__ __forceinline__ void operator()(const ACC_T, const Unit& u, int wr, int wc, int fr, int fq) const {
        const float isg = wsc[4 * u.kind], isu = wsc[4 * u.kind + 1], hsc = 1.52587890625e-05f / (isg * isu);
#pragma unroll
        for (int ai = 0; ai < 2; ++ai)
#pragma unroll
            for (int m = 0; m < 4; ++m) { const int row = u.row0 + 128 * ai + 64 * wr + 16 * m + fr;
                u32x2 w; w.x = f8x4(swiglu4(acc[ai][0][m][0] * isg, acc[ai][1][m][0] * isu) * hsc); w.y = f8x4(swiglu4(acc[ai][0][m][1] * isg, acc[ai][1][m][1] * isu) * hsc);
                *(u32x2*)(HB + (size_t)row * FF + u.col0 + 32 * wc + 8 * fq) = w; }
    }
};
template <bool ROUTED> struct EpiMoeDown {
    unsigned char* YQ; h16* YS;
    __device__ __forceinline__ void operator()(const ACC_T, const Unit& u, int wr, int wc, int fr, int fq) const {
        const int grp = (u.col0 >> 8) * 16 + 4 * wc + fq;
#pragma unroll
        for (int ai = 0; ai < 2; ++ai)
#pragma unroll
            for (int m = 0; m < 4; ++m) {
                const int r = 128 * ai + 64 * wr + 16 * m + fr; int id; if constexpr (ROUTED) id = u.oidl[r]; else id = (u.row0 + r) * 9 + 8;
                const f32x4 v0 = acc[ai][0][m][0], v1 = acc[ai][0][m][1], v2 = acc[ai][1][m][0], v3 = acc[ai][1][m][1];
                if constexpr (ROUTED) { u32x4 w; w.x = f8x4(v0 * 0.015625f); w.y = f8x4(v1 * 0.015625f); w.z = f8x4(v2 * 0.015625f); w.w = f8x4(v3 * 0.015625f);
                    *(u32x4*)(YQ + (size_t)id * 1024 + grp * 16) = w; }
                else {
                float mx = fmaxf(fmaxf(fabsf(v0[0]), fabsf(v0[1])), fmaxf(fabsf(v0[2]), fabsf(v0[3])));
                mx = fmaxf(mx, fmaxf(fmaxf(fabsf(v1[0]), fabsf(v1[1])), fmaxf(fabsf(v1[2]), fabsf(v1[3]))));
                mx = fmaxf(mx, fmaxf(fmaxf(fabsf(v2[0]), fabsf(v2[1])), fmaxf(fabsf(v2[2]), fabsf(v2[3]))));
                mx = fmaxf(mx, fmaxf(fmaxf(fabsf(v3[0]), fabsf(v3[1])), fmaxf(fabsf(v3[2]), fabsf(v3[3]))));
                const unsigned short sh = f2h(mx * (1.0f / 127.0f) * 1.0005f);
                const float scr = h2f(sh); const float inv = scr > 0.f ? __builtin_amdgcn_rcpf(scr) : 0.f;
                u32x4 w; w.x = q8x4(v0[0], v0[1], v0[2], v0[3], inv); w.y = q8x4(v1[0], v1[1], v1[2], v1[3], inv); w.z = q8x4(v2[0], v2[1], v2[2], v2[3], inv); w.w = q8x4(v3[0], v3[1], v3[2], v3[3], inv);
                *(u32x4*)(YQ + (size_t)id * 1024 + grp * 16) = w;
                *(unsigned short*)(YS + (size_t)id * 64 + grp) = sh; } }
    }
};

struct Args { const float* in[23]; float* out; unsigned char* ws; int ph_lo, ph_hi; };
struct Frame {
    LAS unsigned char* lds; int wave, vcu, G, gw, NGW;
};

__device__ __forceinline__ void ln_store(f32x4 (&v)[4], const float* gam, const float* bet, float* o32, h16* o16, int lane) {
    float s = 0.f;
#pragma unroll
    for (int j = 0; j < 4; ++j) s += (v[j].x + v[j].y) + (v[j].z + v[j].w);
    const float mean = wave_sum(s) * (1.f / D); float s2 = 0.f;
#pragma unroll
    for (int j = 0; j < 4; ++j) { v[j] = v[j] - mean; s2 += (v[j].x * v[j].x + v[j].y * v[j].y) + (v[j].z * v[j].z + v[j].w * v[j].w); }
    const float rstd = 1.f / sqrtf(wave_sum(s2) * (1.f / D) + LN_EPS);
#pragma unroll
    for (int j = 0; j < 4; ++j) { const f32x4 g = *(const f32x4*)(gam + 4 * lane + 256 * j), b = *(const f32x4*)(bet + 4 * lane + 256 * j); const f32x4 y = v[j] * rstd * g + b;
        *(f32x4*)(o32 + 4 * lane + 256 * j) = y; u32x2 w; w.x = cvt_pk_h16(y[0], y[1]); w.y = cvt_pk_h16(y[2], y[3]); *(u32x2*)(o16 + 4 * lane + 256 * j) = w; }
}


__device__ __forceinline__ void ln_store8(f32x4 (&v)[4], const float* gam, const float* bet, float* o32, h16* o16, int lane, int c0 = -1, int c1 = -1, unsigned char* o8 = nullptr) {
    if (c0 < 0) { c0 = 8 * lane; c1 = 512 + 8 * lane; }
    float s = 0.f;
#pragma unroll
    for (int j = 0; j < 4; ++j) s += (v[j].x + v[j].y) + (v[j].z + v[j].w);
    const float mean = wave_sum(s) * (1.f / D); float s2 = 0.f;
#pragma unroll
    for (int j = 0; j < 4; ++j) { v[j] = v[j] - mean; s2 += (v[j].x * v[j].x + v[j].y * v[j].y) + (v[j].z * v[j].z + v[j].w * v[j].w); }
    const float rstd = 1.f / sqrtf(wave_sum(s2) * (1.f / D) + LN_EPS);
    f32x4 y[4];
#pragma unroll
    for (int j = 0; j < 4; ++j) { const int c = ((j >> 1) ? c1 : c0) + 4 * (j & 1); const f32x4 g = *(const f32x4*)(gam + c), b = *(const f32x4*)(bet + c); y[j] = v[j] * rstd * g + b; if (o32) *(f32x4*)(o32 + c) = y[j]; }
    *(u32x4*)(o16 + c0) = pack8(y[0], y[1]); *(u32x4*)(o16 + c1) = pack8(y[2], y[3]);
    if (o8) { u32x2 w; w.x = f8x4(y[0]); w.y = f8x4(y[1]); *(u32x2*)(o8 + c0) = w; w.x = f8x4(y[2]); w.y = f8x4(y[3]); *(u32x2*)(o8 + c1) = w; }
}
__device__ __forceinline__ void tr_item(const float* W, int N, h16* WT, int ldt, int k0, int n0, int drow0, LAS float* scr, int lane) {
    float tv[32];
#pragma unroll
    for (int i = 0; i < 32; ++i) { const int kk = 2 * i + (lane >> 5); tv[i] = __builtin_nontemporal_load(W + (size_t)(k0 + kk) * N + n0 + (lane & 31)); }
#pragma unroll
    for (int i = 0; i < 32; ++i) { const int kk = 2 * i + (lane >> 5); scr[kk * 33 + (lane & 31)] = tv[i]; }
    asm volatile("s_waitcnt lgkmcnt(0)" ::: "memory");
    const int c = lane & 7;
#pragma unroll
    for (int j = 0; j < 4; ++j) { const int n = (lane >> 3) + 8 * j; const LAS float* s = scr + (8 * c) * 33 + n;
        u32x4 o; o.x = cvt_pk_h16(s[0 * 33], s[1 * 33]); o.y = cvt_pk_h16(s[2 * 33], s[3 * 33]); o.z = cvt_pk_h16(s[4 * 33], s[5 * 33]); o.w = cvt_pk_h16(s[6 * 33], s[7 * 33]);
        *(u32x4*)(WT + (size_t)(drow0 + n) * ldt + k0 + 8 * c) = o; }
    asm volatile("s_waitcnt lgkmcnt(0)" ::: "memory");
}
__device__ __forceinline__ void tr_item_f8(const float* W, int N, unsigned char* WT, int ldt, int k0, int n0, int drow0, LAS float* scr, int lane, float scale) {
    float tv[32];
#pragma unroll
    for (int i = 0; i < 32; ++i) { const int kk = 2 * i + (lane >> 5); tv[i] = __builtin_nontemporal_load(W + (size_t)(k0 + kk) * N + n0 + (lane & 31)); }
#pragma unroll
    for (int i = 0; i < 32; ++i) { const int kk = 2 * i + (lane >> 5); scr[kk * 33 + (lane & 31)] = tv[i]; }
    asm volatile("s_waitcnt lgkmcnt(0)" ::: "memory");
    const int c = lane & 7;
#pragma unroll
    for (int j = 0; j < 4; ++j) { const int n = (lane >> 3) + 8 * j; const LAS float* s = scr + (8 * c) * 33 + n;
        u32x2 o; o.x = f8x4((f32x4){s[0 * 33], s[1 * 33], s[2 * 33], s[3 * 33]} * scale); o.y = f8x4((f32x4){s[4 * 33], s[5 * 33], s[6 * 33], s[7 * 33]} * scale);
        *(u32x2*)(WT + (size_t)(drow0 + n) * ldt + k0 + 8 * c) = o; }
    asm volatile("s_waitcnt lgkmcnt(0)" ::: "memory");
}
__device__ __forceinline__ float f8_scale_of(const float* W, int lane) {
    const f32x4 q = *(const f32x4*)(W + 4 * lane); const float ma = wave_sum((fabsf(q.x) + fabsf(q.y)) + (fabsf(q.z) + fabsf(q.w))) * (1.2533f / 256.f);
    float t = 32.f / fmaxf(ma, 1e-30f); t = fminf(fmaxf(t, 1.0e-18f), 1.0e18f);
    return __uint_as_float(__builtin_amdgcn_readfirstlane(__float_as_uint(t)) & 0x7f800000u);
}
__device__ __forceinline__ void tr_item_hilo(const float* W, int N, h16* WT, int ldt, int k0, int n0, LAS float* scr, int lane) {
    float tv[32];
#pragma unroll
    for (int i = 0; i < 32; ++i) { const int kk = 2 * i + (lane >> 5); tv[i] = __builtin_nontemporal_load(W + (size_t)(k0 + kk) * N + n0 + (lane & 31)); }
#pragma unroll
    for (int i = 0; i < 32; ++i) { const int kk = 2 * i + (lane >> 5); scr[kk * 33 + (lane & 31)] = tv[i]; }
    asm volatile("s_waitcnt lgkmcnt(0)" ::: "memory");
    const int c = lane & 7;
#pragma unroll
    for (int j = 0; j < 4; ++j) { const int n = (lane >> 3) + 8 * j; const LAS float* s = scr + (8 * c) * 33 + n;
        float v[8], r[8];
#pragma unroll
        for (int q = 0; q < 8; ++q) { v[q] = s[q * 33]; r[q] = v[q] - h2f(f2h(v[q])); }
        u32x4 o; o.x = cvt_pk_h16(v[0], v[1]); o.y = cvt_pk_h16(v[2], v[3]); o.z = cvt_pk_h16(v[4], v[5]); o.w = cvt_pk_h16(v[6], v[7]);
        *(u32x4*)(WT + (size_t)(n0 + n) * ldt + k0 + 8 * c) = o;
        o.x = cvt_pk_h16(r[0], r[1]); o.y = cvt_pk_h16(r[2], r[3]); o.z = cvt_pk_h16(r[4], r[5]); o.w = cvt_pk_h16(r[6], r[7]);
        *(u32x4*)(WT + (size_t)(128 + n0 + n) * ldt + k0 + 8 * c) = o; }
    asm volatile("s_waitcnt lgkmcnt(0)" ::: "memory");
}


typedef float f32x16 __attribute__((ext_vector_type(16)));
constexpr int AT_KP = 144, AT_VP = 528, AT_VOFF = 256 * AT_KP;
__device__ __forceinline__ int crow(int r, int hi) { return (r & 3) + 8 * (r >> 2) + 4 * hi; }
struct KVRegs { u32x4 k[4], v[4]; };
__device__ __forceinline__ void attn_load_kv(const h16* HHp, const int b, const int n, const int hk, const int tid, KVRegs& r) {
    const int tb = b * SEQ + n * 128;
#pragma unroll
    for (int i = 0; i < 4; ++i) { const int idx = tid + 512 * i, key = idx >> 3, ch = idx & 7; const int tok = (n > 0) ? tb - 128 + key : tb + (key & 127);
        const h16* kp = HHp + (size_t)tok * DIN + C_K + hk * 64 + ch * 8; r.k[i] = *(const u32x4*)kp; r.v[i] = *(const u32x4*)(kp + 128); }
}
__device__ __forceinline__ void attn_unit(LAS unsigned char* lds, h16* HHp, unsigned char* OUTp, const float osc, const float* sinks, const int b, const int n, const int hk, const int tid,
                                          const int unused_ = 0) {
    const int lane = tid & 63, wid = __builtin_amdgcn_readfirstlane(tid >> 6), q32 = lane & 31, hi = lane >> 5;
    const int g = wid >> 1, qh = wid & 1, hq = hk * 4 + g;
    const int tb = b * SEQ + n * 128;
    LAS unsigned char* Ks = lds; LAS unsigned char* Vs = lds + AT_VOFF;
    KVRegs cur; attn_load_kv(HHp, b, n, hk, tid, cur);
    f16x8 qs[4];
    { const h16* qp = HHp + (size_t)(tb + 64 * qh + q32) * DIN + C_Q + hq * 64;
#pragma unroll
      for (int ks = 0; ks < 4; ++ks) qs[ks] = *(const f16x8*)(qp + 16 * ks + 8 * hi); }
#pragma unroll
    for (int i = 0; i < 4; ++i) { const int idx = tid + 512 * i, key = idx >> 3, ch = idx & 7; const u32x4 kw = cur.k[i], vw = cur.v[i];
        *(LAS u32x4*)(Ks + key * AT_KP + ch * 16) = kw;
        LAS unsigned short* vd = (LAS unsigned short*)(Vs + (ch * 8) * AT_VP + key * 2);
        vd[0 * (AT_VP / 2)] = (unsigned short)(vw.x & 0xffffu); vd[1 * (AT_VP / 2)] = (unsigned short)(vw.x >> 16); vd[2 * (AT_VP / 2)] = (unsigned short)(vw.y & 0xffffu); vd[3 * (AT_VP / 2)] = (unsigned short)(vw.y >> 16);
        vd[4 * (AT_VP / 2)] = (unsigned short)(vw.z & 0xffffu); vd[5 * (AT_VP / 2)] = (unsigned short)(vw.z >> 16); vd[6 * (AT_VP / 2)] = (unsigned short)(vw.w & 0xffffu); vd[7 * (AT_VP / 2)] = (unsigned short)(vw.w >> 16); }
    __syncthreads();
    const float slope = exp2f(-(float)(hq + 1)), sink = sinks[hq];
    float ab[16];
#pragma unroll
    for (int r = 0; r < 16; ++r) ab[r] = slope * (float)(crow(r, hi) - 128 - q32);
#pragma unroll 1
    for (int sub = 0; sub < 2; ++sub) {
        const int q0 = 64 * qh + 32 * sub, qi = q0 + q32;
        f32x16 sv[5]; float mx = -INFINITY;
#pragma unroll
        for (int j = 0; j < 5; ++j) { const int key0 = q0 + 32 * j; f32x16 c; float sl = slope; asm volatile("" : "+v"(sl)); const float aj = sl * (float)(32 * j);
#pragma unroll
            for (int r = 0; r < 16; ++r) c[r] = ab[r] + aj;
#pragma unroll
            for (int ks = 0; ks < 4; ++ks) { const f16x8 kf = *(const LAS f16x8*)(Ks + (key0 + q32) * AT_KP + (16 * ks + 8 * hi) * 2); c = __builtin_amdgcn_mfma_f32_32x32x16_f16(kf, qs[ks], c, 0, 0, 0); }
            const bool dead = (n == 0) && (key0 < 128);
            int hil = hi; asm volatile("" : "+v"(hil));
#pragma unroll
            for (int r = 0; r < 16; ++r) { float v = c[r];
                if (j == 0) v = (crow(r, hil) > q32) ? v : -INFINITY;
                if (j == 4) v = (crow(r, hil) <= q32) ? v : -INFINITY;
                if (dead) v = -INFINITY;
                c[r] = v; mx = fmaxf(mx, v); }
            sv[j] = c; __builtin_amdgcn_sched_barrier(0); }
        if (sub == 0) { const h16* qp = HHp + (size_t)(tb + 64 * qh + 32 + q32) * DIN + C_Q + hq * 64;
#pragma unroll
            for (int ks = 0; ks < 4; ++ks) qs[ks] = *(const f16x8*)(qp + 16 * ks + 8 * hi); }
        mx = fmaxf(mx, dppf_swap32(mx)); mx = fmaxf(mx, sink);
        float lsum = 0.f; f32x16 o0, o1;
#pragma unroll
        for (int r = 0; r < 16; ++r) { o0[r] = 0.f; o1[r] = 0.f; }
#pragma unroll
        for (int j = 0; j < 5; ++j) { const int key0 = q0 + 32 * j;
#pragma unroll
            for (int r = 0; r < 16; ++r) { const float pv = __expf(sv[j][r] - mx); sv[j][r] = pv; lsum += pv; }
#pragma unroll
            for (int cc = 0; cc < 2; ++cc) {
                u32x4 pw; pw.x = cvt_pk_h16(sv[j][8 * cc + 0], sv[j][8 * cc + 1]); pw.y = cvt_pk_h16(sv[j][8 * cc + 2], sv[j][8 * cc + 3]); pw.z = cvt_pk_h16(sv[j][8 * cc + 4], sv[j][8 * cc + 5]); pw.w = cvt_pk_h16(sv[j][8 * cc + 6], sv[j][8 * cc + 7]);
                const f16x8 pb = __builtin_bit_cast(f16x8, pw);
                const LAS unsigned char* vp = Vs + q32 * AT_VP + (key0 + 16 * cc + 4 * hi) * 2;
                { const u32x2 a0 = *(const LAS u32x2*)vp, a1 = *(const LAS u32x2*)(vp + 16); const u32x4 vw = {a0.x, a0.y, a1.x, a1.y}; o0 = __builtin_amdgcn_mfma_f32_32x32x16_f16(__builtin_bit_cast(f16x8, vw), pb, o0, 0, 0, 0); }
                { const u32x2 a0 = *(const LAS u32x2*)(vp + 32 * AT_VP), a1 = *(const LAS u32x2*)(vp + 32 * AT_VP + 16); const u32x4 vw = {a0.x, a0.y, a1.x, a1.y}; o1 = __builtin_amdgcn_mfma_f32_32x32x16_f16(__builtin_bit_cast(f16x8, vw), pb, o1, 0, 0, 0); }
                __builtin_amdgcn_sched_barrier(0);
            } }
        lsum += dppf_swap32(lsum); lsum += __expf(sink - mx);
        const float rl = 1.0f / lsum;
#pragma unroll
        for (int rg = 0; rg < 4; ++rg) {
            const float ro = rl * osc;
            unsigned char* op = OUTp + (size_t)(tb + qi) * 512 + hq * 64;
            *(unsigned*)(op + 8 * rg + 4 * hi) = f8x4((f32x4){o0[4 * rg], o0[4 * rg + 1], o0[4 * rg + 2], o0[4 * rg + 3]} * ro);
            *(unsigned*)(op + 32 + 8 * rg + 4 * hi) = f8x4((f32x4){o1[4 * rg], o1[4 * rg + 1], o1[4 * rg + 2], o1[4 * rg + 3]} * ro); }
    }
    __syncthreads();
}
template <int W> __device__ __forceinline__ void pool_pair(const h16* HHp, unsigned char* PDp, const float psc, const int c8, const int tA, const int tB) {
    u32x4 q[2][W];
#pragma unroll
    for (int p = 0; p < 2; ++p) { const int t = p ? tB : tA; const int s = t & (SEQ - 1); const h16* up = HHp + (size_t)t * DIN + C_U + c8 * 8;
#pragma unroll
        for (int i = 0; i < W; ++i) { const int ii = (i <= s) ? i : 0; q[p][i] = *(const u32x4*)(up - (size_t)ii * DIN); } }
#pragma unroll
    for (int p = 0; p < 2; ++p) { const int t = p ? tB : tA; const int s = t & (SEQ - 1); f32x4 a0 = {0.f, 0.f, 0.f, 0.f}, a1 = {0.f, 0.f, 0.f, 0.f}, u0, u1;
#pragma unroll
        for (int i = 0; i < W; ++i) { f32x4 v0, v1; unpack8(q[p][i], v0, v1); if (i == 0) { u0 = v0; u1 = v1; } if (i <= s) { a0 += v0; a1 += v1; } }
        const float rn = 1.0f / (float)((s + 1 < W) ? s + 1 : W);
        u32x2 w; w.x = f8x4((a0 * rn - u0) * psc); w.y = f8x4((a1 * rn - u1) * psc); *(u32x2*)(PDp + (size_t)t * 512 + c8 * 8) = w; }
}


__device__ __forceinline__ void prep_expert_items(const float* w_eg, const float* w_eu, const float* w_ed, unsigned char* egu_t, unsigned char* ed_t, float* wsc, int e_lo, int e_hi, int wrk, int nwrk, LAS float* scr, int lane) {
    for (int it = e_lo + wrk; it < e_hi; it += nwrk) {
        if (it < 2 * 8192) { const int up = it >> 13, q = it & 8191, e = q >> 7, q2 = q & 127, kb = q2 >> 3, nb = q2 & 7, n0 = 32 * nb;
            const float* Wm = (up ? w_eu : w_eg) + (size_t)e * D * FF; const float sc = f8_scale_of(Wm, lane); if (q2 == 0 && lane == 0) wsc[4 * e + up] = 1.0f / sc;
            tr_item_f8(Wm, FF, egu_t + (size_t)e * 512 * 1024, 1024, 64 * kb, n0, 256 * (n0 >> 7) + (n0 & 127) + 128 * up, scr, lane, sc); }
        else { const int r = it - 2 * 8192, e = r >> 7, q2 = r & 127, kb = q2 >> 5, nb = q2 & 31; const float* Wm = w_ed + (size_t)e * FF * D; const float sc = f8_scale_of(Wm, lane); if (q2 == 0 && lane == 0) wsc[4 * e + 2] = 1.0f / sc;
            tr_item_f8(Wm, D, ed_t + (size_t)e * 1024 * 256, 256, 64 * kb, 32 * nb, 32 * nb, scr, lane, sc); }
    }
}
#define W_EGU_P(lt) ((unsigned char*)(args.ws + (((lt) & 1) ? W_EGU_ALT : W_EGU_T)))
#define WSC_P(lt) ((float*)(args.ws + MS_WSC) + ((lt) & 1) * 256)
#define W_ED_P(lt)  ((unsigned char*)(args.ws + (((lt) & 1) ? W_ED_ALT : W_ED_T)))
#define PREP_EXPERTS(lt, e_lo, e_hi, wrk, nwrk) prep_expert_items(args.in[15] + (size_t)(lt) * NE * D * FF, args.in[16] + (size_t)(lt) * NE * D * FF, args.in[17] + (size_t)(lt) * NE * FF * D, W_EGU_P(lt), W_ED_P(lt), WSC_P(lt), e_lo, e_hi, wrk, nwrk, (LAS float*)(F.lds + F.wave * 16384), lane_id())
#ifndef P9_IPW
#define P9_IPW 5
#endif
constexpr int PE_A = 9830, PE_B = PE_A + 8602, PE_ALL = 3 * 8192;
#define PREP_WEIGHTS(E_LO) do { \
            LAS float* scr = (LAS float*)(F.lds + F.wave * 16384); \
            const float* w_in = L_W_IN; const float* w_br_attn = L_W_BRA; const float* w_out = L_W_OUT; const float* w_sg = L_W_SG; const float* w_su = L_W_SU; const float* w_sd = L_W_SD; \
            const float* w_eg = L_W_EG; const float* w_eu = L_W_EU; const float* w_ed = L_W_ED; const float* w_router = L_W_R; \
            constexpr int I_IN = 16 * 104, I_BA = 8 * 32, I_OUT = 16 * 32, I_SG = 16 * 8, I_SD = 4 * 32, I_EG = 64 * 128, I_ED = 64 * 128, I_R = 16 * 2; \
            constexpr int NITEMS = I_IN + I_BA + I_OUT + 2 * I_SG + I_SD + I_R; \
            for (int it = F.gw; it < NITEMS; it += F.NGW) { \
                int r = it; \
                if (r < I_IN) { const int kb = r / 104, nb = r % 104; const float sc = f8_scale_of(w_in, lane); if (r == 0 && lane == 0) *WSC_IN = 1.0f / sc; tr_item_f8(w_in, DIN, (unsigned char*)(args.ws + W_IN_T), 1024, 64 * kb, 32 * nb, 32 * nb, scr, lane, sc); continue; } r -= I_IN; \
                if (r < I_BA) { const int kb = r / 32, nb = r % 32; tr_item_f8(w_br_attn, D, (unsigned char*)(args.ws + W_BA_T), 512, 64 * kb, 32 * nb, 32 * nb, scr, lane, f8_scale_of(w_br_attn, lane)); continue; } r -= I_BA; \
                if (r < I_OUT) { const int kb = r / 32, nb = r % 32; const float sc = f8_scale_of(w_out, lane); if (r == 0 && lane == 0) WSC_IN[1] = 1.0f / sc; tr_item_f8(w_out, D, (unsigned char*)(args.ws + W_OUT_T), 1024, 64 * kb, 32 * nb, 32 * nb, scr, lane, sc); continue; } r -= I_OUT; \
                if (r < 2 * I_SG) { const int up = r / I_SG, q = r % I_SG, kb = q / 8, nb = q % 8, n0 = 32 * nb; tr_item(up ? w_su : w_sg, FF, (h16*)(args.ws + W_SGU_T), 1024, 64 * kb, n0, 256 * (n0 >> 7) + (n0 & 127) + 128 * up, scr, lane); continue; } r -= 2 * I_SG; \
                if (r < I_SD) { const int kb = r / 32, nb = r % 32; tr_item(w_sd, D, (h16*)(args.ws + W_SD_T), 256, 64 * kb, 32 * nb, 32 * nb, scr, lane); continue; } r -= I_SD; \
                { const int kb = r / 2, nb = r % 2; tr_item_hilo(w_router, NE, (h16*)(args.ws + W_R_T), 1024, 64 * kb, 32 * nb, scr, lane); } \
            } \
            PREP_EXPERTS(l, (E_LO), PE_ALL, F.gw, F.NGW); \
            { unsigned char* wpe = (unsigned char*)(args.ws + W_PE_T); const float* w_pool = L_W_POOL; const float* pool_scale = L_PSCALE; const float* w_br_pool = L_W_BRP; \
                \
              const float sc_pe = f8_scale_of(w_pool, lane) * f8_scale_of(w_br_pool, lane) * (1.0f / 512.0f), sc_ba = f8_scale_of(w_br_attn, lane), sc_i = f8_scale_of(w_in, lane); \
              if (F.gw == 0 && lane == 0) { float psc = sc_i * (1.0f / 256.0f); asm volatile("" : "+v"(psc)); const float osc = psc * 4.0f; WSC_IN[2] = psc; WSC_IN[3] = osc; WSC_IN[4] = (osc * sc_ba) / (psc * sc_pe); WSC_IN[5] = 16.0f / (osc * sc_ba); } \
              for (int idx = F.gw; idx < 512 * 16; idx += F.NGW) { const int cg = idx >> 4, n = ((idx & 15) << 6) + lane, g = cg >> 7; float s = 0.f; \
                  const float* wp = w_pool + (size_t)cg * 128; const float* ps = pool_scale + 128 * g; const float* wb = w_br_pool + (size_t)(128 * g) * D + n; \
                  float wv[128]; \
            _Pragma("unroll") \
                  for (int d = 0; d < 128; ++d) wv[d] = wb[(size_t)d * D]; \
            _Pragma("unroll") \
                  for (int d = 0; d < 128; ++d) s += wp[d] * ps[d] * wv[d]; \
                  wpe[(size_t)n * 512 + cg] = (unsigned char)(f8x4((f32x4){s, s, s, s} * sc_pe) & 0xffu); } } \
} while (0)
#define X32   (args.out)
#define XB    ((h16*)(args.ws + WS_XB))
#define XB8   ((unsigned char*)(args.ws + W_XB8))
#define WSC_IN ((float*)(args.ws + MS_WSC) + 512)
#define HH    ((h16*)(args.ws + R_HH))
#define PD8   ((unsigned char*)(args.ws + R_PD))
#define O8    ((unsigned char*)(args.ws + R_PD + 16 * MiB))
#define MG    ((h16*)(args.ws + R_MG))
#define G8B   ((unsigned char*)(args.ws + WS_R + 336 * MiB))
#define HB    ((h16*)(args.ws + WS_HB))
#define HS    ((h16*)(args.ws + WS_HS))
#define YD    ((h16*)(args.ws + WS_R))
#define LOGIT ((float*)(args.ws + WS_HB))
#define ESEL  ((int*)(args.ws + MS_ESEL))
#define GATE  ((float*)(args.ws + MS_GATE))
#define RANKL ((int*)(args.ws + MS_RANK))
#define SLOT  ((int*)(args.ws + MS_SLOT))
#define TOKL  ((int*)(args.ws + MS_TOKL))
#define GATL  ((float*)(args.ws + MS_GATL))
#define WCNT  ((int*)(args.ws + MS_WCNT))
#define GTOT  ((int*)(args.ws + MS_GTOT))
#define BLKE  ((int*)(args.ws + MS_BLKE))
#define L_W_IN   (args.in[3] + (size_t)l * D * DIN)
#define L_B_IN   (args.in[4] + (size_t)l * DIN)
#define L_W_POOL (args.in[5] + (size_t)l * 4 * 128 * 128)
#define L_PSCALE (args.in[6] + (size_t)l * 512)
#define L_SINKS  (args.in[7] + (size_t)l * 8)
#define L_W_BRP  (args.in[8] + (size_t)l * 512 * D)
#define L_W_BRA  (args.in[9] + (size_t)l * 512 * D)
#define L_W_OUT  (args.in[10] + (size_t)l * D * D)
#define L_LN1G   (args.in[11] + (size_t)l * D)
#define L_LN1B   (args.in[12] + (size_t)l * D)
#define L_W_R    (args.in[13] + (size_t)l * D * NE)
#define L_RBIAS  (args.in[14] + (size_t)l * NE)
#define L_W_EG   (args.in[15] + (size_t)l * NE * D * FF)
#define L_W_EU   (args.in[16] + (size_t)l * NE * D * FF)
#define L_W_ED   (args.in[17] + (size_t)l * NE * FF * D)
#define L_W_SG   (args.in[18] + (size_t)l * D * FF)
#define L_W_SU   (args.in[19] + (size_t)l * D * FF)
#define L_W_SD   (args.in[20] + (size_t)l * FF * D)
#define L_LN2G   (args.in[21] + (size_t)l * D)
#define L_LN2B   (args.in[22] + (size_t)l * D)
__global__ void __launch_bounds__(512, 2) fwd_kernel(Args args) {
    extern __shared__ __attribute__((aligned(16))) unsigned char lds_raw[];
    Frame F;
    F.lds = (LAS unsigned char*)lds_raw;
    F.wave = __builtin_amdgcn_readfirstlane((int)threadIdx.x >> 6);
    F.G = gridDim.x; { const int bx = blockIdx.x; F.vcu = (F.G % 8 == 0) ? (bx % 8) * (F.G / 8) + bx / 8 : bx; }
    F.gw = F.vcu * 8 + F.wave; F.NGW = F.G * 8;
    unsigned* ctl = (unsigned*)(args.ws + WS_CTL);
    volatile LAS unsigned* MISC = (volatile LAS unsigned*)(F.lds + MISC_OFF);
    for (int u = threadIdx.x; u < (LDS_BYTES - LDSCTL_OFF) / 4; u += 512) ((LAS unsigned*)(F.lds + LDSCTL_OFF))[u] = 0u;
    __syncthreads();
#if MK_ONE_LAUNCH
    XcdBarrier bar = xcd_barrier_post(ctl + CW_BAR, MISC + 8);
#define GRID_BAR() xcd_barrier(bar, F.wave)
#else
#define GRID_BAR() do {} while (0)
#endif
    const int lo = args.ph_lo, hi = args.ph_hi;
#ifndef PHASE_MASK
#define PHASE_MASK 0xfff
#endif
#ifndef REPEAT_MASK
#define REPEAT_MASK 0
#endif
#define REPS(p) for (int rep_ = 0; rep_ < 1 + ((REPEAT_MASK >> (p)) & 1); ++rep_)
#define IN(p) (((PHASE_MASK >> ((p) - pb)) & 1) && lo <= (p) && (p) < hi)
#define PHASE_REGS const int lane = lane_id(); const int tid = F.wave * 64 + lane; int vcu = F.vcu, bx = (int)blockIdx.x; asm volatile("" : "+s"(vcu), "+s"(bx)); (void)lane; (void)tid; (void)vcu; (void)bx;

    for (int l = 0; l < DEPTH; ++l) {
        const int pb = l * NPH;
        if (IN(pb + 0) && l == 0) {
            PHASE_REGS
            PREP_WEIGHTS(0);
            for (int m = F.gw; m < T; m += F.NGW) { f32x4 v[4];
#pragma unroll
                for (int j = 0; j < 4; ++j) v[j] = *(const f32x4*)(args.in[0] + (size_t)m * D + 8 * lane + 4 * (j & 1) + 512 * (j >> 1));
                ln_store8(v, args.in[1], args.in[2], nullptr, XB + (size_t)m * D, lane, -1, -1, XB8 + (size_t)m * D); }
            GRID_BAR();
        }
        if (IN(pb + 1)) {
            PHASE_REGS
            SchedDense S; S.o.init(T, DIN, F.G, bx); S.a = (const char*)XB8; S.b = (const char*)(args.ws + W_IN_T); S.apitch = 1024; S.bpitch = 1024;
            EpiInProj E{HH, L_B_IN, *WSC_IN};
            REPS(1) GEMM_PHASE_F8(512, S, E);
            if (l + 1 < DEPTH && F.G == 256 && bx >= 128) PREP_EXPERTS(l + 1, 0, PE_A, (bx - 128) * 8 + F.wave, 128 * 8);
            GRID_BAR();
        }
        if (IN(pb + 2)) {
            PHASE_REGS
            { const int g = F.gw & 3, c8 = 16 * g + (lane & 15); const float psc = WSC_IN[2];
              for (int it = F.gw; it < T; it += 2 * F.NGW) { const int tA = (it >> 2) * 4 + (lane >> 4); const int it2 = (it + F.NGW < T) ? it + F.NGW : it; const int tB = (it2 >> 2) * 4 + (lane >> 4);
                  if (g == 0) pool_pair<2>(HH, PD8, psc, c8, tA, tB); else if (g == 1) pool_pair<4>(HH, PD8, psc, c8, tA, tB); else if (g == 2) pool_pair<8>(HH, PD8, psc, c8, tA, tB); else pool_pair<16>(HH, PD8, psc, c8, tA, tB); } }
            for (int U = vcu; U < NB * 16 * 2; U += F.G) attn_unit(F.lds, HH, O8, WSC_IN[3], L_SINKS, U >> 5, (U >> 1) & 15, U & 1, tid);
            GRID_BAR();
        }
        if (IN(pb + 3)) {
            PHASE_REGS
            SchedMerged S; S.o.init(T, D, F.G, bx); S.pd = (const char*)PD8; S.oo = (const char*)O8; S.wpe = (const char*)(args.ws + W_PE_T); S.wba = (const char*)(args.ws + W_BA_T);
            EpiMerged E{(unsigned char*)MG, G8B, WSC_IN[4], WSC_IN[5]};
            REPS(3) GEMM_PHASE_F8(256, S, E);
            GRID_BAR();
        }
        if (IN(pb + 4)) {
            PHASE_REGS
            SchedDense S; S.o.init(T, D, F.G, bx); S.a = (const char*)MG; S.b = (const char*)(args.ws + W_OUT_T); S.apitch = 1024; S.bpitch = 1024;
            EpiResid E{(h16*)X32, XB, WSC_IN[1] * 0.0625f};
            REPS(4) GEMM_PHASE_F8(512, S, E);
            GRID_BAR();
        }
        if (IN(pb + 5)) {
            PHASE_REGS
            for (int m0 = F.gw; m0 < T; m0 += 4 * F.NGW) { u32x4 ra[4], rb4[4];
#pragma unroll
                for (int q = 0; q < 4; ++q) { const int m = (m0 + q * F.NGW < T) ? m0 + q * F.NGW : m0; const h16* sp = (const h16*)X32 + (size_t)m * D + 8 * lane;
                    ra[q] = __builtin_nontemporal_load((const u32x4*)sp); rb4[q] = __builtin_nontemporal_load((const u32x4*)(sp + 512)); }
#pragma unroll
                for (int q = 0; q < 4; ++q) { const int m = m0 + q * F.NGW; if (m < T) { f32x4 v[4]; unpack8(ra[q], v[0], v[1]); unpack8(rb4[q], v[2], v[3]); ln_store8(v, L_LN1G, L_LN1B, nullptr, XB + (size_t)m * D, lane, -1, -1, XB8 + (size_t)m * D); } } }
            GRID_BAR();
        }
        if (IN(pb + 6)) {
            PHASE_REGS
            SchedSharedRouter S{F.G, vcu, (const char*)XB, (const char*)(args.ws + W_SGU_T), (const char*)(args.ws + W_R_T)};
            EpiSharedRouter E{HS, LOGIT};
            REPS(6) GEMM_PHASE(1024, S, E);
            GRID_BAR();
        }
        if (IN(pb + 7)) {
            PHASE_REGS
            LAS float* tb = (LAS float*)(F.lds);
            LAS int* lcnt = (LAS int*)(F.lds + 512);
            if (F.wave == 0) { tb[lane] = L_RBIAS[lane]; tb[64 + lane] = WSC_P(l)[4 * lane] * WSC_P(l)[4 * lane + 1] * WSC_P(l)[4 * lane + 2] * 4194304.0f; }
            __syncthreads();
            REPS(7) for (int w = vcu; w < 256; w += F.G) {
                int cntv = 0;
                if (F.wave < 2) {
                    const int t = w * 128 + F.wave * 64 + lane;
                    float key[64];
                    { const float* lp = LOGIT + (size_t)t * NE;
#pragma unroll
                      for (int j = 0; j < 16; ++j) { const f32x4 a = *(const f32x4*)(lp + 4 * j), b = *(const f32x4*)(lp + (size_t)T * NE + 4 * j); key[4 * j] = a.x + b.x; key[4 * j + 1] = a.y + b.y; key[4 * j + 2] = a.z + b.z; key[4 * j + 3] = a.w + b.w; } }
                    float gs[8];
#pragma unroll
                    for (int g = 0; g < 8; ++g) { const f32x4 r0 = *(const LAS f32x4*)(tb + 8 * g), r1 = *(const LAS f32x4*)(tb + 8 * g + 4); float m1 = -INFINITY, m2 = -INFINITY;
#pragma unroll
                        for (int j = 0; j < 8; ++j) { const int e = 8 * g + j; const float bs = sigmoidf_(key[e]) + (j < 4 ? r0[j & 3] : r1[j & 3]); m2 = __builtin_amdgcn_fmed3f(m1, m2, bs); m1 = fmaxf(m1, bs);
                            key[e] = __uint_as_float((__float_as_uint(bs) & ~63u) | (unsigned)(63 - e)); }
                        gs[g] = m1 + m2; }
#pragma unroll
                    for (int g = 0; g < 8; ++g) { int r = 0;
#pragma unroll
                        for (int j = 0; j < 8; ++j) if (j != g) r += (j < g) ? (gs[j] >= gs[g] ? 1 : 0) : (gs[j] > gs[g] ? 1 : 0);
                        const bool keep = r < 4;
#pragma unroll
                        for (int j = 0; j < 8; ++j) key[8 * g + j] = keep ? key[8 * g + j] : -INFINITY; }
                    float tp[8];
#pragma unroll
                    for (int q = 0; q < 8; ++q) tp[q] = -INFINITY;
#pragma unroll
                    for (int e = 0; e < 64; ++e) { float x = key[e];
#pragma unroll
                        for (int q = 0; q < 8; ++q) { const float hi = fmaxf(tp[q], x); x = fminf(tp[q], x); tp[q] = hi; } }
                    unsigned long long M = 0ull; float sc[8]; int es[8]; float ssum = 0.f;
#pragma unroll
                    for (int q = 0; q < 8; ++q) { const unsigned ub = __float_as_uint(tp[q]); es[q] = 63 - (int)(ub & 63u); sc[q] = __uint_as_float(ub & ~63u) - tb[es[q]]; ssum += sc[q]; M |= 1ull << es[q]; }
                    const float inv = 2.5f / ssum;
#pragma unroll
                    for (int q = 0; q < 8; ++q) { const int k = __builtin_popcountll(M & ((1ull << es[q]) - 1ull)); GATE[(size_t)t * 8 + k] = sc[q] * inv * tb[64 + es[q]]; }
                    ((unsigned long long*)ESEL)[t] = M;
#pragma unroll
                    for (int e = 0; e < 64; ++e) { const unsigned long long bb = __ballot(((M >> e) & 1ull) != 0ull); const int pc_ = (int)__builtin_popcountll(bb); asm volatile("v_writelane_b32 %0, %1, %2" : "+v"(cntv) : "s"(pc_), "n"(e)); }
                }
                if (F.wave == 1) lcnt[lane] = cntv;
                __syncthreads();
                if (F.wave == 0) GTOT[w * 64 + lane] = cntv + lcnt[lane];
                __syncthreads();
            }
            GRID_BAR();
        }
        if (IN(pb + 8)) {
            PHASE_REGS
            LAS int* L_tot = (LAS int*)(F.lds); LAS int* L_bef = L_tot + 512; LAS int* L_cc = L_tot + 1024;
            const unsigned long long* MASKS = (const unsigned long long*)ESEL;
            REPS(8) for (int w = vcu; w < 256; w += F.G) {
                const int t0 = w * 128 + F.wave * 16;
                const unsigned long long mm = MASKS[t0 + (lane & 15)]; const int mlo = (int)(unsigned)mm, mhi = (int)(unsigned)(mm >> 32);
                int tp_ = 0, bp_ = 0, cc = 0;
#pragma unroll
                for (int j = 0; j < 32; ++j) { const int w2 = F.wave * 32 + j; const int c = GTOT[w2 * 64 + lane]; tp_ += c; bp_ += (w2 < w) ? c : 0; }
#pragma unroll
                for (int tt = 0; tt < 16; ++tt) { const unsigned long long Mt = ((unsigned long long)(unsigned)__builtin_amdgcn_readlane(mhi, tt) << 32) | (unsigned)__builtin_amdgcn_readlane(mlo, tt); cc += (int)((Mt >> lane) & 1ull); }
                L_tot[F.wave * 64 + lane] = tp_; L_bef[F.wave * 64 + lane] = bp_; L_cc[F.wave * 64 + lane] = cc;
                __syncthreads();
                int tot = 0, before = 0;
#pragma unroll
                for (int v = 0; v < 8; ++v) { tot += L_tot[v * 64 + lane]; before += L_bef[v * 64 + lane] + ((v < F.wave) ? L_cc[v * 64 + lane] : 0); }
                const int pc = (tot + 255) & ~255; int incl = pc;
#pragma unroll
                for (int o = 1; o < 64; o <<= 1) { const int xv = __shfl_up(incl, o); if (lane >= o) incl += xv; }
                const int pstart = incl - pc; int run = pstart + before;
#pragma unroll
                for (int tt = 0; tt < 16; ++tt) { const unsigned hi_ = (unsigned)__builtin_amdgcn_readlane(mhi, tt), lo_ = (unsigned)__builtin_amdgcn_readlane(mlo, tt); const unsigned long long Mt = ((unsigned long long)hi_ << 32) | lo_;
                    const bool sel = ((Mt >> lane) & 1ull) != 0ull; const int k = (int)__builtin_amdgcn_mbcnt_hi(hi_, __builtin_amdgcn_mbcnt_lo(lo_, 0u));
                    if (sel) TOKL[run] = (t0 + tt) * 9 + k;
                    run += sel ? 1 : 0; }
                if (F.wave == 0 && w < 64) {
                    const int ps_ = __shfl(pstart, w), te = __shfl(tot, w), pe = __shfl(pc, w);
                    for (int i2 = te + lane; i2 < pe; i2 += 64) TOKL[ps_ + i2] = YT_DUMP; }
                if (F.wave == 1) {
                    const int nblk = __shfl(incl, 63) >> 8; const int rbk = 8 * w + (lane & 7); int cnt = 0;
                    for (int e = 0; e < 64; ++e) { const int pend = __shfl(incl, e); cnt += (pend <= rbk * 256) ? 1 : 0; }
                    if (lane < 8 && rbk < nblk) BLKE[rbk] = cnt < 63 ? cnt : 63;
                    if (w == 0 && lane == 0) BLKE[NBLK_MAX] = nblk; }
                __syncthreads();
            }
            GRID_BAR();
        }
        if (IN(pb + 9)) {
            PHASE_REGS
            const int nblk = __builtin_amdgcn_readfirstlane(BLKE[NBLK_MAX]);
            { LAS int* bl = (LAS int*)(F.lds + LDS_BLKE); for (int i = tid; i < nblk; i += 512) bl[i] = BLKE[i]; __syncthreads(); }
            SchedMoeGU S{F.G, vcu, nblk, (const char*)(args.ws + W_XB8), (const char*)W_EGU_P(l), (const LAS int*)(F.lds + LDS_BLKE), TOKL};
            EpiMoeGU E{(unsigned char*)HB, WSC_P(l)};
            REPS(9) GEMM_PHASE_F8(512, S, E);
            { const int rounds = (2 * nblk + 255) >> 8, busy = 2 * nblk - 256 * (rounds - 1);
              const int n9 = min(PE_ALL - PE_A, (256 - busy) * 8 * P9_IPW);
              if (l + 1 < DEPTH && F.G == 256 && vcu >= busy) PREP_EXPERTS(l + 1, PE_A, PE_A + n9, (vcu - busy) * 8 + F.wave, (256 - busy) * 8); }
            GRID_BAR();
        }
        if (IN(pb + 10)) {
            PHASE_REGS
            const int nblk = __builtin_amdgcn_readfirstlane(BLKE[NBLK_MAX]);
            { LAS int* bl = (LAS int*)(F.lds + LDS_BLKE); for (int i = tid; i < nblk; i += 512) bl[i] = BLKE[i]; __syncthreads(); }
            { SchedShDown S{F.G, vcu, (const char*)HS, (const char*)(args.ws + W_SD_T)};
              EpiMoeDown<false> E{(unsigned char*)(args.ws + WS_R), (h16*)(args.ws + R_YS)};
              GEMM_PHASE(256, S, E); }
            __syncthreads();
            { SchedMoeDownR S{F.G, vcu, nblk, (const char*)HB, (const char*)W_ED_P(l), (const LAS int*)(F.lds + LDS_BLKE), TOKL};
              EpiMoeDown<true> E{(unsigned char*)(args.ws + WS_R), (h16*)(args.ws + R_YS)};
              REPS(10) GEMM_PHASE_F8(128, S, E); }
            GRID_BAR();
        }
        if (IN(pb + 11)) {
            PHASE_REGS
            { float* xo = (l == DEPTH - 1) ? X32 : nullptr;
            const unsigned char* YQ = (const unsigned char*)(args.ws + WS_R); const h16* YS = (const h16*)(args.ws + R_YS);
            const int c0 = 256 * (lane >> 4) + 32 * ((lane >> 2) & 3) + 8 * (lane & 3), c1 = c0 + 128;
            for (int m0_ = F.gw; m0_ < T; m0_ += 2 * F.NGW) { int m0 = m0_; asm volatile("" : "+s"(m0));
                u32x4 yq[2][9], xa[2], xb2[2]; unsigned short ys[2]; float gt[2];
#pragma unroll
                for (int q = 0; q < 2; ++q) { const int m = (m0 + q * F.NGW < T) ? m0 + q * F.NGW : m0;
                    xa[q] = *(const u32x4*)(XB + (size_t)m * D + c0); xb2[q] = *(const u32x4*)(XB + (size_t)m * D + c1); gt[q] = GATE[(size_t)m * 8 + (lane & 7)];
#pragma unroll
                    for (int k = 0; k < 9; ++k) yq[q][k] = __builtin_nontemporal_load((const u32x4*)(YQ + ((size_t)m * 9 + k) * 1024 + lane * 16));
                    ys[q] = __builtin_nontemporal_load((const unsigned short*)(YS + ((size_t)m * 9 + 8) * 64 + lane)); }
#pragma unroll
                for (int q = 0; q < 2; ++q) { const int m = m0 + q * F.NGW; if (m < T) {
                    f32x4 v[4]; unpack8(xa[q], v[0], v[1]); unpack8(xb2[q], v[2], v[3]);
#pragma unroll
                    for (int j = 0; j < 4; ++j) v[j] = v[j] * ALPHA;
#pragma unroll
                    for (int k = 0; k < 8; ++k) { const float gk = rdlane(gt[q], k);
#pragma unroll
                        for (int j = 0; j < 4; ++j) { const f32x2 lo = __builtin_amdgcn_cvt_pk_f32_fp8((int)yq[q][k][j], false), hi = __builtin_amdgcn_cvt_pk_f32_fp8((int)yq[q][k][j], true);
                            v[j][0] += lo.x * gk; v[j][1] += lo.y * gk; v[j][2] += hi.x * gk; v[j][3] += hi.y * gk; }
                        __builtin_amdgcn_sched_barrier(0); }
                    { const float sc = h2f(ys[q]); const float bias = -128.0f * sc;
#pragma unroll
                        for (int j = 0; j < 4; ++j) { const unsigned wd = yq[q][8][j] ^ 0x80808080u;
                            v[j][0] += (float)(wd & 0xffu) * sc + bias; v[j][1] += (float)((wd >> 8) & 0xffu) * sc + bias; v[j][2] += (float)((wd >> 16) & 0xffu) * sc + bias; v[j][3] += (float)(wd >> 24) * sc + bias; } }
                    ln_store8(v, L_LN2G, L_LN2B, xo ? xo + (size_t)m * D : nullptr, XB + (size_t)m * D, lane, c0, c1, XB8 + (size_t)m * D); } } } }
            if (l + 1 < DEPTH) { const int nblk_ = __builtin_amdgcn_readfirstlane(BLKE[NBLK_MAX]); const int rounds_ = (2 * nblk_ + 255) >> 8, busy_ = 2 * nblk_ - 256 * (rounds_ - 1);
                const int e_lo = (F.G != 256) ? 0 : PE_A + min(PE_ALL - PE_A, (256 - busy_) * 8 * P9_IPW);
                ++l; PREP_WEIGHTS(e_lo); --l; }
            if (pb + 11 != DEPTH * NPH - 1) GRID_BAR();
        }
    }
#undef IN
}

extern "C" void kernel_launch(void* const* d_in, const int* in_sizes, int n_in, void* d_out, int out_size, void* d_ws, size_t ws_size, hipStream_t stream) {
    static int grid = 0;
    if (grid == 0) {
        if (n_in != 23 || out_size != T * D || ws_size < WS_END2) { fprintf(stderr, "kernel_launch: unexpected shapes (n_in %d out %d ws %zu)\n", n_in, out_size, ws_size); grid = -1; return; }
        int dev = 0, cus = 0;
        if (hipGetDevice(&dev) != hipSuccess || hipDeviceGetAttribute(&cus, hipDeviceAttributeMultiprocessorCount, dev) != hipSuccess) { grid = -1; return; }
        if (hipFuncSetAttribute((const void*)fwd_kernel, hipFuncAttributeMaxDynamicSharedMemorySize, LDS_BYTES) != hipSuccess) { fprintf(stderr, "kernel_launch: hipFuncSetAttribute failed\n"); grid = -1; return; }
        int per_cu = 0;
        if (hipOccupancyMaxActiveBlocksPerMultiprocessor(&per_cu, (const void*)fwd_kernel, 512, LDS_BYTES) != hipSuccess || per_cu < 1) { fprintf(stderr, "kernel_launch: occupancy query says %d\n", per_cu); }
        (void)hipGetLastError();
        grid = cus;
    }
    if (grid < 0) return;
    (void)hipMemsetAsync((char*)d_ws + WS_CTL, 0, CTL_ZERO_BYTES, stream);
    Args a{};
    for (int i = 0; i < 23; ++i) a.in[i] = (const float*)d_in[i];
    a.out = (float*)d_out; a.ws = (unsigned char*)d_ws;
#if MK_ONE_LAUNCH
    a.ph_lo = 0; a.ph_hi = DEPTH * NPH;
    hipLaunchKernelGGL(fwd_kernel, dim3(grid), dim3(512), LDS_BYTES, stream, a);
#else
    for (int p = 0; p < DEPTH * NPH; ++p) { a.ph_lo = p; a.ph_hi = p + 1; hipLaunchKernelGGL(fwd_kernel, dim3(grid), dim3(512), LDS_BYTES, stream, a); }
#endif
}
```

```cpp
#include <hip/hip_runtime.h>
#include <stdint.h>
#include <stdio.h>

#ifndef MK_ONE_LAUNCH
#define MK_ONE_LAUNCH 1
#endif

#define GAS __attribute__((address_space(1)))
#define LAS __attribute__((address_space(3)))
typedef unsigned short h16;
typedef short h16x8 __attribute__((ext_vector_type(8)));
typedef float f32x4 __attribute__((ext_vector_type(4)));
typedef float f32x2 __attribute__((ext_vector_type(2)));
typedef unsigned u32x4 __attribute__((ext_vector_type(4)));
typedef unsigned u32x2 __attribute__((ext_vector_type(2)));

constexpr int NB = 16, SEQ = 2048, T = NB * SEQ, D = 1024, DIN = 3328, DEPTH = 4;
constexpr int C_U = 0, C_Q = 512, C_K = 1024, C_V = 1152, C_GP = 1280, C_GA = 2304;
constexpr int NE = 64, FF = 256, TOPK = 8;
constexpr int NASSIGN = T * TOPK;
constexpr int NBLK_MAX = NASSIGN / 256 + NE;
constexpr int A_PAD = NBLK_MAX * 256;
constexpr float ALPHA = 1.6817928305074290f;
constexpr float LN_EPS = 1e-5f;
constexpr int NPH = 12;

constexpr size_t MiB = 1u << 20;
constexpr size_t WS_CTL = 0, CTL_ZERO_BYTES = 64 * 1024;
constexpr size_t WS_W = 1 * MiB;
constexpr size_t W_IN_T = WS_W + 0 * MiB;
constexpr size_t W_PE_T = WS_W + 7 * MiB;
constexpr size_t W_BA_T = WS_W + 8 * MiB;
constexpr size_t W_OUT_T = WS_W + 9 * MiB;
constexpr size_t W_R_T = WS_W + 11 * MiB;
constexpr size_t W_SGU_T = WS_W + 12 * MiB;
constexpr size_t W_SD_T = WS_W + 13 * MiB;
constexpr size_t W_EGU_T = WS_W + 14 * MiB;
constexpr size_t W_ED_T = WS_W + 78 * MiB;
constexpr size_t W_XB8 = W_EGU_T + 32 * MiB;
constexpr size_t WS_XB = 111 * MiB;
constexpr size_t WS_HB = 175 * MiB;
constexpr size_t WS_HS = 311 * MiB;
constexpr size_t WS_MISC = 327 * MiB;
constexpr size_t MS_LOGIT = WS_MISC;
constexpr size_t MS_ESEL = WS_MISC + 8 * MiB;
constexpr size_t MS_GATE = WS_MISC + 9 * MiB;
constexpr size_t MS_RANK = WS_MISC + 10 * MiB;
constexpr size_t MS_SLOT = WS_MISC + 11 * MiB;
constexpr size_t MS_TOKL = WS_MISC + 12 * MiB;
constexpr size_t MS_GATL = WS_MISC + 13 * MiB + 256 * 1024;
constexpr size_t MS_WCNT = WS_MISC + 14 * MiB + 512 * 1024;
constexpr size_t MS_GTOT = WS_MISC + 15 * MiB;
constexpr size_t MS_BLKE = WS_MISC + 15 * MiB + 256 * 1024;
constexpr size_t MS_WSC = WS_MISC + 15 * MiB + 512 * 1024;
constexpr size_t WS_R = 343 * MiB;
constexpr size_t R_HH = WS_R;
constexpr size_t R_PD = WS_R + 208 * MiB;
constexpr size_t R_MG = WS_R + 240 * MiB;
constexpr size_t WS_END = WS_R + 577 * MiB;
constexpr size_t W_EGU_ALT = WS_END;
constexpr size_t W_ED_ALT = WS_END + 64 * MiB;
constexpr size_t WS_END2 = WS_END + 96 * MiB;
constexpr size_t R_YS = WS_R + 296 * MiB;
constexpr int YT_DUMP = T * 9;
static_assert((size_t)A_PAD * 4 <= 1 * MiB + 256 * 1024, "toklist");
static_assert((size_t)A_PAD * 256 * 2 <= 136 * MiB, "Hbuf");
static_assert(((size_t)T * 9 + 1) * 1024 * 2 <= 577 * MiB, "Yt");

constexpr int CW_BAR = 4096;

constexpr int RING_BYTES = 131072;
constexpr int LDSCTL_OFF = RING_BYTES, MISC_OFF = LDSCTL_OFF + 320;
constexpr int LDS_BYTES = 147456;
constexpr int LDS_BLKE = LDSCTL_OFF + 1024;
constexpr int LDS_IDX = LDS_BLKE + 4352;
constexpr int LDS_OID = LDS_IDX + 2048;
static_assert(LDS_OID + 3072 <= LDS_BYTES, "LDS map");

#define RLX_AGENT __ATOMIC_RELAXED, __HIP_MEMORY_SCOPE_AGENT
__device__ __forceinline__ int lane_id() { int l; asm volatile("v_mbcnt_lo_u32_b32 %0, -1, 0\n\tv_mbcnt_hi_u32_b32 %0, -1, %0" : "=v"(l)); return l; }
typedef _Float16 f16x2 __attribute__((ext_vector_type(2)));
typedef _Float16 f16x8 __attribute__((ext_vector_type(8)));
__device__ __forceinline__ float h2f(unsigned short h) { return (float)__builtin_bit_cast(_Float16, h); }
__device__ __forceinline__ unsigned short f2h(float f) { return __builtin_bit_cast(unsigned short, (_Float16)f); }
__device__ __forceinline__ unsigned cvt_pk_h16(float lo, float hi) { f32x2 v = {lo, hi}; return __builtin_bit_cast(unsigned, __builtin_convertvector(v, f16x2)); }
__device__ __forceinline__ float lo16(unsigned w) { return (float)__builtin_bit_cast(f16x2, w)[0]; }
__device__ __forceinline__ float hi16(unsigned w) { return (float)__builtin_bit_cast(f16x2, w)[1]; }
__device__ __forceinline__ float sigmoidf_(float x) { return __builtin_amdgcn_rcpf(1.0f + __builtin_amdgcn_exp2f(-1.4426950408889634f * x)); }
template <int CTRL> __device__ __forceinline__ float dppf(float x) { return __builtin_bit_cast(float, __builtin_amdgcn_update_dpp(0, __builtin_bit_cast(int, x), CTRL, 0xf, 0xf, true)); }
__device__ __forceinline__ float rdlane(float x, int l) { return __builtin_bit_cast(float, __builtin_amdgcn_readlane(__builtin_bit_cast(int, x), l)); }
__device__ __forceinline__ float wave_sum(float v) {
    v += dppf<0xB1>(v); v += dppf<0x4E>(v); v += dppf<0x141>(v); v += dppf<0x140>(v);
    return (rdlane(v, 0) + rdlane(v, 16)) + (rdlane(v, 32) + rdlane(v, 48));
}
__device__ __forceinline__ float wave_max(float v) {
    v = fmaxf(v, dppf<0xB1>(v)); v = fmaxf(v, dppf<0x4E>(v)); v = fmaxf(v, dppf<0x141>(v)); v = fmaxf(v, dppf<0x140>(v));
    return fmaxf(fmaxf(rdlane(v, 0), rdlane(v, 16)), fmaxf(rdlane(v, 32), rdlane(v, 48)));
}
__device__ __forceinline__ float dppf_swap32(float x) { return __shfl_xor(x, 32); }
__device__ __forceinline__ float max8(float v) {
    v = fmaxf(v, dppf<0xB1>(v)); v = fmaxf(v, dppf<0x4E>(v)); return fmaxf(v, dppf<0x141>(v));
}

#define XB_TMO      128
#define XB_XCNT(j)  (256  + 64 * (j))
#define XB_XSUB(j)  (1280 + 64 * (j))
#define XB_XGEN(j)  (2304 + 64 * (j))
#define XB_TOP      3328
#define XB_TOPGEN   3392
#define XCD_BAR_WORDS 3456
#define XB_SPIN_CAP (1u << 18)
__device__ __forceinline__ unsigned xb_ld(unsigned* p)              { return __hip_atomic_load(p, __ATOMIC_RELAXED, __HIP_MEMORY_SCOPE_AGENT); }
__device__ __forceinline__ unsigned xb_add(unsigned* p, unsigned v) { return __hip_atomic_fetch_add(p, v, __ATOMIC_RELAXED, __HIP_MEMORY_SCOPE_AGENT); }
__device__ __forceinline__ unsigned xb_xcc_id() { return (unsigned)__builtin_amdgcn_s_getreg((3 << 11) | 20) & 0xFu; }
#define XB_SPIN(cond, bar) do { unsigned _sp = 0; while (cond) { __builtin_amdgcn_s_sleep(1); \
    if ((++_sp & 255u) == 0u) { if (xb_ld(&(bar)[XB_TMO])) break; if (_sp > XB_SPIN_CAP) { atomicAdd(&(bar)[XB_TMO], 1u); break; } } } } while (0)
struct XcdBarrier { unsigned* bar; unsigned x; volatile LAS unsigned* st; };
__device__ __forceinline__ XcdBarrier xcd_barrier_post(unsigned* bar, volatile LAS unsigned* st) {
    XcdBarrier b; b.bar = bar; b.x = xb_xcc_id(); b.st = st;
    if (threadIdx.x == 0) (void)xb_add(&bar[XB_XCNT(b.x)], 1u);
    return b;
}
__device__ __forceinline__ void xcd_barrier_complete(unsigned* bar, unsigned x, unsigned& nloc, unsigned& nx) {
    const unsigned G = gridDim.x * gridDim.y * gridDim.z;
    unsigned sum, cnt, mine, sp = 0u;
    for (;;) {
        sum = 0u; cnt = 0u; mine = 0u;
#pragma unroll
        for (unsigned j = 0; j < 16; ++j) { const unsigned c = xb_ld(&bar[XB_XCNT(j)]); sum += c; cnt += (c > 0u) ? 1u : 0u; mine = (j == x) ? c : mine; }
        if (sum == G) break;
        __builtin_amdgcn_s_sleep(1);
        if ((++sp & 255u) == 0u) { if (xb_ld(&bar[XB_TMO])) break; if (sp > XB_SPIN_CAP) { atomicAdd(&bar[XB_TMO], 1u); break; } }
    }
    nloc = mine > 0u ? mine : 1u; nx = cnt > 0u ? cnt : 1u;
}
__device__ __forceinline__ void xcd_barrier(const XcdBarrier& b, const int wave) {
    asm volatile("s_waitcnt vmcnt(0)" ::: "memory");
    __syncthreads();
    if (wave == 0 && lane_id() == 0) {
        unsigned* bar = b.bar;
        __builtin_amdgcn_s_waitcnt(0);
        unsigned nloc = b.st[0], nx = b.st[1];
        if (nloc == 0u) { xcd_barrier_complete(bar, b.x, nloc, nx); b.st[0] = nloc; b.st[1] = nx; }
        const unsigned old = xb_add(&bar[XB_XSUB(b.x)], 1u);
        const unsigned gen = old / nloc;
        if (old + 1u == (gen + 1u) * nloc) {
            __builtin_amdgcn_fence(__ATOMIC_RELEASE, "agent");
            asm volatile("s_waitcnt vmcnt(0)" ::: "memory");
            const unsigned og = xb_add(&bar[XB_TOP], 1u);
            const unsigned tg = og / nx;
            if (og + 1u == (tg + 1u) * nx) xb_add(&bar[XB_TOPGEN], 1u);
            else XB_SPIN(xb_ld(&bar[XB_TOPGEN]) == tg, bar);
            __builtin_amdgcn_fence(__ATOMIC_ACQUIRE, "agent");
            xb_add(&bar[XB_XGEN(b.x)], 1u);
            asm volatile("s_waitcnt vmcnt(0)" ::: "memory");
        } else {
            XB_SPIN(xb_ld(&bar[XB_XGEN(b.x)]) == gen, bar);
            __builtin_amdgcn_fence(__ATOMIC_ACQUIRE, "agent");
            asm volatile("s_waitcnt vmcnt(0)" ::: "memory");
        }
    }
    __syncthreads();
}

struct Unit {
    const char* a;
    const char* b;
    const int* ridx;
    unsigned apitch, bpitch;
    int row0;
    int col0;
    int kind;
    const int* oidx;
    const LAS int* oidl;
    int nt;
    int keep;
};
__device__ __forceinline__ int id2tok(int id) { const int t = (int)(((unsigned long long)(unsigned)id * 954437177ull) >> 33); return t < T ? t : T - 1; }
#define ACC_T f32x4 (&acc)[2][2][4][2]

template <class Epi, class Sched>
__device__ __forceinline__ void gemm_phase_simple(const int wid, const int K, const Sched& S, const Epi& E) {
    const int lane = lane_id(), tid = wid * 64 + lane; (void)tid;
    const int  wr = wid >> 2, wc = wid & 3, fr = lane & 15, fq = lane >> 4;
    Unit u;
    for (int i = 0; S.next(i, u); ++i) {
        f32x4 acc[2][2][4][2];
#pragma unroll
        for (int a = 0; a < 2; ++a)
#pragma unroll
            for (int b = 0; b < 2; ++b)
#pragma unroll
                for (int m = 0; m < 4; ++m)
#pragma unroll
                    for (int n = 0; n < 2; ++n) acc[a][b][m][n] = (f32x4){0.f, 0.f, 0.f, 0.f};
        unsigned offA[2][4], offB[2][2];
#pragma unroll
        for (int ai = 0; ai < 2; ++ai)
#pragma unroll
            for (int m = 0; m < 4; ++m) { const int r = 128 * ai + 64 * wr + 16 * m + fr; const int row = u.ridx ? id2tok(u.ridx[r]) : u.row0 + r; offA[ai][m] = (unsigned)row * u.apitch + (unsigned)fq * 16u; }
#pragma unroll
        for (int bj = 0; bj < 2; ++bj)
#pragma unroll
            for (int n = 0; n < 2; ++n) { const int wrow = 128 * bj + 32 * wc + 8 * (fr >> 2) + 4 * n + (fr & 3); offB[bj][n] = (unsigned)wrow * u.bpitch + (unsigned)fq * 16u; }
#pragma unroll 1
        for (int k0 = 0; k0 < K; k0 += 32) {
            h16x8 b[2][2];
#pragma unroll
            for (int bj = 0; bj < 2; ++bj)
#pragma unroll
                for (int n = 0; n < 2; ++n) b[bj][n] = *(const h16x8*)(u.b + offB[bj][n] + (size_t)k0 * 2);
#pragma unroll
            for (int ai = 0; ai < 2; ++ai) {
                h16x8 a[4];
#pragma unroll
                for (int m = 0; m < 4; ++m) a[m] = *(const h16x8*)(u.a + offA[ai][m] + (size_t)k0 * 2);
#pragma unroll
                for (int bj = 0; bj < 2; ++bj)
#pragma unroll
                    for (int m = 0; m < 4; ++m)
#pragma unroll
                        for (int n = 0; n < 2; ++n) acc[ai][bj][m][n] = __builtin_amdgcn_mfma_f32_16x16x32_f16(__builtin_bit_cast(f16x8, b[bj][n]), __builtin_bit_cast(f16x8, a[m]), acc[ai][bj][m][n], 0, 0, 0);
                asm volatile("" ::: "memory");
            }
        }
        u.oidl = nullptr;
        E(acc, u, wr, wc, fr, fq);
    }
}


#ifndef FAST_GEMM
#define FAST_GEMM 1
#endif
constexpr int HTB = 128 * 64 * 2;
__device__ __forceinline__ int lds_byte(int r, int c) { const int st = (r >> 4) * 2 + (c >> 5), rr = r & 15, cc = c & 31, ob = rr * 64 + cc * 2; return st * 1024 + (ob ^ (((ob >> 9) & 1) << 5)); }
__device__ __forceinline__ void stage_rc(int b, int& R, int& C) { const int st = b / 1024, sb = b % 1024, swz = sb ^ (((sb >> 9) & 1) << 5); R = (st >> 1) * 16 + swz / 64; C = (st & 1) * 32 + (swz % 64) / 2; }
__device__ __forceinline__ int perm32(int rho) { const int n = rho >> 4, i = rho & 15; return 8 * (i >> 2) + 4 * n + (i & 3); }

__device__ __forceinline__ const char* uptr(const char* p) { const unsigned long long v = (unsigned long long)p; const unsigned lo = __builtin_amdgcn_readfirstlane((unsigned)v), hi = __builtin_amdgcn_readfirstlane((unsigned)(v >> 32)); return (const char*)(((unsigned long long)hi << 32) | lo); }
typedef int i32x8 __attribute__((ext_vector_type(8)));
__device__ __forceinline__ i32x8 cat8(const u32x4 a, const u32x4 b) { return (i32x8){(int)a.x, (int)a.y, (int)a.z, (int)a.w, (int)b.x, (int)b.y, (int)b.z, (int)b.w}; }
template <int H> __device__ __forceinline__ f16x8 half8(const i32x8 v) { typedef int i32x4_ __attribute__((ext_vector_type(4))); const i32x4_ q = __builtin_shufflevector(v, v, 4 * H, 4 * H + 1, 4 * H + 2, 4 * H + 3); return __builtin_bit_cast(f16x8, q); }
template <bool F8, class Epi, class Sched>
__device__ __forceinline__ void gemm_phase(LAS unsigned char* lds, const int wid, const int K, const Sched& S, const Epi& E) {
    const int lane = lane_id(), tid = wid * 64 + lane;
    const int  wr = wid >> 2, wc = wid & 3, fr = lane & 15, fq = lane >> 4;
    int nt = K / 64; asm volatile("" : "+s"(nt));
    const unsigned ldsw = (unsigned)wid * 1024u;
    const int aoff = lds_byte(wr * 64 + fr, fq * 8), boff = lds_byte(wc * 32 + fr, fq * 8);
#define G_SA(b, h) (((b) * 2 + (h)) * HTB)
#define G_SB(b, h) ((4 + (b) * 2 + (h)) * HTB)
#define G_STAGE(bufoff, gbase, o0, o1) do { \
        __builtin_amdgcn_global_load_lds((const unsigned*)((const char*)(gbase) + (o0)), (LAS unsigned*)(lds + (bufoff) + ldsw), 16, 0, 0); \
        __builtin_amdgcn_global_load_lds((const unsigned*)((const char*)(gbase) + (o1)), (LAS unsigned*)(lds + (bufoff) + ldsw + 8192), 16, 0, 0); } while (0)
#define G_LDA(dst, b, h) do { _Pragma("unroll") for (int m = 0; m < 4; ++m) dst[m] = cat8(*(const LAS u32x4*)(lds + G_SA(b, h) + aoff + m * 2048), *(const LAS u32x4*)(lds + G_SA(b, h) + aoff + m * 2048 + 1024)); } while (0)
#define G_LDB(dst, b, h) do { _Pragma("unroll") for (int n = 0; n < 2; ++n) dst[n] = cat8(*(const LAS u32x4*)(lds + G_SB(b, h) + boff + n * 2048), *(const LAS u32x4*)(lds + G_SB(b, h) + boff + n * 2048 + 1024)); } while (0)
#define G_MMA(ai, bj, At, Bt) do { __builtin_amdgcn_s_setprio(1); _Pragma("unroll") for (int m = 0; m < 4; ++m) _Pragma("unroll") for (int n = 0; n < 2; ++n) { \
        if constexpr (F8) { acc[ai][bj][m][n] = __builtin_amdgcn_mfma_scale_f32_16x16x128_f8f6f4(Bt[n], At[m], acc[ai][bj][m][n], 0, 0, 0, 0, 0, 0); } \
        else { acc[ai][bj][m][n] = __builtin_amdgcn_mfma_f32_16x16x32_f16(half8<0>(Bt[n]), half8<0>(At[m]), acc[ai][bj][m][n], 0, 0, 0); \
               acc[ai][bj][m][n] = __builtin_amdgcn_mfma_f32_16x16x32_f16(half8<1>(Bt[n]), half8<1>(At[m]), acc[ai][bj][m][n], 0, 0, 0); } } \
        __builtin_amdgcn_s_setprio(0); } while (0)
#define G_WAIT_V(n) asm volatile("s_waitcnt vmcnt(" #n ")" ::: "memory")
#define G_WAIT_L(n) asm volatile("s_waitcnt lgkmcnt(" #n ")" ::: "memory")
#define G_BAR __builtin_amdgcn_s_barrier()
#define G_SCHED __builtin_amdgcn_sched_barrier(0)
#define G_OFFS(u, OA, OB, IDXB) do { int tl_ = wid * 64 + lane_id(); _Pragma("unroll") for (int i = 0; i < 2; ++i) { int R_, C_; stage_rc(tl_ * 16 + i * 8192, R_, C_); const int Rb_ = (R_ & ~31) + perm32(R_ & 31); \
        _Pragma("unroll") for (int h = 0; h < 2; ++h) { const int r_ = h * 128 + R_; const int row_ = (u).ridx ? id2tok(((const LAS int*)(lds + LDS_IDX + (IDXB) * 1024))[r_]) : (u).row0 + r_; \
        OA[h][i] = (unsigned)row_ * (u).apitch + (unsigned)C_ * 2u; OB[h][i] = (unsigned)(h * 128 + Rb_) * (u).bpitch + (unsigned)C_ * 2u; } } } while (0)
#define G_IDX_DMA(u, IDXB, OIDB) do { if ((u).ridx && wid < 4) __builtin_amdgcn_global_load_lds((const unsigned*)((u).ridx + wid * 64 + lane_id()), (LAS unsigned*)(lds + LDS_IDX + (IDXB) * 1024 + wid * 256), 4, 0, 0); \
        if ((u).oidx && wid < 4) __builtin_amdgcn_global_load_lds((const unsigned*)((u).oidx + wid * 64 + lane_id()), (LAS unsigned*)(lds + LDS_OID + (OIDB) * 1024 + wid * 256), 4, 0, 0); } while (0)
    Unit cur, nxt; int ui = 0;
    if (!S.next(0, cur)) return;
    if constexpr (Sched::DYN) nt = cur.nt;
    unsigned cOA[2][2], cOB[2][2];
    G_IDX_DMA(cur, 0, 0); asm volatile("s_waitcnt vmcnt(0)" ::: "memory"); __builtin_amdgcn_s_barrier(); asm volatile("" ::: "memory");
    G_OFFS(cur, cOA, cOB, 0);
    f32x4 acc[2][2][4][2];
#pragma unroll
    for (int a = 0; a < 2; ++a)
#pragma unroll
        for (int b = 0; b < 2; ++b)
#pragma unroll
            for (int m = 0; m < 4; ++m)
#pragma unroll
                for (int n = 0; n < 2; ++n) acc[a][b][m][n] = (f32x4){0.f, 0.f, 0.f, 0.f};
    i32x8 At[4], B0[2], B1[2];
    const char* cA = uptr(cur.a); const char* cB = uptr(cur.b);
    G_STAGE(G_SB(0, 0), cB, cOB[0][0], cOB[0][1]); G_STAGE(G_SB(0, 1), cB, cOB[1][0], cOB[1][1]); G_STAGE(G_SA(0, 0), cA, cOA[0][0], cOA[0][1]); G_STAGE(G_SA(0, 1), cA, cOA[1][0], cOA[1][1]);
    if (wr == 1) G_BAR;
    G_WAIT_V(2); G_BAR;
    { const char* cA1 = uptr(cA + 128); const char* cB1 = uptr(cB + 128);
      G_STAGE(G_SB(1, 0), cB1, cOB[0][0], cOB[0][1]); G_STAGE(G_SA(1, 0), cA1, cOA[0][0], cOA[0][1]); G_STAGE(G_SB(1, 1), cB1, cOB[1][0], cOB[1][1]); }
    G_WAIT_V(6); G_BAR;
    for (;;) {
        const bool has_next = S.next(ui + 1, nxt); const char* nA = cA; const char* nB = cB;
        if (has_next) G_IDX_DMA(nxt, (ui + 1) & 1, (ui + 1) % 3);
#pragma unroll 1
        for (int t = 0; t < nt; t += 2) {
            const bool last = (t == nt - 2);
            const char* a1 = uptr(cA + (size_t)(t + 1) * 128);
            G_LDB(B0, 0, 0); G_LDB(B1, 0, 1); G_SCHED; G_LDA(At, 0, 0); G_STAGE(G_SA(1, 1), a1, cOA[1][0], cOA[1][1]);
            G_WAIT_V(8); G_WAIT_L(0); G_BAR; G_MMA(0, 0, At, B0); G_MMA(0, 1, At, B1); G_BAR; G_SCHED;
            if (last && has_next) { nA = uptr(nxt.a); nB = uptr(nxt.b); G_OFFS(nxt, cOA, cOB, (ui + 1) & 1); }
            const char* a2 = uptr(last ? nA : cA + (size_t)(t + 2) * 128); const char* b2 = uptr(last ? nB : cB + (size_t)(t + 2) * 128);
            const char* a3 = uptr(a2 + 128); const char* b3 = uptr(b2 + 128);
            G_LDA(At, 0, 1); G_STAGE(G_SB(0, 0), b2, cOB[0][0], cOB[0][1]); G_STAGE(G_SB(0, 1), b2, cOB[1][0], cOB[1][1]); G_STAGE(G_SA(0, 0), a2, cOA[0][0], cOA[0][1]);
            G_WAIT_V(8); G_WAIT_L(0); G_BAR; G_MMA(1, 0, At, B0); G_MMA(1, 1, At, B1); G_BAR; G_SCHED;
            G_LDB(B0, 1, 0); G_LDB(B1, 1, 1); G_SCHED; G_LDA(At, 1, 0); G_STAGE(G_SA(0, 1), a2, cOA[1][0], cOA[1][1]);
            G_WAIT_V(8); G_WAIT_L(0); G_BAR; G_MMA(0, 0, At, B0); G_MMA(0, 1, At, B1); G_BAR; G_SCHED;
            G_LDA(At, 1, 1); G_STAGE(G_SB(1, 0), b3, cOB[0][0], cOB[0][1]); G_STAGE(G_SB(1, 1), b3, cOB[1][0], cOB[1][1]); G_STAGE(G_SA(1, 0), a3, cOA[0][0], cOA[0][1]);
            G_WAIT_V(8); G_WAIT_L(0); G_BAR; G_MMA(1, 0, At, B0); G_MMA(1, 1, At, B1); G_BAR; G_SCHED;
        }
        if (wr == 0) G_BAR;
        cur.oidl = (const LAS int*)(lds + LDS_OID + (ui % 3) * 1024);
        { const int le = lane_id(); E(acc, cur, wr, wc, le & 15, le >> 4); }
        if (!has_next) break;
        if (!nxt.keep) {
#pragma unroll
        for (int a = 0; a < 2; ++a)
#pragma unroll
            for (int b = 0; b < 2; ++b)
#pragma unroll
                for (int m = 0; m < 4; ++m)
#pragma unroll
                    for (int n = 0; n < 2; ++n) acc[a][b][m][n] = (f32x4){0.f, 0.f, 0.f, 0.f};
        }
        cur = nxt; cA = nA; cB = nB; ++ui;
        if constexpr (Sched::DYN) nt = cur.nt;
        if (wr == 1) G_BAR;
    }
    G_WAIT_V(0);
    G_BAR;
#undef G_SA
#undef G_SB
#undef G_STAGE
#undef G_LDA
#undef G_LDB
#undef G_MMA
#undef G_WAIT_V
#undef G_WAIT_L
#undef G_BAR
#undef G_SCHED
#undef G_OFFS
#undef G_IDX_DMA
}
#if FAST_GEMM
#define GEMM_PHASE(K, S, E) gemm_phase<false>(F.lds, F.wave, K, S, E)
#define GEMM_PHASE_F8(K, S, E) gemm_phase<true>(F.lds, F.wave, K, S, E)
#else
#define GEMM_PHASE(K, S, E) gemm_phase_simple(F.wave, K, S, E)
#endif

constexpr int NXCD = 8, WGM = 8;
struct TileOrder {
    int nM, nN, nwg, G, c;
    __device__ void init(int M, int N, int G_, int c_) { nM = M / 256; nN = N / 256; nwg = nM * nN; G = G_; c = c_; }
    __device__ bool tile(int i, int& pm, int& pn) const {
        const long L = (long)i * G + c; if (L >= nwg) return false;
        int wgid = (int)L; { const int q = nwg / NXCD, r = nwg % NXCD, xcd = wgid % NXCD, off = wgid / NXCD; wgid = (xcd < r ? xcd * (q + 1) : r * (q + 1) + (xcd - r) * q) + off; }
        const int nig = WGM * nN, gid = wgid / nig, fm = gid * WGM, gsz = (nM - fm) < WGM ? (nM - fm) : WGM;
        pm = fm + ((wgid % nig) % gsz); pn = (wgid % nig) / gsz; return true;
    }
};
struct SchedDense { static constexpr bool DYN = false;
    TileOrder o; const char* a; const char* b; unsigned apitch, bpitch;
    __device__ bool next(int i, Unit& u) const {
        int pm, pn; if (!o.tile(i, pm, pn)) return false;
        u.a = a; u.b = b + (size_t)pn * 256 * bpitch; u.ridx = nullptr; u.apitch = apitch; u.bpitch = bpitch; u.row0 = pm * 256; u.col0 = pn * 256; u.kind = 0; u.oidx = nullptr; u.keep = 0; return true;
    }
};
struct SchedMerged { static constexpr bool DYN = false;
    TileOrder o; const char* pd; const char* oo; const char* wpe; const char* wba;
    __device__ bool next(int i, Unit& u) const {
        int pm, pn; if (!o.tile(i >> 1, pm, pn)) return false;
        const int part = i & 1;
        u.a = part ? oo : pd; u.apitch = 512; u.b = (part ? wba : wpe) + (size_t)pn * 256 * 512; u.bpitch = 512; u.ridx = nullptr; u.row0 = pm * 256; u.col0 = pn * 256; u.kind = part; u.oidx = nullptr; u.keep = part; return true;
    }
};
struct SchedShared { static constexpr bool DYN = false;
    int G, c; const char* xb8; const char* wsgu;
    __device__ bool next(int i, Unit& u) const {
        const int L = i * G + c; if (L >= 256) return false;
        const int pm = L >> 1, pn = L & 1; u.apitch = 1024; u.bpitch = 1024; u.ridx = nullptr; u.oidx = nullptr; u.keep = 0; u.a = xb8; u.b = wsgu + (size_t)pn * 256 * 1024; u.row0 = pm * 256; u.col0 = pn * 128; u.kind = 0; return true;
    }
};
struct SchedRouter { static constexpr bool DYN = false;
    int G, c; const char* xb; const char* wr;
    __device__ bool next(int i, Unit& u) const {
        const int L = i * G + c; if (L >= 256) return false;
        const int pm = L >> 1, kh = L & 1; u.apitch = 2048; u.bpitch = 2048; u.ridx = nullptr; u.oidx = nullptr; u.keep = 0; u.a = xb + kh * 1024; u.b = wr + kh * 1024; u.row0 = pm * 256; u.col0 = kh; u.kind = 1; return true;
    }
};
struct SchedMoeGU { static constexpr bool DYN = false;
    int G, c, nblk; const char* xb; const char* wegu; const LAS int* blke; const int* tokl;
    __device__ bool next(int i, Unit& u) const {
        const int L = i * G + c; if (L >= 2 * nblk) return false;
        const int rb = L >> 1, pn = L & 1, e = __builtin_amdgcn_readfirstlane(blke[rb]);
        u.a = xb; u.apitch = 1024; u.bpitch = 1024; u.b = wegu + ((size_t)e * 512 + pn * 256) * 1024; u.ridx = tokl + rb * 256; u.row0 = rb * 256; u.col0 = pn * 128; u.kind = e; u.oidx = nullptr; u.keep = 0; return true;
    }
};
struct SchedMoeDownR { static constexpr bool DYN = false;
    int G, c, nblk; const char* hb; const char* wed; const LAS int* blke; const int* tokl;
    __device__ bool next(int i, Unit& u) const {
        const int L = i * G + c; if (L >= 4 * nblk) return false;
        const int rb = L >> 2, pn = L & 3, e = __builtin_amdgcn_readfirstlane(blke[rb]);
        u.apitch = 256; u.bpitch = 256; u.ridx = nullptr; u.a = hb; u.b = wed + ((size_t)e * 1024 + pn * 256) * 256; u.row0 = rb * 256; u.col0 = pn * 256; u.kind = e; u.oidx = tokl + rb * 256; u.keep = 0; return true;
    }
};
struct SchedShDown { static constexpr bool DYN = false;
    int G, c; const char* hs; const char* wsd;
    __device__ bool next(int i, Unit& u) const {
        const int L = i * G + c; if (L >= 512) return false;
        const int pm = L >> 2, pn = L & 3; u.apitch = 512; u.bpitch = 512; u.ridx = nullptr; u.a = hs; u.b = wsd + (size_t)pn * 256 * 512; u.row0 = pm * 256; u.col0 = pn * 256; u.kind = 64; u.oidx = nullptr; u.keep = 0; return true;
    }
};

__device__ __forceinline__ u32x4 pack8(const f32x4& v0, const f32x4& v1) { u32x4 w; w.x = cvt_pk_h16(v0[0], v0[1]); w.y = cvt_pk_h16(v0[2], v0[3]); w.z = cvt_pk_h16(v1[0], v1[1]); w.w = cvt_pk_h16(v1[2], v1[3]); return w; }
__device__ __forceinline__ void unpack8(const u32x4& w, f32x4& v0, f32x4& v1) { v0 = (f32x4){lo16(w.x), hi16(w.x), lo16(w.y), hi16(w.y)}; v1 = (f32x4){lo16(w.z), hi16(w.z), lo16(w.w), hi16(w.w)}; }
__device__ __forceinline__ f32x4 sig4(const f32x4& v) { return (f32x4){sigmoidf_(v[0]), sigmoidf_(v[1]), sigmoidf_(v[2]), sigmoidf_(v[3])}; }
__device__ __forceinline__ f32x4 swiglu4(const f32x4& g, const f32x4& u) { return (f32x4){g[0] * sigmoidf_(g[0]) * u[0], g[1] * sigmoidf_(g[1]) * u[1], g[2] * sigmoidf_(g[2]) * u[2], g[3] * sigmoidf_(g[3]) * u[3]}; }

__device__ __forceinline__ unsigned q8x4(float a, float b, float c, float d, float inv) {
    const unsigned ua = __float_as_uint(a * inv + 12582912.0f), ub = __float_as_uint(b * inv + 12582912.0f), uc = __float_as_uint(c * inv + 12582912.0f), ud = __float_as_uint(d * inv + 12582912.0f);
    const unsigned lo = __builtin_amdgcn_perm(ub, ua, 0x0c0c0400u), hi = __builtin_amdgcn_perm(ud, uc, 0x0c0c0400u);
    return __builtin_amdgcn_perm(hi, lo, 0x05040100u);
}
__device__ __forceinline__ unsigned f8x4(const f32x4 v) {
    int w = __builtin_amdgcn_cvt_pk_fp8_f32(__builtin_amdgcn_fmed3f(v.x, -448.f, 448.f), __builtin_amdgcn_fmed3f(v.y, -448.f, 448.f), 0, false);
    w = __builtin_amdgcn_cvt_pk_fp8_f32(__builtin_amdgcn_fmed3f(v.z, -448.f, 448.f), __builtin_amdgcn_fmed3f(v.w, -448.f, 448.f), w, true); return (unsigned)w; }
struct EpiInProj {
    h16* H; const float* bias; float isc;
    __device__ __forceinline__ void operator()(const ACC_T, const Unit& u, int wr, int wc, int fr, int fq) const {
        const int pn = u.col0 >> 8; const float sc = (pn == 2 || pn == 3) ? 0.125f : 1.f; const bool sg = pn >= 5;
        f32x4 bv[2][2];
#pragma unroll
        for (int bj = 0; bj < 2; ++bj)
#pragma unroll
            for (int n = 0; n < 2; ++n) bv[bj][n] = *(const f32x4*)(bias + u.col0 + 128 * bj + 32 * wc + 8 * fq + 4 * n);
        if (sg) {
            unsigned char* gb = (unsigned char*)H + 336 * MiB + ((size_t)((u.row0 >> 8) * 8 + (pn - 5)) << 16) + (size_t)((wr * 4 + wc) * 8) * 1024 + (size_t)(fq * 16 + fr) * 16;
#pragma unroll
            for (int ai = 0; ai < 2; ++ai)
#pragma unroll
                for (int m = 0; m < 4; ++m) { u32x4 w;
                    { const f32x4 v0 = sig4(acc[ai][0][m][0] * isc + bv[0][0]), v1 = sig4(acc[ai][0][m][1] * isc + bv[0][1]); w.x = q8x4(v0[0], v0[1], v0[2], v0[3], 255.0f); w.y = q8x4(v1[0], v1[1], v1[2], v1[3], 255.0f); }
                    { const f32x4 v0 = sig4(acc[ai][1][m][0] * isc + bv[1][0]), v1 = sig4(acc[ai][1][m][1] * isc + bv[1][1]); w.z = q8x4(v0[0], v0[1], v0[2], v0[3], 255.0f); w.w = q8x4(v1[0], v1[1], v1[2], v1[3], 255.0f); }
                    *(u32x4*)(gb + (ai * 4 + m) * 1024) = w; }
            return;
        }
#pragma unroll
        for (int ai = 0; ai < 2; ++ai)
#pragma unroll
            for (int m = 0; m < 4; ++m) { const int row = u.row0 + 128 * ai + 64 * wr + 16 * m + fr; h16* rowp = H + (size_t)row * DIN + u.col0 + 32 * wc + 8 * fq;
#pragma unroll
                for (int bj = 0; bj < 2; ++bj) { const f32x4 v0 = (acc[ai][bj][m][0] * isc + bv[bj][0]) * sc, v1 = (acc[ai][bj][m][1] * isc + bv[bj][1]) * sc;
                    *(u32x4*)(rowp + 128 * bj) = pack8(v0, v1); } }
    }
};
__device__ __forceinline__ void ungate8(const u32x2& w, f32x4& v0, f32x4& v1) {
    const float k = 1.0f / 255.0f;
    v0 = (f32x4){(float)(w.x & 0xffu) * k, (float)((w.x >> 8) & 0xffu) * k, (float)((w.x >> 16) & 0xffu) * k, (float)(w.x >> 24) * k};
    v1 = (f32x4){(float)(w.y & 0xffu) * k, (float)((w.y >> 8) & 0xffu) * k, (float)((w.y >> 16) & 0xffu) * k, (float)(w.y >> 24) * k};
}
struct EpiMerged {
    unsigned char* MG; const unsigned char* G8; float r01, i1;
    __device__ __forceinline__ void operator()(f32x4 (&acc)[2][2][4][2], const Unit& u, int wr, int wc, int fr, int fq) const {
        const int col = u.col0 + 32 * wc + 8 * fq;
        const unsigned char* gpb = G8 + ((size_t)((u.row0 >> 8) * 8 + (u.col0 >> 8)) << 16) + (size_t)((wr * 4 + wc) * 8) * 1024 + (size_t)(fq * 16 + fr) * 16;
        const unsigned char* gab = gpb + 4 * 65536;
#pragma unroll
        for (int ai = 0; ai < 2; ++ai) {
            u32x4 ga[2][4], gp[2][4];
#pragma unroll
            for (int m = 0; m < 4; ++m) { ga[ai][m] = *(const u32x4*)(gab + (ai * 4 + m) * 1024); if (u.kind == 0) gp[ai][m] = *(const u32x4*)(gpb + (ai * 4 + m) * 1024); }
#pragma unroll
            for (int m = 0; m < 4; ++m) { const int row = u.row0 + 128 * ai + 64 * wr + 16 * m + fr;
#pragma unroll
                for (int bj = 0; bj < 2; ++bj) { f32x4 a0, a1; { u32x2 t; t.x = bj ? ga[ai][m].z : ga[ai][m].x; t.y = bj ? ga[ai][m].w : ga[ai][m].y; ungate8(t, a0, a1); }
                    if (u.kind == 0) { f32x4 p0, p1; { u32x2 t; t.x = bj ? gp[ai][m].z : gp[ai][m].x; t.y = bj ? gp[ai][m].w : gp[ai][m].y; ungate8(t, p0, p1); }
#pragma unroll
                        for (int j = 0; j < 4; ++j) { acc[ai][bj][m][0][j] *= p0[j] * r01 * __builtin_amdgcn_rcpf(fmaxf(a0[j], 6.2e-5f)); acc[ai][bj][m][1][j] *= p1[j] * r01 * __builtin_amdgcn_rcpf(fmaxf(a1[j], 6.2e-5f)); } }
                    else { u32x2 w; w.x = f8x4(acc[ai][bj][m][0] * a0 * i1); w.y = f8x4(acc[ai][bj][m][1] * a1 * i1); *(u32x2*)(MG + (size_t)row * D + col + 128 * bj) = w; } } }
        }
    }
};
struct EpiResid {
    h16* S; const h16* XBp; float isc;
    __device__ __forceinline__ void operator()(const ACC_T, const Unit& u, int wr, int wc, int fr, int fq) const {
#pragma unroll
        for (int ai = 0; ai < 2; ++ai) {
            u32x4 xw[4][2];
#pragma unroll
            for (int m = 0; m < 4; ++m) { const int row = u.row0 + 128 * ai + 64 * wr + 16 * m + fr; const size_t off = (size_t)row * D + u.col0 + 32 * wc + 8 * fq;
#pragma unroll
                for (int bj = 0; bj < 2; ++bj) xw[m][bj] = *(const u32x4*)(XBp + off + 128 * bj); }
#pragma unroll
            for (int m = 0; m < 4; ++m) { const int row = u.row0 + 128 * ai + 64 * wr + 16 * m + fr; const size_t off = (size_t)row * D + u.col0 + 32 * wc + 8 * fq;
#pragma unroll
                for (int bj = 0; bj < 2; ++bj) { f32x4 x0, x1; unpack8(xw[m][bj], x0, x1);
                    *(u32x4*)(S + off + 128 * bj) = pack8(x0 * ALPHA + acc[ai][bj][m][0] * isc, x1 * ALPHA + acc[ai][bj][m][1] * isc); } }
        }
    }
};
struct EpiShared {
    h16* HS; const float* wsc;
    __device__ __forceinline__ void operator()(const ACC_T, const Unit& u, int wr, int wc, int fr, int fq) const {
        const float isg = wsc[0], isu = wsc[1];
#pragma unroll
        for (int ai = 0; ai < 2; ++ai)
#pragma unroll
            for (int m = 0; m < 4; ++m) { const int row = u.row0 + 128 * ai + 64 * wr + 16 * m + fr;
                *(u32x4*)(HS + (size_t)row * FF + u.col0 + 32 * wc + 8 * fq) = pack8(swiglu4(acc[ai][0][m][0] * isg, acc[ai][1][m][0] * isu), swiglu4(acc[ai][0][m][1] * isg, acc[ai][1][m][1] * isu)); }
    }
};
struct EpiRouter {
    float* LG;
    __device__ __forceinline__ void operator()(const ACC_T, const Unit& u, int wr, int wc, int fr, int fq) const {
        if (wc < 2) {
#pragma unroll
        for (int ai = 0; ai < 2; ++ai)
#pragma unroll
            for (int m = 0; m < 4; ++m) { const int row = u.row0 + 128 * ai + 64 * wr + 16 * m + fr;
#pragma unroll
                for (int n = 0; n < 2; ++n) *(f32x4*)(LG + (size_t)u.col0 * T * NE + (size_t)row * NE + 32 * wc + 8 * fq + 4 * n) = acc[ai][0][m][n] + acc[ai][1][m][n]; } }
    }
};
struct EpiMoeGU {
    unsigned char* HB; const float* wsc;
    __device__ __forceinline__ void operator()(const ACC_T, const Unit& u, int wr, int wc, int fr, int fq) const {
        const float isg = wsc[4 * u.kind], isu = wsc[4 * u.kind + 1], hsc = 1.52587890625e-05f / (isg * isu);
#pragma unroll
        for (int ai = 0; ai < 2; ++ai)
#pragma unroll
            for (int m = 0; m < 4; ++m) { const int row = u.row0 + 128 * ai + 64 * wr + 16 * m + fr;
                u32x2 w; w.x = f8x4(swiglu4(acc[ai][0][m][0] * isg, acc[ai][1][m][0] * isu) * hsc); w.y = f8x4(swiglu4(acc[ai][0][m][1] * isg, acc[ai][1][m][1] * isu) * hsc);
                *(u32x2*)(HB + (size_t)row * FF + u.col0 + 32 * wc + 8 * fq) = w; }
    }
};
template <bool ROUTED> struct EpiMoeDown {
    unsigned char* YQ; h16* YS;
    __device__ __forceinline__ void operator()(const ACC_T, const Unit& u, int wr, int wc, int fr, int fq) const {
        const int grp = (u.col0 >> 8) * 16 + 4 * wc + fq;
#pragma unroll
        for (int ai = 0; ai < 2; ++ai)
#pragma unroll
            for (int m = 0; m < 4; ++m) {
                const int r = 128 * ai + 64 * wr + 16 * m + fr; int id; if constexpr (ROUTED) id = u.oidl[r]; else id = (u.row0 + r) * 9 + 8;
                const f32x4 v0 = acc[ai][0][m][0], v1 = acc[ai][0][m][1], v2 = acc[ai][1][m][0], v3 = acc[ai][1][m][1];
                if constexpr (ROUTED) { u32x4 w; w.x = f8x4(v0 * 0.015625f); w.y = f8x4(v1 * 0.015625f); w.z = f8x4(v2 * 0.015625f); w.w = f8x4(v3 * 0.015625f);
                    *(u32x4*)(YQ + (size_t)id * 1024 + grp * 16) = w; }
                else {
                float mx = fmaxf(fmaxf(fabsf(v0[0]), fabsf(v0[1])), fmaxf(fabsf(v0[2]), fabsf(v0[3])));
                mx = fmaxf(mx, fmaxf(fmaxf(fabsf(v1[0]), fabsf(v1[1])), fmaxf(fabsf(v1[2]), fabsf(v1[3]))));
                mx = fmaxf(mx, fmaxf(fmaxf(fabsf(v2[0]), fabsf(v2[1])), fmaxf(fabsf(v2[2]), fabsf(v2[3]))));
                mx = fmaxf(mx, fmaxf(fmaxf(fabsf(v3[0]), fabsf(v3[1])), fmaxf(fabsf(v3[2]), fabsf(v3[3]))));
                const unsigned short sh = f2h(mx * (1.0f / 127.0f) * 1.0005f);
                const float scr = h2f(sh); const float inv = scr > 0.f ? __builtin_amdgcn_rcpf(scr) : 0.f;
                u32x4 w; w.x = q8x4(v0[0], v0[1], v0[2], v0[3], inv); w.y = q8x4(v1[0], v1[1], v1[2], v1[3], inv); w.z = q8x4(v2[0], v2[1], v2[2], v2[3], inv); w.w = q8x4(v3[0], v3[1], v3[2], v3[3], inv);
                *(u32x4*)(YQ + (size_t)id * 1024 + grp * 16) = w;
                *(unsigned short*)(YS + (size_t)id * 64 + grp) = sh; } }
    }
};

struct Args { const float* in[23]; float* out; unsigned char* ws; int ph_lo, ph_hi; };
struct Frame {
    LAS unsigned char* lds; int wave, vcu, G, gw, NGW;
};

__device__ __forceinline__ void ln_store(f32x4 (&v)[4], const float* gam, const float* bet, float* o32, h16* o16, int lane) {
    float s = 0.f;
#pragma unroll
    for (int j = 0; j < 4; ++j) s += (v[j].x + v[j].y) + (v[j].z + v[j].w);
    const float mean = wave_sum(s) * (1.f / D); float s2 = 0.f;
#pragma unroll
    for (int j = 0; j < 4; ++j) { v[j] = v[j] - mean; s2 += (v[j].x * v[j].x + v[j].y * v[j].y) + (v[j].z * v[j].z + v[j].w * v[j].w); }
    const float rstd = 1.f / sqrtf(wave_sum(s2) * (1.f / D) + LN_EPS);
#pragma unroll
    for (int j = 0; j < 4; ++j) { const f32x4 g = *(const f32x4*)(gam + 4 * lane + 256 * j), b = *(const f32x4*)(bet + 4 * lane + 256 * j); const f32x4 y = v[j] * rstd * g + b;
        *(f32x4*)(o32 + 4 * lane + 256 * j) = y; u32x2 w; w.x = cvt_pk_h16(y[0], y[1]); w.y = cvt_pk_h16(y[2], y[3]); *(u32x2*)(o16 + 4 * lane + 256 * j) = w; }
}


__device__ __forceinline__ void ln_store8(f32x4 (&v)[4], const float* gam, const float* bet, float* o32, h16* o16, int lane, int c0 = -1, int c1 = -1, unsigned char* o8 = nullptr) {
    if (c0 < 0) { c0 = 8 * lane; c1 = 512 + 8 * lane; }
    float s = 0.f;
#pragma unroll
    for (int j = 0; j < 4; ++j) s += (v[j].x + v[j].y) + (v[j].z + v[j].w);
    const float mean = wave_sum(s) * (1.f / D); float s2 = 0.f;
#pragma unroll
    for (int j = 0; j < 4; ++j) { v[j] = v[j] - mean; s2 += (v[j].x * v[j].x + v[j].y * v[j].y) + (v[j].z * v[j].z + v[j].w * v[j].w); }
    const float rstd = 1.f / sqrtf(wave_sum(s2) * (1.f / D) + LN_EPS);
    f32x4 y[4];
#pragma unroll
    for (int j = 0; j < 4; ++j) { const int c = ((j >> 1) ? c1 : c0) + 4 * (j & 1); const f32x4 g = *(const f32x4*)(gam + c), b = *(const f32x4*)(bet + c); y[j] = v[j] * rstd * g + b; if (o32) *(f32x4*)(o32 + c) = y[j]; }
    *(u32x4*)(o16 + c0) = pack8(y[0], y[1]); *(u32x4*)(o16 + c1) = pack8(y[2], y[3]);
    if (o8) { u32x2 w; w.x = f8x4(y[0]); w.y = f8x4(y[1]); *(u32x2*)(o8 + c0) = w; w.x = f8x4(y[2]); w.y = f8x4(y[3]); *(u32x2*)(o8 + c1) = w; }
}
__device__ __forceinline__ void ln_store8r(f32x4 (&v)[4], const f32x4 (&g)[4], const f32x4 (&b)[4], float* o32, h16* o16, int c0, int c1, unsigned char* o8) {
    float s = 0.f;
#pragma unroll
    for (int j = 0; j < 4; ++j) s += (v[j].x + v[j].y) + (v[j].z + v[j].w);
    const float mean = wave_sum(s) * (1.f / D); float s2 = 0.f;
#pragma unroll
    for (int j = 0; j < 4; ++j) { v[j] = v[j] - mean; s2 += (v[j].x * v[j].x + v[j].y * v[j].y) + (v[j].z * v[j].z + v[j].w * v[j].w); }
    const float rstd = 1.f / sqrtf(wave_sum(s2) * (1.f / D) + LN_EPS);
    f32x4 y[4];
#pragma unroll
    for (int j = 0; j < 4; ++j) { const int c = ((j >> 1) ? c1 : c0) + 4 * (j & 1); y[j] = v[j] * rstd * g[j] + b[j]; if (o32) *(f32x4*)(o32 + c) = y[j]; }
    *(u32x4*)(o16 + c0) = pack8(y[0], y[1]); *(u32x4*)(o16 + c1) = pack8(y[2], y[3]);
    { u32x2 w; w.x = f8x4(y[0]); w.y = f8x4(y[1]); *(u32x2*)(o8 + c0) = w; w.x = f8x4(y[2]); w.y = f8x4(y[3]); *(u32x2*)(o8 + c1) = w; }
}
__device__ __forceinline__ void ln_store8l(f32x4 (&v)[4], const LAS float* lg, const LAS float* lb, float* o32, h16* o16, int c0, int c1, unsigned char* o8) {
    f32x4 g[4], b[4];
#pragma unroll
    for (int j = 0; j < 4; ++j) { const int c = ((j >> 1) ? c1 : c0) + 4 * (j & 1); g[j] = *(const LAS f32x4*)(lg + c); b[j] = *(const LAS f32x4*)(lb + c); }
    ln_store8r(v, g, b, o32, o16, c0, c1, o8);
}
#define LN_GB(gam, bet, c0, c1) f32x4 lg_[4], lb_[4]; _Pragma("unroll") for (int j = 0; j < 4; ++j) { const int c = ((j >> 1) ? (c1) : (c0)) + 4 * (j & 1); lg_[j] = *(const f32x4*)((gam) + c); lb_[j] = *(const f32x4*)((bet) + c); }
__device__ __forceinline__ void tr_item(const float* W, int N, h16* WT, int ldt, int k0, int n0, int drow0, LAS float* scr, int lane) {
    float tv[32];
#pragma unroll
    for (int i = 0; i < 32; ++i) { const int kk = 2 * i + (lane >> 5); tv[i] = __builtin_nontemporal_load(W + (size_t)(k0 + kk) * N + n0 + (lane & 31)); }
#pragma unroll
    for (int i = 0; i < 32; ++i) { const int kk = 2 * i + (lane >> 5); scr[kk * 33 + (lane & 31)] = tv[i]; }
    asm volatile("s_waitcnt lgkmcnt(0)" ::: "memory");
    const int c = lane & 7;
#pragma unroll
    for (int j = 0; j < 4; ++j) { const int n = (lane >> 3) + 8 * j; const LAS float* s = scr + (8 * c) * 33 + n;
        u32x4 o; o.x = cvt_pk_h16(s[0 * 33], s[1 * 33]); o.y = cvt_pk_h16(s[2 * 33], s[3 * 33]); o.z = cvt_pk_h16(s[4 * 33], s[5 * 33]); o.w = cvt_pk_h16(s[6 * 33], s[7 * 33]);
        *(u32x4*)(WT + (size_t)(drow0 + n) * ldt + k0 + 8 * c) = o; }
    asm volatile("s_waitcnt lgkmcnt(0)" ::: "memory");
}
__device__ __forceinline__ void tr_item_f8(const float* W, int N, unsigned char* WT, int ldt, int k0, int n0, int drow0, LAS float* scr, int lane, float scale) {
    float tv[32];
#pragma unroll
    for (int i = 0; i < 32; ++i) { const int kk = 2 * i + (lane >> 5); tv[i] = __builtin_nontemporal_load(W + (size_t)(k0 + kk) * N + n0 + (lane & 31)); }
#pragma unroll
    for (int i = 0; i < 32; ++i) { const int kk = 2 * i + (lane >> 5); scr[kk * 33 + (lane & 31)] = tv[i]; }
    asm volatile("s_waitcnt lgkmcnt(0)" ::: "memory");
    const int c = lane & 7;
#pragma unroll
    for (int j = 0; j < 4; ++j) { const int n = (lane >> 3) + 8 * j; const LAS float* s = scr + (8 * c) * 33 + n;
        u32x2 o; o.x = f8x4((f32x4){s[0 * 33], s[1 * 33], s[2 * 33], s[3 * 33]} * scale); o.y = f8x4((f32x4){s[4 * 33], s[5 * 33], s[6 * 33], s[7 * 33]} * scale);
        *(u32x2*)(WT + (size_t)(drow0 + n) * ldt + k0 + 8 * c) = o; }
    asm volatile("s_waitcnt lgkmcnt(0)" ::: "memory");
}
__device__ __forceinline__ float f8_scale_of(const float* W, int lane) {
    const f32x4 q = *(const f32x4*)(W + 4 * lane); const float ma = wave_sum((fabsf(q.x) + fabsf(q.y)) + (fabsf(q.z) + fabsf(q.w))) * (1.2533f / 256.f);
    float t = 32.f / fmaxf(ma, 1e-30f); t = fminf(fmaxf(t, 1.0e-18f), 1.0e18f);
    return __uint_as_float(__builtin_amdgcn_readfirstlane(__float_as_uint(t)) & 0x7f800000u);
}
__device__ __forceinline__ void tr_item_hilo(const float* W, int N, h16* WT, int ldt, int k0, int n0, LAS float* scr, int lane) {
    float tv[32];
#pragma unroll
    for (int i = 0; i < 32; ++i) { const int kk = 2 * i + (lane >> 5); tv[i] = __builtin_nontemporal_load(W + (size_t)(k0 + kk) * N + n0 + (lane & 31)); }
#pragma unroll
    for (int i = 0; i < 32; ++i) { const int kk = 2 * i + (lane >> 5); scr[kk * 33 + (lane & 31)] = tv[i]; }
    asm volatile("s_waitcnt lgkmcnt(0)" ::: "memory");
    const int c = lane & 7;
#pragma unroll
    for (int j = 0; j < 4; ++j) { const int n = (lane >> 3) + 8 * j; const LAS float* s = scr + (8 * c) * 33 + n;
        float v[8], r[8];
#pragma unroll
        for (int q = 0; q < 8; ++q) { v[q] = s[q * 33]; r[q] = v[q] - h2f(f2h(v[q])); }
        u32x4 o; o.x = cvt_pk_h16(v[0], v[1]); o.y = cvt_pk_h16(v[2], v[3]); o.z = cvt_pk_h16(v[4], v[5]); o.w = cvt_pk_h16(v[6], v[7]);
        *(u32x4*)(WT + (size_t)(n0 + n) * ldt + k0 + 8 * c) = o;
        o.x = cvt_pk_h16(r[0], r[1]); o.y = cvt_pk_h16(r[2], r[3]); o.z = cvt_pk_h16(r[4], r[5]); o.w = cvt_pk_h16(r[6], r[7]);
        *(u32x4*)(WT + (size_t)(128 + n0 + n) * ldt + k0 + 8 * c) = o; }
    asm volatile("s_waitcnt lgkmcnt(0)" ::: "memory");
}


typedef float f32x16 __attribute__((ext_vector_type(16)));
constexpr int AT_KP = 144, AT_VP = 520, AT_VOFF = 256 * AT_KP;
__device__ __forceinline__ int crow(int r, int hi) { return (r & 3) + 8 * (r >> 2) + 4 * hi; }
struct KVRegs { u32x4 k[4], v[4]; };
__device__ __forceinline__ void attn_load_kv(const h16* HHp, const int b, const int n, const int hk, const int tid, KVRegs& r) {
    const int tb = b * SEQ + n * 128;
#pragma unroll
    for (int i = 0; i < 4; ++i) { const int idx = tid + 512 * i, key = idx >> 3, ch = idx & 7; const int tok = (n > 0) ? tb - 128 + key : tb + (key & 127);
        const h16* kp = HHp + (size_t)tok * DIN + C_K + hk * 64 + ch * 8; r.k[i] = *(const u32x4*)kp; r.v[i] = *(const u32x4*)(kp + 128); }
}
__device__ __forceinline__ void attn_unit(LAS unsigned char* lds, h16* HHp, unsigned char* OUTp, const float osc, const float* sinks, const int b, const int n, const int hk, const int tid,
                                          const int unused_ = 0) {
    const int lane = tid & 63, wid = __builtin_amdgcn_readfirstlane(tid >> 6), q32 = lane & 31, hi = lane >> 5;
    const int g = wid >> 1, qh = wid & 1, hq = hk * 4 + g;
    const int tb = b * SEQ + n * 128;
    LAS unsigned char* Ks = lds; LAS unsigned char* Vs = lds + AT_VOFF;
    KVRegs cur; attn_load_kv(HHp, b, n, hk, tid, cur);
    f16x8 qs[4];
    { const h16* qp = HHp + (size_t)(tb + 64 * qh + q32) * DIN + C_Q + hq * 64;
#pragma unroll
      for (int ks = 0; ks < 4; ++ks) qs[ks] = *(const f16x8*)(qp + 16 * ks + 8 * hi); }
#pragma unroll
    for (int i = 0; i < 4; ++i) { const int idx = tid + 512 * i, key = idx >> 3, ch = idx & 7; const u32x4 kw = cur.k[i], vw = cur.v[i];
        *(LAS u32x4*)(Ks + key * AT_KP + ch * 16) = kw;
        LAS unsigned short* vd = (LAS unsigned short*)(Vs + (ch * 8) * AT_VP + key * 2);
        vd[0 * (AT_VP / 2)] = (unsigned short)(vw.x & 0xffffu); vd[1 * (AT_VP / 2)] = (unsigned short)(vw.x >> 16); vd[2 * (AT_VP / 2)] = (unsigned short)(vw.y & 0xffffu); vd[3 * (AT_VP / 2)] = (unsigned short)(vw.y >> 16);
        vd[4 * (AT_VP / 2)] = (unsigned short)(vw.z & 0xffffu); vd[5 * (AT_VP / 2)] = (unsigned short)(vw.z >> 16); vd[6 * (AT_VP / 2)] = (unsigned short)(vw.w & 0xffffu); vd[7 * (AT_VP / 2)] = (unsigned short)(vw.w >> 16); }
    __syncthreads();
    const float slope = exp2f(-(float)(hq + 1)), sink = sinks[hq];
    float ab[16];
#pragma unroll
    for (int r = 0; r < 16; ++r) ab[r] = slope * (float)(crow(r, hi) - 128 - q32);
#pragma unroll 1
    for (int sub = 0; sub < 2; ++sub) {
        const int q0 = 64 * qh + 32 * sub, qi = q0 + q32;
        f32x16 sv[5]; float mx = -INFINITY;
#pragma unroll
        for (int j = 0; j < 5; ++j) { const int key0 = q0 + 32 * j; f32x16 c; float sl = slope; asm volatile("" : "+v"(sl)); const float aj = sl * (float)(32 * j);
#pragma unroll
            for (int r = 0; r < 16; ++r) c[r] = ab[r] + aj;
#pragma unroll
            for (int ks = 0; ks < 4; ++ks) { const f16x8 kf = *(const LAS f16x8*)(Ks + (key0 + q32) * AT_KP + (16 * ks + 8 * hi) * 2); c = __builtin_amdgcn_mfma_f32_32x32x16_f16(kf, qs[ks], c, 0, 0, 0); }
            const bool dead = (n == 0) && (key0 < 128);
            int hil = hi; asm volatile("" : "+v"(hil));
#pragma unroll
            for (int r = 0; r < 16; ++r) { float v = c[r];
                if (j == 0) v = (crow(r, hil) > q32) ? v : -INFINITY;
                if (j == 4) v = (crow(r, hil) <= q32) ? v : -INFINITY;
                if (dead) v = -INFINITY;
                c[r] = v; mx = fmaxf(mx, v); }
            sv[j] = c; __builtin_amdgcn_sched_barrier(0); }
        if (sub == 0) { const h16* qp = HHp + (size_t)(tb + 64 * qh + 32 + q32) * DIN + C_Q + hq * 64;
#pragma unroll
            for (int ks = 0; ks < 4; ++ks) qs[ks] = *(const f16x8*)(qp + 16 * ks + 8 * hi); }
        mx = fmaxf(mx, dppf_swap32(mx)); mx = fmaxf(mx, sink);
        float lsum = 0.f; f32x16 o0, o1;
#pragma unroll
        for (int r = 0; r < 16; ++r) { o0[r] = 0.f; o1[r] = 0.f; }
#pragma unroll
        for (int j = 0; j < 5; ++j) { const int key0 = q0 + 32 * j;
#pragma unroll
            for (int r = 0; r < 16; ++r) { const float pv = __expf(sv[j][r] - mx); sv[j][r] = pv; lsum += pv; }
#pragma unroll
            for (int cc = 0; cc < 2; ++cc) {
                u32x4 pw; pw.x = cvt_pk_h16(sv[j][8 * cc + 0], sv[j][8 * cc + 1]); pw.y = cvt_pk_h16(sv[j][8 * cc + 2], sv[j][8 * cc + 3]); pw.z = cvt_pk_h16(sv[j][8 * cc + 4], sv[j][8 * cc + 5]); pw.w = cvt_pk_h16(sv[j][8 * cc + 6], sv[j][8 * cc + 7]);
                const f16x8 pb = __builtin_bit_cast(f16x8, pw);
                const LAS unsigned char* vp = Vs + q32 * AT_VP + (key0 + 16 * cc + 4 * hi) * 2;
                { const u32x2 a0 = *(const LAS u32x2*)vp, a1 = *(const LAS u32x2*)(vp + 16); const u32x4 vw = {a0.x, a0.y, a1.x, a1.y}; o0 = __builtin_amdgcn_mfma_f32_32x32x16_f16(__builtin_bit_cast(f16x8, vw), pb, o0, 0, 0, 0); }
                { const u32x2 a0 = *(const LAS u32x2*)(vp + 32 * AT_VP), a1 = *(const LAS u32x2*)(vp + 32 * AT_VP + 16); const u32x4 vw = {a0.x, a0.y, a1.x, a1.y}; o1 = __builtin_amdgcn_mfma_f32_32x32x16_f16(__builtin_bit_cast(f16x8, vw), pb, o1, 0, 0, 0); }
                __builtin_amdgcn_sched_barrier(0);
            } }
        lsum += dppf_swap32(lsum); lsum += __expf(sink - mx);
        const float rl = 1.0f / lsum;
#pragma unroll
        for (int rg = 0; rg < 4; ++rg) {
            const float ro = rl * osc;
            unsigned char* op = OUTp + (size_t)(tb + qi) * 512 + hq * 64;
            *(unsigned*)(op + 8 * rg + 4 * hi) = f8x4((f32x4){o0[4 * rg], o0[4 * rg + 1], o0[4 * rg + 2], o0[4 * rg + 3]} * ro);
            *(unsigned*)(op + 32 + 8 * rg + 4 * hi) = f8x4((f32x4){o1[4 * rg], o1[4 * rg + 1], o1[4 * rg + 2], o1[4 * rg + 3]} * ro); }
    }
    __syncthreads();
}
template <int W> __device__ __forceinline__ void pool_run(const h16* HHp, unsigned char* PDp, const float psc, const int c8, const int t0) {
    const int s0 = t0 & (SEQ - 1); const bool head = (s0 == 0);
    const h16* up = HHp + (size_t)t0 * DIN + C_U + c8 * 8;
    u32x4 q[W + 15];
#pragma unroll
    for (int j = 0; j < W + 15; ++j) { const int jj = j - (W - 1); const int off = (jj < 0 && head) ? 0 : jj; q[j] = *(const u32x4*)(up + (ptrdiff_t)off * DIN); }
    f32x4 a0 = {0.f, 0.f, 0.f, 0.f}, a1 = {0.f, 0.f, 0.f, 0.f};
#pragma unroll
    for (int j = 0; j < W - 1; ++j) { f32x4 v0, v1; unpack8(q[j], v0, v1); if (!head) { a0 += v0; a1 += v1; } }
#pragma unroll
    for (int o = 0; o < 16; ++o) {
        f32x4 u0, u1; unpack8(q[W - 1 + o], u0, u1); a0 += u0; a1 += u1;
        if (o >= 1) { f32x4 v0, v1; unpack8(q[o - 1], v0, v1); if (!head || o >= W) { a0 -= v0; a1 -= v1; } }
        const float rn = (head && o + 1 < W) ? 1.0f / (float)(o + 1) : 1.0f / (float)W;
        u32x2 w; w.x = f8x4((a0 * rn - u0) * psc); w.y = f8x4((a1 * rn - u1) * psc); *(u32x2*)(PDp + (size_t)(t0 + o) * 512 + c8 * 8) = w; }
}


__device__ __forceinline__ void prep_expert_items(const float* w_eg, const float* w_eu, const float* w_ed, unsigned char* egu_t, unsigned char* ed_t, float* wsc, int e_lo, int e_hi, int wrk, int nwrk, LAS float* scr, int lane) {
    for (int it = e_lo + wrk; it < e_hi; it += nwrk) {
        if (it < 2 * 8192) { const int up = it >> 13, q = it & 8191, e = q >> 7, q2 = q & 127, kb = q2 >> 3, nb = q2 & 7, n0 = 32 * nb;
            const float* Wm = (up ? w_eu : w_eg) + (size_t)e * D * FF; const float sc = f8_scale_of(Wm, lane); if (q2 == 0 && lane == 0) wsc[4 * e + up] = 1.0f / sc;
            tr_item_f8(Wm, FF, egu_t + (size_t)e * 512 * 1024, 1024, 64 * kb, n0, 256 * (n0 >> 7) + (n0 & 127) + 128 * up, scr, lane, sc); }
        else { const int r = it - 2 * 8192, e = r >> 7, q2 = r & 127, kb = q2 >> 5, nb = q2 & 31; const float* Wm = w_ed + (size_t)e * FF * D; const float sc = f8_scale_of(Wm, lane); if (q2 == 0 && lane == 0) wsc[4 * e + 2] = 1.0f / sc;
            tr_item_f8(Wm, D, ed_t + (size_t)e * 1024 * 256, 256, 64 * kb, 32 * nb, 32 * nb, scr, lane, sc); }
    }
}
#define W_EGU_P(lt) ((unsigned char*)(args.ws + (((lt) & 1) ? W_EGU_ALT : W_EGU_T)))
#define WSC_P(lt) ((float*)(args.ws + MS_WSC) + ((lt) & 1) * 256)
#define W_ED_P(lt)  ((unsigned char*)(args.ws + (((lt) & 1) ? W_ED_ALT : W_ED_T)))
#define PREP_EXPERTS(lt, e_lo, e_hi, wrk, nwrk) prep_expert_items(args.in[15] + (size_t)(lt) * NE * D * FF, args.in[16] + (size_t)(lt) * NE * D * FF, args.in[17] + (size_t)(lt) * NE * FF * D, W_EGU_P(lt), W_ED_P(lt), WSC_P(lt), e_lo, e_hi, wrk, nwrk, (LAS float*)(F.lds + F.wave * 16384), lane_id())
#ifndef P9_IPW
#define P9_IPW 5
#endif
#ifndef P10_IPW
#define P10_IPW 3
#endif
constexpr int PE_A = 9830, PE_B = PE_A + 8602, PE_ALL = 3 * 8192;
#define PREP_WEIGHTS(E_LO) do { \
            LAS float* scr = (LAS float*)(F.lds + F.wave * 16384); \
            const float* w_in = L_W_IN; const float* w_br_attn = L_W_BRA; const float* w_out = L_W_OUT; const float* w_sg = L_W_SG; const float* w_su = L_W_SU; const float* w_sd = L_W_SD; \
            const float* w_eg = L_W_EG; const float* w_eu = L_W_EU; const float* w_ed = L_W_ED; const float* w_router = L_W_R; \
            constexpr int I_IN = 16 * 104, I_BA = 8 * 32, I_OUT = 16 * 32, I_SG = 16 * 8, I_SD = 4 * 32, I_EG = 64 * 128, I_ED = 64 * 128, I_R = 16 * 2; \
            constexpr int NITEMS = I_IN + I_BA + I_OUT + 2 * I_SG + I_SD + I_R; \
            for (int it = F.gw; it < NITEMS; it += F.NGW) { \
                int r = it; \
                if (r < I_IN) { const int kb = r / 104, nb = r % 104; const float sc = f8_scale_of(w_in, lane); if (r == 0 && lane == 0) *WSC_IN = 1.0f / sc; tr_item_f8(w_in, DIN, (unsigned char*)(args.ws + W_IN_T), 1024, 64 * kb, 32 * nb, 32 * nb, scr, lane, sc); continue; } r -= I_IN; \
                if (r < I_BA) { const int kb = r / 32, nb = r % 32; tr_item_f8(w_br_attn, D, (unsigned char*)(args.ws + W_BA_T), 512, 64 * kb, 32 * nb, 32 * nb, scr, lane, f8_scale_of(w_br_attn, lane)); continue; } r -= I_BA; \
                if (r < I_OUT) { const int kb = r / 32, nb = r % 32; const float sc = f8_scale_of(w_out, lane); if (r == 0 && lane == 0) WSC_IN[1] = 1.0f / sc; tr_item_f8(w_out, D, (unsigned char*)(args.ws + W_OUT_T), 1024, 64 * kb, 32 * nb, 32 * nb, scr, lane, sc); continue; } r -= I_OUT; \
                if (r < 2 * I_SG) { const int up = r / I_SG, q = r % I_SG, kb = q / 8, nb = q % 8, n0 = 32 * nb; const float sc = f8_scale_of(up ? w_su : w_sg, lane); if (q == 0 && lane == 0) WSC_IN[6 + up] = 1.0f / sc; tr_item_f8(up ? w_su : w_sg, FF, (unsigned char*)(args.ws + W_SGU_T), 1024, 64 * kb, n0, 256 * (n0 >> 7) + (n0 & 127) + 128 * up, scr, lane, sc); continue; } r -= 2 * I_SG; \
                if (r < I_SD) { const int kb = r / 32, nb = r % 32; tr_item(w_sd, D, (h16*)(args.ws + W_SD_T), 256, 64 * kb, 32 * nb, 32 * nb, scr, lane); continue; } r -= I_SD; \
                { const int kb = r / 2, nb = r % 2; tr_item_hilo(w_router, NE, (h16*)(args.ws + W_R_T), 1024, 64 * kb, 32 * nb, scr, lane); } \
            } \
            PREP_EXPERTS(l, (E_LO), PE_ALL, F.gw, F.NGW); \
            { unsigned char* wpe = (unsigned char*)(args.ws + W_PE_T); const float* w_pool = L_W_POOL; const float* pool_scale = L_PSCALE; const float* w_br_pool = L_W_BRP; \
                \
              const float sc_pe = f8_scale_of(w_pool, lane) * f8_scale_of(w_br_pool, lane) * (1.0f / 512.0f), sc_ba = f8_scale_of(w_br_attn, lane), sc_i = f8_scale_of(w_in, lane); \
              if (F.gw == 0 && lane == 0) { float psc = sc_i * (1.0f / 256.0f); asm volatile("" : "+v"(psc)); const float osc = psc * 4.0f; WSC_IN[2] = psc; WSC_IN[3] = osc; WSC_IN[4] = (osc * sc_ba) / (psc * sc_pe); WSC_IN[5] = 16.0f / (osc * sc_ba); } \
              for (int idx = F.gw; idx < 512 * 16; idx += F.NGW) { const int cg = idx >> 4, n = ((idx & 15) << 6) + lane, g = cg >> 7; float s = 0.f; \
                  const float* wp = w_pool + (size_t)cg * 128; const float* ps = pool_scale + 128 * g; const float* wb = w_br_pool + (size_t)(128 * g) * D + n; \
                  float wv[128]; \
            _Pragma("unroll") \
                  for (int d = 0; d < 128; ++d) wv[d] = wb[(size_t)d * D]; \
            _Pragma("unroll") \
                  for (int d = 0; d < 128; ++d) s += wp[d] * ps[d] * wv[d]; \
                  wpe[(size_t)n * 512 + cg] = (unsigned char)(f8x4((f32x4){s, s, s, s} * sc_pe) & 0xffu); } } \
} while (0)
#define X32   (args.out)
#define XB    ((h16*)(args.ws + WS_XB))
#define XB8   ((unsigned char*)(args.ws + W_XB8))
#define WSC_IN ((float*)(args.ws + MS_WSC) + 512)
#define HH    ((h16*)(args.ws + R_HH))
#define PD8   ((unsigned char*)(args.ws + R_PD))
#define O8    ((unsigned char*)(args.ws + R_PD + 16 * MiB))
#define MG    ((h16*)(args.ws + R_MG))
#define G8B   ((unsigned char*)(args.ws + WS_R + 336 * MiB))
#define HB    ((h16*)(args.ws + WS_HB))
#define HS    ((h16*)(args.ws + WS_HS))
#define YD    ((h16*)(args.ws + WS_R))
#define LOGIT ((float*)(args.ws + WS_HB))
#define ESEL  ((int*)(args.ws + MS_ESEL))
#define GATE  ((float*)(args.ws + MS_GATE))
#define RANKL ((int*)(args.ws + MS_RANK))
#define SLOT  ((int*)(args.ws + MS_SLOT))
#define TOKL  ((int*)(args.ws + MS_TOKL))
#define GATL  ((float*)(args.ws + MS_GATL))
#define WCNT  ((int*)(args.ws + MS_WCNT))
#define GTOT  ((int*)(args.ws + MS_GTOT))
#define BLKE  ((int*)(args.ws + MS_BLKE))
#define L_W_IN   (args.in[3] + (size_t)l * D * DIN)
#define L_B_IN   (args.in[4] + (size_t)l * DIN)
#define L_W_POOL (args.in[5] + (size_t)l * 4 * 128 * 128)
#define L_PSCALE (args.in[6] + (size_t)l * 512)
#define L_SINKS  (args.in[7] + (size_t)l * 8)
#define L_W_BRP  (args.in[8] + (size_t)l * 512 * D)
#define L_W_BRA  (args.in[9] + (size_t)l * 512 * D)
#define L_W_OUT  (args.in[10] + (size_t)l * D * D)
#define L_LN1G   (args.in[11] + (size_t)l * D)
#define L_LN1B   (args.in[12] + (size_t)l * D)
#define L_W_R    (args.in[13] + (size_t)l * D * NE)
#define L_RBIAS  (args.in[14] + (size_t)l * NE)
#define L_W_EG   (args.in[15] + (size_t)l * NE * D * FF)
#define L_W_EU   (args.in[16] + (size_t)l * NE * D * FF)
#define L_W_ED   (args.in[17] + (size_t)l * NE * FF * D)
#define L_W_SG   (args.in[18] + (size_t)l * D * FF)
#define L_W_SU   (args.in[19] + (size_t)l * D * FF)
#define L_W_SD   (args.in[20] + (size_t)l * FF * D)
#define L_LN2G   (args.in[21] + (size_t)l * D)
#define L_LN2B   (args.in[22] + (size_t)l * D)
__global__ void __launch_bounds__(512, 2) fwd_kernel(Args args) {
    extern __shared__ __attribute__((aligned(16))) unsigned char lds_raw[];
    Frame F;
    F.lds = (LAS unsigned char*)lds_raw;
    F.wave = __builtin_amdgcn_readfirstlane((int)threadIdx.x >> 6);
    F.G = gridDim.x; { const int bx = blockIdx.x; F.vcu = (F.G % 8 == 0) ? (bx % 8) * (F.G / 8) + bx / 8 : bx; }
    F.gw = F.vcu * 8 + F.wave; F.NGW = F.G * 8;
    unsigned* ctl = (unsigned*)(args.ws + WS_CTL);
    volatile LAS unsigned* MISC = (volatile LAS unsigned*)(F.lds + MISC_OFF);
    for (int u = threadIdx.x; u < (LDS_BYTES - LDSCTL_OFF) / 4; u += 512) ((LAS unsigned*)(F.lds + LDSCTL_OFF))[u] = 0u;
    __syncthreads();
#if MK_ONE_LAUNCH
    XcdBarrier bar = xcd_barrier_post(ctl + CW_BAR, MISC + 8);
#define GRID_BAR() xcd_barrier(bar, F.wave)
#else
#define GRID_BAR() do {} while (0)
#endif
    const int lo = args.ph_lo, hi = args.ph_hi;
#ifndef PHASE_MASK
#define PHASE_MASK 0xfff
#endif
#ifndef REPEAT_MASK
#define REPEAT_MASK 0
#endif
#define REPS(p) for (int rep_ = 0; rep_ < 1 + ((REPEAT_MASK >> (p)) & 1); ++rep_)
#define IN(p) (((PHASE_MASK >> ((p) - pb)) & 1) && lo <= (p) && (p) < hi)
#define PHASE_REGS const int lane = lane_id(); const int tid = F.wave * 64 + lane; int vcu = F.vcu, bx = (int)blockIdx.x; asm volatile("" : "+s"(vcu), "+s"(bx)); (void)lane; (void)tid; (void)vcu; (void)bx;

    for (int l = 0; l < DEPTH; ++l) {
        const int pb = l * NPH;
        if (IN(pb + 0) && l == 0) {
            PHASE_REGS
            PREP_WEIGHTS(0);
            LN_GB(args.in[1], args.in[2], 8 * lane, 512 + 8 * lane)
            for (int m0 = F.gw; m0 < T; m0 += 4 * F.NGW) { f32x4 v[4][4];
#pragma unroll
                for (int q = 0; q < 4; ++q) { const int m = (m0 + q * F.NGW < T) ? m0 + q * F.NGW : m0;
#pragma unroll
                    for (int j = 0; j < 4; ++j) v[q][j] = __builtin_nontemporal_load((const f32x4*)(args.in[0] + (size_t)m * D + 8 * lane + 4 * (j & 1) + 512 * (j >> 1))); }
#pragma unroll
                for (int q = 0; q < 4; ++q) { const int m = m0 + q * F.NGW; if (m < T) ln_store8r(v[q], lg_, lb_, nullptr, XB + (size_t)m * D, 8 * lane, 512 + 8 * lane, XB8 + (size_t)m * D); } }
            GRID_BAR();
        }
        if (IN(pb + 1)) {
            PHASE_REGS
            SchedDense S; S.o.init(T, DIN, F.G, bx); S.a = (const char*)XB8; S.b = (const char*)(args.ws + W_IN_T); S.apitch = 1024; S.bpitch = 1024;
            EpiInProj E{HH, L_B_IN, *WSC_IN};
            REPS(1) GEMM_PHASE_F8(512, S, E);
            if (l + 1 < DEPTH && F.G == 256 && bx >= 128) PREP_EXPERTS(l + 1, 0, PE_A, (bx - 128) * 8 + F.wave, 128 * 8);
            GRID_BAR();
        }
        if (IN(pb + 2)) {
            PHASE_REGS
            { const int g = F.gw & 3, c8 = 16 * g + (lane & 15); const float psc = WSC_IN[2];
              for (int it = F.gw >> 2; it < T / 64; it += F.NGW >> 2) { const int t0 = (it * 4 + (lane >> 4)) * 16;
                  if (g == 0) pool_run<2>(HH, PD8, psc, c8, t0); else if (g == 1) pool_run<4>(HH, PD8, psc, c8, t0); else if (g == 2) pool_run<8>(HH, PD8, psc, c8, t0); else pool_run<16>(HH, PD8, psc, c8, t0); } }
            for (int U = vcu; U < NB * 16 * 2; U += F.G) attn_unit(F.lds, HH, O8, WSC_IN[3], L_SINKS, U >> 5, (U >> 1) & 15, U & 1, tid);
            GRID_BAR();
        }
        if (IN(pb + 3)) {
            PHASE_REGS
            SchedMerged S; S.o.init(T, D, F.G, bx); S.pd = (const char*)PD8; S.oo = (const char*)O8; S.wpe = (const char*)(args.ws + W_PE_T); S.wba = (const char*)(args.ws + W_BA_T);
            EpiMerged E{(unsigned char*)MG, G8B, WSC_IN[4], WSC_IN[5]};
            REPS(3) GEMM_PHASE_F8(256, S, E);
            GRID_BAR();
        }
        if (IN(pb + 4)) {
            PHASE_REGS
            SchedDense S; S.o.init(T, D, F.G, bx); S.a = (const char*)MG; S.b = (const char*)(args.ws + W_OUT_T); S.apitch = 1024; S.bpitch = 1024;
            EpiResid E{(h16*)X32, XB, WSC_IN[1] * 0.0625f};
            REPS(4) GEMM_PHASE_F8(512, S, E);
            GRID_BAR();
        }
        if (IN(pb + 5)) {
            PHASE_REGS
            LN_GB(L_LN1G, L_LN1B, 8 * lane, 512 + 8 * lane)
            for (int m0 = F.gw; m0 < T; m0 += 4 * F.NGW) { u32x4 ra[4], rb4[4];
#pragma unroll
                for (int q = 0; q < 4; ++q) { const int m = (m0 + q * F.NGW < T) ? m0 + q * F.NGW : m0; const h16* sp = (const h16*)X32 + (size_t)m * D + 8 * lane;
                    ra[q] = __builtin_nontemporal_load((const u32x4*)sp); rb4[q] = __builtin_nontemporal_load((const u32x4*)(sp + 512)); }
#pragma unroll
                for (int q = 0; q < 4; ++q) { const int m = m0 + q * F.NGW; if (m < T) { f32x4 v[4]; unpack8(ra[q], v[0], v[1]); unpack8(rb4[q], v[2], v[3]); ln_store8r(v, lg_, lb_, nullptr, XB + (size_t)m * D, 8 * lane, 512 + 8 * lane, XB8 + (size_t)m * D); } } }
            GRID_BAR();
        }
        if (IN(pb + 6)) {
            PHASE_REGS
            { SchedShared S{F.G, vcu, (const char*)XB8, (const char*)(args.ws + W_SGU_T)}; EpiShared E{HS, WSC_IN + 6}; GEMM_PHASE_F8(512, S, E); }
            { SchedRouter S{F.G, vcu, (const char*)XB, (const char*)(args.ws + W_R_T)}; EpiRouter E{LOGIT}; GEMM_PHASE(512, S, E); }
            GRID_BAR();
        }
        if (IN(pb + 7)) {
            PHASE_REGS
            LAS float* tb = (LAS float*)(F.lds);
            LAS int* lcnt = (LAS int*)(F.lds + 512);
            if (F.wave == 0) { tb[lane] = L_RBIAS[lane]; tb[64 + lane] = WSC_P(l)[4 * lane] * WSC_P(l)[4 * lane + 1] * WSC_P(l)[4 * lane + 2] * 4194304.0f; }
            __syncthreads();
            REPS(7) for (int w = vcu; w < 256; w += F.G) {
                int cntv = 0;
                if (F.wave < 2) {
                    const int t = w * 128 + F.wave * 64 + lane;
                    float key[64];
                    { const float* lp = LOGIT + (size_t)t * NE;
#pragma unroll
                      for (int j = 0; j < 16; ++j) { const f32x4 a = *(const f32x4*)(lp + 4 * j), b = *(const f32x4*)(lp + (size_t)T * NE + 4 * j); key[4 * j] = a.x + b.x; key[4 * j + 1] = a.y + b.y; key[4 * j + 2] = a.z + b.z; key[4 * j + 3] = a.w + b.w; } }
                    float gs[8];
#pragma unroll
                    for (int g = 0; g < 8; ++g) { const f32x4 r0 = *(const LAS f32x4*)(tb + 8 * g), r1 = *(const LAS f32x4*)(tb + 8 * g + 4); float m1 = -INFINITY, m2 = -INFINITY;
#pragma unroll
                        for (int j = 0; j < 8; ++j) { const int e = 8 * g + j; const float bs = sigmoidf_(key[e]) + (j < 4 ? r0[j & 3] : r1[j & 3]); m2 = __builtin_amdgcn_fmed3f(m1, m2, bs); m1 = fmaxf(m1, bs);
                            key[e] = __uint_as_float((__float_as_uint(bs) & ~63u) | (unsigned)(63 - e)); }
                        gs[g] = m1 + m2; }
#pragma unroll
                    for (int g = 0; g < 8; ++g) { int r = 0;
#pragma unroll
                        for (int j = 0; j < 8; ++j) if (j != g) r += (j < g) ? (gs[j] >= gs[g] ? 1 : 0) : (gs[j] > gs[g] ? 1 : 0);
                        const bool keep = r < 4;
#pragma unroll
                        for (int j = 0; j < 8; ++j) key[8 * g + j] = keep ? key[8 * g + j] : -INFINITY; }
                    float tp[8];
#pragma unroll
                    for (int q = 0; q < 8; ++q) tp[q] = -INFINITY;
#pragma unroll
                    for (int e = 0; e < 64; ++e) { float x = key[e];
#pragma unroll
                        for (int q = 0; q < 8; ++q) { const float hi = fmaxf(tp[q], x); x = fminf(tp[q], x); tp[q] = hi; } }
                    unsigned long long M = 0ull; float sc[8]; int es[8]; float ssum = 0.f;
#pragma unroll
                    for (int q = 0; q < 8; ++q) { const unsigned ub = __float_as_uint(tp[q]); es[q] = 63 - (int)(ub & 63u); sc[q] = __uint_as_float(ub & ~63u) - tb[es[q]]; ssum += sc[q]; M |= 1ull << es[q]; }
                    const float inv = 2.5f / ssum;
#pragma unroll
                    for (int q = 0; q < 8; ++q) { const int k = __builtin_popcountll(M & ((1ull << es[q]) - 1ull)); GATE[(size_t)t * 8 + k] = sc[q] * inv * tb[64 + es[q]]; }
                    ((unsigned long long*)ESEL)[t] = M;
#pragma unroll
                    for (int e = 0; e < 64; ++e) { const unsigned long long bb = __ballot(((M >> e) & 1ull) != 0ull); const int pc_ = (int)__builtin_popcountll(bb); asm volatile("v_writelane_b32 %0, %1, %2" : "+v"(cntv) : "s"(pc_), "n"(e)); }
                }
                if (F.wave == 1) lcnt[lane] = cntv;
                __syncthreads();
                if (F.wave == 0) GTOT[w * 64 + lane] = cntv + lcnt[lane];
                __syncthreads();
            }
            GRID_BAR();
        }
        if (IN(pb + 8)) {
            PHASE_REGS
            LAS int* L_tot = (LAS int*)(F.lds); LAS int* L_bef = L_tot + 512; LAS int* L_cc = L_tot + 1024;
            const unsigned long long* MASKS = (const unsigned long long*)ESEL;
            REPS(8) for (int w = vcu; w < 256; w += F.G) {
                const int t0 = w * 128 + F.wave * 16;
                const unsigned long long mm = MASKS[t0 + (lane & 15)]; const int mlo = (int)(unsigned)mm, mhi = (int)(unsigned)(mm >> 32);
                int tp_ = 0, bp_ = 0, cc = 0;
#pragma unroll
                for (int j = 0; j < 32; ++j) { const int w2 = F.wave * 32 + j; const int c = GTOT[w2 * 64 + lane]; tp_ += c; bp_ += (w2 < w) ? c : 0; }
#pragma unroll
                for (int tt = 0; tt < 16; ++tt) { const unsigned long long Mt = ((unsigned long long)(unsigned)__builtin_amdgcn_readlane(mhi, tt) << 32) | (unsigned)__builtin_amdgcn_readlane(mlo, tt); cc += (int)((Mt >> lane) & 1ull); }
                L_tot[F.wave * 64 + lane] = tp_; L_bef[F.wave * 64 + lane] = bp_; L_cc[F.wave * 64 + lane] = cc;
                __syncthreads();
                int tot = 0, before = 0;
#pragma unroll
                for (int v = 0; v < 8; ++v) { tot += L_tot[v * 64 + lane]; before += L_bef[v * 64 + lane] + ((v < F.wave) ? L_cc[v * 64 + lane] : 0); }
                const int pc = (tot + 255) & ~255; int incl = pc;
#pragma unroll
                for (int o = 1; o < 64; o <<= 1) { const int xv = __shfl_up(incl, o); if (lane >= o) incl += xv; }
                const int pstart = incl - pc; int run = pstart + before;
#pragma unroll
                for (int tt = 0; tt < 16; ++tt) { const unsigned hi_ = (unsigned)__builtin_amdgcn_readlane(mhi, tt), lo_ = (unsigned)__builtin_amdgcn_readlane(mlo, tt); const unsigned long long Mt = ((unsigned long long)hi_ << 32) | lo_;
                    const bool sel = ((Mt >> lane) & 1ull) != 0ull; const int k = (int)__builtin_amdgcn_mbcnt_hi(hi_, __builtin_amdgcn_mbcnt_lo(lo_, 0u));
                    if (sel) TOKL[run] = (t0 + tt) * 9 + k;
                    run += sel ? 1 : 0; }
                if (F.wave == 0 && w < 64) {
                    const int ps_ = __shfl(pstart, w), te = __shfl(tot, w), pe = __shfl(pc, w);
                    for (int i2 = te + lane; i2 < pe; i2 += 64) TOKL[ps_ + i2] = YT_DUMP; }
                if (F.wave == 1) {
                    const int nblk = __shfl(incl, 63) >> 8; const int rbk = 8 * w + (lane & 7); int cnt = 0;
                    for (int e = 0; e < 64; ++e) { const int pend = __shfl(incl, e); cnt += (pend <= rbk * 256) ? 1 : 0; }
                    if (lane < 8 && rbk < nblk) BLKE[rbk] = cnt < 63 ? cnt : 63;
                    if (w == 0 && lane == 0) BLKE[NBLK_MAX] = nblk; }
                __syncthreads();
            }
            GRID_BAR();
        }
        if (IN(pb + 9)) {
            PHASE_REGS
            const int nblk = __builtin_amdgcn_readfirstlane(BLKE[NBLK_MAX]);
            { LAS int* bl = (LAS int*)(F.lds + LDS_BLKE); for (int i = tid; i < nblk; i += 512) bl[i] = BLKE[i]; __syncthreads(); }
            SchedMoeGU S{F.G, vcu, nblk, (const char*)(args.ws + W_XB8), (const char*)W_EGU_P(l), (const LAS int*)(F.lds + LDS_BLKE), TOKL};
            EpiMoeGU E{(unsigned char*)HB, WSC_P(l)};
            REPS(9) GEMM_PHASE_F8(512, S, E);
            { const int rounds = (2 * nblk + 255) >> 8, busy = 2 * nblk - 256 * (rounds - 1);
              const int n9 = min(PE_ALL - PE_A, (256 - busy) * 8 * P9_IPW);
              if (l + 1 < DEPTH && F.G == 256 && vcu >= busy) PREP_EXPERTS(l + 1, PE_A, PE_A + n9, (vcu - busy) * 8 + F.wave, (256 - busy) * 8); }
            GRID_BAR();
        }
        if (IN(pb + 10)) {
            PHASE_REGS
            const int nblk = __builtin_amdgcn_readfirstlane(BLKE[NBLK_MAX]);
            { LAS int* bl = (LAS int*)(F.lds + LDS_BLKE); for (int i = tid; i < nblk; i += 512) bl[i] = BLKE[i]; __syncthreads(); }
            { SchedShDown S{F.G, vcu, (const char*)HS, (const char*)(args.ws + W_SD_T)};
              EpiMoeDown<false> E{(unsigned char*)(args.ws + WS_R), (h16*)(args.ws + R_YS)};
              GEMM_PHASE(256, S, E); }
            __syncthreads();
            { SchedMoeDownR S{F.G, vcu, nblk, (const char*)HB, (const char*)W_ED_P(l), (const LAS int*)(F.lds + LDS_BLKE), TOKL};
              EpiMoeDown<true> E{(unsigned char*)(args.ws + WS_R), (h16*)(args.ws + R_YS)};
              REPS(10) GEMM_PHASE_F8(128, S, E); }
            { const int r9 = (2 * nblk + 255) >> 8, b9 = 2 * nblk - 256 * (r9 - 1), n9 = min(PE_ALL - PE_A, (256 - b9) * 8 * P9_IPW);
              const int r10 = (4 * nblk + 255) >> 8, b10 = 4 * nblk - 256 * (r10 - 1), n10 = min(PE_ALL - PE_A - n9, (256 - b10) * 8 * P10_IPW);
              if (l + 1 < DEPTH && F.G == 256 && vcu >= b10 && n10 > 0) PREP_EXPERTS(l + 1, PE_A + n9, PE_A + n9 + n10, (vcu - b10) * 8 + F.wave, (256 - b10) * 8); }
            GRID_BAR();
        }
        if (IN(pb + 11)) {
            PHASE_REGS
            { float* xo = (l == DEPTH - 1) ? X32 : nullptr;
            const unsigned char* YQ = (const unsigned char*)(args.ws + WS_R); const h16* YS = (const h16*)(args.ws + R_YS);
            const int c0 = 256 * (lane >> 4) + 32 * ((lane >> 2) & 3) + 8 * (lane & 3), c1 = c0 + 128;
            LAS float* lg2 = (LAS float*)(F.lds + LDS_BLKE); LAS float* lb2 = lg2 + D;
            for (int i = tid; i < D; i += 512) { lg2[i] = L_LN2G[i]; lb2[i] = L_LN2B[i]; }
            __syncthreads();
            for (int m0_ = F.gw; m0_ < T; m0_ += 2 * F.NGW) { int m0 = m0_; asm volatile("" : "+s"(m0));
                u32x4 yq[2][9], xa[2], xb2[2]; unsigned short ys[2]; float gt[2];
#pragma unroll
                for (int q = 0; q < 2; ++q) { const int m = (m0 + q * F.NGW < T) ? m0 + q * F.NGW : m0;
                    xa[q] = *(const u32x4*)(XB + (size_t)m * D + c0); xb2[q] = *(const u32x4*)(XB + (size_t)m * D + c1); gt[q] = GATE[(size_t)m * 8 + (lane & 7)];
#pragma unroll
                    for (int k = 0; k < 9; ++k) yq[q][k] = __builtin_nontemporal_load((const u32x4*)(YQ + ((size_t)m * 9 + k) * 1024 + lane * 16));
                    ys[q] = __builtin_nontemporal_load((const unsigned short*)(YS + ((size_t)m * 9 + 8) * 64 + lane)); }
#pragma unroll
                for (int q = 0; q < 2; ++q) { const int m = m0 + q * F.NGW; if (m < T) {
                    f32x4 v[4]; unpack8(xa[q], v[0], v[1]); unpack8(xb2[q], v[2], v[3]);
#pragma unroll
                    for (int j = 0; j < 4; ++j) v[j] = v[j] * ALPHA;
#pragma unroll
                    for (int k = 0; k < 8; ++k) { const float gk = rdlane(gt[q], k);
#pragma unroll
                        for (int j = 0; j < 4; ++j) { const f32x2 lo = __builtin_amdgcn_cvt_pk_f32_fp8((int)yq[q][k][j], false), hi = __builtin_amdgcn_cvt_pk_f32_fp8((int)yq[q][k][j], true);
                            v[j][0] += lo.x * gk; v[j][1] += lo.y * gk; v[j][2] += hi.x * gk; v[j][3] += hi.y * gk; }
                        __builtin_amdgcn_sched_barrier(0); }
                    { const float sc = h2f(ys[q]); const float bias = -128.0f * sc;
#pragma unroll
                        for (int j = 0; j < 4; ++j) { const unsigned wd = yq[q][8][j] ^ 0x80808080u;
                            v[j][0] += (float)(wd & 0xffu) * sc + bias; v[j][1] += (float)((wd >> 8) & 0xffu) * sc + bias; v[j][2] += (float)((wd >> 16) & 0xffu) * sc + bias; v[j][3] += (float)(wd >> 24) * sc + bias; } }
                    ln_store8l(v, lg2, lb2, xo ? xo + (size_t)m * D : nullptr, XB + (size_t)m * D, c0, c1, XB8 + (size_t)m * D); } } } }
            if (l + 1 < DEPTH) { const int nblk_ = __builtin_amdgcn_readfirstlane(BLKE[NBLK_MAX]); const int rounds_ = (2 * nblk_ + 255) >> 8, busy_ = 2 * nblk_ - 256 * (rounds_ - 1);
                const int n9_ = min(PE_ALL - PE_A, (256 - busy_) * 8 * P9_IPW); const int r10_ = (4 * nblk_ + 255) >> 8, b10_ = 4 * nblk_ - 256 * (r10_ - 1);
                const int e_lo = (F.G != 256) ? 0 : PE_A + n9_ + min(PE_ALL - PE_A - n9_, (256 - b10_) * 8 * P10_IPW);
                ++l; PREP_WEIGHTS(e_lo); --l; }
            if (pb + 11 != DEPTH * NPH - 1) GRID_BAR();
        }
    }
#undef IN
}

extern "C" void kernel_launch(void* const* d_in, const int* in_sizes, int n_in, void* d_out, int out_size, void* d_ws, size_t ws_size, hipStream_t stream) {
    static int grid = 0;
    if (grid == 0) {
        if (n_in != 23 || out_size != T * D || ws_size < WS_END2) { fprintf(stderr, "kernel_launch: unexpected shapes (n_in %d out %d ws %zu)\n", n_in, out_size, ws_size); grid = -1; return; }
        int dev = 0, cus = 0;
        if (hipGetDevice(&dev) != hipSuccess || hipDeviceGetAttribute(&cus, hipDeviceAttributeMultiprocessorCount, dev) != hipSuccess) { grid = -1; return; }
        if (hipFuncSetAttribute((const void*)fwd_kernel, hipFuncAttributeMaxDynamicSharedMemorySize, LDS_BYTES) != hipSuccess) { fprintf(stderr, "kernel_launch: hipFuncSetAttribute failed\n"); grid = -1; return; }
        int per_cu = 0;
        if (hipOccupancyMaxActiveBlocksPerMultiprocessor(&per_cu, (const void*)fwd_kernel, 512, LDS_BYTES) != hipSuccess || per_cu < 1) { fprintf(stderr, "kernel_launch: occupancy query says %d\n", per_cu); }
        (void)hipGetLastError();
        grid = cus;
    }
    if (grid < 0) return;
    (void)hipMemsetAsync((char*)d_ws + WS_CTL, 0, CTL_ZERO_BYTES, stream);
    Args a{};
    for (int i = 0; i < 23; ++i) a.in[i] = (const float*)d_in[i];
    a.out = (float*)d_out; a.ws = (unsigned char*)d_ws;
#if MK_ONE_LAUNCH
    a.ph_lo = 0; a.ph_hi = DEPTH * NPH;
    hipLaunchKernelGGL(fwd_kernel, dim3(grid), dim3(512), LDS_BYTES, stream, a);
#else
    for (int p = 0; p < DEPTH * NPH; ++p) { a.ph_lo = p; a.ph_hi = p + 1; hipLaunchKernelGGL(fwd_kernel, dim3(grid), dim3(512), LDS_BYTES, stream, a); }
#endif
}
```
